# Optimizing an MI355X kernel written in HIP

```python
import math
import jax, jax.numpy as jnp
from jax import lax
import numpy as np

D_MODEL = 1024
BATCH = 4
SEQ = 4096
DEPTH = 4

N_MIXERS = 2
N_NSA_LAYERS = (DEPTH + 1) // 2
N_DIFF_LAYERS = DEPTH // 2
HEAD_DIM = 64
ROPE_DIM = HEAD_DIM // 4
ROPE_THETA = 500000.0
NSA_HEADS = D_MODEL // HEAD_DIM
NSA_GROUPS = 4
NSA_HPG = NSA_HEADS // NSA_GROUPS
CMP_BLOCK = 32
CMP_STRIDE = 16
CMP_HIDDEN = 2 * HEAD_DIM
SEL_BLOCK = 64
SEL_TOPK = 16
WINDOW = 512
NSA_Q_CHUNK = 64
NSA_Q_W = NSA_HEADS * HEAD_DIM
NSA_KV_W = NSA_GROUPS * HEAD_DIM
NSA_IN = NSA_Q_W + 6 * NSA_KV_W + 3 * NSA_HEADS
DIFF_HEADS = D_MODEL // (2 * HEAD_DIM)
DIFF_V_DIM = 2 * HEAD_DIM
DIFF_W = DIFF_HEADS * 2 * HEAD_DIM
DIFF_IN = 3 * DIFF_W
ATT_BLOCK = 128
D_FF = 4 * D_MODEL
EPS = 1e-6
NEG_INF = -1e30
SEL_FORCE = 1e6

kernel_name = "hybrid_nsa_diffattn_adaln_trunk"


def rms_norm(x, g):
    xf = x.astype(jnp.float32)
    y = xf * lax.rsqrt(jnp.mean(xf * xf, axis=-1, keepdims=True) + EPS)
    return (y * g.astype(jnp.float32)).astype(x.dtype)


def rope_tables(positions):
    inv = ROPE_THETA ** (-jnp.arange(0, ROPE_DIM, 2, dtype=jnp.float32) / ROPE_DIM)
    ang = positions.astype(jnp.float32)[..., None] * inv
    return jnp.cos(ang), jnp.sin(ang)


def apply_partial_rope(x, cos, sin):
    half = ROPE_DIM // 2
    shape = cos.shape[:2] + (1,) * (x.ndim - 3) + cos.shape[-1:]
    c = cos.reshape(shape)
    s = sin.reshape(shape)
    x1 = x[..., :half].astype(jnp.float32)
    x2 = x[..., half:ROPE_DIM].astype(jnp.float32)
    rot = jnp.concatenate([x1 * c - x2 * s, x2 * c + x1 * s], axis=-1).astype(x.dtype)
    return jnp.concatenate([rot, x[..., ROPE_DIM:]], axis=-1)


def masked_softmax(s, mask):
    return jax.nn.softmax(jnp.where(mask, s, NEG_INF), axis=-1) * mask


def compress_blocks(blk, pe, w1, w2):
    B, NC = blk.shape[:2]
    z = (blk + pe[:, None, :]).transpose(0, 1, 3, 2, 4).reshape(B, NC, NSA_GROUPS, CMP_BLOCK * HEAD_DIM)
    return jax.nn.silu(z @ w1) @ w2


def nsa_mixer(h, cos, sin, w_in, b_gate, q_gain, k_gain, pe_k, w_ck1, w_ck2, pe_v, w_cv1, w_cv2, w_out):
    B, S, _ = h.shape
    G, HPG, dh = NSA_GROUPS, NSA_HPG, HEAD_DIM
    scale = 1.0 / math.sqrt(dh)
    sizes = [NSA_Q_W] + [NSA_KV_W] * 6 + [3 * NSA_HEADS]
    q, kc, vc, ks, vs, kw, vw, gl = jnp.split(h @ w_in, list(np.cumsum(sizes)[:-1]), axis=-1)
    q = rms_norm(q.reshape(B, S, NSA_HEADS, dh), q_gain)
    q_rot = apply_partial_rope(q, cos, sin)
    q_cmp = q.reshape(B, S, G, HPG, dh).transpose(0, 2, 3, 1, 4)
    q_rot = q_rot.reshape(B, S, G, HPG, dh).transpose(0, 2, 3, 1, 4)
    gates = jax.nn.sigmoid(gl.astype(jnp.float32) + b_gate.astype(jnp.float32)).reshape(B, S, NSA_HEADS, 3)

    n_cmp = (S - CMP_BLOCK) // CMP_STRIDE + 1
    idx = jnp.arange(n_cmp)[:, None] * CMP_STRIDE + jnp.arange(CMP_BLOCK)[None, :]
    kc = kc.reshape(B, S, G, dh)
    vc = vc.reshape(B, S, G, dh)
    k_cmp = rms_norm(compress_blocks(kc[:, idx], pe_k, w_ck1, w_ck2), k_gain[0]).transpose(0, 2, 1, 3)
    v_cmp = compress_blocks(vc[:, idx], pe_v, w_cv1, w_cv2).transpose(0, 2, 1, 3)
    cmp_start = jnp.arange(n_cmp) * CMP_STRIDE
    cmp_end = cmp_start + CMP_BLOCK - 1
    n_sel = S // SEL_BLOCK
    top_n = min(SEL_TOPK, n_sel)
    sel_start = jnp.arange(n_sel) * SEL_BLOCK
    overlap = ((cmp_start[:, None] <= sel_start[None, :] + SEL_BLOCK - 1)
               & (cmp_end[:, None] >= sel_start[None, :])).astype(jnp.float32)

    ks = apply_partial_rope(rms_norm(ks.reshape(B, S, G, dh), k_gain[1]), cos, sin)
    ks_blk = ks.transpose(0, 2, 1, 3).reshape(B, G, n_sel, SEL_BLOCK, dh)
    vs_blk = vs.reshape(B, S, G, dh).transpose(0, 2, 1, 3).reshape(B, G, n_sel, SEL_BLOCK, dh)
    kw = apply_partial_rope(rms_norm(kw.reshape(B, S, G, dh), k_gain[2]), cos, sin)
    pad = ((0, 0), (0, 0), (WINDOW, 0), (0, 0))
    kw_pad = jnp.pad(kw.transpose(0, 2, 1, 3), pad)
    vw_pad = jnp.pad(vw.reshape(B, S, G, dh).transpose(0, 2, 1, 3), pad)
    b_idx = jnp.arange(B)[:, None, None, None]
    g_idx = jnp.arange(G)[None, :, None, None]
    blk_ids = jnp.arange(n_sel)
    QC = NSA_Q_CHUNK

    def chunk(ci):
        s0 = ci * QC
        t = s0 + jnp.arange(QC)
        qc_ = lax.dynamic_slice_in_dim(q_cmp, s0, QC, axis=3)
        qr_ = lax.dynamic_slice_in_dim(q_rot, s0, QC, axis=3)
        sc = jnp.einsum('bghqd,bgcd->bghqc', qc_, k_cmp).astype(jnp.float32) * scale
        pc = masked_softmax(sc, cmp_end[None, :] <= t[:, None])
        o_cmp = jnp.einsum('bghqc,bgcd->bghqd', pc.astype(v_cmp.dtype), v_cmp)
        imp = jnp.einsum('bghqc,cs->bgqs', pc, overlap)
        bt = (t // SEL_BLOCK)[:, None]
        valid = blk_ids[None, :] <= bt
        forced = (blk_ids[None, :] == 0) | (blk_ids[None, :] == bt) | (blk_ids[None, :] == bt - 1)
        imp = jnp.where(forced, SEL_FORCE, jnp.where(valid, imp, -1.0))
        _, sel = lax.top_k(imp, top_n)
        kg = ks_blk[b_idx, g_idx, sel]
        vg = vs_blk[b_idx, g_idx, sel]
        ss = jnp.einsum('bghqd,bgqnld->bghqnl', qr_, kg).astype(jnp.float32) * scale
        tok = sel[..., None] * SEL_BLOCK + jnp.arange(SEL_BLOCK)
        ms = (tok <= t[:, None, None])[:, :, None]
        shp = ss.shape
        ps = masked_softmax(ss.reshape(shp[:4] + (top_n * SEL_BLOCK,)),
                            ms.reshape(ms.shape[:4] + (top_n * SEL_BLOCK,))).reshape(shp)
        o_sel = jnp.einsum('bghqnl,bgqnld->bghqd', ps.astype(vg.dtype), vg)
        kw_ = lax.dynamic_slice_in_dim(kw_pad, s0, WINDOW + QC, axis=2)
        vw_ = lax.dynamic_slice_in_dim(vw_pad, s0, WINDOW + QC, axis=2)
        kpos = s0 - WINDOW + jnp.arange(WINDOW + QC)
        mw = (kpos[None, :] <= t[:, None]) & (kpos[None, :] > t[:, None] - WINDOW) & (kpos[None, :] >= 0)
        sw = jnp.einsum('bghqd,bgkd->bghqk', qr_, kw_).astype(jnp.float32) * scale
        o_win = jnp.einsum('bghqk,bgkd->bghqd', masked_softmax(sw, mw).astype(vw_.dtype), vw_)
        g = lax.dynamic_slice_in_dim(gates, s0, QC, axis=1)
        g = g.reshape(B, QC, G, HPG, 3).transpose(0, 2, 3, 1, 4).astype(o_win.dtype)
        o = g[..., 0:1] * o_cmp + g[..., 1:2] * o_sel + g[..., 2:3] * o_win
        return o.transpose(0, 3, 1, 2, 4).reshape(B, QC, NSA_Q_W)

    outs = lax.map(chunk, jnp.arange(S // QC))
    return outs.transpose(1, 0, 2, 3).reshape(B, S, NSA_Q_W) @ w_out


def diff_mixer(h, cos, sin, layer_depth, w_in, q_gain, k_gain, lq1, lk1, lq2, lk2, subln_g, w_out):
    B, S, _ = h.shape
    dh = HEAD_DIM
    scale = 1.0 / math.sqrt(dh)
    q, k, v = jnp.split(h @ w_in, [DIFF_W, 2 * DIFF_W], axis=-1)
    q = apply_partial_rope(rms_norm(q.reshape(B, S, DIFF_HEADS, 2, dh), q_gain), cos, sin)
    k = apply_partial_rope(rms_norm(k.reshape(B, S, DIFF_HEADS, 2, dh), k_gain), cos, sin)
    q = q.transpose(0, 2, 3, 1, 4)
    k = k.transpose(0, 2, 3, 1, 4)
    v = v.reshape(B, S, DIFF_HEADS, DIFF_V_DIM).transpose(0, 2, 1, 3)
    lam_init = 0.8 - 0.6 * math.exp(-0.3 * (layer_depth - 1))
    lam = (jnp.exp(jnp.sum(lq1.astype(jnp.float32) * lk1.astype(jnp.float32)))
           - jnp.exp(jnp.sum(lq2.astype(jnp.float32) * lk2.astype(jnp.float32))) + lam_init)
    kpos = jnp.arange(S)

    def block(bi):
        s0 = bi * ATT_BLOCK
        qb = lax.dynamic_slice_in_dim(q, s0, ATT_BLOCK, axis=3)
        s = jnp.einsum('bhcqd,bhckd->bhcqk', qb, k).astype(jnp.float32) * scale
        t = s0 + jnp.arange(ATT_BLOCK)
        p = masked_softmax(s, kpos[None, :] <= t[:, None])
        a = p[:, :, 0] - lam * p[:, :, 1]
        o = jnp.einsum('bhqk,bhkd->bhqd', a.astype(v.dtype), v)
        o = rms_norm(o, subln_g) * (1.0 - lam_init)
        return o.transpose(0, 2, 1, 3).reshape(B, ATT_BLOCK, DIFF_W)

    outs = lax.map(block, jnp.arange(S // ATT_BLOCK))
    return outs.transpose(1, 0, 2, 3).reshape(B, S, DIFF_W) @ w_out


def setup_inputs(seed: int = 0) -> dict:
    key = jax.random.key(seed)
    ks = iter(jax.random.split(key, 32))
    D = D_MODEL

    def nrm(shape, scale):
        return jax.random.normal(next(ks), shape, jnp.float32) * scale

    def gain(shape):
        return 1.0 + nrm(shape, 0.02)

    x = nrm((BATCH, SEQ, D), 1.0)
    c = nrm((BATCH, D), 1.0)
    offsets = jax.random.randint(next(ks), (BATCH, 1), 0, 1024, dtype=jnp.int32)
    positions = (offsets + jnp.arange(SEQ, dtype=jnp.int32)[None, :]).astype(jnp.int32)
    NL, NDF = N_NSA_LAYERS, N_DIFF_LAYERS
    return {
        'x': x, 'c': c, 'positions': positions,
        'ln_mix_g': gain((DEPTH, D)), 'ln_mlp_g': gain((DEPTH, D)),
        'w_ada': nrm((DEPTH, D, 6 * D), D ** -0.5), 'b_ada': nrm((DEPTH, 6 * D), 0.01),
        'w_mlp_in': nrm((DEPTH, D, D_FF), D ** -0.5), 'w_mlp_out': nrm((DEPTH, D_FF, D), D_FF ** -0.5),
        'nsa_w_in': nrm((NL, D, NSA_IN), D ** -0.5), 'nsa_b_gate': nrm((NL, 3 * NSA_HEADS), 0.01),
        'nsa_q_gain': gain((NL, HEAD_DIM)), 'nsa_k_gain': gain((NL, 3, HEAD_DIM)),
        'nsa_pe_k': nrm((NL, CMP_BLOCK, HEAD_DIM), 0.1),
        'nsa_w_ck1': nrm((NL, CMP_BLOCK * HEAD_DIM, CMP_HIDDEN), (CMP_BLOCK * HEAD_DIM) ** -0.5),
        'nsa_w_ck2': nrm((NL, CMP_HIDDEN, HEAD_DIM), CMP_HIDDEN ** -0.5),
        'nsa_pe_v': nrm((NL, CMP_BLOCK, HEAD_DIM), 0.1),
        'nsa_w_cv1': nrm((NL, CMP_BLOCK * HEAD_DIM, CMP_HIDDEN), (CMP_BLOCK * HEAD_DIM) ** -0.5),
        'nsa_w_cv2': nrm((NL, CMP_HIDDEN, HEAD_DIM), CMP_HIDDEN ** -0.5),
        'nsa_w_out': nrm((NL, NSA_Q_W, D), NSA_Q_W ** -0.5),
        'diff_w_in': nrm((NDF, D, DIFF_IN), D ** -0.5),
        'diff_q_gain': gain((NDF, HEAD_DIM)), 'diff_k_gain': gain((NDF, HEAD_DIM)),
        'diff_lq1': nrm((NDF, HEAD_DIM), 0.1), 'diff_lk1': nrm((NDF, HEAD_DIM), 0.1),
        'diff_lq2': nrm((NDF, HEAD_DIM), 0.1), 'diff_lk2': nrm((NDF, HEAD_DIM), 0.1),
        'diff_subln_g': gain((NDF, DIFF_V_DIM)),
        'diff_w_out': nrm((NDF, DIFF_W, D), DIFF_W ** -0.5),
    }


def reference(x, c, positions, ln_mix_g, ln_mlp_g, w_ada, b_ada, w_mlp_in, w_mlp_out,
              nsa_w_in, nsa_b_gate, nsa_q_gain, nsa_k_gain, nsa_pe_k, nsa_w_ck1, nsa_w_ck2,
              nsa_pe_v, nsa_w_cv1, nsa_w_cv2, nsa_w_out,
              diff_w_in, diff_q_gain, diff_k_gain, diff_lq1, diff_lk1, diff_lq2, diff_lk2,
              diff_subln_g, diff_w_out):
    cos, sin = rope_tables(positions)
    cond = jax.nn.silu(c)
    for i in range(DEPTH):
        mod = cond @ w_ada[i] + b_ada[i]
        sh1, sc1, g1, sh2, sc2, g2 = jnp.split(mod, 6, axis=-1)
        h = rms_norm(x, ln_mix_g[i]) * (1.0 + sc1[:, None, :]) + sh1[:, None, :]
        j = i // N_MIXERS
        if i % N_MIXERS == 0:
            y = nsa_mixer(h, cos, sin, nsa_w_in[j], nsa_b_gate[j], nsa_q_gain[j], nsa_k_gain[j],
                          nsa_pe_k[j], nsa_w_ck1[j], nsa_w_ck2[j], nsa_pe_v[j], nsa_w_cv1[j],
                          nsa_w_cv2[j], nsa_w_out[j])
        else:
            y = diff_mixer(h, cos, sin, i + 1, diff_w_in[j], diff_q_gain[j], diff_k_gain[j],
                           diff_lq1[j], diff_lk1[j], diff_lq2[j], diff_lk2[j], diff_subln_g[j],
                           diff_w_out[j])
        x = x + g1[:, None, :] * y
        h = rms_norm(x, ln_mlp_g[i]) * (1.0 + sc2[:, None, :]) + sh2[:, None, :]
        x = x + g2[:, None, :] * (jnp.square(jax.nn.relu(h @ w_mlp_in[i])) @ w_mlp_out[i])
    return x
```

```cpp
#include <hip/hip_runtime.h>
#include <hip/hip_cooperative_groups.h>
#include <cstdio>
#include <cstdint>
#include <cstring>
#include <utility>
namespace cg = cooperative_groups;

typedef unsigned short bf16_t;
typedef unsigned long long u64;

constexpr int D = 1024, NB = 4, S = 4096, T = NB * S, DFF = 4096;
constexpr int NSA_IN = 2608, NSA_P = 2816, DIFF_IN = 3072;
constexpr float EPS = 1e-6f;
constexpr float C2 = 0.125f * 1.4426950408889634f;
constexpr int NTHR = 512;
constexpr int LDS_BYTES = 147456;

constexpr size_t MiB = 1u << 20;
constexpr size_t WS_MOD = 1 * MiB;
constexpr size_t WS_ROPE = 2 * MiB;
constexpr size_t WS_SMALL = 3 * MiB;
constexpr size_t WS_H = 104 * MiB;
constexpr size_t WS_PROJ = 136 * MiB;
constexpr size_t WS_ATT = 232 * MiB;
constexpr size_t WS_OC = 328 * MiB;
constexpr size_t WS_KCMP = 360 * MiB;
constexpr size_t WS_VCMP = 361 * MiB;
constexpr size_t WS_SEL = 362 * MiB;
constexpr size_t WS_HID = 136 * MiB;
constexpr size_t WS_END = 364 * MiB;

struct Params {
  const float* x; const float* c; const int* pos; const float* ln_mix_g; const float* ln_mlp_g;
  const float* w_ada; const float* b_ada; const float* w_mlp_in; const float* w_mlp_out;
  const float* nsa_w_in; const float* nsa_b_gate; const float* nsa_q_gain; const float* nsa_k_gain;
  const float* nsa_pe_k; const float* nsa_w_ck1; const float* nsa_w_ck2; const float* nsa_pe_v; const float* nsa_w_cv1; const float* nsa_w_cv2; const float* nsa_w_out;
  const float* diff_w_in; const float* diff_q_gain; const float* diff_k_gain; const float* diff_lq1; const float* diff_lk1; const float* diff_lq2; const float* diff_lk2; const float* diff_subln_g; const float* diff_w_out;
  float* out; unsigned char* ws; int ph_lo, ph_hi;
};

typedef __attribute__((address_space(4))) const unsigned char* kptr_t;
template <class Tp> __device__ __forceinline__ Tp karg_load(unsigned off) {
  asm volatile("" : "+s"(off));
  kptr_t kp = (kptr_t)__builtin_amdgcn_kernarg_segment_ptr();
  return *(const __attribute__((address_space(4))) Tp*)(kp + off);
}
__device__ __forceinline__ int tid_() { int t = (int)threadIdx.x; asm volatile("" : "+v"(t)); return t; }
__device__ __forceinline__ int bid_() { int t = (int)blockIdx.x; asm volatile("" : "+s"(t)); return t; }
__device__ __forceinline__ int gdim_() { int t = (int)gridDim.x; asm volatile("" : "+s"(t)); return t; }
#define P(m) karg_load<decltype(Params::m)>((unsigned)offsetof(Params, m))
__device__ __forceinline__ float bf2f(unsigned v) { return __uint_as_float(v << 16); }
__device__ __forceinline__ unsigned f2bf(float f) { unsigned u = __float_as_uint(f); return (u + 0x7fffu + ((u >> 16) & 1u)) >> 16; }
__device__ __forceinline__ unsigned pk2(float lo, float hi) { return f2bf(lo) | (f2bf(hi) << 16); }
__device__ __forceinline__ void unpack8(const uint4 v, float* f) {
  f[0] = bf2f(v.x & 0xffffu); f[1] = bf2f(v.x >> 16); f[2] = bf2f(v.y & 0xffffu); f[3] = bf2f(v.y >> 16);
  f[4] = bf2f(v.z & 0xffffu); f[5] = bf2f(v.z >> 16); f[6] = bf2f(v.w & 0xffffu); f[7] = bf2f(v.w >> 16);
}
__device__ __forceinline__ uint4 pack8(const float* f) { uint4 v; v.x = pk2(f[0], f[1]); v.y = pk2(f[2], f[3]); v.z = pk2(f[4], f[5]); v.w = pk2(f[6], f[7]); return v; }
__device__ __forceinline__ float wave_sum(float v) {
#pragma unroll
  for (int o = 1; o < 64; o <<= 1) v += __shfl_xor(v, o);
  return v;
}
__device__ __forceinline__ float lam_init_of(int j) { return j == 0 ? 0.35550906759096934f : 0.5560582041556406f; }

__device__ __forceinline__ void ph_prologue(unsigned char* lds) {
  const int tid = tid_();
  float* silu = (float*)lds;
  float* red = silu + 4096;
  float* MOD = (float*)(P(ws) + WS_MOD);
  for (int i = tid; i < 4096; i += NTHR) { const float v = P(c)[i]; silu[i] = v / (1.f + expf(-v)); }
  __syncthreads();
  for (int item = bid_(); item < 4 * 48; item += gdim_()) {
    const int l = item / 48, nc = item % 48, cc = tid & 127, ks = tid >> 7;
    const float* w = P(w_ada) + ((size_t)l * 1024 + ks * 256) * 6144 + nc * 128 + cc;
    float a0 = 0.f, a1 = 0.f, a2 = 0.f, a3 = 0.f;
#pragma unroll 8
    for (int k = 0; k < 256; ++k) { const float wv = w[(size_t)k * 6144]; const int kk = ks * 256 + k;
      a0 += silu[kk] * wv; a1 += silu[1024 + kk] * wv; a2 += silu[2048 + kk] * wv; a3 += silu[3072 + kk] * wv; }
    red[(ks * 4 + 0) * 128 + cc] = a0; red[(ks * 4 + 1) * 128 + cc] = a1; red[(ks * 4 + 2) * 128 + cc] = a2; red[(ks * 4 + 3) * 128 + cc] = a3;
    __syncthreads();
    { const int b = tid >> 7;
      const float s = red[(0 * 4 + b) * 128 + cc] + red[(1 * 4 + b) * 128 + cc] + red[(2 * 4 + b) * 128 + cc] + red[(3 * 4 + b) * 128 + cc];
      MOD[(size_t)(l * 4 + b) * 6144 + nc * 128 + cc] = s + P(b_ada)[l * 6144 + nc * 128 + cc]; }
    __syncthreads();
  }
  float* rope = (float*)(P(ws) + WS_ROPE);
  for (int m = bid_() * NTHR + tid; m < T; m += gdim_() * NTHR) {
    const float fp = (float)P(pos)[m];
    const float INV[8] = {1.0f, 0.1939227432012558f, 0.03760603070259094f, 0.007292664609849453f, 0.0014142135623842478f, 0.00027424818836152554f, 5.3182957344688475e-05f, 1.0313385246263351e-05f};
#pragma unroll
    for (int i = 0; i < 8; ++i) {
      const float ang = fp * INV[i];
      const double a = (double)ang; const double kq = rint(a * 0.63661977236758134308); const double r = a - kq * 1.57079632679489661923;
      const int q = (int)((long long)kq & 3ll);
      const double r2 = r * r;
      const double sr = r * (1.0 + r2 * (-1.0 / 6 + r2 * (1.0 / 120 + r2 * (-1.0 / 5040 + r2 * (1.0 / 362880 + r2 * (-1.0 / 39916800 + r2 * (1.0 / 6227020800.0)))))));
      const double cr = 1.0 + r2 * (-0.5 + r2 * (1.0 / 24 + r2 * (-1.0 / 720 + r2 * (1.0 / 40320 + r2 * (-1.0 / 3628800 + r2 * (1.0 / 479001600.0))))));
      const double sn = (q == 0) ? sr : (q == 1) ? cr : (q == 2) ? -sr : -cr;
      const double cs = (q == 0) ? cr : (q == 1) ? -sr : (q == 2) ? -cr : sr;
      rope[(size_t)m * 16 + i] = (float)cs; rope[(size_t)m * 16 + 8 + i] = (float)sn;
    }
  }
  if (bid_() == 0 && tid < 2) {
    const int j = tid; float s1 = 0.f, s2 = 0.f;
    for (int i = 0; i < 64; ++i) { s1 += P(diff_lq1)[j * 64 + i] * P(diff_lk1)[j * 64 + i]; s2 += P(diff_lq2)[j * 64 + i] * P(diff_lk2)[j * 64 + i]; }
    ((float*)(P(ws) + WS_SMALL))[j] = expf(s1) - expf(s2) + lam_init_of(j);
  }
}

__device__ __forceinline__ void ph_norm(const float* xin, const float* gvec, const float* mod  , int sh_off, int sc_off, bf16_t* H) {
  const int tid = tid_(), lane = tid & 63, wave = tid >> 6;
  for (int m = bid_() * 8 + wave; m < T; m += gdim_() * 8) {
    const int b = m >> 12;
    const float4* xr = (const float4*)(xin + (size_t)m * D) + lane;
    float4 v[4]; float ss = 0.f;
#pragma unroll
    for (int j = 0; j < 4; ++j) { v[j] = xr[64 * j]; ss += (v[j].x * v[j].x + v[j].y * v[j].y) + (v[j].z * v[j].z + v[j].w * v[j].w); }
    ss = wave_sum(ss);
    const float rstd = 1.0f / sqrtf(ss * (1.0f / D) + EPS);
#pragma unroll
    for (int j = 0; j < 4; ++j) {
      const int col = 4 * lane + 256 * j;
      const float4 g = *(const float4*)(gvec + col), sc = *(const float4*)(mod + (size_t)b * 6144 + sc_off + col), sh = *(const float4*)(mod + (size_t)b * 6144 + sh_off + col);
      const float h0 = v[j].x * rstd * g.x * (1.f + sc.x) + sh.x, h1 = v[j].y * rstd * g.y * (1.f + sc.y) + sh.y;
      const float h2 = v[j].z * rstd * g.z * (1.f + sc.z) + sh.z, h3 = v[j].w * rstd * g.w * (1.f + sc.w) + sh.w;
      uint2 o; o.x = pk2(h0, h1); o.y = pk2(h2, h3);
      *(uint2*)(H + (size_t)m * D + col) = o;
    }
  }
}

struct EpiStore { bf16_t* O; int ld; int relu2;
  __device__ __forceinline__ void operator()(int row, int col, const float* v) const {
    float a = v[0], b = v[1], c = v[2], d = v[3];
    if (relu2) { a = fmaxf(a, 0.f); a *= a; b = fmaxf(b, 0.f); b *= b; c = fmaxf(c, 0.f); c *= c; d = fmaxf(d, 0.f); d *= d; }
    uint2 o; o.x = pk2(a, b); o.y = pk2(c, d); *(uint2*)(O + (size_t)row * ld + col) = o; } };
struct EpiResid { const float* xin; float* xout; const float* gate;
  __device__ __forceinline__ void operator()(int row, int col, const float* v) const {
    const int b = row >> 12; const float4 g = *(const float4*)(gate + (size_t)b * 6144 + col); const float4 xi = *(const float4*)(xin + (size_t)row * D + col);
    float4 o; o.x = xi.x + g.x * v[0]; o.y = xi.y + g.y * v[1]; o.z = xi.z + g.z * v[2]; o.w = xi.w + g.w * v[3];
    *(float4*)(xout + (size_t)row * D + col) = o; } };

template <class Epi>
__device__ __forceinline__ void gemm_naive(const bf16_t* A, int lda, const float* W, int N, int K, unsigned char* lds, const Epi& E) {
  asm volatile("" : "+s"(N), "+s"(K), "+s"(lda));
  float* As = (float*)lds;
  float* Bs = As + 16 * 132;
  const int tid = tid_(), tx = tid & 31, ty = tid >> 5;
  const int nN = (N + 127) / 128, nM = T / 128;
  const int ar = tid >> 2, ak = (tid & 3) * 4, bk = tid >> 5, bc = (tid & 31) * 4;
  for (int u = bid_(); u < nM * nN; u += gdim_()) {
    const int pm = u / nN, pn = u % nN;
    float acc[8][4];
#pragma unroll
    for (int i = 0; i < 8; ++i) { acc[i][0] = 0.f; acc[i][1] = 0.f; acc[i][2] = 0.f; acc[i][3] = 0.f; }
    const bf16_t* Ap = A + (size_t)(pm * 128 + ar) * lda + ak;
    const int wcol = pn * 128 + bc; const bool bok = wcol < N;
    const float* Wp = W + (size_t)bk * N + (bok ? wcol : 0);
    for (int k0 = 0; k0 < K; k0 += 16) {
      const uint2 av = *(const uint2*)(Ap + k0);
      float4 bv = *(const float4*)(Wp + (size_t)k0 * N);
      if (!bok) bv = make_float4(0.f, 0.f, 0.f, 0.f);
      __syncthreads();
      As[(ak + 0) * 132 + ar] = bf2f(av.x & 0xffffu); As[(ak + 1) * 132 + ar] = bf2f(av.x >> 16);
      As[(ak + 2) * 132 + ar] = bf2f(av.y & 0xffffu); As[(ak + 3) * 132 + ar] = bf2f(av.y >> 16);
      *(float4*)(Bs + bk * 128 + bc) = bv;
      __syncthreads();
#pragma unroll
      for (int k = 0; k < 16; ++k) {
        const float4 a0 = *(const float4*)(As + k * 132 + ty * 8), a1 = *(const float4*)(As + k * 132 + ty * 8 + 4);
        const float4 b = *(const float4*)(Bs + k * 128 + tx * 4);
        const float a[8] = {a0.x, a0.y, a0.z, a0.w, a1.x, a1.y, a1.z, a1.w};
#pragma unroll
        for (int i = 0; i < 8; ++i) { acc[i][0] += a[i] * b.x; acc[i][1] += a[i] * b.y; acc[i][2] += a[i] * b.z; acc[i][3] += a[i] * b.w; }
      }
    }
    const int col = pn * 128 + tx * 4;
    if (col < N) {
#pragma unroll
      for (int i = 0; i < 8; ++i) E(pm * 128 + ty * 8 + i, col, acc[i]);
    }
  }
}

__device__ __forceinline__ void head_norm_rope(const float* v, const float* gain, const float* cs  , int sub, float* vn, float* vr) {
  float ss = 0.f;
#pragma unroll
  for (int i = 0; i < 8; ++i) ss += v[i] * v[i];
  ss += __shfl_xor(ss, 1); ss += __shfl_xor(ss, 2); ss += __shfl_xor(ss, 4);
  const float rstd = 1.0f / sqrtf(ss * (1.0f / 64.0f) + EPS);
#pragma unroll
  for (int i = 0; i < 8; ++i) vn[i] = v[i] * rstd * gain[sub * 8 + i];
#pragma unroll
  for (int i = 0; i < 8; ++i) {
    const float other = __shfl_xor(vn[i], 1);
    const float c = cs[i], s = cs[8 + i];
    float r = vn[i];
    if (sub == 0) r = vn[i] * c - other * s;
    else if (sub == 1) r = vn[i] * c + other * s;
    vr[i] = r;
  }
}

__device__ __forceinline__ void ph_post_diff(int j, bf16_t* PROJ) {
  const int tid = tid_(), lane = tid & 63, wave = tid >> 6, sub = lane & 7;
  const float* rope = (const float*)(P(ws) + WS_ROPE);
  for (int m = bid_() * 8 + wave; m < T; m += gdim_() * 8) {
    const float* cs = rope + (size_t)m * 16;
#pragma unroll
    for (int it = 0; it < 4; ++it) {
      bf16_t* ptr = PROJ + (size_t)m * DIFF_IN + it * 512 + lane * 8;
      float v[8], vn[8], vr[8]; unpack8(*(const uint4*)ptr, v);
      const float* gain = (it < 2) ? (P(diff_q_gain) + j * 64) : (P(diff_k_gain) + j * 64);
      head_norm_rope(v, gain, cs, sub, vn, vr);
      const float sc = (it < 2) ? C2 : 1.0f;
#pragma unroll
      for (int i = 0; i < 8; ++i) vr[i] *= sc;
      *(uint4*)ptr = pack8(vr);
    }
  }
}
__device__ __forceinline__ void ph_post_nsa(int j, bf16_t* PROJ, bf16_t* QC) {
  const int tid = tid_(), lane = tid & 63, wave = tid >> 6, sub = lane & 7;
  const float* rope = (const float*)(P(ws) + WS_ROPE);
  for (int m = bid_() * 8 + wave; m < T; m += gdim_() * 8) {
    const float* cs = rope + (size_t)m * 16;
#pragma unroll
    for (int it = 0; it < 2; ++it) {
      bf16_t* ptr = PROJ + (size_t)m * NSA_P + it * 512 + lane * 8;
      float v[8], vn[8], vr[8]; unpack8(*(const uint4*)ptr, v);
      head_norm_rope(v, P(nsa_q_gain) + j * 64, cs, sub, vn, vr);
#pragma unroll
      for (int i = 0; i < 8; ++i) { vr[i] *= C2; vn[i] *= C2; }
      *(uint4*)ptr = pack8(vr);
      *(uint4*)(QC + (size_t)m * D + it * 512 + lane * 8) = pack8(vn);
    }
    {
      const int hi = lane >> 5;
      bf16_t* ptr = PROJ + (size_t)m * NSA_P + (hi ? 2048 : 1536) + (lane & 31) * 8;
      float v[8], vn[8], vr[8]; unpack8(*(const uint4*)ptr, v);
      head_norm_rope(v, P(nsa_k_gain) + j * 192 + (hi ? 128 : 64), cs, sub, vn, vr);
      *(uint4*)ptr = pack8(vr);
    }
  }
}

template <int DV, int MODE>
__device__ __forceinline__ void attn_naive_unit(int b, int qc, const bf16_t* Qp, int ldq, const bf16_t* Kp, const bf16_t* Vp, int ldkv, bf16_t* Op, int ldo, const u64* selmask, unsigned char* lds) {
  constexpr int DVS = DV / 8;
  float* Ks = (float*)lds;
  float* Vs = Ks + 64 * 64;
  const int tid = tid_(), qi = tid & 63, sl = tid >> 6;
  const int qabs = qc * 64 + qi;
  const size_t rowq = (size_t)b * S + qabs;
  float q[64];
#pragma unroll
  for (int i = 0; i < 8; ++i) unpack8(*(const uint4*)(Qp + rowq * ldq + i * 8), q + i * 8);
  float m = -INFINITY, l = 0.f, o[DVS];
#pragma unroll
  for (int i = 0; i < DVS; ++i) o[i] = 0.f;
  u64 msk = 0ull; if (MODE == 1) msk = selmask[qabs];
  const int t_lo = (MODE == 2) ? (qc > 8 ? qc - 8 : 0) : 0;
  for (int tt = t_lo; tt <= qc; ++tt) {
    __syncthreads();
    { const int key = tid >> 3, ch = tid & 7; float f[8];
      unpack8(*(const uint4*)(Kp + ((size_t)b * S + tt * 64 + key) * ldkv + ch * 8), f);
#pragma unroll
      for (int i = 0; i < 8; ++i) Ks[key * 64 + ch * 8 + i] = f[i];
#pragma unroll
      for (int r = 0; r < DV / 64; ++r) {
        unpack8(*(const uint4*)(Vp + ((size_t)b * S + tt * 64 + key) * ldkv + r * 64 + ch * 8), f);
#pragma unroll
        for (int i = 0; i < 8; ++i) Vs[key * DV + r * 64 + ch * 8 + i] = f[i];
      } }
    __syncthreads();
    const bool tile_on = (MODE == 1) ? (((msk >> tt) & 1ull) != 0ull) : true;
    if (tile_on) {
      for (int jk = 0; jk < 64; ++jk) {
        const int key = tt * 64 + jk;
        bool valid = key <= qabs; if (MODE == 2) valid = valid && (key > qabs - 512);
        if (valid) {
          float s = 0.f;
#pragma unroll
          for (int d = 0; d < 64; d += 4) { const float4 kk = *(const float4*)(Ks + jk * 64 + d); s += q[d] * kk.x + q[d + 1] * kk.y + q[d + 2] * kk.z + q[d + 3] * kk.w; }
          const float mn = fmaxf(m, s); const float sc = exp2f(m - mn), pp = exp2f(s - mn);
          l = l * sc + pp;
#pragma unroll
          for (int i = 0; i < DVS; ++i) o[i] = o[i] * sc + pp * Vs[jk * DV + sl * DVS + i];
          m = mn;
        }
      }
    }
  }
  const float inv = l > 0.f ? 1.0f / l : 0.f;
  bf16_t* op = Op + rowq * ldo + sl * DVS;
  if (DVS == 8) { float r[8];
#pragma unroll
    for (int i = 0; i < 8; ++i) r[i] = o[i] * inv;
    *(uint4*)op = pack8(r);
  } else {
#pragma unroll
    for (int h2 = 0; h2 < DVS / 8; ++h2) { float r[8];
#pragma unroll
      for (int i = 0; i < 8; ++i) r[i] = o[h2 * 8 + i] * inv;
      *(uint4*)(op + h2 * 8) = pack8(r); }
  }
}

__device__ __forceinline__ void ph_attn_diff(unsigned char* lds) {
  const bf16_t* PROJ = (const bf16_t*)(P(ws) + WS_PROJ); bf16_t* ATT = (bf16_t*)(P(ws) + WS_ATT);
  const int NU = NB * 64 * 16;
  for (int u = bid_(); u < NU; u += gdim_()) {
    const int vh = u & 15, qc = 63 - ((u >> 4) & 63), b = u >> 10;
    const int h8 = vh >> 1, c = vh & 1;
    attn_naive_unit<128, 0>(b, qc, PROJ + vh * 64, DIFF_IN, PROJ + 1024 + vh * 64, PROJ + 2048 + h8 * 128, DIFF_IN, ATT + c * 1024 + h8 * 128, 2048, nullptr, lds);
  }
}
__device__ __forceinline__ void ph_attn_sel(unsigned char* lds) {
  const bf16_t* PROJ = (const bf16_t*)(P(ws) + WS_PROJ); bf16_t* OSEL = (bf16_t*)(P(ws) + WS_ATT + 32 * MiB);
  const u64* SEL = (const u64*)(P(ws) + WS_SEL);
  const int NU = NB * 64 * 16;
  for (int u = bid_(); u < NU; u += gdim_()) {
    const int hd = u & 15, qc = 63 - ((u >> 4) & 63), b = u >> 10, g = hd >> 2;
    attn_naive_unit<64, 1>(b, qc, PROJ + hd * 64, NSA_P, PROJ + 1536 + g * 64, PROJ + 1792 + g * 64, NSA_P, OSEL + hd * 64, D, SEL + (size_t)(b * 4 + g) * S, lds);
  }
}
__device__ __forceinline__ void ph_attn_win(unsigned char* lds) {
  const bf16_t* PROJ = (const bf16_t*)(P(ws) + WS_PROJ); bf16_t* OWIN = (bf16_t*)(P(ws) + WS_ATT + 64 * MiB);
  const int NU = NB * 64 * 16;
  for (int u = bid_(); u < NU; u += gdim_()) {
    const int hd = u & 15, qc = (u >> 4) & 63, b = u >> 10, g = hd >> 2;
    attn_naive_unit<64, 2>(b, qc, PROJ + hd * 64, NSA_P, PROJ + 2048 + g * 64, PROJ + 2304 + g * 64, NSA_P, OWIN + hd * 64, D, nullptr, lds);
  }
}

__device__ __forceinline__ void ph_compress(int j, unsigned char* lds) {
  const bf16_t* PROJ = (const bf16_t*)(P(ws) + WS_PROJ);
  float* z = (float*)lds;
  float* red = z + 2048;
  float* hid = red + 512;
  float* red2 = hid + 128;
  const int tid = tid_();
  const int NI = NB * 4 * 255 * 2;
  for (int it = bid_(); it < NI; it += gdim_()) {
    const int kv = it & 1, c = (it >> 1) % 255, bg = (it >> 1) / 255, b = bg >> 2, g = bg & 3;
    const float* pe = (kv ? P(nsa_pe_v) : P(nsa_pe_k)) + j * 2048;
    const float* w1 = (kv ? P(nsa_w_cv1) : P(nsa_w_ck1)) + (size_t)j * 2048 * 128;
    const float* w2 = (kv ? P(nsa_w_cv2) : P(nsa_w_ck2)) + (size_t)j * 128 * 64;
    const int colbase = (kv ? 1280 : 1024) + g * 64;
    __syncthreads();
    {
      const int l = tid >> 4, d4 = (tid & 15) * 4;
      const uint2 sv = *(const uint2*)(PROJ + ((size_t)b * S + 16 * c + l) * NSA_P + colbase + d4);
      z[l * 64 + d4 + 0] = bf2f(sv.x & 0xffffu) + pe[l * 64 + d4 + 0]; z[l * 64 + d4 + 1] = bf2f(sv.x >> 16) + pe[l * 64 + d4 + 1];
      z[l * 64 + d4 + 2] = bf2f(sv.y & 0xffffu) + pe[l * 64 + d4 + 2]; z[l * 64 + d4 + 3] = bf2f(sv.y >> 16) + pe[l * 64 + d4 + 3]; }
    __syncthreads();
    { const int n = tid & 127, ks = tid >> 7; float a = 0.f;
      const float* wp = w1 + (size_t)(ks * 512) * 128 + n;
#pragma unroll 8
      for (int k = 0; k < 512; ++k) a += z[ks * 512 + k] * wp[(size_t)k * 128];
      red[ks * 128 + n] = a; }
    __syncthreads();
    if (tid < 128) { const float hsum = red[tid] + red[128 + tid] + red[256 + tid] + red[384 + tid]; hid[tid] = hsum / (1.f + expf(-hsum)); }
    __syncthreads();
    { const int e = tid & 63, sp = tid >> 6; float a = 0.f;
#pragma unroll
      for (int h = 0; h < 16; ++h) a += hid[sp * 16 + h] * w2[(sp * 16 + h) * 64 + e];
      red2[sp * 64 + e] = a; }
    __syncthreads();
    if (tid < 64) {
      float o = 0.f;
#pragma unroll
      for (int sp = 0; sp < 8; ++sp) o += red2[sp * 64 + tid];
      if (kv == 0) { const float ss = wave_sum(o * o); o = o * (1.0f / sqrtf(ss * (1.0f / 64.0f) + EPS)) * P(nsa_k_gain)[j * 192 + tid]; }
      float* dst = (float*)(P(ws) + (kv ? WS_VCMP : WS_KCMP));
      dst[((size_t)bg * 256 + c) * 64 + tid] = o;
    }
  }
}

__device__ __forceinline__ void ph_cmp_attn(unsigned char* lds) {
  float* Kc = (float*)lds;
  float* Pm = Kc + 256 * 65;
  float* imp = Pm + 32 * 256;
  unsigned* selb = (unsigned*)(imp + 8 * 64);
  const bf16_t* QC = (const bf16_t*)(P(ws) + WS_OC);
  const float* KCMP = (const float*)(P(ws) + WS_KCMP); const float* VCMP = (const float*)(P(ws) + WS_VCMP);
  bf16_t* OCMP = (bf16_t*)(P(ws) + WS_ATT);
  u64* SEL = (u64*)(P(ws) + WS_SEL);
  const int tid = tid_();
  const int NU = NB * 4 * 512;
  for (int u = bid_(); u < NU; u += gdim_()) {
    const int qc8 = u & 511, bg = u >> 9, b = bg >> 2, g = bg & 3;
    const int t0 = qc8 * 8;
    int ncv = (t0 + 7 >= 31) ? ((t0 + 7 - 31) / 16 + 1) : 0; if (ncv > 255) ncv = 255;
    __syncthreads();
    for (int i = tid; i < ncv * 64; i += NTHR) Kc[(i >> 6) * 65 + (i & 63)] = KCMP[(size_t)bg * 256 * 64 + i];
    if (tid < 16) selb[tid] = 0u;
    __syncthreads();
    const int r = tid >> 4, sub = tid & 15, qi = r >> 2, hh = r & 3, t = t0 + qi;
    {
      float q[64];
      const bf16_t* qp = QC + ((size_t)b * S + t) * D + (g * 4 + hh) * 64;
#pragma unroll
      for (int i = 0; i < 8; ++i) unpack8(*(const uint4*)(qp + i * 8), q + i * 8);
      float mx = -INFINITY;
#pragma unroll 1
      for (int i = 0; i < 16; ++i) {
        const int c = sub + 16 * i; float a = -INFINITY;
        if (c < ncv && 16 * c + 31 <= t) { a = 0.f;
#pragma unroll
          for (int d = 0; d < 64; ++d) a += q[d] * Kc[c * 65 + d]; }
        Pm[r * 256 + c] = a; mx = fmaxf(mx, a);
      }
      mx = fmaxf(mx, __shfl_xor(mx, 1)); mx = fmaxf(mx, __shfl_xor(mx, 2)); mx = fmaxf(mx, __shfl_xor(mx, 4)); mx = fmaxf(mx, __shfl_xor(mx, 8));
      float sum = 0.f;
#pragma unroll 1
      for (int i = 0; i < 16; ++i) { const float sv = Pm[r * 256 + sub + 16 * i]; const float e = (sv == -INFINITY) ? 0.f : exp2f(sv - mx); Pm[r * 256 + sub + 16 * i] = e; sum += e; }
      sum += __shfl_xor(sum, 1); sum += __shfl_xor(sum, 2); sum += __shfl_xor(sum, 4); sum += __shfl_xor(sum, 8);
      const float inv = sum > 0.f ? 1.0f / sum : 0.f;
#pragma unroll 1
      for (int i = 0; i < 16; ++i) Pm[r * 256 + sub + 16 * i] *= inv;
    }
    __syncthreads();
    {
      float o0 = 0.f, o1 = 0.f, o2 = 0.f, o3 = 0.f;
      const float* vb = VCMP + (size_t)bg * 256 * 64 + sub * 4;
      for (int c = 0; c < ncv; ++c) { const float pr = Pm[r * 256 + c]; const float4 v0 = *(const float4*)(vb + c * 64);
        o0 += pr * v0.x; o1 += pr * v0.y; o2 += pr * v0.z; o3 += pr * v0.w; }
      uint2 ov; ov.x = pk2(o0, o1); ov.y = pk2(o2, o3);
      *(uint2*)(OCMP + ((size_t)b * S + t) * D + (g * 4 + hh) * 64 + sub * 4) = ov;
    }
    {
      const int qi2 = tid >> 6, sb = tid & 63, tq = t0 + qi2, bt = tq >> 6;
      float v = 0.f;
      const int c_lo = (4 * sb - 1 < 0) ? 0 : 4 * sb - 1, c_hi = (4 * sb + 3 > 254) ? 254 : 4 * sb + 3;
      for (int h = 0; h < 4; ++h) for (int c = c_lo; c <= c_hi; ++c) v += Pm[(qi2 * 4 + h) * 256 + c];
      const bool forced = (sb == 0) || (sb == bt) || (sb == bt - 1), valid = sb <= bt;
      imp[qi2 * 64 + sb] = forced ? 1e6f : (valid ? v : -1.0f);
    }
    __syncthreads();
    {
      const int qi2 = tid >> 6, sb = tid & 63;
      const float v = imp[qi2 * 64 + sb]; int cnt = 0;
      for (int s2 = 0; s2 < 64; ++s2) { const float w = imp[qi2 * 64 + s2]; cnt += (w > v || (w == v && s2 < sb)) ? 1 : 0; }
      if (cnt < 16) atomicOr(&selb[qi2 * 2 + (sb >> 5)], 1u << (sb & 31));
    }
    __syncthreads();
    if (tid < 8) SEL[(size_t)bg * S + t0 + tid] = (u64)selb[tid * 2] | ((u64)selb[tid * 2 + 1] << 32);
  }
}

__device__ __forceinline__ void ph_combine_nsa(int j) {
  const bf16_t* PROJ = (const bf16_t*)(P(ws) + WS_PROJ);
  const bf16_t* OCMP = (const bf16_t*)(P(ws) + WS_ATT); const bf16_t* OSEL = OCMP + (size_t)T * D; const bf16_t* OWIN = OSEL + (size_t)T * D;
  bf16_t* OC = (bf16_t*)(P(ws) + WS_OC);
  for (size_t i = (size_t)bid_() * NTHR + tid_(); i < (size_t)T * 128; i += (size_t)gdim_() * NTHR) {
    const size_t m = i >> 7; const int cg8 = (int)(i & 127), hd = cg8 >> 3;
    float gt[3];
#pragma unroll
    for (int r = 0; r < 3; ++r) { const float gl = bf2f(PROJ[m * NSA_P + 2560 + hd * 3 + r]) + P(nsa_b_gate)[j * 48 + hd * 3 + r]; gt[r] = 1.0f / (1.0f + expf(-gl)); }
    float a[8], bb[8], cc[8], o[8];
    unpack8(*(const uint4*)(OCMP + m * D + cg8 * 8), a); unpack8(*(const uint4*)(OSEL + m * D + cg8 * 8), bb); unpack8(*(const uint4*)(OWIN + m * D + cg8 * 8), cc);
#pragma unroll
    for (int k = 0; k < 8; ++k) o[k] = gt[0] * a[k] + gt[1] * bb[k] + gt[2] * cc[k];
    *(uint4*)(OC + m * D + cg8 * 8) = pack8(o);
  }
}
__device__ __forceinline__ void ph_combine_diff(int j) {
  const bf16_t* ATT = (const bf16_t*)(P(ws) + WS_ATT); bf16_t* OC = (bf16_t*)(P(ws) + WS_OC);
  const float lam = ((const float*)(P(ws) + WS_SMALL))[j]; const float osc = 1.0f - lam_init_of(j);
  const int tid = tid_(), lane = tid & 63, wave = tid >> 6;
  for (int m = bid_() * 8 + wave; m < T; m += gdim_() * 8) {
#pragma unroll
    for (int it = 0; it < 2; ++it) {
      const int col = it * 512 + lane * 8;
      float a[8], b2[8], o[8]; unpack8(*(const uint4*)(ATT + (size_t)m * 2048 + col), a); unpack8(*(const uint4*)(ATT + (size_t)m * 2048 + 1024 + col), b2);
      float ss = 0.f;
#pragma unroll
      for (int k = 0; k < 8; ++k) { o[k] = a[k] - lam * b2[k]; ss += o[k] * o[k]; }
      ss += __shfl_xor(ss, 1); ss += __shfl_xor(ss, 2); ss += __shfl_xor(ss, 4); ss += __shfl_xor(ss, 8);
      const float rstd = 1.0f / sqrtf(ss * (1.0f / 128.0f) + EPS);
#pragma unroll
      for (int k = 0; k < 8; ++k) o[k] = o[k] * rstd * P(diff_subln_g)[j * 128 + (col & 127) + k] * osc;
      *(uint4*)(OC + (size_t)m * D + col) = pack8(o);
    }
  }
}

constexpr int N_PHASES = 1 + 4 * 10;
template <int PH> __device__ __forceinline__ void run_phase(unsigned char* lds, int lo, int hi) {
  if (PH < lo || PH >= hi) return;
  bool did = true;
  if constexpr (PH == 0) ph_prologue(lds);
  else {
    constexpr int i = (PH - 1) / 10, lp = (PH - 1) % 10, j = i >> 1; constexpr bool nsa = (i & 1) == 0;
    float* MOD = (float*)(P(ws) + WS_MOD);
    bf16_t* H = (bf16_t*)(P(ws) + WS_H); bf16_t* PROJ = (bf16_t*)(P(ws) + WS_PROJ); bf16_t* OC = (bf16_t*)(P(ws) + WS_OC); bf16_t* HID = (bf16_t*)(P(ws) + WS_HID);
    const float* mod = MOD + (size_t)i * 4 * 6144;
    const float* xcur = (i == 0 && lp < 7) ? P(x) : P(out);
    if constexpr (lp == 0) ph_norm(xcur, P(ln_mix_g) + i * D, mod, 0, 1024, H);
    if constexpr (lp == 1) {
      if constexpr (nsa) { EpiStore E{PROJ, NSA_P, 0}; gemm_naive(H, D, P(nsa_w_in) + (size_t)j * D * NSA_IN, NSA_IN, D, lds, E); }
      else { EpiStore E{PROJ, DIFF_IN, 0}; gemm_naive(H, D, P(diff_w_in) + (size_t)j * D * DIFF_IN, DIFF_IN, D, lds, E); }
    }
    if constexpr (lp == 2) { if constexpr (nsa) { ph_post_nsa(j, PROJ, OC); ph_compress(j, lds); } else ph_post_diff(j, PROJ); }
    if constexpr (lp == 3) { if constexpr (nsa) { ph_cmp_attn(lds); ph_attn_win(lds); } else ph_attn_diff(lds); }
    if constexpr (lp == 4) { if constexpr (nsa) ph_attn_sel(lds); else did = false; }
    if constexpr (lp == 5) { if constexpr (nsa) ph_combine_nsa(j); else ph_combine_diff(j); }
    if constexpr (lp == 6) { EpiResid E{xcur, P(out), mod + 2048}; gemm_naive(OC, D, (nsa ? P(nsa_w_out) : P(diff_w_out)) + (size_t)j * D * D, D, D, lds, E); }
    if constexpr (lp == 7) ph_norm(P(out), P(ln_mlp_g) + i * D, mod, 3072, 4096, H);
    if constexpr (lp == 8) { EpiStore E{HID, DFF, 1}; gemm_naive(H, D, P(w_mlp_in) + (size_t)i * D * DFF, DFF, D, lds, E); }
    if constexpr (lp == 9) { EpiResid E{P(out), P(out), mod + 5120}; gemm_naive(HID, DFF, P(w_mlp_out) + (size_t)i * DFF * D, D, DFF, lds, E); }
  }
  if (did && PH + 1 < hi) cg::this_grid().sync();
}
template <int... I> __device__ __forceinline__ void run_all(std::integer_sequence<int, I...>, unsigned char* lds, int lo, int hi) { (run_phase<I>(lds, lo, hi), ...); }
__global__ void __launch_bounds__(NTHR) fwd_kernel(Params p) {
  extern __shared__ __attribute__((aligned(16))) unsigned char lds[];
  run_all(std::make_integer_sequence<int, N_PHASES>{}, lds, p.ph_lo, p.ph_hi);
}

extern "C" void kernel_launch(void* const* d_in, const int* in_sizes, int n_in, void* d_out, int out_size, void* d_ws, size_t ws_size, hipStream_t stream) {
  static int grid = 0;
  if (grid == 0) {
    if (n_in != 29 || out_size != T * D || ws_size < WS_END) { fprintf(stderr, "kernel_launch: unexpected problem (n_in %d, out %d, ws %zu)\n", n_in, out_size, ws_size); grid = -1; return; }
    int dev = 0, cus = 0, per_cu = 0;
    hipGetDevice(&dev); hipDeviceGetAttribute(&cus, hipDeviceAttributeMultiprocessorCount, dev);
    hipFuncSetAttribute((const void*)fwd_kernel, hipFuncAttributeMaxDynamicSharedMemorySize, LDS_BYTES);
    hipOccupancyMaxActiveBlocksPerMultiprocessor(&per_cu, (const void*)fwd_kernel, NTHR, LDS_BYTES);
    if (per_cu < 1) { fprintf(stderr, "kernel_launch: occupancy query says %d blocks/CU\n", per_cu); per_cu = 1; }
    grid = cus * 1;
    (void)hipGetLastError();
  }
  if (grid < 0) return;
  Params p{};
  memcpy((void*)&p, (const void*)d_in, 29 * sizeof(void*));
  p.out = (float*)d_out; p.ws = (unsigned char*)d_ws; p.ph_lo = 0; p.ph_hi = N_PHASES;
  void* args[] = {&p};
  hipError_t e = hipLaunchCooperativeKernel((const void*)fwd_kernel, dim3(grid), dim3(NTHR), args, LDS_BYTES, stream);
  if (e != hipSuccess) fprintf(stderr, "cooperative launch failed: %s (grid %d)\n", hipGetErrorString(e), grid);
}
```

```cpp
#include <hip/hip_runtime.h>
#include <hip/hip_cooperative_groups.h>
#include <cstdio>
#include <cstdint>
#include <cstring>
#include <utility>
namespace cg = cooperative_groups;

typedef unsigned short bf16_t;
typedef unsigned long long u64;

constexpr int D = 1024, NB = 4, S = 4096, T = NB * S, DFF = 4096;
constexpr int NSA_IN = 2608, NSA_P = 2816, DIFF_IN = 3072;
constexpr float EPS = 1e-6f;
constexpr float C2 = 0.125f * 1.4426950408889634f;
constexpr int NTHR = 512;
constexpr int LDS_BYTES = 147456;

constexpr size_t MiB = 1u << 20;
constexpr size_t WS_MOD = 1 * MiB;
constexpr size_t WS_ROPE = 2 * MiB;
constexpr size_t WS_SMALL = 3 * MiB;
constexpr size_t WS_WT = 4 * MiB;
constexpr size_t WT_LAYER = 24 * MiB, WT_OUT = 6 * MiB, WT_MI = 8 * MiB, WT_MO = 16 * MiB;
constexpr size_t WS_H = 104 * MiB;
constexpr size_t WS_PROJ = 136 * MiB;
constexpr size_t WS_ATT = 232 * MiB;
constexpr size_t WS_OC = 328 * MiB;
constexpr size_t WS_KCMP = 360 * MiB;
constexpr size_t WS_VCMP = 361 * MiB;
constexpr size_t WS_SEL = 362 * MiB;
constexpr size_t WS_HID = 136 * MiB;
constexpr size_t WS_END = 364 * MiB;

struct Params {
  const float* x; const float* c; const int* pos; const float* ln_mix_g; const float* ln_mlp_g;
  const float* w_ada; const float* b_ada; const float* w_mlp_in; const float* w_mlp_out;
  const float* nsa_w_in; const float* nsa_b_gate; const float* nsa_q_gain; const float* nsa_k_gain;
  const float* nsa_pe_k; const float* nsa_w_ck1; const float* nsa_w_ck2; const float* nsa_pe_v; const float* nsa_w_cv1; const float* nsa_w_cv2; const float* nsa_w_out;
  const float* diff_w_in; const float* diff_q_gain; const float* diff_k_gain; const float* diff_lq1; const float* diff_lk1; const float* diff_lq2; const float* diff_lk2; const float* diff_subln_g; const float* diff_w_out;
  float* out; unsigned char* ws; int ph_lo, ph_hi;
};

typedef __attribute__((address_space(4))) const unsigned char* kptr_t;
template <class Tp> __device__ __forceinline__ Tp karg_load(unsigned off) {
  asm volatile("" : "+s"(off));
  kptr_t kp = (kptr_t)__builtin_amdgcn_kernarg_segment_ptr();
  return *(const __attribute__((address_space(4))) Tp*)(kp + off);
}
__device__ __forceinline__ int tid_() { int t = (int)threadIdx.x; asm volatile("" : "+v"(t)); return t; }
__device__ __forceinline__ int bid_() { int t = (int)blockIdx.x; asm volatile("" : "+s"(t)); return t; }
__device__ __forceinline__ int gdim_() { int t = (int)gridDim.x; asm volatile("" : "+s"(t)); return t; }
#define P(m) karg_load<decltype(Params::m)>((unsigned)offsetof(Params, m))
__device__ __forceinline__ float bf2f(unsigned v) { return __uint_as_float(v << 16); }
__device__ __forceinline__ unsigned f2bf(float f) { unsigned u = __float_as_uint(f); return (u + 0x7fffu + ((u >> 16) & 1u)) >> 16; }
__device__ __forceinline__ unsigned pk2(float lo, float hi) { return f2bf(lo) | (f2bf(hi) << 16); }
__device__ __forceinline__ void unpack8(const uint4 v, float* f) {
  f[0] = bf2f(v.x & 0xffffu); f[1] = bf2f(v.x >> 16); f[2] = bf2f(v.y & 0xffffu); f[3] = bf2f(v.y >> 16);
  f[4] = bf2f(v.z & 0xffffu); f[5] = bf2f(v.z >> 16); f[6] = bf2f(v.w & 0xffffu); f[7] = bf2f(v.w >> 16);
}
__device__ __forceinline__ uint4 pack8(const float* f) { uint4 v; v.x = pk2(f[0], f[1]); v.y = pk2(f[2], f[3]); v.z = pk2(f[4], f[5]); v.w = pk2(f[6], f[7]); return v; }
__device__ __forceinline__ float wave_sum(float v) {
#pragma unroll
  for (int o = 1; o < 64; o <<= 1) v += __shfl_xor(v, o);
  return v;
}
__device__ __forceinline__ float lam_init_of(int j) { return j == 0 ? 0.35550906759096934f : 0.5560582041556406f; }

namespace pg8 {
#define PG8_LAS __attribute__((address_space(3)))
typedef unsigned short bf16_t;
typedef short bf16x8 __attribute__((ext_vector_type(8)));
typedef float f32x4 __attribute__((ext_vector_type(4)));
typedef unsigned u32x4 __attribute__((ext_vector_type(4)));
constexpr int BM = 256, BK = 64, HALF = 128, HTB = HALF * BK * 2  , STAGE_BYTES = 8 * HTB, NXCD = 8, WGM = 8;

__host__ __device__ __forceinline__ int lds_byte(int r, int c) { const int st = (r >> 4) * 2 + (c >> 5), rr = r & 15, cc = c & 31, ob = rr * 64 + cc * 2; return st * 1024 + (ob ^ (((ob >> 9) & 1) << 5)); }
__host__ __device__ __forceinline__ void stage_rc(int b, int& R, int& C) { const int st = b / 1024, sb = b % 1024, swz = sb ^ (((sb >> 9) & 1) << 5); R = (st >> 1) * 16 + swz / 64; C = (st & 1) * 32 + (swz % 64) / 2; }
__host__ __device__ __forceinline__ int perm32(int rho) { const int n = rho >> 4, i = rho & 15; return 8 * (i >> 2) + 4 * n + (i & 3); }

struct Unit { int pm, pn; };
struct Gemm { const bf16_t* A; const bf16_t* Bt; int M, N, K; };

struct StaticOrder {
    int nM, nN, nwg, G, c;
    __host__ __device__ void init(int M, int N, int G_, int c_) { nM = M / BM; nN = N / BM; nwg = nM * nN; G = G_; c = c_; }
    __host__ __device__ bool next(int i, Unit& u) const {
        const long L = (long)i * G + c; if (L >= nwg) return false;
        int wgid = (int)L; { const int q = nwg / NXCD, r = nwg % NXCD, xcd = wgid % NXCD, off = wgid / NXCD; wgid = (xcd < r ? xcd * (q + 1) : r * (q + 1) + (xcd - r) * q) + off; }
        const int nig = WGM * nN, gid = wgid / nig, fm = gid * WGM, gsz = (nM - fm) < WGM ? (nM - fm) : WGM;
        u.pm = fm + ((wgid % nig) % gsz); u.pn = (wgid % nig) / gsz; return true;
    }
    __device__ __forceinline__ void a_ready(const Unit&) const {}
    __device__ __forceinline__ void done(const Unit&) const {}
};


__device__ __forceinline__ unsigned cvt_pk_bf16(float lo, float hi) { unsigned r; asm volatile("v_cvt_pk_bf16_f32 %0, %1, %2" : "=v"(r) : "v"(lo), "v"(hi)); return r; }
template <int ACT  > struct EpiBf16 {
    static constexpr bool PERM = true, AFTER_DRAIN = false;
    bf16_t* O; int ldc;
    __device__ __forceinline__ void operator()(const f32x4 (&acc)[2][2][4][2], const Unit& u, int wr, int wc, int fr, int fq) const {
        const int row0 = u.pm * BM + wr * 64 + fr; const int col0 = u.pn * BM + wc * 32 + 8 * fq;
#pragma unroll
        for (int ai = 0; ai < 2; ++ai)
#pragma unroll
            for (int m = 0; m < 4; ++m) { bf16_t* rowp = O + (size_t)(row0 + ai * HALF + m * 16) * ldc + col0;
#pragma unroll
                for (int bj = 0; bj < 2; ++bj) { f32x4 v0 = acc[ai][bj][m][0], v1 = acc[ai][bj][m][1];
                    if (ACT == 2) {
#pragma unroll
                        for (int e = 0; e < 4; ++e) { float a = v0[e] > 0.f ? v0[e] : 0.f; v0[e] = a * a; float b = v1[e] > 0.f ? v1[e] : 0.f; v1[e] = b * b; } }
                    u32x4 w; w.x = cvt_pk_bf16(v0[0], v0[1]); w.y = cvt_pk_bf16(v0[2], v0[3]); w.z = cvt_pk_bf16(v1[0], v1[1]); w.w = cvt_pk_bf16(v1[2], v1[3]);
                    *(u32x4*)(rowp + bj * HALF) = w; } }
    }
};
struct EpiResid {
    static constexpr bool PERM = false, AFTER_DRAIN = false;
    const float* xin; float* xout; const float* gate;
    __device__ __forceinline__ void operator()(const f32x4 (&acc)[2][2][4][2], const Unit& u, int wr, int wc, int fr, int fq) const {
        const int col0 = u.pn * BM + wc * 32 + 4 * fq; const int b = (u.pm * BM) >> 12;
        f32x4 gv[2][2];
#pragma unroll
        for (int bj = 0; bj < 2; ++bj)
#pragma unroll
            for (int n = 0; n < 2; ++n) gv[bj][n] = *(const f32x4*)(gate + (size_t)b * 6144 + col0 + bj * HALF + n * 16);
#pragma unroll
        for (int ai = 0; ai < 2; ++ai)
#pragma unroll
            for (int m = 0; m < 4; ++m) { const size_t off = (size_t)(u.pm * BM + ai * HALF + wr * 64 + m * 16 + fr) * 1024 + col0;
#pragma unroll
                for (int bj = 0; bj < 2; ++bj)
#pragma unroll
                    for (int n = 0; n < 2; ++n) { const f32x4 xi = *(const f32x4*)(xin + off + bj * HALF + n * 16); *(f32x4*)(xout + off + bj * HALF + n * 16) = xi + gv[bj][n] * acc[ai][bj][m][n]; }
                if (m & 1) asm volatile("" ::: "memory"); }
    }
};

template <class Epi, class Sched, bool ALIGN_EPI = false, bool SP2 = false>
__device__ __forceinline__ void gemm_phase(PG8_LAS unsigned char* lds, const Gemm g, const Sched& S, const Epi& E) {
    const int tid = tid_(), wid = __builtin_amdgcn_readfirstlane(tid >> 6), lane = tid & 63, wr = wid >> 2, wc = wid & 3, fr = lane & 15, fq = lane >> 4;
    const int K = g.K, nt = K / BK;
    unsigned voffA[2], voffB[2];
#pragma unroll
    for (int i = 0; i < 2; ++i) { int R, C; stage_rc(tid * 16 + i * 8192, R, C); const int Rb = Epi::PERM ? ((R & ~31) + perm32(R & 31)) : R;
        voffA[i] = (unsigned)(R * K + C) * 2u; voffB[i] = (unsigned)(Rb * K + C) * 2u; }
    const size_t kstep = (size_t)(BK * 2);
    const size_t hstep = (size_t)HALF * K * 2;
    const size_t tstep = 2 * hstep;
    const unsigned ldsw = (unsigned)wid * 1024u;
    const int aoff = lds_byte(wr * 64 + fr, fq * 8), boff = lds_byte(wc * 32 + fr, fq * 8);
#define PG8_SA(b, h) (((b) * 2 + (h)) * HTB)
#define PG8_SB(b, h) ((4 + (b) * 2 + (h)) * HTB)
#define PG8_STAGE(bufoff, gbase, voff) do { _Pragma("unroll") for (int _i = 0; _i < 2; ++_i) \
        __builtin_amdgcn_global_load_lds((const unsigned*)((const char*)(gbase) + (voff)[_i]), (PG8_LAS unsigned*)(lds + (bufoff) + ldsw + _i * 8192), 16, 0, 0); } while (0)
#define PG8_LDA(dst, b, h) do { _Pragma("unroll") for (int m = 0; m < 4; ++m) _Pragma("unroll") for (int k = 0; k < 2; ++k) dst[m][k] = *(const PG8_LAS bf16x8*)(lds + PG8_SA(b, h) + aoff + m * 2048 + k * 1024); } while (0)
#define PG8_LDB(dst, b, h) do { _Pragma("unroll") for (int n = 0; n < 2; ++n) _Pragma("unroll") for (int k = 0; k < 2; ++k) dst[n][k] = *(const PG8_LAS bf16x8*)(lds + PG8_SB(b, h) + boff + n * 2048 + k * 1024); } while (0)
#define PG8_MMA(ai, bj, At, Bt) do { __builtin_amdgcn_s_setprio(1); _Pragma("unroll") for (int m = 0; m < 4; ++m) _Pragma("unroll") for (int n = 0; n < 2; ++n) _Pragma("unroll") for (int k = 0; k < 2; ++k) \
        acc[ai][bj][m][n] = __builtin_amdgcn_mfma_f32_16x16x32_bf16(Bt[n][k], At[m][k], acc[ai][bj][m][n], 0, 0, 0); __builtin_amdgcn_s_setprio(0); } while (0)
#define PG8_WAIT_V(n) asm volatile("s_waitcnt vmcnt(" #n ")" ::: "memory")
#define PG8_WAIT_L(n) asm volatile("s_waitcnt lgkmcnt(" #n ")" ::: "memory")
#define PG8_BAR __builtin_amdgcn_s_barrier()
#define PG8_SCHED __builtin_amdgcn_sched_barrier(0)
    Unit cur, nxt; int ui = 0;
    if (!S.next(0, cur)) return;
    f32x4 acc[2][2][4][2];
#pragma unroll
    for (int a = 0; a < 2; ++a)
#pragma unroll
        for (int b = 0; b < 2; ++b)
#pragma unroll
            for (int m = 0; m < 4; ++m)
#pragma unroll
                for (int n = 0; n < 2; ++n) acc[a][b][m][n] = (f32x4){0.f, 0.f, 0.f, 0.f};
    bf16x8 At[4][2], B0[2][2], B1[2][2];
    const char* cA = (const char*)g.A + (size_t)cur.pm * tstep; const char* cB = (const char*)g.Bt + (size_t)cur.pn * tstep;
    S.a_ready(cur);
    if constexpr (SP2) {
        PG8_STAGE(PG8_SB(0, 0), cB, voffB); PG8_STAGE(PG8_SB(0, 1), cB + hstep, voffB); PG8_STAGE(PG8_SA(0, 0), cA, voffA); PG8_STAGE(PG8_SA(0, 1), cA + hstep, voffA);
        if (wr == 1) PG8_BAR;
        PG8_WAIT_V(2); PG8_BAR;
        PG8_STAGE(PG8_SB(1, 0), cB + kstep, voffB); PG8_STAGE(PG8_SA(1, 0), cA + kstep, voffA); PG8_STAGE(PG8_SB(1, 1), cB + hstep + kstep, voffB);
        PG8_WAIT_V(6); PG8_BAR;
    } else {
        PG8_STAGE(PG8_SB(0, 0), cB, voffB); PG8_STAGE(PG8_SA(0, 0), cA, voffA); PG8_STAGE(PG8_SB(0, 1), cB + hstep, voffB); PG8_STAGE(PG8_SA(0, 1), cA + hstep, voffA);
        if (wr == 1) PG8_BAR;
        PG8_WAIT_V(4); PG8_BAR;
        PG8_STAGE(PG8_SB(1, 0), cB + kstep, voffB); PG8_STAGE(PG8_SA(1, 0), cA + kstep, voffA); PG8_STAGE(PG8_SB(1, 1), cB + hstep + kstep, voffB);
        PG8_WAIT_V(6); PG8_BAR;
    }
    for (;;) {
        const bool has_next = S.next(ui + 1, nxt);
        const char* nA = has_next ? (const char*)g.A + (size_t)nxt.pm * tstep : cA; const char* nB = has_next ? (const char*)g.Bt + (size_t)nxt.pn * tstep : cB;
        for (int t = 0; t < nt; t += 2) {
            const bool last = (t == nt - 2);
            const char* a1 = cA + (size_t)(t + 1) * kstep;
            const char* a2 = last ? nA : cA + (size_t)(t + 2) * kstep; const char* b2 = last ? nB : cB + (size_t)(t + 2) * kstep;
            const char* a3 = a2 + kstep; const char* b3 = b2 + kstep;
            if (last && has_next) S.a_ready(nxt);
            if constexpr (SP2) {
            PG8_LDB(B0, 0, 0); PG8_LDB(B1, 0, 1); PG8_SCHED; PG8_LDA(At, 0, 0); PG8_STAGE(PG8_SA(1, 1), a1 + hstep, voffA);
            PG8_WAIT_V(8); PG8_WAIT_L(0); PG8_BAR; PG8_MMA(0, 0, At, B0); PG8_MMA(0, 1, At, B1); PG8_BAR; PG8_SCHED;
            PG8_LDA(At, 0, 1); PG8_STAGE(PG8_SB(0, 0), b2, voffB); PG8_STAGE(PG8_SB(0, 1), b2 + hstep, voffB); PG8_STAGE(PG8_SA(0, 0), a2, voffA);
            PG8_WAIT_V(8); PG8_WAIT_L(0); PG8_BAR; PG8_MMA(1, 0, At, B0); PG8_MMA(1, 1, At, B1); PG8_BAR; PG8_SCHED;
            PG8_LDB(B0, 1, 0); PG8_LDB(B1, 1, 1); PG8_SCHED; PG8_LDA(At, 1, 0); PG8_STAGE(PG8_SA(0, 1), a2 + hstep, voffA);
            PG8_WAIT_V(8); PG8_WAIT_L(0); PG8_BAR; PG8_MMA(0, 0, At, B0); PG8_MMA(0, 1, At, B1); PG8_BAR; PG8_SCHED;
            PG8_LDA(At, 1, 1); PG8_STAGE(PG8_SB(1, 0), b3, voffB); PG8_STAGE(PG8_SB(1, 1), b3 + hstep, voffB); PG8_STAGE(PG8_SA(1, 0), a3, voffA);
            PG8_WAIT_V(8); PG8_WAIT_L(0); PG8_BAR; PG8_MMA(1, 0, At, B0); PG8_MMA(1, 1, At, B1); PG8_BAR; PG8_SCHED;
            } else {
            PG8_LDB(B0, 0, 0); PG8_SCHED; PG8_LDA(At, 0, 0); PG8_STAGE(PG8_SA(1, 1), a1 + hstep, voffA);
            PG8_WAIT_L(8); PG8_BAR; PG8_WAIT_L(0); PG8_MMA(0, 0, At, B0); PG8_BAR; PG8_SCHED;
            PG8_LDB(B1, 0, 1); PG8_STAGE(PG8_SB(0, 0), b2, voffB);
            PG8_BAR; PG8_WAIT_L(0); PG8_MMA(0, 1, At, B1); PG8_BAR;
            PG8_LDA(At, 0, 1); PG8_STAGE(PG8_SA(0, 0), a2, voffA);
            PG8_BAR; PG8_WAIT_L(0); PG8_MMA(1, 0, At, B0); PG8_BAR; PG8_SCHED;
            PG8_STAGE(PG8_SB(0, 1), b2 + hstep, voffB);
            PG8_WAIT_V(6); PG8_BAR; PG8_MMA(1, 1, At, B1); PG8_BAR;
            PG8_LDB(B0, 1, 0); PG8_SCHED; PG8_LDA(At, 1, 0); PG8_STAGE(PG8_SA(0, 1), a2 + hstep, voffA);
            PG8_WAIT_L(8); PG8_BAR; PG8_WAIT_L(0); PG8_MMA(0, 0, At, B0); PG8_BAR; PG8_SCHED;
            PG8_LDB(B1, 1, 1); PG8_STAGE(PG8_SB(1, 0), b3, voffB);
            PG8_BAR; PG8_WAIT_L(0); PG8_MMA(0, 1, At, B1); PG8_BAR;
            PG8_LDA(At, 1, 1); PG8_STAGE(PG8_SA(1, 0), a3, voffA);
            PG8_BAR; PG8_WAIT_L(0); PG8_MMA(1, 0, At, B0); PG8_BAR; PG8_SCHED;
            PG8_STAGE(PG8_SB(1, 1), b3 + hstep, voffB);
            PG8_WAIT_V(6); PG8_BAR; PG8_MMA(1, 1, At, B1); PG8_BAR;
            }
        }
        if constexpr (ALIGN_EPI) { if (wr == 0) PG8_BAR; }
        if constexpr (!Epi::AFTER_DRAIN) { E(acc, cur, wr, wc, fr, fq); S.done(cur); }
        if (!has_next) break;
#pragma unroll
        for (int a = 0; a < 2; ++a)
#pragma unroll
            for (int b = 0; b < 2; ++b)
#pragma unroll
                for (int m = 0; m < 4; ++m)
#pragma unroll
                    for (int n = 0; n < 2; ++n) acc[a][b][m][n] = (f32x4){0.f, 0.f, 0.f, 0.f};
        cur = nxt; cA = nA; cB = nB; ++ui;
        if constexpr (ALIGN_EPI) { if (wr == 1) PG8_BAR; }
    }
    PG8_WAIT_V(0);
    if constexpr (!ALIGN_EPI) { if (wr == 0) PG8_BAR; }
    PG8_BAR;
    if constexpr (Epi::AFTER_DRAIN) { E.fused(acc, cur, wr, wc, fr, fq, lds, wid, lane); S.done(cur); }
#undef PG8_SA
#undef PG8_SB
#undef PG8_STAGE
#undef PG8_LDA
#undef PG8_LDB
#undef PG8_MMA
#undef PG8_WAIT_V
#undef PG8_WAIT_L
#undef PG8_BAR
#undef PG8_SCHED
}
}

__device__ __forceinline__ void ph_prologue(unsigned char* lds) {
  const int tid = tid_();
  float* silu = (float*)lds;
  float* red = silu + 4096;
  float* MOD = (float*)(P(ws) + WS_MOD);
  for (int i = tid; i < 4096; i += NTHR) { const float v = P(c)[i]; silu[i] = v / (1.f + expf(-v)); }
  __syncthreads();
  for (int item = bid_(); item < 4 * 48; item += gdim_()) {
    const int l = item / 48, nc = item % 48, cc = tid & 127, ks = tid >> 7;
    const float* w = P(w_ada) + ((size_t)l * 1024 + ks * 256) * 6144 + nc * 128 + cc;
    float a0 = 0.f, a1 = 0.f, a2 = 0.f, a3 = 0.f;
#pragma unroll 8
    for (int k = 0; k < 256; ++k) { const float wv = w[(size_t)k * 6144]; const int kk = ks * 256 + k;
      a0 += silu[kk] * wv; a1 += silu[1024 + kk] * wv; a2 += silu[2048 + kk] * wv; a3 += silu[3072 + kk] * wv; }
    red[(ks * 4 + 0) * 128 + cc] = a0; red[(ks * 4 + 1) * 128 + cc] = a1; red[(ks * 4 + 2) * 128 + cc] = a2; red[(ks * 4 + 3) * 128 + cc] = a3;
    __syncthreads();
    { const int b = tid >> 7;
      const float s = red[(0 * 4 + b) * 128 + cc] + red[(1 * 4 + b) * 128 + cc] + red[(2 * 4 + b) * 128 + cc] + red[(3 * 4 + b) * 128 + cc];
      MOD[(size_t)(l * 4 + b) * 6144 + nc * 128 + cc] = s + P(b_ada)[l * 6144 + nc * 128 + cc]; }
    __syncthreads();
  }
  float* rope = (float*)(P(ws) + WS_ROPE);
  for (int m = bid_() * NTHR + tid; m < T; m += gdim_() * NTHR) {
    const float fp = (float)P(pos)[m];
    const float INV[8] = {1.0f, 0.1939227432012558f, 0.03760603070259094f, 0.007292664609849453f, 0.0014142135623842478f, 0.00027424818836152554f, 5.3182957344688475e-05f, 1.0313385246263351e-05f};
#pragma unroll
    for (int i = 0; i < 8; ++i) {
      const float ang = fp * INV[i];
      const double a = (double)ang; const double kq = rint(a * 0.63661977236758134308); const double r = a - kq * 1.57079632679489661923;
      const int q = (int)((long long)kq & 3ll);
      const double r2 = r * r;
      const double sr = r * (1.0 + r2 * (-1.0 / 6 + r2 * (1.0 / 120 + r2 * (-1.0 / 5040 + r2 * (1.0 / 362880 + r2 * (-1.0 / 39916800 + r2 * (1.0 / 6227020800.0)))))));
      const double cr = 1.0 + r2 * (-0.5 + r2 * (1.0 / 24 + r2 * (-1.0 / 720 + r2 * (1.0 / 40320 + r2 * (-1.0 / 3628800 + r2 * (1.0 / 479001600.0))))));
      const double sn = (q == 0) ? sr : (q == 1) ? cr : (q == 2) ? -sr : -cr;
      const double cs = (q == 0) ? cr : (q == 1) ? -sr : (q == 2) ? -cr : sr;
      rope[(size_t)m * 16 + i] = (float)cs; rope[(size_t)m * 16 + 8 + i] = (float)sn;
    }
  }
  if (bid_() == 0 && tid < 2) {
    const int j = tid; float s1 = 0.f, s2 = 0.f;
    for (int i = 0; i < 64; ++i) { s1 += P(diff_lq1)[j * 64 + i] * P(diff_lk1)[j * 64 + i]; s2 += P(diff_lq2)[j * 64 + i] * P(diff_lk2)[j * 64 + i]; }
    ((float*)(P(ws) + WS_SMALL))[j] = expf(s1) - expf(s2) + lam_init_of(j);
  }
}


__device__ __forceinline__ void transpose_item(const float* W, int K, int N, int Npad, bf16_t* WT, float* scr, int item, int lane) {
  const int nblk = Npad / 32, kb = item / nblk, nb = item % nblk, k0 = 64 * kb, n0 = 32 * nb;
  const int ncol = n0 + (lane & 31); const bool ok = ncol < N;
#pragma unroll 8
  for (int i = 0; i < 32; ++i) { const int kk = 2 * i + (lane >> 5); scr[kk * 33 + (lane & 31)] = ok ? W[(size_t)(k0 + kk) * N + ncol] : 0.f; }
  asm volatile("s_waitcnt lgkmcnt(0)" ::: "memory");
  const int c = lane & 7;
#pragma unroll
  for (int j = 0; j < 4; ++j) { const int n = (lane >> 3) + 8 * j; const float* sp = scr + (8 * c) * 33 + n;
    uint4 o; o.x = pk2(sp[0 * 33], sp[1 * 33]); o.y = pk2(sp[2 * 33], sp[3 * 33]); o.z = pk2(sp[4 * 33], sp[5 * 33]); o.w = pk2(sp[6 * 33], sp[7 * 33]);
    *(uint4*)(WT + (size_t)(n0 + n) * K + k0 + 8 * c) = o; }
  asm volatile("s_waitcnt lgkmcnt(0)" ::: "memory");
}
__device__ __forceinline__ void ph_weights(unsigned char* lds) {
  const int tid = tid_(), lane = tid & 63, wave = tid >> 6;
  float* scr = (float*)(lds + wave * 16384);
  const int gw = bid_() * 8 + wave, NGW = gdim_() * 8;
  for (int it = gw; it < 4 * 6144; it += NGW) {
    const int i = it / 6144; int r = it % 6144; const int j = i >> 1; const bool nsa = (i & 1) == 0;
    bf16_t* base = (bf16_t*)(P(ws) + WS_WT + (size_t)i * WT_LAYER);
    const int n_in = nsa ? 16 * (NSA_P / 32) : 16 * (DIFF_IN / 32);
    if (r < n_in) { if (nsa) transpose_item(P(nsa_w_in) + (size_t)j * D * NSA_IN, D, NSA_IN, NSA_P, base, scr, r, lane); else transpose_item(P(diff_w_in) + (size_t)j * D * DIFF_IN, D, DIFF_IN, DIFF_IN, base, scr, r, lane); continue; }
    r -= n_in;
    if (r < 512) { transpose_item((nsa ? P(nsa_w_out) : P(diff_w_out)) + (size_t)j * D * D, D, D, D, base + WT_OUT / 2, scr, r, lane); continue; }
    r -= 512;
    if (r < 2048) { transpose_item(P(w_mlp_in) + (size_t)i * D * DFF, D, DFF, DFF, base + WT_MI / 2, scr, r, lane); continue; }
    r -= 2048;
    if (r < 2048) transpose_item(P(w_mlp_out) + (size_t)i * DFF * D, DFF, D, D, base + WT_MO / 2, scr, r, lane);
  }
}

__device__ __forceinline__ void ph_norm(const float* xin, const float* gvec, const float* mod  , int sh_off, int sc_off, bf16_t* H) {
  const int tid = tid_(), lane = tid & 63, wave = tid >> 6;
  for (int m = bid_() * 8 + wave; m < T; m += gdim_() * 8) {
    const int b = m >> 12;
    const float4* xr = (const float4*)(xin + (size_t)m * D) + lane;
    float4 v[4]; float ss = 0.f;
#pragma unroll
    for (int j = 0; j < 4; ++j) { v[j] = xr[64 * j]; ss += (v[j].x * v[j].x + v[j].y * v[j].y) + (v[j].z * v[j].z + v[j].w * v[j].w); }
    ss = wave_sum(ss);
    const float rstd = 1.0f / sqrtf(ss * (1.0f / D) + EPS);
#pragma unroll
    for (int j = 0; j < 4; ++j) {
      const int col = 4 * lane + 256 * j;
      const float4 g = *(const float4*)(gvec + col), sc = *(const float4*)(mod + (size_t)b * 6144 + sc_off + col), sh = *(const float4*)(mod + (size_t)b * 6144 + sh_off + col);
      const float h0 = v[j].x * rstd * g.x * (1.f + sc.x) + sh.x, h1 = v[j].y * rstd * g.y * (1.f + sc.y) + sh.y;
      const float h2 = v[j].z * rstd * g.z * (1.f + sc.z) + sh.z, h3 = v[j].w * rstd * g.w * (1.f + sc.w) + sh.w;
      uint2 o; o.x = pk2(h0, h1); o.y = pk2(h2, h3);
      *(uint2*)(H + (size_t)m * D + col) = o;
    }
  }
}

struct EpiStore { bf16_t* O; int ld; int relu2;
  __device__ __forceinline__ void operator()(int row, int col, const float* v) const {
    float a = v[0], b = v[1], c = v[2], d = v[3];
    if (relu2) { a = fmaxf(a, 0.f); a *= a; b = fmaxf(b, 0.f); b *= b; c = fmaxf(c, 0.f); c *= c; d = fmaxf(d, 0.f); d *= d; }
    uint2 o; o.x = pk2(a, b); o.y = pk2(c, d); *(uint2*)(O + (size_t)row * ld + col) = o; } };
struct EpiResid { const float* xin; float* xout; const float* gate;
  __device__ __forceinline__ void operator()(int row, int col, const float* v) const {
    const int b = row >> 12; const float4 g = *(const float4*)(gate + (size_t)b * 6144 + col); const float4 xi = *(const float4*)(xin + (size_t)row * D + col);
    float4 o; o.x = xi.x + g.x * v[0]; o.y = xi.y + g.y * v[1]; o.z = xi.z + g.z * v[2]; o.w = xi.w + g.w * v[3];
    *(float4*)(xout + (size_t)row * D + col) = o; } };

template <class Epi>
__device__ __forceinline__ void gemm_naive(const bf16_t* A, int lda, const float* W, int N, int K, unsigned char* lds, const Epi& E) {
  asm volatile("" : "+s"(N), "+s"(K), "+s"(lda));
  float* As = (float*)lds;
  float* Bs = As + 16 * 132;
  const int tid = tid_(), tx = tid & 31, ty = tid >> 5;
  const int nN = (N + 127) / 128, nM = T / 128;
  const int ar = tid >> 2, ak = (tid & 3) * 4, bk = tid >> 5, bc = (tid & 31) * 4;
  for (int u = bid_(); u < nM * nN; u += gdim_()) {
    const int pm = u / nN, pn = u % nN;
    float acc[8][4];
#pragma unroll
    for (int i = 0; i < 8; ++i) { acc[i][0] = 0.f; acc[i][1] = 0.f; acc[i][2] = 0.f; acc[i][3] = 0.f; }
    const bf16_t* Ap = A + (size_t)(pm * 128 + ar) * lda + ak;
    const int wcol = pn * 128 + bc; const bool bok = wcol < N;
    const float* Wp = W + (size_t)bk * N + (bok ? wcol : 0);
    for (int k0 = 0; k0 < K; k0 += 16) {
      const uint2 av = *(const uint2*)(Ap + k0);
      float4 bv = *(const float4*)(Wp + (size_t)k0 * N);
      if (!bok) bv = make_float4(0.f, 0.f, 0.f, 0.f);
      __syncthreads();
      As[(ak + 0) * 132 + ar] = bf2f(av.x & 0xffffu); As[(ak + 1) * 132 + ar] = bf2f(av.x >> 16);
      As[(ak + 2) * 132 + ar] = bf2f(av.y & 0xffffu); As[(ak + 3) * 132 + ar] = bf2f(av.y >> 16);
      *(float4*)(Bs + bk * 128 + bc) = bv;
      __syncthreads();
#pragma unroll
      for (int k = 0; k < 16; ++k) {
        const float4 a0 = *(const float4*)(As + k * 132 + ty * 8), a1 = *(const float4*)(As + k * 132 + ty * 8 + 4);
        const float4 b = *(const float4*)(Bs + k * 128 + tx * 4);
        const float a[8] = {a0.x, a0.y, a0.z, a0.w, a1.x, a1.y, a1.z, a1.w};
#pragma unroll
        for (int i = 0; i < 8; ++i) { acc[i][0] += a[i] * b.x; acc[i][1] += a[i] * b.y; acc[i][2] += a[i] * b.z; acc[i][3] += a[i] * b.w; }
      }
    }
    const int col = pn * 128 + tx * 4;
    if (col < N) {
#pragma unroll
      for (int i = 0; i < 8; ++i) E(pm * 128 + ty * 8 + i, col, acc[i]);
    }
  }
}

__device__ __forceinline__ void head_norm_rope(const float* v, const float* gain, const float* cs  , int sub, float* vn, float* vr) {
  float ss = 0.f;
#pragma unroll
  for (int i = 0; i < 8; ++i) ss += v[i] * v[i];
  ss += __shfl_xor(ss, 1); ss += __shfl_xor(ss, 2); ss += __shfl_xor(ss, 4);
  const float rstd = 1.0f / sqrtf(ss * (1.0f / 64.0f) + EPS);
#pragma unroll
  for (int i = 0; i < 8; ++i) vn[i] = v[i] * rstd * gain[sub * 8 + i];
#pragma unroll
  for (int i = 0; i < 8; ++i) {
    const float other = __shfl_xor(vn[i], 1);
    const float c = cs[i], s = cs[8 + i];
    float r = vn[i];
    if (sub == 0) r = vn[i] * c - other * s;
    else if (sub == 1) r = vn[i] * c + other * s;
    vr[i] = r;
  }
}

__device__ __forceinline__ void ph_post_diff(int j, bf16_t* PROJ) {
  const int tid = tid_(), lane = tid & 63, wave = tid >> 6, sub = lane & 7;
  const float* rope = (const float*)(P(ws) + WS_ROPE);
  for (int m = bid_() * 8 + wave; m < T; m += gdim_() * 8) {
    const float* cs = rope + (size_t)m * 16;
#pragma unroll
    for (int it = 0; it < 4; ++it) {
      bf16_t* ptr = PROJ + (size_t)m * DIFF_IN + it * 512 + lane * 8;
      float v[8], vn[8], vr[8]; unpack8(*(const uint4*)ptr, v);
      const float* gain = (it < 2) ? (P(diff_q_gain) + j * 64) : (P(diff_k_gain) + j * 64);
      head_norm_rope(v, gain, cs, sub, vn, vr);
      const float sc = (it < 2) ? C2 : 1.0f;
#pragma unroll
      for (int i = 0; i < 8; ++i) vr[i] *= sc;
      *(uint4*)ptr = pack8(vr);
    }
  }
}
__device__ __forceinline__ void ph_post_nsa(int j, bf16_t* PROJ, bf16_t* QC) {
  const int tid = tid_(), lane = tid & 63, wave = tid >> 6, sub = lane & 7;
  const float* rope = (const float*)(P(ws) + WS_ROPE);
  for (int m = bid_() * 8 + wave; m < T; m += gdim_() * 8) {
    const float* cs = rope + (size_t)m * 16;
#pragma unroll
    for (int it = 0; it < 2; ++it) {
      bf16_t* ptr = PROJ + (size_t)m * NSA_P + it * 512 + lane * 8;
      float v[8], vn[8], vr[8]; unpack8(*(const uint4*)ptr, v);
      head_norm_rope(v, P(nsa_q_gain) + j * 64, cs, sub, vn, vr);
#pragma unroll
      for (int i = 0; i < 8; ++i) { vr[i] *= C2; vn[i] *= C2; }
      *(uint4*)ptr = pack8(vr);
      *(uint4*)(QC + (size_t)m * D + it * 512 + lane * 8) = pack8(vn);
    }
    {
      const int hi = lane >> 5;
      bf16_t* ptr = PROJ + (size_t)m * NSA_P + (hi ? 2048 : 1536) + (lane & 31) * 8;
      float v[8], vn[8], vr[8]; unpack8(*(const uint4*)ptr, v);
      head_norm_rope(v, P(nsa_k_gain) + j * 192 + (hi ? 128 : 64), cs, sub, vn, vr);
      *(uint4*)ptr = pack8(vr);
    }
  }
}

template <int DV, int MODE>
__device__ __forceinline__ void attn_naive_unit(int b, int qc, const bf16_t* Qp, int ldq, const bf16_t* Kp, const bf16_t* Vp, int ldkv, bf16_t* Op, int ldo, const u64* selmask, unsigned char* lds) {
  constexpr int DVS = DV / 8;
  float* Ks = (float*)lds;
  float* Vs = Ks + 64 * 64;
  const int tid = tid_(), qi = tid & 63, sl = tid >> 6;
  const int qabs = qc * 64 + qi;
  const size_t rowq = (size_t)b * S + qabs;
  float q[64];
#pragma unroll
  for (int i = 0; i < 8; ++i) unpack8(*(const uint4*)(Qp + rowq * ldq + i * 8), q + i * 8);
  float m = -INFINITY, l = 0.f, o[DVS];
#pragma unroll
  for (int i = 0; i < DVS; ++i) o[i] = 0.f;
  u64 msk = 0ull; if (MODE == 1) msk = selmask[qabs];
  const int t_lo = (MODE == 2) ? (qc > 8 ? qc - 8 : 0) : 0;
  for (int tt = t_lo; tt <= qc; ++tt) {
    __syncthreads();
    { const int key = tid >> 3, ch = tid & 7; float f[8];
      unpack8(*(const uint4*)(Kp + ((size_t)b * S + tt * 64 + key) * ldkv + ch * 8), f);
#pragma unroll
      for (int i = 0; i < 8; ++i) Ks[key * 64 + ch * 8 + i] = f[i];
#pragma unroll
      for (int r = 0; r < DV / 64; ++r) {
        unpack8(*(const uint4*)(Vp + ((size_t)b * S + tt * 64 + key) * ldkv + r * 64 + ch * 8), f);
#pragma unroll
        for (int i = 0; i < 8; ++i) Vs[key * DV + r * 64 + ch * 8 + i] = f[i];
      } }
    __syncthreads();
    const bool tile_on = (MODE == 1) ? (((msk >> tt) & 1ull) != 0ull) : true;
    if (tile_on) {
      for (int jk = 0; jk < 64; ++jk) {
        const int key = tt * 64 + jk;
        bool valid = key <= qabs; if (MODE == 2) valid = valid && (key > qabs - 512);
        if (valid) {
          float s = 0.f;
#pragma unroll
          for (int d = 0; d < 64; d += 4) { const float4 kk = *(const float4*)(Ks + jk * 64 + d); s += q[d] * kk.x + q[d + 1] * kk.y + q[d + 2] * kk.z + q[d + 3] * kk.w; }
          const float mn = fmaxf(m, s); const float sc = exp2f(m - mn), pp = exp2f(s - mn);
          l = l * sc + pp;
#pragma unroll
          for (int i = 0; i < DVS; ++i) o[i] = o[i] * sc + pp * Vs[jk * DV + sl * DVS + i];
          m = mn;
        }
      }
    }
  }
  const float inv = l > 0.f ? 1.0f / l : 0.f;
  bf16_t* op = Op + rowq * ldo + sl * DVS;
  if (DVS == 8) { float r[8];
#pragma unroll
    for (int i = 0; i < 8; ++i) r[i] = o[i] * inv;
    *(uint4*)op = pack8(r);
  } else {
#pragma unroll
    for (int h2 = 0; h2 < DVS / 8; ++h2) { float r[8];
#pragma unroll
      for (int i = 0; i < 8; ++i) r[i] = o[h2 * 8 + i] * inv;
      *(uint4*)(op + h2 * 8) = pack8(r); }
  }
}

__device__ __forceinline__ void ph_attn_diff(unsigned char* lds) {
  const bf16_t* PROJ = (const bf16_t*)(P(ws) + WS_PROJ); bf16_t* ATT = (bf16_t*)(P(ws) + WS_ATT);
  const int NU = NB * 64 * 16;
  for (int u = bid_(); u < NU; u += gdim_()) {
    const int vh = u & 15, qc = 63 - ((u >> 4) & 63), b = u >> 10;
    const int h8 = vh >> 1, c = vh & 1;
    attn_naive_unit<128, 0>(b, qc, PROJ + vh * 64, DIFF_IN, PROJ + 1024 + vh * 64, PROJ + 2048 + h8 * 128, DIFF_IN, ATT + c * 1024 + h8 * 128, 2048, nullptr, lds);
  }
}
__device__ __forceinline__ void ph_attn_sel(unsigned char* lds) {
  const bf16_t* PROJ = (const bf16_t*)(P(ws) + WS_PROJ); bf16_t* OSEL = (bf16_t*)(P(ws) + WS_ATT + 32 * MiB);
  const u64* SEL = (const u64*)(P(ws) + WS_SEL);
  const int NU = NB * 64 * 16;
  for (int u = bid_(); u < NU; u += gdim_()) {
    const int hd = u & 15, qc = 63 - ((u >> 4) & 63), b = u >> 10, g = hd >> 2;
    attn_naive_unit<64, 1>(b, qc, PROJ + hd * 64, NSA_P, PROJ + 1536 + g * 64, PROJ + 1792 + g * 64, NSA_P, OSEL + hd * 64, D, SEL + (size_t)(b * 4 + g) * S, lds);
  }
}
__device__ __forceinline__ void ph_attn_win(unsigned char* lds) {
  const bf16_t* PROJ = (const bf16_t*)(P(ws) + WS_PROJ); bf16_t* OWIN = (bf16_t*)(P(ws) + WS_ATT + 64 * MiB);
  const int NU = NB * 64 * 16;
  for (int u = bid_(); u < NU; u += gdim_()) {
    const int hd = u & 15, qc = (u >> 4) & 63, b = u >> 10, g = hd >> 2;
    attn_naive_unit<64, 2>(b, qc, PROJ + hd * 64, NSA_P, PROJ + 2048 + g * 64, PROJ + 2304 + g * 64, NSA_P, OWIN + hd * 64, D, nullptr, lds);
  }
}

__device__ __forceinline__ void ph_compress(int j, unsigned char* lds) {
  const bf16_t* PROJ = (const bf16_t*)(P(ws) + WS_PROJ);
  float* z = (float*)lds;
  float* red = z + 2048;
  float* hid = red + 512;
  float* red2 = hid + 128;
  const int tid = tid_();
  const int NI = NB * 4 * 255 * 2;
  for (int it = bid_(); it < NI; it += gdim_()) {
    const int kv = it & 1, c = (it >> 1) % 255, bg = (it >> 1) / 255, b = bg >> 2, g = bg & 3;
    const float* pe = (kv ? P(nsa_pe_v) : P(nsa_pe_k)) + j * 2048;
    const float* w1 = (kv ? P(nsa_w_cv1) : P(nsa_w_ck1)) + (size_t)j * 2048 * 128;
    const float* w2 = (kv ? P(nsa_w_cv2) : P(nsa_w_ck2)) + (size_t)j * 128 * 64;
    const int colbase = (kv ? 1280 : 1024) + g * 64;
    __syncthreads();
    {
      const int l = tid >> 4, d4 = (tid & 15) * 4;
      const uint2 sv = *(const uint2*)(PROJ + ((size_t)b * S + 16 * c + l) * NSA_P + colbase + d4);
      z[l * 64 + d4 + 0] = bf2f(sv.x & 0xffffu) + pe[l * 64 + d4 + 0]; z[l * 64 + d4 + 1] = bf2f(sv.x >> 16) + pe[l * 64 + d4 + 1];
      z[l * 64 + d4 + 2] = bf2f(sv.y & 0xffffu) + pe[l * 64 + d4 + 2]; z[l * 64 + d4 + 3] = bf2f(sv.y >> 16) + pe[l * 64 + d4 + 3]; }
    __syncthreads();
    { const int n = tid & 127, ks = tid >> 7; float a = 0.f;
      const float* wp = w1 + (size_t)(ks * 512) * 128 + n;
#pragma unroll 8
      for (int k = 0; k < 512; ++k) a += z[ks * 512 + k] * wp[(size_t)k * 128];
      red[ks * 128 + n] = a; }
    __syncthreads();
    if (tid < 128) { const float hsum = red[tid] + red[128 + tid] + red[256 + tid] + red[384 + tid]; hid[tid] = hsum / (1.f + expf(-hsum)); }
    __syncthreads();
    { const int e = tid & 63, sp = tid >> 6; float a = 0.f;
#pragma unroll
      for (int h = 0; h < 16; ++h) a += hid[sp * 16 + h] * w2[(sp * 16 + h) * 64 + e];
      red2[sp * 64 + e] = a; }
    __syncthreads();
    if (tid < 64) {
      float o = 0.f;
#pragma unroll
      for (int sp = 0; sp < 8; ++sp) o += red2[sp * 64 + tid];
      if (kv == 0) { const float ss = wave_sum(o * o); o = o * (1.0f / sqrtf(ss * (1.0f / 64.0f) + EPS)) * P(nsa_k_gain)[j * 192 + tid]; }
      float* dst = (float*)(P(ws) + (kv ? WS_VCMP : WS_KCMP));
      dst[((size_t)bg * 256 + c) * 64 + tid] = o;
    }
  }
}

__device__ __forceinline__ void ph_cmp_attn(unsigned char* lds) {
  float* Kc = (float*)lds;
  float* Pm = Kc + 256 * 65;
  float* imp = Pm + 32 * 256;
  unsigned* selb = (unsigned*)(imp + 8 * 64);
  const bf16_t* QC = (const bf16_t*)(P(ws) + WS_OC);
  const float* KCMP = (const float*)(P(ws) + WS_KCMP); const float* VCMP = (const float*)(P(ws) + WS_VCMP);
  bf16_t* OCMP = (bf16_t*)(P(ws) + WS_ATT);
  u64* SEL = (u64*)(P(ws) + WS_SEL);
  const int tid = tid_();
  const int NU = NB * 4 * 512;
  for (int u = bid_(); u < NU; u += gdim_()) {
    const int qc8 = u & 511, bg = u >> 9, b = bg >> 2, g = bg & 3;
    const int t0 = qc8 * 8;
    int ncv = (t0 + 7 >= 31) ? ((t0 + 7 - 31) / 16 + 1) : 0; if (ncv > 255) ncv = 255;
    __syncthreads();
    for (int i = tid; i < ncv * 64; i += NTHR) Kc[(i >> 6) * 65 + (i & 63)] = KCMP[(size_t)bg * 256 * 64 + i];
    if (tid < 16) selb[tid] = 0u;
    __syncthreads();
    const int r = tid >> 4, sub = tid & 15, qi = r >> 2, hh = r & 3, t = t0 + qi;
    {
      float q[64];
      const bf16_t* qp = QC + ((size_t)b * S + t) * D + (g * 4 + hh) * 64;
#pragma unroll
      for (int i = 0; i < 8; ++i) unpack8(*(const uint4*)(qp + i * 8), q + i * 8);
      float mx = -INFINITY;
#pragma unroll 1
      for (int i = 0; i < 16; ++i) {
        const int c = sub + 16 * i; float a = -INFINITY;
        if (c < ncv && 16 * c + 31 <= t) { a = 0.f;
#pragma unroll
          for (int d = 0; d < 64; ++d) a += q[d] * Kc[c * 65 + d]; }
        Pm[r * 256 + c] = a; mx = fmaxf(mx, a);
      }
      mx = fmaxf(mx, __shfl_xor(mx, 1)); mx = fmaxf(mx, __shfl_xor(mx, 2)); mx = fmaxf(mx, __shfl_xor(mx, 4)); mx = fmaxf(mx, __shfl_xor(mx, 8));
      float sum = 0.f;
#pragma unroll 1
      for (int i = 0; i < 16; ++i) { const float sv = Pm[r * 256 + sub + 16 * i]; const float e = (sv == -INFINITY) ? 0.f : exp2f(sv - mx); Pm[r * 256 + sub + 16 * i] = e; sum += e; }
      sum += __shfl_xor(sum, 1); sum += __shfl_xor(sum, 2); sum += __shfl_xor(sum, 4); sum += __shfl_xor(sum, 8);
      const float inv = sum > 0.f ? 1.0f / sum : 0.f;
#pragma unroll 1
      for (int i = 0; i < 16; ++i) Pm[r * 256 + sub + 16 * i] *= inv;
    }
    __syncthreads();
    {
      float o0 = 0.f, o1 = 0.f, o2 = 0.f, o3 = 0.f;
      const float* vb = VCMP + (size_t)bg * 256 * 64 + sub * 4;
      for (int c = 0; c < ncv; ++c) { const float pr = Pm[r * 256 + c]; const float4 v0 = *(const float4*)(vb + c * 64);
        o0 += pr * v0.x; o1 += pr * v0.y; o2 += pr * v0.z; o3 += pr * v0.w; }
      uint2 ov; ov.x = pk2(o0, o1); ov.y = pk2(o2, o3);
      *(uint2*)(OCMP + ((size_t)b * S + t) * D + (g * 4 + hh) * 64 + sub * 4) = ov;
    }
    {
      const int qi2 = tid >> 6, sb = tid & 63, tq = t0 + qi2, bt = tq >> 6;
      float v = 0.f;
      const int c_lo = (4 * sb - 1 < 0) ? 0 : 4 * sb - 1, c_hi = (4 * sb + 3 > 254) ? 254 : 4 * sb + 3;
      for (int h = 0; h < 4; ++h) for (int c = c_lo; c <= c_hi; ++c) v += Pm[(qi2 * 4 + h) * 256 + c];
      const bool forced = (sb == 0) || (sb == bt) || (sb == bt - 1), valid = sb <= bt;
      imp[qi2 * 64 + sb] = forced ? 1e6f : (valid ? v : -1.0f);
    }
    __syncthreads();
    {
      const int qi2 = tid >> 6, sb = tid & 63;
      const float v = imp[qi2 * 64 + sb]; int cnt = 0;
      for (int s2 = 0; s2 < 64; ++s2) { const float w = imp[qi2 * 64 + s2]; cnt += (w > v || (w == v && s2 < sb)) ? 1 : 0; }
      if (cnt < 16) atomicOr(&selb[qi2 * 2 + (sb >> 5)], 1u << (sb & 31));
    }
    __syncthreads();
    if (tid < 8) SEL[(size_t)bg * S + t0 + tid] = (u64)selb[tid * 2] | ((u64)selb[tid * 2 + 1] << 32);
  }
}

__device__ __forceinline__ void ph_combine_nsa(int j) {
  const bf16_t* PROJ = (const bf16_t*)(P(ws) + WS_PROJ);
  const bf16_t* OCMP = (const bf16_t*)(P(ws) + WS_ATT); const bf16_t* OSEL = OCMP + (size_t)T * D; const bf16_t* OWIN = OSEL + (size_t)T * D;
  bf16_t* OC = (bf16_t*)(P(ws) + WS_OC);
  for (size_t i = (size_t)bid_() * NTHR + tid_(); i < (size_t)T * 128; i += (size_t)gdim_() * NTHR) {
    const size_t m = i >> 7; const int cg8 = (int)(i & 127), hd = cg8 >> 3;
    float gt[3];
#pragma unroll
    for (int r = 0; r < 3; ++r) { const float gl = bf2f(PROJ[m * NSA_P + 2560 + hd * 3 + r]) + P(nsa_b_gate)[j * 48 + hd * 3 + r]; gt[r] = 1.0f / (1.0f + expf(-gl)); }
    float a[8], bb[8], cc[8], o[8];
    unpack8(*(const uint4*)(OCMP + m * D + cg8 * 8), a); unpack8(*(const uint4*)(OSEL + m * D + cg8 * 8), bb); unpack8(*(const uint4*)(OWIN + m * D + cg8 * 8), cc);
#pragma unroll
    for (int k = 0; k < 8; ++k) o[k] = gt[0] * a[k] + gt[1] * bb[k] + gt[2] * cc[k];
    *(uint4*)(OC + m * D + cg8 * 8) = pack8(o);
  }
}
__device__ __forceinline__ void ph_combine_diff(int j) {
  const bf16_t* ATT = (const bf16_t*)(P(ws) + WS_ATT); bf16_t* OC = (bf16_t*)(P(ws) + WS_OC);
  const float lam = ((const float*)(P(ws) + WS_SMALL))[j]; const float osc = 1.0f - lam_init_of(j);
  const int tid = tid_(), lane = tid & 63, wave = tid >> 6;
  for (int m = bid_() * 8 + wave; m < T; m += gdim_() * 8) {
#pragma unroll
    for (int it = 0; it < 2; ++it) {
      const int col = it * 512 + lane * 8;
      float a[8], b2[8], o[8]; unpack8(*(const uint4*)(ATT + (size_t)m * 2048 + col), a); unpack8(*(const uint4*)(ATT + (size_t)m * 2048 + 1024 + col), b2);
      float ss = 0.f;
#pragma unroll
      for (int k = 0; k < 8; ++k) { o[k] = a[k] - lam * b2[k]; ss += o[k] * o[k]; }
      ss += __shfl_xor(ss, 1); ss += __shfl_xor(ss, 2); ss += __shfl_xor(ss, 4); ss += __shfl_xor(ss, 8);
      const float rstd = 1.0f / sqrtf(ss * (1.0f / 128.0f) + EPS);
#pragma unroll
      for (int k = 0; k < 8; ++k) o[k] = o[k] * rstd * P(diff_subln_g)[j * 128 + (col & 127) + k] * osc;
      *(uint4*)(OC + (size_t)m * D + col) = pack8(o);
    }
  }
}

constexpr int N_PHASES = 1 + 4 * 10;
template <int PH> __device__ __forceinline__ void run_phase(unsigned char* lds, int lo, int hi) {
  if (PH < lo || PH >= hi) return;
  bool did = true;
  if constexpr (PH == 0) { ph_prologue(lds); __syncthreads(); ph_weights(lds); }
  else {
    constexpr int i = (PH - 1) / 10, lp = (PH - 1) % 10, j = i >> 1; constexpr bool nsa = (i & 1) == 0;
    float* MOD = (float*)(P(ws) + WS_MOD);
    bf16_t* H = (bf16_t*)(P(ws) + WS_H); bf16_t* PROJ = (bf16_t*)(P(ws) + WS_PROJ); bf16_t* OC = (bf16_t*)(P(ws) + WS_OC); bf16_t* HID = (bf16_t*)(P(ws) + WS_HID);
    const float* mod = MOD + (size_t)i * 4 * 6144;
    const float* xcur = (i == 0 && lp < 7) ? P(x) : P(out);
    if constexpr (lp == 0) ph_norm(xcur, P(ln_mix_g) + i * D, mod, 0, 1024, H);
    const bf16_t* WTL = (const bf16_t*)(P(ws) + WS_WT + (size_t)i * WT_LAYER);
    PG8_LAS unsigned char* l3 = (PG8_LAS unsigned char*)lds;
    if constexpr (lp == 1) {
      constexpr int N = nsa ? NSA_P : DIFF_IN;
      pg8::Gemm g{H, WTL, T, N, D}; pg8::StaticOrder S; S.init(T, N, gdim_(), bid_());
      pg8::EpiBf16<0> E{PROJ, N};
      pg8::gemm_phase<pg8::EpiBf16<0>, pg8::StaticOrder, true, true>(l3, g, S, E);
    }
    if constexpr (lp == 2) { if constexpr (nsa) { ph_post_nsa(j, PROJ, OC); ph_compress(j, lds); } else ph_post_diff(j, PROJ); }
    if constexpr (lp == 3) { if constexpr (nsa) { ph_cmp_attn(lds); ph_attn_win(lds); } else ph_attn_diff(lds); }
    if constexpr (lp == 4) { if constexpr (nsa) ph_attn_sel(lds); else did = false; }
    if constexpr (lp == 5) { if constexpr (nsa) ph_combine_nsa(j); else ph_combine_diff(j); }
    if constexpr (lp == 6) {
      pg8::Gemm g{OC, WTL + WT_OUT / 2, T, D, D}; pg8::StaticOrder S; S.init(T, D, gdim_(), bid_());
      pg8::EpiResid E{xcur, P(out), mod + 2048};
      pg8::gemm_phase<pg8::EpiResid, pg8::StaticOrder, true, true>(l3, g, S, E);
    }
    if constexpr (lp == 7) ph_norm(P(out), P(ln_mlp_g) + i * D, mod, 3072, 4096, H);
    if constexpr (lp == 8) {
      pg8::Gemm g{H, WTL + WT_MI / 2, T, DFF, D}; pg8::StaticOrder S; S.init(T, DFF, gdim_(), bid_());
      pg8::EpiBf16<2> E{HID, DFF};
      pg8::gemm_phase<pg8::EpiBf16<2>, pg8::StaticOrder, true, true>(l3, g, S, E);
    }
    if constexpr (lp == 9) {
      pg8::Gemm g{HID, WTL + WT_MO / 2, T, D, DFF}; pg8::StaticOrder S; S.init(T, D, gdim_(), bid_());
      pg8::EpiResid E{P(out), P(out), mod + 5120};
      pg8::gemm_phase<pg8::EpiResid, pg8::StaticOrder, true, true>(l3, g, S, E);
    }
  }
  if (did && PH + 1 < hi) cg::this_grid().sync();
}
template <int... I> __device__ __forceinline__ void run_all(std::integer_sequence<int, I...>, unsigned char* lds, int lo, int hi) { (run_phase<I>(lds, lo, hi), ...); }
__global__ void __launch_bounds__(NTHR) fwd_kernel(Params p) {
  extern __shared__ __attribute__((aligned(16))) unsigned char lds[];
  run_all(std::make_integer_sequence<int, N_PHASES>{}, lds, p.ph_lo, p.ph_hi);
}

extern "C" void kernel_launch(void* const* d_in, const int* in_sizes, int n_in, void* d_out, int out_size, void* d_ws, size_t ws_size, hipStream_t stream) {
  static int grid = 0;
  if (grid == 0) {
    if (n_in != 29 || out_size != T * D || ws_size < WS_END) { fprintf(stderr, "kernel_launch: unexpected problem (n_in %d, out %d, ws %zu)\n", n_in, out_size, ws_size); grid = -1; return; }
    int dev = 0, cus = 0, per_cu = 0;
    hipGetDevice(&dev); hipDeviceGetAttribute(&cus, hipDeviceAttributeMultiprocessorCount, dev);
    hipFuncSetAttribute((const void*)fwd_kernel, hipFuncAttributeMaxDynamicSharedMemorySize, LDS_BYTES);
    hipOccupancyMaxActiveBlocksPerMultiprocessor(&per_cu, (const void*)fwd_kernel, NTHR, LDS_BYTES);
    if (per_cu < 1) { fprintf(stderr, "kernel_launch: occupancy query says %d blocks/CU\n", per_cu); per_cu = 1; }
    grid = cus * 1;
    (void)hipGetLastError();
  }
  if (grid < 0) return;
  Params p{};
  memcpy((void*)&p, (const void*)d_in, 29 * sizeof(void*));
  p.out = (float*)d_out; p.ws = (unsigned char*)d_ws; p.ph_lo = 0; p.ph_hi = N_PHASES;
  void* args[] = {&p};
  hipError_t e = hipLaunchCooperativeKernel((const void*)fwd_kernel, dim3(grid), dim3(NTHR), args, LDS_BYTES, stream);
  if (e != hipSuccess) fprintf(stderr, "cooperative launch failed: %s (grid %d)\n", hipGetErrorString(e), grid);
}
```

```cpp
#include <hip/hip_runtime.h>
#include <hip/hip_cooperative_groups.h>
#include <hip/hip_bf16.h>
#include <cstdio>
#include <cstdint>
#include <cstring>
#include <utility>
namespace cg = cooperative_groups;

typedef unsigned short bf16_t;
typedef unsigned long long u64;

constexpr int D = 1024, NB = 4, S = 4096, T = NB * S, DFF = 4096;
constexpr int NSA_IN = 2608, NSA_P = 2816, DIFF_IN = 3072;
constexpr float EPS = 1e-6f;
constexpr float C2 = 0.125f * 1.4426950408889634f;
constexpr int NTHR = 512;
constexpr int LDS_BYTES = 147456;

constexpr size_t MiB = 1u << 20;
constexpr size_t WS_MOD = 1 * MiB;
constexpr size_t WS_ROPE = 2 * MiB;
constexpr size_t WS_SMALL = 3 * MiB;
constexpr size_t WS_WT = 4 * MiB;
constexpr size_t WT_LAYER = 24 * MiB, WT_OUT = 6 * MiB, WT_MI = 8 * MiB, WT_MO = 16 * MiB;
constexpr size_t WS_H = 104 * MiB;
constexpr size_t WS_PROJ = 136 * MiB;
constexpr size_t WS_ATT = 232 * MiB;
constexpr size_t WS_OC = 328 * MiB;
constexpr size_t WS_KCMP = 360 * MiB;
constexpr size_t WS_VCMP = 361 * MiB;
constexpr size_t WS_SEL = 362 * MiB;
constexpr size_t WS_HID = 136 * MiB;
constexpr size_t WS_END = 364 * MiB;

struct Params {
  const float* x; const float* c; const int* pos; const float* ln_mix_g; const float* ln_mlp_g;
  const float* w_ada; const float* b_ada; const float* w_mlp_in; const float* w_mlp_out;
  const float* nsa_w_in; const float* nsa_b_gate; const float* nsa_q_gain; const float* nsa_k_gain;
  const float* nsa_pe_k; const float* nsa_w_ck1; const float* nsa_w_ck2; const float* nsa_pe_v; const float* nsa_w_cv1; const float* nsa_w_cv2; const float* nsa_w_out;
  const float* diff_w_in; const float* diff_q_gain; const float* diff_k_gain; const float* diff_lq1; const float* diff_lk1; const float* diff_lq2; const float* diff_lk2; const float* diff_subln_g; const float* diff_w_out;
  float* out; unsigned char* ws; int ph_lo, ph_hi;
};

typedef __attribute__((address_space(4))) const unsigned char* kptr_t;
template <class Tp> __device__ __forceinline__ Tp karg_load(unsigned off) {
  asm volatile("" : "+s"(off));
  kptr_t kp = (kptr_t)__builtin_amdgcn_kernarg_segment_ptr();
  return *(const __attribute__((address_space(4))) Tp*)(kp + off);
}
__device__ __forceinline__ int tid_() { int t = (int)threadIdx.x; asm volatile("" : "+v"(t)); return t; }
__device__ __forceinline__ int bid_() { int t = (int)blockIdx.x; asm volatile("" : "+s"(t)); return t; }
__device__ __forceinline__ int gdim_() { int t = (int)gridDim.x; asm volatile("" : "+s"(t)); return t; }
#define P(m) karg_load<decltype(Params::m)>((unsigned)offsetof(Params, m))
__device__ __forceinline__ float bf2f(unsigned v) { return __uint_as_float(v << 16); }
__device__ __forceinline__ unsigned f2bf(float f) { unsigned u = __float_as_uint(f); return (u + 0x7fffu + ((u >> 16) & 1u)) >> 16; }
__device__ __forceinline__ unsigned pk2(float lo, float hi) { return f2bf(lo) | (f2bf(hi) << 16); }
__device__ __forceinline__ void unpack8(const uint4 v, float* f) {
  f[0] = bf2f(v.x & 0xffffu); f[1] = bf2f(v.x >> 16); f[2] = bf2f(v.y & 0xffffu); f[3] = bf2f(v.y >> 16);
  f[4] = bf2f(v.z & 0xffffu); f[5] = bf2f(v.z >> 16); f[6] = bf2f(v.w & 0xffffu); f[7] = bf2f(v.w >> 16);
}
__device__ __forceinline__ uint4 pack8(const float* f) { uint4 v; v.x = pk2(f[0], f[1]); v.y = pk2(f[2], f[3]); v.z = pk2(f[4], f[5]); v.w = pk2(f[6], f[7]); return v; }
__device__ __forceinline__ float wave_sum(float v) {
#pragma unroll
  for (int o = 1; o < 64; o <<= 1) v += __shfl_xor(v, o);
  return v;
}
__device__ __forceinline__ float lam_init_of(int j) { return j == 0 ? 0.35550906759096934f : 0.5560582041556406f; }

namespace pg8 {
#define PG8_LAS __attribute__((address_space(3)))
typedef unsigned short bf16_t;
typedef short bf16x8 __attribute__((ext_vector_type(8)));
typedef float f32x4 __attribute__((ext_vector_type(4)));
typedef unsigned u32x4 __attribute__((ext_vector_type(4)));
constexpr int BM = 256, BK = 64, HALF = 128, HTB = HALF * BK * 2  , STAGE_BYTES = 8 * HTB, NXCD = 8, WGM = 8;

__host__ __device__ __forceinline__ int lds_byte(int r, int c) { const int st = (r >> 4) * 2 + (c >> 5), rr = r & 15, cc = c & 31, ob = rr * 64 + cc * 2; return st * 1024 + (ob ^ (((ob >> 9) & 1) << 5)); }
__host__ __device__ __forceinline__ void stage_rc(int b, int& R, int& C) { const int st = b / 1024, sb = b % 1024, swz = sb ^ (((sb >> 9) & 1) << 5); R = (st >> 1) * 16 + swz / 64; C = (st & 1) * 32 + (swz % 64) / 2; }
__host__ __device__ __forceinline__ int perm32(int rho) { const int n = rho >> 4, i = rho & 15; return 8 * (i >> 2) + 4 * n + (i & 3); }

struct Unit { int pm, pn; };
struct Gemm { const bf16_t* A; const bf16_t* Bt; int M, N, K; };

struct StaticOrder {
    int nM, nN, nwg, G, c;
    __host__ __device__ void init(int M, int N, int G_, int c_) { nM = M / BM; nN = N / BM; nwg = nM * nN; G = G_; c = c_; }
    __host__ __device__ bool next(int i, Unit& u) const {
        const long L = (long)i * G + c; if (L >= nwg) return false;
        int wgid = (int)L; { const int q = nwg / NXCD, r = nwg % NXCD, xcd = wgid % NXCD, off = wgid / NXCD; wgid = (xcd < r ? xcd * (q + 1) : r * (q + 1) + (xcd - r) * q) + off; }
        const int nig = WGM * nN, gid = wgid / nig, fm = gid * WGM, gsz = (nM - fm) < WGM ? (nM - fm) : WGM;
        u.pm = fm + ((wgid % nig) % gsz); u.pn = (wgid % nig) / gsz; return true;
    }
    __device__ __forceinline__ void a_ready(const Unit&) const {}
    __device__ __forceinline__ void done(const Unit&) const {}
};


__device__ __forceinline__ unsigned cvt_pk_bf16(float lo, float hi) { unsigned r; asm volatile("v_cvt_pk_bf16_f32 %0, %1, %2" : "=v"(r) : "v"(lo), "v"(hi)); return r; }
template <int ACT  > struct EpiBf16 {
    static constexpr bool PERM = true, AFTER_DRAIN = false;
    bf16_t* O; int ldc;
    __device__ __forceinline__ void operator()(const f32x4 (&acc)[2][2][4][2], const Unit& u, int wr, int wc, int fr, int fq) const {
        const int row0 = u.pm * BM + wr * 64 + fr; const int col0 = u.pn * BM + wc * 32 + 8 * fq;
#pragma unroll
        for (int ai = 0; ai < 2; ++ai)
#pragma unroll
            for (int m = 0; m < 4; ++m) { bf16_t* rowp = O + (size_t)(row0 + ai * HALF + m * 16) * ldc + col0;
#pragma unroll
                for (int bj = 0; bj < 2; ++bj) { f32x4 v0 = acc[ai][bj][m][0], v1 = acc[ai][bj][m][1];
                    if (ACT == 2) {
#pragma unroll
                        for (int e = 0; e < 4; ++e) { float a = v0[e] > 0.f ? v0[e] : 0.f; v0[e] = a * a; float b = v1[e] > 0.f ? v1[e] : 0.f; v1[e] = b * b; } }
                    u32x4 w; w.x = cvt_pk_bf16(v0[0], v0[1]); w.y = cvt_pk_bf16(v0[2], v0[3]); w.z = cvt_pk_bf16(v1[0], v1[1]); w.w = cvt_pk_bf16(v1[2], v1[3]);
                    *(u32x4*)(rowp + bj * HALF) = w; } }
    }
};
struct EpiResid {
    static constexpr bool PERM = false, AFTER_DRAIN = false;
    const float* xin; float* xout; const float* gate;
    __device__ __forceinline__ void operator()(const f32x4 (&acc)[2][2][4][2], const Unit& u, int wr, int wc, int fr, int fq) const {
        const int col0 = u.pn * BM + wc * 32 + 4 * fq; const int b = (u.pm * BM) >> 12;
        f32x4 gv[2][2];
#pragma unroll
        for (int bj = 0; bj < 2; ++bj)
#pragma unroll
            for (int n = 0; n < 2; ++n) gv[bj][n] = *(const f32x4*)(gate + (size_t)b * 6144 + col0 + bj * HALF + n * 16);
#pragma unroll
        for (int ai = 0; ai < 2; ++ai)
#pragma unroll
            for (int m = 0; m < 4; ++m) { const size_t off = (size_t)(u.pm * BM + ai * HALF + wr * 64 + m * 16 + fr) * 1024 + col0;
#pragma unroll
                for (int bj = 0; bj < 2; ++bj)
#pragma unroll
                    for (int n = 0; n < 2; ++n) { const f32x4 xi = *(const f32x4*)(xin + off + bj * HALF + n * 16); *(f32x4*)(xout + off + bj * HALF + n * 16) = xi + gv[bj][n] * acc[ai][bj][m][n]; }
                if (m & 1) asm volatile("" ::: "memory"); }
    }
};

template <class Epi, class Sched, bool ALIGN_EPI = false, bool SP2 = false>
__device__ __forceinline__ void gemm_phase(PG8_LAS unsigned char* lds, const Gemm g, const Sched& S, const Epi& E) {
    const int tid = tid_(), wid = __builtin_amdgcn_readfirstlane(tid >> 6), lane = tid & 63, wr = wid >> 2, wc = wid & 3, fr = lane & 15, fq = lane >> 4;
    const int K = g.K, nt = K / BK;
    unsigned voffA[2], voffB[2];
#pragma unroll
    for (int i = 0; i < 2; ++i) { int R, C; stage_rc(tid * 16 + i * 8192, R, C); const int Rb = Epi::PERM ? ((R & ~31) + perm32(R & 31)) : R;
        voffA[i] = (unsigned)(R * K + C) * 2u; voffB[i] = (unsigned)(Rb * K + C) * 2u; }
    const size_t kstep = (size_t)(BK * 2);
    const size_t hstep = (size_t)HALF * K * 2;
    const size_t tstep = 2 * hstep;
    const unsigned ldsw = (unsigned)wid * 1024u;
    const int aoff = lds_byte(wr * 64 + fr, fq * 8), boff = lds_byte(wc * 32 + fr, fq * 8);
#define PG8_SA(b, h) (((b) * 2 + (h)) * HTB)
#define PG8_SB(b, h) ((4 + (b) * 2 + (h)) * HTB)
#define PG8_STAGE(bufoff, gbase, voff) do { _Pragma("unroll") for (int _i = 0; _i < 2; ++_i) \
        __builtin_amdgcn_global_load_lds((const unsigned*)((const char*)(gbase) + (voff)[_i]), (PG8_LAS unsigned*)(lds + (bufoff) + ldsw + _i * 8192), 16, 0, 0); } while (0)
#define PG8_LDA(dst, b, h) do { _Pragma("unroll") for (int m = 0; m < 4; ++m) _Pragma("unroll") for (int k = 0; k < 2; ++k) dst[m][k] = *(const PG8_LAS bf16x8*)(lds + PG8_SA(b, h) + aoff + m * 2048 + k * 1024); } while (0)
#define PG8_LDB(dst, b, h) do { _Pragma("unroll") for (int n = 0; n < 2; ++n) _Pragma("unroll") for (int k = 0; k < 2; ++k) dst[n][k] = *(const PG8_LAS bf16x8*)(lds + PG8_SB(b, h) + boff + n * 2048 + k * 1024); } while (0)
#define PG8_MMA(ai, bj, At, Bt) do { __builtin_amdgcn_s_setprio(1); _Pragma("unroll") for (int m = 0; m < 4; ++m) _Pragma("unroll") for (int n = 0; n < 2; ++n) _Pragma("unroll") for (int k = 0; k < 2; ++k) \
        acc[ai][bj][m][n] = __builtin_amdgcn_mfma_f32_16x16x32_bf16(Bt[n][k], At[m][k], acc[ai][bj][m][n], 0, 0, 0); __builtin_amdgcn_s_setprio(0); } while (0)
#define PG8_WAIT_V(n) asm volatile("s_waitcnt vmcnt(" #n ")" ::: "memory")
#define PG8_WAIT_L(n) asm volatile("s_waitcnt lgkmcnt(" #n ")" ::: "memory")
#define PG8_BAR __builtin_amdgcn_s_barrier()
#define PG8_SCHED __builtin_amdgcn_sched_barrier(0)
    Unit cur, nxt; int ui = 0;
    if (!S.next(0, cur)) return;
    f32x4 acc[2][2][4][2];
#pragma unroll
    for (int a = 0; a < 2; ++a)
#pragma unroll
        for (int b = 0; b < 2; ++b)
#pragma unroll
            for (int m = 0; m < 4; ++m)
#pragma unroll
                for (int n = 0; n < 2; ++n) acc[a][b][m][n] = (f32x4){0.f, 0.f, 0.f, 0.f};
    bf16x8 At[4][2], B0[2][2], B1[2][2];
    const char* cA = (const char*)g.A + (size_t)cur.pm * tstep; const char* cB = (const char*)g.Bt + (size_t)cur.pn * tstep;
    S.a_ready(cur);
    if constexpr (SP2) {
        PG8_STAGE(PG8_SB(0, 0), cB, voffB); PG8_STAGE(PG8_SB(0, 1), cB + hstep, voffB); PG8_STAGE(PG8_SA(0, 0), cA, voffA); PG8_STAGE(PG8_SA(0, 1), cA + hstep, voffA);
        if (wr == 1) PG8_BAR;
        PG8_WAIT_V(2); PG8_BAR;
        PG8_STAGE(PG8_SB(1, 0), cB + kstep, voffB); PG8_STAGE(PG8_SA(1, 0), cA + kstep, voffA); PG8_STAGE(PG8_SB(1, 1), cB + hstep + kstep, voffB);
        PG8_WAIT_V(6); PG8_BAR;
    } else {
        PG8_STAGE(PG8_SB(0, 0), cB, voffB); PG8_STAGE(PG8_SA(0, 0), cA, voffA); PG8_STAGE(PG8_SB(0, 1), cB + hstep, voffB); PG8_STAGE(PG8_SA(0, 1), cA + hstep, voffA);
        if (wr == 1) PG8_BAR;
        PG8_WAIT_V(4); PG8_BAR;
        PG8_STAGE(PG8_SB(1, 0), cB + kstep, voffB); PG8_STAGE(PG8_SA(1, 0), cA + kstep, voffA); PG8_STAGE(PG8_SB(1, 1), cB + hstep + kstep, voffB);
        PG8_WAIT_V(6); PG8_BAR;
    }
    for (;;) {
        const bool has_next = S.next(ui + 1, nxt);
        const char* nA = has_next ? (const char*)g.A + (size_t)nxt.pm * tstep : cA; const char* nB = has_next ? (const char*)g.Bt + (size_t)nxt.pn * tstep : cB;
        for (int t = 0; t < nt; t += 2) {
            const bool last = (t == nt - 2);
            const char* a1 = cA + (size_t)(t + 1) * kstep;
            const char* a2 = last ? nA : cA + (size_t)(t + 2) * kstep; const char* b2 = last ? nB : cB + (size_t)(t + 2) * kstep;
            const char* a3 = a2 + kstep; const char* b3 = b2 + kstep;
            if (last && has_next) S.a_ready(nxt);
            if constexpr (SP2) {
            PG8_LDB(B0, 0, 0); PG8_LDB(B1, 0, 1); PG8_SCHED; PG8_LDA(At, 0, 0); PG8_STAGE(PG8_SA(1, 1), a1 + hstep, voffA);
            PG8_WAIT_V(8); PG8_WAIT_L(0); PG8_BAR; PG8_MMA(0, 0, At, B0); PG8_MMA(0, 1, At, B1); PG8_BAR; PG8_SCHED;
            PG8_LDA(At, 0, 1); PG8_STAGE(PG8_SB(0, 0), b2, voffB); PG8_STAGE(PG8_SB(0, 1), b2 + hstep, voffB); PG8_STAGE(PG8_SA(0, 0), a2, voffA);
            PG8_WAIT_V(8); PG8_WAIT_L(0); PG8_BAR; PG8_MMA(1, 0, At, B0); PG8_MMA(1, 1, At, B1); PG8_BAR; PG8_SCHED;
            PG8_LDB(B0, 1, 0); PG8_LDB(B1, 1, 1); PG8_SCHED; PG8_LDA(At, 1, 0); PG8_STAGE(PG8_SA(0, 1), a2 + hstep, voffA);
            PG8_WAIT_V(8); PG8_WAIT_L(0); PG8_BAR; PG8_MMA(0, 0, At, B0); PG8_MMA(0, 1, At, B1); PG8_BAR; PG8_SCHED;
            PG8_LDA(At, 1, 1); PG8_STAGE(PG8_SB(1, 0), b3, voffB); PG8_STAGE(PG8_SB(1, 1), b3 + hstep, voffB); PG8_STAGE(PG8_SA(1, 0), a3, voffA);
            PG8_WAIT_V(8); PG8_WAIT_L(0); PG8_BAR; PG8_MMA(1, 0, At, B0); PG8_MMA(1, 1, At, B1); PG8_BAR; PG8_SCHED;
            } else {
            PG8_LDB(B0, 0, 0); PG8_SCHED; PG8_LDA(At, 0, 0); PG8_STAGE(PG8_SA(1, 1), a1 + hstep, voffA);
            PG8_WAIT_L(8); PG8_BAR; PG8_WAIT_L(0); PG8_MMA(0, 0, At, B0); PG8_BAR; PG8_SCHED;
            PG8_LDB(B1, 0, 1); PG8_STAGE(PG8_SB(0, 0), b2, voffB);
            PG8_BAR; PG8_WAIT_L(0); PG8_MMA(0, 1, At, B1); PG8_BAR;
            PG8_LDA(At, 0, 1); PG8_STAGE(PG8_SA(0, 0), a2, voffA);
            PG8_BAR; PG8_WAIT_L(0); PG8_MMA(1, 0, At, B0); PG8_BAR; PG8_SCHED;
            PG8_STAGE(PG8_SB(0, 1), b2 + hstep, voffB);
            PG8_WAIT_V(6); PG8_BAR; PG8_MMA(1, 1, At, B1); PG8_BAR;
            PG8_LDB(B0, 1, 0); PG8_SCHED; PG8_LDA(At, 1, 0); PG8_STAGE(PG8_SA(0, 1), a2 + hstep, voffA);
            PG8_WAIT_L(8); PG8_BAR; PG8_WAIT_L(0); PG8_MMA(0, 0, At, B0); PG8_BAR; PG8_SCHED;
            PG8_LDB(B1, 1, 1); PG8_STAGE(PG8_SB(1, 0), b3, voffB);
            PG8_BAR; PG8_WAIT_L(0); PG8_MMA(0, 1, At, B1); PG8_BAR;
            PG8_LDA(At, 1, 1); PG8_STAGE(PG8_SA(1, 0), a3, voffA);
            PG8_BAR; PG8_WAIT_L(0); PG8_MMA(1, 0, At, B0); PG8_BAR; PG8_SCHED;
            PG8_STAGE(PG8_SB(1, 1), b3 + hstep, voffB);
            PG8_WAIT_V(6); PG8_BAR; PG8_MMA(1, 1, At, B1); PG8_BAR;
            }
        }
        if constexpr (ALIGN_EPI) { if (wr == 0) PG8_BAR; }
        if constexpr (!Epi::AFTER_DRAIN) { E(acc, cur, wr, wc, fr, fq); S.done(cur); }
        if (!has_next) break;
#pragma unroll
        for (int a = 0; a < 2; ++a)
#pragma unroll
            for (int b = 0; b < 2; ++b)
#pragma unroll
                for (int m = 0; m < 4; ++m)
#pragma unroll
                    for (int n = 0; n < 2; ++n) acc[a][b][m][n] = (f32x4){0.f, 0.f, 0.f, 0.f};
        cur = nxt; cA = nA; cB = nB; ++ui;
        if constexpr (ALIGN_EPI) { if (wr == 1) PG8_BAR; }
    }
    PG8_WAIT_V(0);
    if constexpr (!ALIGN_EPI) { if (wr == 0) PG8_BAR; }
    PG8_BAR;
    if constexpr (Epi::AFTER_DRAIN) { E.fused(acc, cur, wr, wc, fr, fq, lds, wid, lane); S.done(cur); }
#undef PG8_SA
#undef PG8_SB
#undef PG8_STAGE
#undef PG8_LDA
#undef PG8_LDB
#undef PG8_MMA
#undef PG8_WAIT_V
#undef PG8_WAIT_L
#undef PG8_BAR
#undef PG8_SCHED
}
}

namespace attn_body {
using bf16=__hip_bfloat16;
using bf16x8=__attribute__((ext_vector_type(8)))short;
using s16x4=__attribute__((ext_vector_type(4)))short;
using f32x16=__attribute__((ext_vector_type(16)))float;
using u32x4=__attribute__((ext_vector_type(4)))unsigned;
constexpr int D=64;
constexpr int NW=8,QBLK=32,QB=QBLK*NW,KVBLK=64;
__device__ __forceinline__ int crow(int r,int hi){return (r&3)+8*(r>>2)+4*hi;}
#define SBAR() __builtin_amdgcn_sched_barrier(0)
__device__ __forceinline__ void cmask(f32x16&p0,f32x16&p1,int jb,int qrel,int hi){
  const float NEG=-INFINITY; int kb=64*jb+4*hi;
  #pragma unroll
  for(int r=0;r<16;++r){int kv=kb+(r&3)+8*(r>>2); if(kv>qrel)p0[r]=NEG; if(kv+32>qrel)p1[r]=NEG;}
}

__device__ __forceinline__ void lmask(f32x16&p0,f32x16&p1,int t,int qrel,int hi){
  const float NEG=-30000.f; int kb=64*t+4*hi;
  #pragma unroll
  for(int r=0;r<16;++r){int kv=kb+(r&3)+8*(r>>2); if(kv<=qrel)p0[r]=NEG; if(kv+32<=qrel)p1[r]=NEG;}
}
__device__ __forceinline__ void smask(f32x16&p0,f32x16&p1,bool on){
  const float NEG=-INFINITY;
  #pragma unroll
  for(int r=0;r<16;++r){ p0[r]=on?p0[r]:NEG; p1[r]=on?p1[r]:NEG; }
}
constexpr int NSLOT=3, SLOTB=8192;
constexpr int LDS_K=0, LDS_V=NSLOT*SLOTB, LDS_WS=2*NSLOT*SLOTB, LDS_OST=LDS_WS+NW*64*4, LDS_BYTES=LDS_OST+NW*4096;
constexpr float C2=0.125f*1.4426950408889634f;
__device__ __forceinline__ void glds16(const void*gsrc,unsigned lds_dst){unsigned keep;
  asm volatile("s_mov_b32 %0, m0\n\ts_mov_b32 m0, %2\n\ts_nop 0\n\tglobal_load_lds_dwordx4 %1, off\n\ts_mov_b32 m0, %0":"=&s"(keep):"v"(gsrc),"s"(lds_dst):"memory");}
__device__ __forceinline__ float max3f(float a,float b,float c){float r;asm("v_max3_f32 %0, %1, %2, %3":"=v"(r):"v"(a),"v"(b),"v"(c));return r;}
__device__ __forceinline__ float max2f(float a,float b){float r;asm("v_max_f32_e32 %0, %1, %2":"=v"(r):"v"(a),"v"(b));return r;}
__device__ __forceinline__ float fadd_s(float a,float b){float r;asm("v_add_f32_e32 %0, %1, %2":"=v"(r):"v"(a),"v"(b));return r;}
__device__ __forceinline__ float fsub_s(float a,float b){float r;asm("v_sub_f32_e32 %0, %1, %2":"=v"(r):"v"(a),"v"(b));return r;}
typedef float f32x2_t __attribute__((ext_vector_type(2))); typedef __bf16 bf16x2_t __attribute__((ext_vector_type(2)));
__device__ __forceinline__ unsigned cvtpk_s(float lo,float hi){f32x2_t v={lo,hi};bf16x2_t b=__builtin_convertvector(v,bf16x2_t);return __builtin_bit_cast(unsigned,b);}
#define WAIT_BAR(N) asm volatile("s_waitcnt vmcnt(" #N ") lgkmcnt(0)\n\ts_barrier":::"memory")

__device__ __forceinline__ void qkt(f32x16&p0,f32x16&p1,const char*Kslot,const bf16x8*qr,const f32x16&negm,int r32,int hi){
  const char*kb=Kslot+hi*1024+r32*16;
  #pragma unroll
  for(int d0=0;d0<4;++d0){
    const bf16x8 b0=*reinterpret_cast<const bf16x8*>(kb+d0*2048);
    const bf16x8 b1=*reinterpret_cast<const bf16x8*>(kb+d0*2048+512);
    if(d0==0){p0=__builtin_amdgcn_mfma_f32_32x32x16_bf16(b0,qr[0],negm,0,0,0);p1=__builtin_amdgcn_mfma_f32_32x32x16_bf16(b1,qr[0],negm,0,0,0);}
    else{p0=__builtin_amdgcn_mfma_f32_32x32x16_bf16(b0,qr[d0],p0,0,0,0);p1=__builtin_amdgcn_mfma_f32_32x32x16_bf16(b1,qr[d0],p1,0,0,0);}}
}
typedef __attribute__((address_space(3))) const char* lds_cptr;
typedef short v4i16_t __attribute__((ext_vector_type(4)));
__device__ __forceinline__ void kload8(bf16x8*kf,lds_cptr kp){
  kf[0]=*(const __attribute__((address_space(3))) bf16x8*)(kp);      kf[1]=*(const __attribute__((address_space(3))) bf16x8*)(kp+512);
  kf[2]=*(const __attribute__((address_space(3))) bf16x8*)(kp+2048); kf[3]=*(const __attribute__((address_space(3))) bf16x8*)(kp+2560);
  kf[4]=*(const __attribute__((address_space(3))) bf16x8*)(kp+4096); kf[5]=*(const __attribute__((address_space(3))) bf16x8*)(kp+4608);
  kf[6]=*(const __attribute__((address_space(3))) bf16x8*)(kp+6144); kf[7]=*(const __attribute__((address_space(3))) bf16x8*)(kp+6656);
}
__device__ __forceinline__ void kload2(bf16x8*kf,lds_cptr kp,int j){ kf[2*j]=*(const __attribute__((address_space(3))) bf16x8*)(kp+j*2048); kf[2*j+1]=*(const __attribute__((address_space(3))) bf16x8*)(kp+j*2048+512); }
__device__ __forceinline__ s16x4 vtr(lds_cptr p){ return __builtin_bit_cast(s16x4,__builtin_amdgcn_ds_read_tr16_b64_v4i16((__attribute__((address_space(3))) v4i16_t*)p)); }
__device__ __forceinline__ float rowmax(const f32x16&p0,const f32x16&p1){
  float a=max3f(p0[0],p0[1],p1[0]),b=max3f(p0[2],p0[3],p1[1]);a=max3f(a,p1[2],p1[3]);
  #pragma unroll
  for(int r=4;r<16;r+=4){a=max3f(a,p0[r],p0[r+1]);b=max3f(b,p0[r+2],p0[r+3]);a=max3f(a,p1[r],p1[r+1]);b=max3f(b,p1[r+2],p1[r+3]);}
  const float m=max2f(a,b);
  auto rr=__builtin_amdgcn_permlane32_swap(__float_as_uint(m),__float_as_uint(m),false,false);
  return max2f(__uint_as_float(rr[0]),__uint_as_float(rr[1]));
}
__device__ __forceinline__ void pv(f32x16*o,int vb,bf16x8 pa0,bf16x8 pa1,bf16x8 pa2,bf16x8 pa3){
  #pragma unroll
  for(int d0=0;d0<2;++d0){s16x4 lo[4],hi[4];
    #pragma unroll
    for(int ks=0;ks<4;++ks){
      asm volatile("ds_read_b64_tr_b16 %0,%1 offset:%c2":"=&v"(lo[ks]):"v"(vb),"i"(d0*4096+ks*1024):"memory");
      asm volatile("ds_read_b64_tr_b16 %0,%1 offset:%c2":"=&v"(hi[ks]):"v"(vb),"i"(d0*4096+ks*1024+512):"memory");}
    asm volatile("s_waitcnt lgkmcnt(0)":::"memory");SBAR();
    #define PK(k) (bf16x8){lo[k][0],lo[k][1],lo[k][2],lo[k][3],hi[k][0],hi[k][1],hi[k][2],hi[k][3]}
    o[d0]=__builtin_amdgcn_mfma_f32_32x32x16_bf16(pa0,PK(0),o[d0],0,0,0);
    o[d0]=__builtin_amdgcn_mfma_f32_32x32x16_bf16(pa1,PK(1),o[d0],0,0,0);
    o[d0]=__builtin_amdgcn_mfma_f32_32x32x16_bf16(pa2,PK(2),o[d0],0,0,0);
    o[d0]=__builtin_amdgcn_mfma_f32_32x32x16_bf16(pa3,PK(3),o[d0],0,0,0);
    #undef PK
  }
}

#ifndef ATTN_STORE16
#define ATTN_STORE16(p,v) (*(u32x4*)(p)=(v))
#endif
template<int THRL,int MODE> __device__ __forceinline__ void attn_unit(long rowbase,int qb,const bf16*Qh,int ldq,const bf16*__restrict__ Kh0,const bf16*__restrict__ Vh0,int ldkv,bf16*Oh,int ldo,const unsigned long long*selrow,char*shm){
  const int tid=tid_(),lane=tid&63,r32=lane&31,hi=lane>>5; const int wid=__builtin_amdgcn_readfirstlane(tid>>6);
  const int q0=qb*QB;
  int t_lo=0; bool lower=false; if(MODE==2){ if(qb>=2){ t_lo=4*qb-8; lower=true; } }
  const bf16*Qw=Qh+(rowbase+q0+wid*QBLK)*ldq;
  const bf16*Kh=Kh0+(rowbase+(long)t_lo*KVBLK)*ldkv,*Vh=Vh0+(rowbase+(long)t_lo*KVBLK)*ldkv;
  const unsigned lds0=(unsigned)(uintptr_t)shm;
  float*wsf=(float*)(shm+LDS_WS)+wid*64;
  const bf16*ksrc=Kh+(long)lane*ldkv+wid*8;
  const bf16*vsrc=Vh+(long)(16*(wid&3)+(lane>>2))*ldkv+(wid>>2)*32+(lane&3)*8;
  const unsigned kdst=lds0+LDS_K+wid*1024, vdst=lds0+LDS_V+wid*1024;
  #define DMA_K(t,slot) glds16(ksrc+(long)(t)*KVBLK*ldkv,(unsigned)__builtin_amdgcn_readfirstlane(kdst+(slot)))
  #define DMA_V(t,slot) glds16(vsrc+(long)(t)*KVBLK*ldkv,(unsigned)__builtin_amdgcn_readfirstlane(vdst+(slot)))
  const int vb0=(int)(lds0+LDS_V)+((lane>>4)&1)*32+(lane&3)*8+(4*hi+((lane&15)>>2))*64;
  const char*Kbase=shm+LDS_K; bf16x8 kf[8];
  const lds_cptr shm3=(lds_cptr)shm; const lds_cptr kp0=shm3+LDS_K+hi*1024+r32*16; const lds_cptr vp0=shm3+LDS_V+((lane>>4)&1)*32+(lane&3)*8+(4*hi+((lane&15)>>2))*64;
  const int NT=(q0+QB)/KVBLK-t_lo;
  DMA_K(0,0);DMA_V(0,0);DMA_K(1,SLOTB);
  bf16x8 qr[4];
  #pragma unroll
  for(int d0=0;d0<4;++d0)qr[d0]=*reinterpret_cast<const bf16x8*>(&Qw[(long)r32*ldq+d0*16+hi*8]);
  float mhat=0.f,l_reg=0.f;f32x16 o[2];o[0]=f32x16{};o[1]=f32x16{};f32x16 negm=f32x16{};asm volatile("":"+v"(negm));
  const int qrel=wid*QBLK+r32;
  unsigned long long msk=0ull; if(MODE==1) msk=selrow[q0+qrel];
  #define XMASK(P0,P1,t) do{ if(MODE==1) smask(P0,P1,((msk>>(t))&1ull)!=0ull); if(MODE==2){ if(lower&&(t)<4) lmask(P0,P1,(t),qrel,hi); } }while(0)
  #define CMASK(P0,P1,t) do{ XMASK(P0,P1,t); int jb_=(t)-(NT-4); if(jb_>=0)cmask(P0,P1,jb_,qrel,hi);}while(0)
  bool resc=false;
  #define START(P0,P1) do{ const float rm=rowmax(P0,P1); resc=false; \
    { const float dl=rm; mhat=fadd_s(mhat,dl); \
      _Pragma("unroll") for(int r=0;r<16;++r){P0[r]=fsub_s(P0[r],dl);P1[r]=fsub_s(P1[r],dl);} \
      _Pragma("unroll") for(int r=0;r<16;++r)negm[r]=-mhat; asm volatile("":"+v"(negm)); } \
    _Pragma("unroll") for(int r=0;r<16;++r)P0[r]=__builtin_amdgcn_exp2f(P0[r]); }while(0)
  #define RESC() do{ if(resc){ asm volatile("s_waitcnt lgkmcnt(0)":::"memory"); \
      _Pragma("unroll") for(int d_=0;d_<2;++d_) _Pragma("unroll") for(int r=0;r<16;++r)o[d_][r]*=wsf[crow(r,hi)]; } }while(0)
  f32x16 pA0,pA1,pB0,pB1;
  int sl_prev=0,sl_cur=0,sl_next=SLOTB;
  #define ROT() do{sl_prev=sl_cur;sl_cur=sl_next;sl_next=(sl_next==(NSLOT-1)*SLOTB)?0:sl_next+SLOTB;}while(0)
  DMA_K(2,2*SLOTB);
  WAIT_BAR(3);
  qkt(pA0,pA1,Kbase,qr,negm,r32,hi);asm volatile("s_nop 15\n\ts_nop 7":"+v"(pA0),"+v"(pA1));CMASK(pA0,pA1,0);
  START(pA0,pA1);
  _Pragma("unroll") for(int r=0;r<16;++r)pA1[r]=__builtin_amdgcn_exp2f(pA1[r]);
  WAIT_BAR(0);
  DMA_K(3,0);DMA_V(1,SLOTB);
  ROT();
  kload8(kf,kp0+sl_cur);
  WAIT_BAR(2);
  s16x4 vlo[8],vhi[8]; u32x4 pw0,pw1,pw2,pw3;
  #define PKW(P,B) cvtpk_s(P[B],P[B+1])
  #define PAF(k) __builtin_bit_cast(bf16x8,pw##k)
  #define VFR(i) (bf16x8){vlo[i][0],vlo[i][1],vlo[i][2],vlo[i][3],vhi[i][0],vhi[i][1],vhi[i][2],vhi[i][3]}
  #define PIN(x) asm volatile("":"+v"(x))
  #define MX3(a,b,c) __builtin_fmaxf(__builtin_fmaxf((a),(b)),(c))
  #define GAPA(MF,A0,A1,A2,A3,W0,W1,PW) do{ MF; sacc+=A0; sacc+=A1; sacc+=A2; sacc+=A3; PIN(sacc); W0; W1; PIN(PW); SBAR(); }while(0)
  #define EX(v) __builtin_amdgcn_exp2f(v)
  #define GAPB(MF,X,B) do{ MF; X[B]=EX(X[B]); X[B+1]=EX(X[B+1]); X[B+2]=EX(X[B+2]); X[B+3]=EX(X[B+3]); PIN(X); SBAR(); }while(0)
  #define VRD(i) do{ vlo[i]=vtr(vp_+(((i)>>2)*4096+((i)&3)*1024)); vhi[i]=vtr(vp_+(((i)>>2)*4096+((i)&3)*1024+512)); }while(0)
  #define KRD(G,j) do{ if(G){ kload2(kf,kp0+sl_next,j); SBAR(); } }while(0)
  #define STEP(C0,C1,P0,P1,t,GK,GV,GL) do{ SBAR(); \
    const lds_cptr vp_=vp0+sl_prev; \
    VRD(0); SBAR(); float sacc=(P0[0]+P0[1]); \
    GAPA(C0=__builtin_amdgcn_mfma_f32_32x32x16_bf16(kf[0],qr[0],negm,0,0,0), P0[2],P0[3],P0[4],P0[5],     pw0[0]=PKW(P0,0), pw0[1]=PKW(P0,2), pw0); \
    VRD(4); SBAR(); GAPA(C1=__builtin_amdgcn_mfma_f32_32x32x16_bf16(kf[1],qr[0],negm,0,0,0), P0[6],P0[7],P0[8],P0[9],     pw0[2]=PKW(P0,4), pw0[3]=PKW(P0,6), pw0); \
    VRD(1); SBAR(); GAPA(C0=__builtin_amdgcn_mfma_f32_32x32x16_bf16(kf[2],qr[1],C0,0,0,0),   P0[10],P0[11],P0[12],P0[13], pw1[0]=PKW(P0,8), pw1[1]=PKW(P0,10), pw1); \
    VRD(5); SBAR(); GAPA(C1=__builtin_amdgcn_mfma_f32_32x32x16_bf16(kf[3],qr[1],C1,0,0,0),   P0[14],P0[15],P1[0],P1[1],   pw1[2]=PKW(P0,12),pw1[3]=PKW(P0,14), pw1); \
    VRD(2); SBAR(); GAPA(C0=__builtin_amdgcn_mfma_f32_32x32x16_bf16(kf[4],qr[2],C0,0,0,0),   P1[2],P1[3],P1[4],P1[5],     pw2[0]=PKW(P1,0), pw2[1]=PKW(P1,2), pw2); \
    VRD(6); SBAR(); GAPA(C1=__builtin_amdgcn_mfma_f32_32x32x16_bf16(kf[5],qr[2],C1,0,0,0),   P1[6],P1[7],P1[8],P1[9],     pw2[2]=PKW(P1,4), pw2[3]=PKW(P1,6), pw2); \
    VRD(3); SBAR(); GAPA(C0=__builtin_amdgcn_mfma_f32_32x32x16_bf16(kf[6],qr[3],C0,0,0,0),   P1[10],P1[11],P1[12],P1[13], pw3[0]=PKW(P1,8), pw3[1]=PKW(P1,10), pw3); \
    VRD(7); SBAR(); GAPA(C1=__builtin_amdgcn_mfma_f32_32x32x16_bf16(kf[7],qr[3],C1,0,0,0),   P1[14],P1[15],0.f,0.f,       pw3[2]=PKW(P1,12),pw3[3]=PKW(P1,14), pw3); \
    l_reg+=sacc; \
    if(GK){DMA_K((t)+3,sl_cur);} if(GV){DMA_V((t)+1,sl_next);} \
    CMASK(C0,C1,t); \
    { float a=MX3(C0[0],C0[1],C1[0]),b=MX3(C0[2],C0[3],C1[1]); a=MX3(a,C1[2],C1[3]); \
      _Pragma("unroll") for(int r=4;r<16;r+=4){a=MX3(a,C0[r],C0[r+1]);b=MX3(b,C0[r+2],C0[r+3]);a=MX3(a,C1[r],C1[r+1]);b=MX3(b,C1[r+2],C1[r+3]);} \
      float rm=__builtin_fmaxf(a,b); { auto rr=__builtin_amdgcn_permlane32_swap(__float_as_uint(rm),__float_as_uint(rm),false,false); rm=__builtin_fmaxf(__uint_as_float(rr[0]),__uint_as_float(rr[1])); } \
      resc=false; \
      if(__builtin_expect(__any(rm>(float)THRL),0)){ const float dl=__builtin_fmaxf(rm,0.f); mhat+=dl; \
        _Pragma("unroll") for(int r=0;r<16;++r){C0[r]-=dl;C1[r]-=dl;} \
        _Pragma("unroll") for(int r=0;r<16;++r)negm[r]=-mhat; asm volatile("":"+v"(negm)); \
        const float f=__builtin_amdgcn_exp2f(-dl); l_reg*=f; if(hi==0)wsf[r32]=f; resc=true; } } \
    SBAR(); \
    GAPB(o[0]=__builtin_amdgcn_mfma_f32_32x32x16_bf16(PAF(0),VFR(0),o[0],0,0,0), C0,0); \
    GAPB(o[1]=__builtin_amdgcn_mfma_f32_32x32x16_bf16(PAF(0),VFR(4),o[1],0,0,0), C0,4); \
    KRD(GL,0); GAPB(o[0]=__builtin_amdgcn_mfma_f32_32x32x16_bf16(PAF(1),VFR(1),o[0],0,0,0), C0,8); \
    KRD(GL,1); GAPB(o[1]=__builtin_amdgcn_mfma_f32_32x32x16_bf16(PAF(1),VFR(5),o[1],0,0,0), C0,12); \
    KRD(GL,2); GAPB(o[0]=__builtin_amdgcn_mfma_f32_32x32x16_bf16(PAF(2),VFR(2),o[0],0,0,0), C1,0); \
    KRD(GL,3); GAPB(o[1]=__builtin_amdgcn_mfma_f32_32x32x16_bf16(PAF(2),VFR(6),o[1],0,0,0), C1,4); \
    GAPB(o[0]=__builtin_amdgcn_mfma_f32_32x32x16_bf16(PAF(3),VFR(3),o[0],0,0,0), C1,8); \
    GAPB(o[1]=__builtin_amdgcn_mfma_f32_32x32x16_bf16(PAF(3),VFR(7),o[1],0,0,0), C1,12); \
    }while(0)
  int t=1;
  #undef CMASK
  #define CMASK(P0,P1,t) XMASK(P0,P1,t)
  for(;t+5<NT;t+=2){
    STEP(pB0,pB1,pA0,pA1,t,true,true,true);     WAIT_BAR(2); RESC(); ROT();
    STEP(pA0,pA1,pB0,pB1,t+1,true,true,true);   WAIT_BAR(2); RESC(); ROT();
  }
  #undef CMASK
  #define CMASK(P0,P1,t) do{ XMASK(P0,P1,t); int jb_=(t)-(NT-4); if(jb_>=0)cmask(P0,P1,jb_,qrel,hi);}while(0)
  #define ENDW(tt) do{ if((tt)+3<NT){WAIT_BAR(2);} else if((tt)+2<NT){WAIT_BAR(1);} else {WAIT_BAR(0);} }while(0)
  for(;t+1<NT;t+=2){
    STEP(pB0,pB1,pA0,pA1,t,(t+3<NT),(t+1<NT),(t+1<NT));       ENDW(t);   RESC(); ROT();
    STEP(pA0,pA1,pB0,pB1,t+1,(t+4<NT),(t+2<NT),(t+2<NT));     ENDW(t+1); RESC(); ROT();
  }
  STEP(pB0,pB1,pA0,pA1,NT-1,false,false,false); RESC();
  { float sacc=pB0[0]+pB0[1]; _Pragma("unroll") for(int r=2;r<16;++r)sacc+=pB0[r]; _Pragma("unroll") for(int r=0;r<16;++r)sacc+=pB1[r]; l_reg+=sacc;
    pw0=(u32x4){PKW(pB0,0),PKW(pB0,2),PKW(pB0,4),PKW(pB0,6)};pw1=(u32x4){PKW(pB0,8),PKW(pB0,10),PKW(pB0,12),PKW(pB0,14)};pw2=(u32x4){PKW(pB1,0),PKW(pB1,2),PKW(pB1,4),PKW(pB1,6)};pw3=(u32x4){PKW(pB1,8),PKW(pB1,10),PKW(pB1,12),PKW(pB1,14)};
    SBAR(); pv(o,vb0+sl_cur,PAF(0),PAF(1),PAF(2),PAF(3)); }
  #undef PKW
  #undef PAF
  #undef VFR
  #undef PIN
  #undef MX3
  #undef GAPA
  #undef GAPB
  #undef EX
  #undef VRD
  #undef KRD
  #undef STEP
  #undef ENDW
  {auto rr=__builtin_amdgcn_permlane32_swap(__float_as_uint(l_reg),__float_as_uint(l_reg),false,false);l_reg=__uint_as_float(rr[0])+__uint_as_float(rr[1]);}
  if(hi==0)wsf[32+r32]=l_reg;asm volatile("s_waitcnt lgkmcnt(0)":::"memory");
  float rli[16];
  #pragma unroll
  for(int r=0;r<16;++r)rli[r]=__builtin_amdgcn_rcpf(wsf[32+crow(r,hi)]);
  bf16*Ow=Oh+(rowbase+q0+wid*QBLK)*ldo;
  { bf16*stg=(bf16*)(shm+LDS_OST)+wid*2048;
    #pragma unroll
    for(int r=0;r<16;++r){const int orow=crow(r,hi);
      #pragma unroll
      for(int d0=0;d0<2;++d0)stg[orow*64+d0*32+r32]=__float2bfloat16(o[d0][r]*rli[r]);}
    asm volatile("s_waitcnt lgkmcnt(0)":::"memory");
    #pragma unroll
    for(int i=0;i<4;++i){const int row=i*8+(lane>>3),ch=lane&7; const u32x4 v=*(const u32x4*)(stg+row*64+ch*8); ATTN_STORE16(Ow+(long)row*ldo+ch*8,v);} }
  asm volatile("s_waitcnt lgkmcnt(0)\n\ts_barrier":::"memory");
  #undef DMA_K
  #undef DMA_V
  #undef CMASK
  #undef XMASK
  #undef START
  #undef RESC
  #undef ROT
}
constexpr int ATTN_LDS_BYTES=LDS_BYTES;
#undef SBAR
#undef WAIT_BAR
}

__device__ __forceinline__ void ph_attn_diff_fast(unsigned char* lds) {
  using namespace attn_body;
  const bf16* PROJ = (const bf16*)(P(ws) + WS_PROJ); bf16* ATT = (bf16*)(P(ws) + WS_ATT);
  const int G = gdim_(), bx = bid_(); const int v0 = (G % 8 == 0) ? (bx % 8) * (G / 8) + bx / 8 : bx;
  for (int vcu = v0; vcu < 256; vcu += G) {
    const int bhp = vcu >> 1, half = bhp & 1, c = (bhp >> 1) & 1, h8 = (bhp >> 2) & 7, b = bhp >> 5;
#pragma unroll 1
    for (int i = 0; i < 8; ++i) { const int sp = 4 * (vcu & 1) + (i >> 1); const int qb = (i & 1) ? 15 - sp : sp;
      attn_unit<8, 0>((long)b * S, qb, PROJ + (h8 * 2 + c) * 64, DIFF_IN, PROJ + 1024 + (h8 * 2 + c) * 64, PROJ + 2048 + h8 * 128 + half * 64, DIFF_IN,
                      ATT + c * 1024 + h8 * 128 + half * 64, 2048, nullptr, (char*)lds); }
  }
}
__device__ __forceinline__ void ph_attn_sel_fast(unsigned char* lds) {
  using namespace attn_body;
  const bf16* PROJ = (const bf16*)(P(ws) + WS_PROJ); bf16* OSEL = (bf16*)(P(ws) + WS_ATT + 32 * MiB);
  const u64* SEL = (const u64*)(P(ws) + WS_SEL);
  const int G = gdim_(), bx = bid_(); const int v0 = (G % 8 == 0) ? (bx % 8) * (G / 8) + bx / 8 : bx;
  for (int vcu = v0; vcu < 256; vcu += G) {
    const int bh = vcu >> 2, hd = bh & 15, b = bh >> 4, g = hd >> 2;
#pragma unroll 1
    for (int i = 0; i < 4; ++i) { const int sp = 2 * (vcu & 3) + (i >> 1); const int qb = (i & 1) ? 15 - sp : sp;
      attn_unit<8, 1>((long)b * S, qb, PROJ + hd * 64, NSA_P, PROJ + 1536 + g * 64, PROJ + 1792 + g * 64, NSA_P, OSEL + hd * 64, 1024, SEL + (size_t)(b * 4 + g) * S, (char*)lds); }
  }
}
__device__ __forceinline__ void ph_attn_win_fast(unsigned char* lds) {
  using namespace attn_body;
  const bf16* PROJ = (const bf16*)(P(ws) + WS_PROJ); bf16* OWIN = (bf16*)(P(ws) + WS_ATT + 64 * MiB);
  const int G = gdim_(), bx = bid_(); const int v0 = (G % 8 == 0) ? (bx % 8) * (G / 8) + bx / 8 : bx;
  for (int vcu = v0; vcu < 256; vcu += G) {
    const int bh = vcu >> 2, hd = bh & 15, b = bh >> 4, g = hd >> 2;
#pragma unroll 1
    for (int i = 0; i < 4; ++i) { const int qb = (vcu & 3) + 4 * i;
      attn_unit<8, 2>((long)b * S, qb, PROJ + hd * 64, NSA_P, PROJ + 2048 + g * 64, PROJ + 2304 + g * 64, NSA_P, OWIN + hd * 64, 1024, nullptr, (char*)lds); }
  }
}

__device__ __forceinline__ void ph_prologue(unsigned char* lds) {
  const int tid = tid_();
  float* silu = (float*)lds;
  float* red = silu + 4096;
  float* MOD = (float*)(P(ws) + WS_MOD);
  for (int i = tid; i < 4096; i += NTHR) { const float v = P(c)[i]; silu[i] = v / (1.f + expf(-v)); }
  __syncthreads();
  for (int item = bid_(); item < 4 * 48; item += gdim_()) {
    const int l = item / 48, nc = item % 48, cc = tid & 127, ks = tid >> 7;
    const float* w = P(w_ada) + ((size_t)l * 1024 + ks * 256) * 6144 + nc * 128 + cc;
    float a0 = 0.f, a1 = 0.f, a2 = 0.f, a3 = 0.f;
#pragma unroll 8
    for (int k = 0; k < 256; ++k) { const float wv = w[(size_t)k * 6144]; const int kk = ks * 256 + k;
      a0 += silu[kk] * wv; a1 += silu[1024 + kk] * wv; a2 += silu[2048 + kk] * wv; a3 += silu[3072 + kk] * wv; }
    red[(ks * 4 + 0) * 128 + cc] = a0; red[(ks * 4 + 1) * 128 + cc] = a1; red[(ks * 4 + 2) * 128 + cc] = a2; red[(ks * 4 + 3) * 128 + cc] = a3;
    __syncthreads();
    { const int b = tid >> 7;
      const float s = red[(0 * 4 + b) * 128 + cc] + red[(1 * 4 + b) * 128 + cc] + red[(2 * 4 + b) * 128 + cc] + red[(3 * 4 + b) * 128 + cc];
      MOD[(size_t)(l * 4 + b) * 6144 + nc * 128 + cc] = s + P(b_ada)[l * 6144 + nc * 128 + cc]; }
    __syncthreads();
  }
  float* rope = (float*)(P(ws) + WS_ROPE);
  for (int m = bid_() * NTHR + tid; m < T; m += gdim_() * NTHR) {
    const float fp = (float)P(pos)[m];
    const float INV[8] = {1.0f, 0.1939227432012558f, 0.03760603070259094f, 0.007292664609849453f, 0.0014142135623842478f, 0.00027424818836152554f, 5.3182957344688475e-05f, 1.0313385246263351e-05f};
#pragma unroll
    for (int i = 0; i < 8; ++i) {
      const float ang = fp * INV[i];
      const double a = (double)ang; const double kq = rint(a * 0.63661977236758134308); const double r = a - kq * 1.57079632679489661923;
      const int q = (int)((long long)kq & 3ll);
      const double r2 = r * r;
      const double sr = r * (1.0 + r2 * (-1.0 / 6 + r2 * (1.0 / 120 + r2 * (-1.0 / 5040 + r2 * (1.0 / 362880 + r2 * (-1.0 / 39916800 + r2 * (1.0 / 6227020800.0)))))));
      const double cr = 1.0 + r2 * (-0.5 + r2 * (1.0 / 24 + r2 * (-1.0 / 720 + r2 * (1.0 / 40320 + r2 * (-1.0 / 3628800 + r2 * (1.0 / 479001600.0))))));
      const double sn = (q == 0) ? sr : (q == 1) ? cr : (q == 2) ? -sr : -cr;
      const double cs = (q == 0) ? cr : (q == 1) ? -sr : (q == 2) ? -cr : sr;
      rope[(size_t)m * 16 + i] = (float)cs; rope[(size_t)m * 16 + 8 + i] = (float)sn;
    }
  }
  if (bid_() == 0 && tid < 2) {
    const int j = tid; float s1 = 0.f, s2 = 0.f;
    for (int i = 0; i < 64; ++i) { s1 += P(diff_lq1)[j * 64 + i] * P(diff_lk1)[j * 64 + i]; s2 += P(diff_lq2)[j * 64 + i] * P(diff_lk2)[j * 64 + i]; }
    ((float*)(P(ws) + WS_SMALL))[j] = expf(s1) - expf(s2) + lam_init_of(j);
  }
}


__device__ __forceinline__ void transpose_item(const float* W, int K, int N, int Npad, bf16_t* WT, float* scr, int item, int lane) {
  const int nblk = Npad / 32, kb = item / nblk, nb = item % nblk, k0 = 64 * kb, n0 = 32 * nb;
  const int ncol = n0 + (lane & 31); const bool ok = ncol < N;
#pragma unroll 8
  for (int i = 0; i < 32; ++i) { const int kk = 2 * i + (lane >> 5); scr[kk * 33 + (lane & 31)] = ok ? W[(size_t)(k0 + kk) * N + ncol] : 0.f; }
  asm volatile("s_waitcnt lgkmcnt(0)" ::: "memory");
  const int c = lane & 7;
#pragma unroll
  for (int j = 0; j < 4; ++j) { const int n = (lane >> 3) + 8 * j; const float* sp = scr + (8 * c) * 33 + n;
    uint4 o; o.x = pk2(sp[0 * 33], sp[1 * 33]); o.y = pk2(sp[2 * 33], sp[3 * 33]); o.z = pk2(sp[4 * 33], sp[5 * 33]); o.w = pk2(sp[6 * 33], sp[7 * 33]);
    *(uint4*)(WT + (size_t)(n0 + n) * K + k0 + 8 * c) = o; }
  asm volatile("s_waitcnt lgkmcnt(0)" ::: "memory");
}
__device__ __forceinline__ void ph_weights(unsigned char* lds) {
  const int tid = tid_(), lane = tid & 63, wave = tid >> 6;
  float* scr = (float*)(lds + wave * 16384);
  const int gw = bid_() * 8 + wave, NGW = gdim_() * 8;
  for (int it = gw; it < 4 * 6144; it += NGW) {
    const int i = it / 6144; int r = it % 6144; const int j = i >> 1; const bool nsa = (i & 1) == 0;
    bf16_t* base = (bf16_t*)(P(ws) + WS_WT + (size_t)i * WT_LAYER);
    const int n_in = nsa ? 16 * (NSA_P / 32) : 16 * (DIFF_IN / 32);
    if (r < n_in) { if (nsa) transpose_item(P(nsa_w_in) + (size_t)j * D * NSA_IN, D, NSA_IN, NSA_P, base, scr, r, lane); else transpose_item(P(diff_w_in) + (size_t)j * D * DIFF_IN, D, DIFF_IN, DIFF_IN, base, scr, r, lane); continue; }
    r -= n_in;
    if (r < 512) { transpose_item((nsa ? P(nsa_w_out) : P(diff_w_out)) + (size_t)j * D * D, D, D, D, base + WT_OUT / 2, scr, r, lane); continue; }
    r -= 512;
    if (r < 2048) { transpose_item(P(w_mlp_in) + (size_t)i * D * DFF, D, DFF, DFF, base + WT_MI / 2, scr, r, lane); continue; }
    r -= 2048;
    if (r < 2048) transpose_item(P(w_mlp_out) + (size_t)i * DFF * D, DFF, D, D, base + WT_MO / 2, scr, r, lane);
  }
}

__device__ __forceinline__ void ph_norm(const float* xin, const float* gvec, const float* mod  , int sh_off, int sc_off, bf16_t* H) {
  const int tid = tid_(), lane = tid & 63, wave = tid >> 6;
  for (int m = bid_() * 8 + wave; m < T; m += gdim_() * 8) {
    const int b = m >> 12;
    const float4* xr = (const float4*)(xin + (size_t)m * D) + lane;
    float4 v[4]; float ss = 0.f;
#pragma unroll
    for (int j = 0; j < 4; ++j) { v[j] = xr[64 * j]; ss += (v[j].x * v[j].x + v[j].y * v[j].y) + (v[j].z * v[j].z + v[j].w * v[j].w); }
    ss = wave_sum(ss);
    const float rstd = 1.0f / sqrtf(ss * (1.0f / D) + EPS);
#pragma unroll
    for (int j = 0; j < 4; ++j) {
      const int col = 4 * lane + 256 * j;
      const float4 g = *(const float4*)(gvec + col), sc = *(const float4*)(mod + (size_t)b * 6144 + sc_off + col), sh = *(const float4*)(mod + (size_t)b * 6144 + sh_off + col);
      const float h0 = v[j].x * rstd * g.x * (1.f + sc.x) + sh.x, h1 = v[j].y * rstd * g.y * (1.f + sc.y) + sh.y;
      const float h2 = v[j].z * rstd * g.z * (1.f + sc.z) + sh.z, h3 = v[j].w * rstd * g.w * (1.f + sc.w) + sh.w;
      uint2 o; o.x = pk2(h0, h1); o.y = pk2(h2, h3);
      *(uint2*)(H + (size_t)m * D + col) = o;
    }
  }
}

struct EpiStore { bf16_t* O; int ld; int relu2;
  __device__ __forceinline__ void operator()(int row, int col, const float* v) const {
    float a = v[0], b = v[1], c = v[2], d = v[3];
    if (relu2) { a = fmaxf(a, 0.f); a *= a; b = fmaxf(b, 0.f); b *= b; c = fmaxf(c, 0.f); c *= c; d = fmaxf(d, 0.f); d *= d; }
    uint2 o; o.x = pk2(a, b); o.y = pk2(c, d); *(uint2*)(O + (size_t)row * ld + col) = o; } };
struct EpiResid { const float* xin; float* xout; const float* gate;
  __device__ __forceinline__ void operator()(int row, int col, const float* v) const {
    const int b = row >> 12; const float4 g = *(const float4*)(gate + (size_t)b * 6144 + col); const float4 xi = *(const float4*)(xin + (size_t)row * D + col);
    float4 o; o.x = xi.x + g.x * v[0]; o.y = xi.y + g.y * v[1]; o.z = xi.z + g.z * v[2]; o.w = xi.w + g.w * v[3];
    *(float4*)(xout + (size_t)row * D + col) = o; } };

template <class Epi>
__device__ __forceinline__ void gemm_naive(const bf16_t* A, int lda, const float* W, int N, int K, unsigned char* lds, const Epi& E) {
  asm volatile("" : "+s"(N), "+s"(K), "+s"(lda));
  float* As = (float*)lds;
  float* Bs = As + 16 * 132;
  const int tid = tid_(), tx = tid & 31, ty = tid >> 5;
  const int nN = (N + 127) / 128, nM = T / 128;
  const int ar = tid >> 2, ak = (tid & 3) * 4, bk = tid >> 5, bc = (tid & 31) * 4;
  for (int u = bid_(); u < nM * nN; u += gdim_()) {
    const int pm = u / nN, pn = u % nN;
    float acc[8][4];
#pragma unroll
    for (int i = 0; i < 8; ++i) { acc[i][0] = 0.f; acc[i][1] = 0.f; acc[i][2] = 0.f; acc[i][3] = 0.f; }
    const bf16_t* Ap = A + (size_t)(pm * 128 + ar) * lda + ak;
    const int wcol = pn * 128 + bc; const bool bok = wcol < N;
    const float* Wp = W + (size_t)bk * N + (bok ? wcol : 0);
    for (int k0 = 0; k0 < K; k0 += 16) {
      const uint2 av = *(const uint2*)(Ap + k0);
      float4 bv = *(const float4*)(Wp + (size_t)k0 * N);
      if (!bok) bv = make_float4(0.f, 0.f, 0.f, 0.f);
      __syncthreads();
      As[(ak + 0) * 132 + ar] = bf2f(av.x & 0xffffu); As[(ak + 1) * 132 + ar] = bf2f(av.x >> 16);
      As[(ak + 2) * 132 + ar] = bf2f(av.y & 0xffffu); As[(ak + 3) * 132 + ar] = bf2f(av.y >> 16);
      *(float4*)(Bs + bk * 128 + bc) = bv;
      __syncthreads();
#pragma unroll
      for (int k = 0; k < 16; ++k) {
        const float4 a0 = *(const float4*)(As + k * 132 + ty * 8), a1 = *(const float4*)(As + k * 132 + ty * 8 + 4);
        const float4 b = *(const float4*)(Bs + k * 128 + tx * 4);
        const float a[8] = {a0.x, a0.y, a0.z, a0.w, a1.x, a1.y, a1.z, a1.w};
#pragma unroll
        for (int i = 0; i < 8; ++i) { acc[i][0] += a[i] * b.x; acc[i][1] += a[i] * b.y; acc[i][2] += a[i] * b.z; acc[i][3] += a[i] * b.w; }
      }
    }
    const int col = pn * 128 + tx * 4;
    if (col < N) {
#pragma unroll
      for (int i = 0; i < 8; ++i) E(pm * 128 + ty * 8 + i, col, acc[i]);
    }
  }
}

__device__ __forceinline__ void head_norm_rope(const float* v, const float* gain, const float* cs  , int sub, float* vn, float* vr) {
  float ss = 0.f;
#pragma unroll
  for (int i = 0; i < 8; ++i) ss += v[i] * v[i];
  ss += __shfl_xor(ss, 1); ss += __shfl_xor(ss, 2); ss += __shfl_xor(ss, 4);
  const float rstd = 1.0f / sqrtf(ss * (1.0f / 64.0f) + EPS);
#pragma unroll
  for (int i = 0; i < 8; ++i) vn[i] = v[i] * rstd * gain[sub * 8 + i];
#pragma unroll
  for (int i = 0; i < 8; ++i) {
    const float other = __shfl_xor(vn[i], 1);
    const float c = cs[i], s = cs[8 + i];
    float r = vn[i];
    if (sub == 0) r = vn[i] * c - other * s;
    else if (sub == 1) r = vn[i] * c + other * s;
    vr[i] = r;
  }
}

__device__ __forceinline__ void ph_post_diff(int j, bf16_t* PROJ) {
  const int tid = tid_(), lane = tid & 63, wave = tid >> 6, sub = lane & 7;
  const float* rope = (const float*)(P(ws) + WS_ROPE);
  for (int m = bid_() * 8 + wave; m < T; m += gdim_() * 8) {
    const float* cs = rope + (size_t)m * 16;
#pragma unroll
    for (int it = 0; it < 4; ++it) {
      bf16_t* ptr = PROJ + (size_t)m * DIFF_IN + it * 512 + lane * 8;
      float v[8], vn[8], vr[8]; unpack8(*(const uint4*)ptr, v);
      const float* gain = (it < 2) ? (P(diff_q_gain) + j * 64) : (P(diff_k_gain) + j * 64);
      head_norm_rope(v, gain, cs, sub, vn, vr);
      const float sc = (it < 2) ? C2 : 1.0f;
#pragma unroll
      for (int i = 0; i < 8; ++i) vr[i] *= sc;
      *(uint4*)ptr = pack8(vr);
    }
  }
}
__device__ __forceinline__ void ph_post_nsa(int j, bf16_t* PROJ, bf16_t* QC) {
  const int tid = tid_(), lane = tid & 63, wave = tid >> 6, sub = lane & 7;
  const float* rope = (const float*)(P(ws) + WS_ROPE);
  for (int m = bid_() * 8 + wave; m < T; m += gdim_() * 8) {
    const float* cs = rope + (size_t)m * 16;
#pragma unroll
    for (int it = 0; it < 2; ++it) {
      bf16_t* ptr = PROJ + (size_t)m * NSA_P + it * 512 + lane * 8;
      float v[8], vn[8], vr[8]; unpack8(*(const uint4*)ptr, v);
      head_norm_rope(v, P(nsa_q_gain) + j * 64, cs, sub, vn, vr);
#pragma unroll
      for (int i = 0; i < 8; ++i) { vr[i] *= C2; vn[i] *= C2; }
      *(uint4*)ptr = pack8(vr);
      *(uint4*)(QC + (size_t)m * D + it * 512 + lane * 8) = pack8(vn);
    }
    {
      const int hi = lane >> 5;
      bf16_t* ptr = PROJ + (size_t)m * NSA_P + (hi ? 2048 : 1536) + (lane & 31) * 8;
      float v[8], vn[8], vr[8]; unpack8(*(const uint4*)ptr, v);
      head_norm_rope(v, P(nsa_k_gain) + j * 192 + (hi ? 128 : 64), cs, sub, vn, vr);
      *(uint4*)ptr = pack8(vr);
    }
  }
}

template <int DV, int MODE>
__device__ __forceinline__ void attn_naive_unit(int b, int qc, const bf16_t* Qp, int ldq, const bf16_t* Kp, const bf16_t* Vp, int ldkv, bf16_t* Op, int ldo, const u64* selmask, unsigned char* lds) {
  constexpr int DVS = DV / 8;
  float* Ks = (float*)lds;
  float* Vs = Ks + 64 * 64;
  const int tid = tid_(), qi = tid & 63, sl = tid >> 6;
  const int qabs = qc * 64 + qi;
  const size_t rowq = (size_t)b * S + qabs;
  float q[64];
#pragma unroll
  for (int i = 0; i < 8; ++i) unpack8(*(const uint4*)(Qp + rowq * ldq + i * 8), q + i * 8);
  float m = -INFINITY, l = 0.f, o[DVS];
#pragma unroll
  for (int i = 0; i < DVS; ++i) o[i] = 0.f;
  u64 msk = 0ull; if (MODE == 1) msk = selmask[qabs];
  const int t_lo = (MODE == 2) ? (qc > 8 ? qc - 8 : 0) : 0;
  for (int tt = t_lo; tt <= qc; ++tt) {
    __syncthreads();
    { const int key = tid >> 3, ch = tid & 7; float f[8];
      unpack8(*(const uint4*)(Kp + ((size_t)b * S + tt * 64 + key) * ldkv + ch * 8), f);
#pragma unroll
      for (int i = 0; i < 8; ++i) Ks[key * 64 + ch * 8 + i] = f[i];
#pragma unroll
      for (int r = 0; r < DV / 64; ++r) {
        unpack8(*(const uint4*)(Vp + ((size_t)b * S + tt * 64 + key) * ldkv + r * 64 + ch * 8), f);
#pragma unroll
        for (int i = 0; i < 8; ++i) Vs[key * DV + r * 64 + ch * 8 + i] = f[i];
      } }
    __syncthreads();
    const bool tile_on = (MODE == 1) ? (((msk >> tt) & 1ull) != 0ull) : true;
    if (tile_on) {
      for (int jk = 0; jk < 64; ++jk) {
        const int key = tt * 64 + jk;
        bool valid = key <= qabs; if (MODE == 2) valid = valid && (key > qabs - 512);
        if (valid) {
          float s = 0.f;
#pragma unroll
          for (int d = 0; d < 64; d += 4) { const float4 kk = *(const float4*)(Ks + jk * 64 + d); s += q[d] * kk.x + q[d + 1] * kk.y + q[d + 2] * kk.z + q[d + 3] * kk.w; }
          const float mn = fmaxf(m, s); const float sc = exp2f(m - mn), pp = exp2f(s - mn);
          l = l * sc + pp;
#pragma unroll
          for (int i = 0; i < DVS; ++i) o[i] = o[i] * sc + pp * Vs[jk * DV + sl * DVS + i];
          m = mn;
        }
      }
    }
  }
  const float inv = l > 0.f ? 1.0f / l : 0.f;
  bf16_t* op = Op + rowq * ldo + sl * DVS;
  if (DVS == 8) { float r[8];
#pragma unroll
    for (int i = 0; i < 8; ++i) r[i] = o[i] * inv;
    *(uint4*)op = pack8(r);
  } else {
#pragma unroll
    for (int h2 = 0; h2 < DVS / 8; ++h2) { float r[8];
#pragma unroll
      for (int i = 0; i < 8; ++i) r[i] = o[h2 * 8 + i] * inv;
      *(uint4*)(op + h2 * 8) = pack8(r); }
  }
}

__device__ __forceinline__ void ph_attn_diff(unsigned char* lds) {
  const bf16_t* PROJ = (const bf16_t*)(P(ws) + WS_PROJ); bf16_t* ATT = (bf16_t*)(P(ws) + WS_ATT);
  const int NU = NB * 64 * 16;
  for (int u = bid_(); u < NU; u += gdim_()) {
    const int vh = u & 15, qc = 63 - ((u >> 4) & 63), b = u >> 10;
    const int h8 = vh >> 1, c = vh & 1;
    attn_naive_unit<128, 0>(b, qc, PROJ + vh * 64, DIFF_IN, PROJ + 1024 + vh * 64, PROJ + 2048 + h8 * 128, DIFF_IN, ATT + c * 1024 + h8 * 128, 2048, nullptr, lds);
  }
}
__device__ __forceinline__ void ph_attn_sel(unsigned char* lds) {
  const bf16_t* PROJ = (const bf16_t*)(P(ws) + WS_PROJ); bf16_t* OSEL = (bf16_t*)(P(ws) + WS_ATT + 32 * MiB);
  const u64* SEL = (const u64*)(P(ws) + WS_SEL);
  const int NU = NB * 64 * 16;
  for (int u = bid_(); u < NU; u += gdim_()) {
    const int hd = u & 15, qc = 63 - ((u >> 4) & 63), b = u >> 10, g = hd >> 2;
    attn_naive_unit<64, 1>(b, qc, PROJ + hd * 64, NSA_P, PROJ + 1536 + g * 64, PROJ + 1792 + g * 64, NSA_P, OSEL + hd * 64, D, SEL + (size_t)(b * 4 + g) * S, lds);
  }
}
__device__ __forceinline__ void ph_attn_win(unsigned char* lds) {
  const bf16_t* PROJ = (const bf16_t*)(P(ws) + WS_PROJ); bf16_t* OWIN = (bf16_t*)(P(ws) + WS_ATT + 64 * MiB);
  const int NU = NB * 64 * 16;
  for (int u = bid_(); u < NU; u += gdim_()) {
    const int hd = u & 15, qc = (u >> 4) & 63, b = u >> 10, g = hd >> 2;
    attn_naive_unit<64, 2>(b, qc, PROJ + hd * 64, NSA_P, PROJ + 2048 + g * 64, PROJ + 2304 + g * 64, NSA_P, OWIN + hd * 64, D, nullptr, lds);
  }
}

__device__ __forceinline__ void ph_compress(int j, unsigned char* lds) {
  const bf16_t* PROJ = (const bf16_t*)(P(ws) + WS_PROJ);
  float* z = (float*)lds;
  float* red = z + 2048;
  float* hid = red + 512;
  float* red2 = hid + 128;
  const int tid = tid_();
  const int NI = NB * 4 * 255 * 2;
  for (int it = bid_(); it < NI; it += gdim_()) {
    const int kv = it & 1, c = (it >> 1) % 255, bg = (it >> 1) / 255, b = bg >> 2, g = bg & 3;
    const float* pe = (kv ? P(nsa_pe_v) : P(nsa_pe_k)) + j * 2048;
    const float* w1 = (kv ? P(nsa_w_cv1) : P(nsa_w_ck1)) + (size_t)j * 2048 * 128;
    const float* w2 = (kv ? P(nsa_w_cv2) : P(nsa_w_ck2)) + (size_t)j * 128 * 64;
    const int colbase = (kv ? 1280 : 1024) + g * 64;
    __syncthreads();
    {
      const int l = tid >> 4, d4 = (tid & 15) * 4;
      const uint2 sv = *(const uint2*)(PROJ + ((size_t)b * S + 16 * c + l) * NSA_P + colbase + d4);
      z[l * 64 + d4 + 0] = bf2f(sv.x & 0xffffu) + pe[l * 64 + d4 + 0]; z[l * 64 + d4 + 1] = bf2f(sv.x >> 16) + pe[l * 64 + d4 + 1];
      z[l * 64 + d4 + 2] = bf2f(sv.y & 0xffffu) + pe[l * 64 + d4 + 2]; z[l * 64 + d4 + 3] = bf2f(sv.y >> 16) + pe[l * 64 + d4 + 3]; }
    __syncthreads();
    { const int n = tid & 127, ks = tid >> 7; float a = 0.f;
      const float* wp = w1 + (size_t)(ks * 512) * 128 + n;
#pragma unroll 8
      for (int k = 0; k < 512; ++k) a += z[ks * 512 + k] * wp[(size_t)k * 128];
      red[ks * 128 + n] = a; }
    __syncthreads();
    if (tid < 128) { const float hsum = red[tid] + red[128 + tid] + red[256 + tid] + red[384 + tid]; hid[tid] = hsum / (1.f + expf(-hsum)); }
    __syncthreads();
    { const int e = tid & 63, sp = tid >> 6; float a = 0.f;
#pragma unroll
      for (int h = 0; h < 16; ++h) a += hid[sp * 16 + h] * w2[(sp * 16 + h) * 64 + e];
      red2[sp * 64 + e] = a; }
    __syncthreads();
    if (tid < 64) {
      float o = 0.f;
#pragma unroll
      for (int sp = 0; sp < 8; ++sp) o += red2[sp * 64 + tid];
      if (kv == 0) { const float ss = wave_sum(o * o); o = o * (1.0f / sqrtf(ss * (1.0f / 64.0f) + EPS)) * P(nsa_k_gain)[j * 192 + tid]; }
      float* dst = (float*)(P(ws) + (kv ? WS_VCMP : WS_KCMP));
      dst[((size_t)bg * 256 + c) * 64 + tid] = o;
    }
  }
}

__device__ __forceinline__ void ph_cmp_attn(unsigned char* lds) {
  float* Kc = (float*)lds;
  float* Pm = Kc + 256 * 65;
  float* imp = Pm + 32 * 256;
  unsigned* selb = (unsigned*)(imp + 8 * 64);
  const bf16_t* QC = (const bf16_t*)(P(ws) + WS_OC);
  const float* KCMP = (const float*)(P(ws) + WS_KCMP); const float* VCMP = (const float*)(P(ws) + WS_VCMP);
  bf16_t* OCMP = (bf16_t*)(P(ws) + WS_ATT);
  u64* SEL = (u64*)(P(ws) + WS_SEL);
  const int tid = tid_();
  const int NU = NB * 4 * 512;
  for (int u = bid_(); u < NU; u += gdim_()) {
    const int qc8 = u & 511, bg = u >> 9, b = bg >> 2, g = bg & 3;
    const int t0 = qc8 * 8;
    int ncv = (t0 + 7 >= 31) ? ((t0 + 7 - 31) / 16 + 1) : 0; if (ncv > 255) ncv = 255;
    __syncthreads();
    for (int i = tid; i < ncv * 64; i += NTHR) Kc[(i >> 6) * 65 + (i & 63)] = KCMP[(size_t)bg * 256 * 64 + i];
    if (tid < 16) selb[tid] = 0u;
    __syncthreads();
    const int r = tid >> 4, sub = tid & 15, qi = r >> 2, hh = r & 3, t = t0 + qi;
    {
      float q[64];
      const bf16_t* qp = QC + ((size_t)b * S + t) * D + (g * 4 + hh) * 64;
#pragma unroll
      for (int i = 0; i < 8; ++i) unpack8(*(const uint4*)(qp + i * 8), q + i * 8);
      float mx = -INFINITY;
#pragma unroll 1
      for (int i = 0; i < 16; ++i) {
        const int c = sub + 16 * i; float a = -INFINITY;
        if (c < ncv && 16 * c + 31 <= t) { a = 0.f;
#pragma unroll
          for (int d = 0; d < 64; ++d) a += q[d] * Kc[c * 65 + d]; }
        Pm[r * 256 + c] = a; mx = fmaxf(mx, a);
      }
      mx = fmaxf(mx, __shfl_xor(mx, 1)); mx = fmaxf(mx, __shfl_xor(mx, 2)); mx = fmaxf(mx, __shfl_xor(mx, 4)); mx = fmaxf(mx, __shfl_xor(mx, 8));
      float sum = 0.f;
#pragma unroll 1
      for (int i = 0; i < 16; ++i) { const float sv = Pm[r * 256 + sub + 16 * i]; const float e = (sv == -INFINITY) ? 0.f : exp2f(sv - mx); Pm[r * 256 + sub + 16 * i] = e; sum += e; }
      sum += __shfl_xor(sum, 1); sum += __shfl_xor(sum, 2); sum += __shfl_xor(sum, 4); sum += __shfl_xor(sum, 8);
      const float inv = sum > 0.f ? 1.0f / sum : 0.f;
#pragma unroll 1
      for (int i = 0; i < 16; ++i) Pm[r * 256 + sub + 16 * i] *= inv;
    }
    __syncthreads();
    {
      float o0 = 0.f, o1 = 0.f, o2 = 0.f, o3 = 0.f;
      const float* vb = VCMP + (size_t)bg * 256 * 64 + sub * 4;
      for (int c = 0; c < ncv; ++c) { const float pr = Pm[r * 256 + c]; const float4 v0 = *(const float4*)(vb + c * 64);
        o0 += pr * v0.x; o1 += pr * v0.y; o2 += pr * v0.z; o3 += pr * v0.w; }
      uint2 ov; ov.x = pk2(o0, o1); ov.y = pk2(o2, o3);
      *(uint2*)(OCMP + ((size_t)b * S + t) * D + (g * 4 + hh) * 64 + sub * 4) = ov;
    }
    {
      const int qi2 = tid >> 6, sb = tid & 63, tq = t0 + qi2, bt = tq >> 6;
      float v = 0.f;
      const int c_lo = (4 * sb - 1 < 0) ? 0 : 4 * sb - 1, c_hi = (4 * sb + 3 > 254) ? 254 : 4 * sb + 3;
      for (int h = 0; h < 4; ++h) for (int c = c_lo; c <= c_hi; ++c) v += Pm[(qi2 * 4 + h) * 256 + c];
      const bool forced = (sb == 0) || (sb == bt) || (sb == bt - 1), valid = sb <= bt;
      imp[qi2 * 64 + sb] = forced ? 1e6f : (valid ? v : -1.0f);
    }
    __syncthreads();
    {
      const int qi2 = tid >> 6, sb = tid & 63;
      const float v = imp[qi2 * 64 + sb]; int cnt = 0;
      for (int s2 = 0; s2 < 64; ++s2) { const float w = imp[qi2 * 64 + s2]; cnt += (w > v || (w == v && s2 < sb)) ? 1 : 0; }
      if (cnt < 16) atomicOr(&selb[qi2 * 2 + (sb >> 5)], 1u << (sb & 31));
    }
    __syncthreads();
    if (tid < 8) SEL[(size_t)bg * S + t0 + tid] = (u64)selb[tid * 2] | ((u64)selb[tid * 2 + 1] << 32);
  }
}

__device__ __forceinline__ void ph_combine_nsa(int j) {
  const bf16_t* PROJ = (const bf16_t*)(P(ws) + WS_PROJ);
  const bf16_t* OCMP = (const bf16_t*)(P(ws) + WS_ATT); const bf16_t* OSEL = OCMP + (size_t)T * D; const bf16_t* OWIN = OSEL + (size_t)T * D;
  bf16_t* OC = (bf16_t*)(P(ws) + WS_OC);
  for (size_t i = (size_t)bid_() * NTHR + tid_(); i < (size_t)T * 128; i += (size_t)gdim_() * NTHR) {
    const size_t m = i >> 7; const int cg8 = (int)(i & 127), hd = cg8 >> 3;
    float gt[3];
#pragma unroll
    for (int r = 0; r < 3; ++r) { const float gl = bf2f(PROJ[m * NSA_P + 2560 + hd * 3 + r]) + P(nsa_b_gate)[j * 48 + hd * 3 + r]; gt[r] = 1.0f / (1.0f + expf(-gl)); }
    float a[8], bb[8], cc[8], o[8];
    unpack8(*(const uint4*)(OCMP + m * D + cg8 * 8), a); unpack8(*(const uint4*)(OSEL + m * D + cg8 * 8), bb); unpack8(*(const uint4*)(OWIN + m * D + cg8 * 8), cc);
#pragma unroll
    for (int k = 0; k < 8; ++k) o[k] = gt[0] * a[k] + gt[1] * bb[k] + gt[2] * cc[k];
    *(uint4*)(OC + m * D + cg8 * 8) = pack8(o);
  }
}
__device__ __forceinline__ void ph_combine_diff(int j) {
  const bf16_t* ATT = (const bf16_t*)(P(ws) + WS_ATT); bf16_t* OC = (bf16_t*)(P(ws) + WS_OC);
  const float lam = ((const float*)(P(ws) + WS_SMALL))[j]; const float osc = 1.0f - lam_init_of(j);
  const int tid = tid_(), lane = tid & 63, wave = tid >> 6;
  for (int m = bid_() * 8 + wave; m < T; m += gdim_() * 8) {
#pragma unroll
    for (int it = 0; it < 2; ++it) {
      const int col = it * 512 + lane * 8;
      float a[8], b2[8], o[8]; unpack8(*(const uint4*)(ATT + (size_t)m * 2048 + col), a); unpack8(*(const uint4*)(ATT + (size_t)m * 2048 + 1024 + col), b2);
      float ss = 0.f;
#pragma unroll
      for (int k = 0; k < 8; ++k) { o[k] = a[k] - lam * b2[k]; ss += o[k] * o[k]; }
      ss += __shfl_xor(ss, 1); ss += __shfl_xor(ss, 2); ss += __shfl_xor(ss, 4); ss += __shfl_xor(ss, 8);
      const float rstd = 1.0f / sqrtf(ss * (1.0f / 128.0f) + EPS);
#pragma unroll
      for (int k = 0; k < 8; ++k) o[k] = o[k] * rstd * P(diff_subln_g)[j * 128 + (col & 127) + k] * osc;
      *(uint4*)(OC + (size_t)m * D + col) = pack8(o);
    }
  }
}

constexpr int N_PHASES = 1 + 4 * 10;
template <int PH> __device__ __forceinline__ void run_phase(unsigned char* lds, int lo, int hi) {
  if (PH < lo || PH >= hi) return;
  bool did = true;
  if constexpr (PH == 0) { ph_prologue(lds); __syncthreads(); ph_weights(lds); }
  else {
    constexpr int i = (PH - 1) / 10, lp = (PH - 1) % 10, j = i >> 1; constexpr bool nsa = (i & 1) == 0;
    float* MOD = (float*)(P(ws) + WS_MOD);
    bf16_t* H = (bf16_t*)(P(ws) + WS_H); bf16_t* PROJ = (bf16_t*)(P(ws) + WS_PROJ); bf16_t* OC = (bf16_t*)(P(ws) + WS_OC); bf16_t* HID = (bf16_t*)(P(ws) + WS_HID);
    const float* mod = MOD + (size_t)i * 4 * 6144;
    const float* xcur = (i == 0 && lp < 7) ? P(x) : P(out);
    if constexpr (lp == 0) ph_norm(xcur, P(ln_mix_g) + i * D, mod, 0, 1024, H);
    const bf16_t* WTL = (const bf16_t*)(P(ws) + WS_WT + (size_t)i * WT_LAYER);
    PG8_LAS unsigned char* l3 = (PG8_LAS unsigned char*)lds;
    if constexpr (lp == 1) {
      constexpr int N = nsa ? NSA_P : DIFF_IN;
      pg8::Gemm g{H, WTL, T, N, D}; pg8::StaticOrder S; S.init(T, N, gdim_(), bid_());
      pg8::EpiBf16<0> E{PROJ, N};
      pg8::gemm_phase<pg8::EpiBf16<0>, pg8::StaticOrder, true, true>(l3, g, S, E);
    }
    if constexpr (lp == 2) { if constexpr (nsa) { ph_post_nsa(j, PROJ, OC); ph_compress(j, lds); } else ph_post_diff(j, PROJ); }
    if constexpr (lp == 3) { if constexpr (nsa) { ph_cmp_attn(lds); __syncthreads(); ph_attn_win_fast(lds); } else ph_attn_diff_fast(lds); }
    if constexpr (lp == 4) { if constexpr (nsa) ph_attn_sel_fast(lds); else did = false; }
    if constexpr (lp == 5) { if constexpr (nsa) ph_combine_nsa(j); else ph_combine_diff(j); }
    if constexpr (lp == 6) {
      pg8::Gemm g{OC, WTL + WT_OUT / 2, T, D, D}; pg8::StaticOrder S; S.init(T, D, gdim_(), bid_());
      pg8::EpiResid E{xcur, P(out), mod + 2048};
      pg8::gemm_phase<pg8::EpiResid, pg8::StaticOrder, true, true>(l3, g, S, E);
    }
    if constexpr (lp == 7) ph_norm(P(out), P(ln_mlp_g) + i * D, mod, 3072, 4096, H);
    if constexpr (lp == 8) {
      pg8::Gemm g{H, WTL + WT_MI / 2, T, DFF, D}; pg8::StaticOrder S; S.init(T, DFF, gdim_(), bid_());
      pg8::EpiBf16<2> E{HID, DFF};
      pg8::gemm_phase<pg8::EpiBf16<2>, pg8::StaticOrder, true, true>(l3, g, S, E);
    }
    if constexpr (lp == 9) {
      pg8::Gemm g{HID, WTL + WT_MO / 2, T, D, DFF}; pg8::StaticOrder S; S.init(T, D, gdim_(), bid_());
      pg8::EpiResid E{P(out), P(out), mod + 5120};
      pg8::gemm_phase<pg8::EpiResid, pg8::StaticOrder, true, true>(l3, g, S, E);
    }
  }
  if (did && PH + 1 < hi) cg::this_grid().sync();
}
template <int... I> __device__ __forceinline__ void run_all(std::integer_sequence<int, I...>, unsigned char* lds, int lo, int hi) { (run_phase<I>(lds, lo, hi), ...); }
__global__ void __launch_bounds__(NTHR) fwd_kernel(Params p) {
  extern __shared__ __attribute__((aligned(16))) unsigned char lds[];
  run_all(std::make_integer_sequence<int, N_PHASES>{}, lds, p.ph_lo, p.ph_hi);
}

extern "C" void kernel_launch(void* const* d_in, const int* in_sizes, int n_in, void* d_out, int out_size, void* d_ws, size_t ws_size, hipStream_t stream) {
  static int grid = 0;
  if (grid == 0) {
    if (n_in != 29 || out_size != T * D || ws_size < WS_END) { fprintf(stderr, "kernel_launch: unexpected problem (n_in %d, out %d, ws %zu)\n", n_in, out_size, ws_size); grid = -1; return; }
    int dev = 0, cus = 0, per_cu = 0;
    hipGetDevice(&dev); hipDeviceGetAttribute(&cus, hipDeviceAttributeMultiprocessorCount, dev);
    hipFuncSetAttribute((const void*)fwd_kernel, hipFuncAttributeMaxDynamicSharedMemorySize, LDS_BYTES);
    hipOccupancyMaxActiveBlocksPerMultiprocessor(&per_cu, (const void*)fwd_kernel, NTHR, LDS_BYTES);
    if (per_cu < 1) { fprintf(stderr, "kernel_launch: occupancy query says %d blocks/CU\n", per_cu); per_cu = 1; }
    grid = cus * 1;
    (void)hipGetLastError();
  }
  if (grid < 0) return;
  Params p{};
  memcpy((void*)&p, (const void*)d_in, 29 * sizeof(void*));
  p.out = (float*)d_out; p.ws = (unsigned char*)d_ws; p.ph_lo = 0; p.ph_hi = N_PHASES;
  void* args[] = {&p};
  hipError_t e = hipLaunchCooperativeKernel((const void*)fwd_kernel, dim3(grid), dim3(NTHR), args, LDS_BYTES, stream);
  if (e != hipSuccess) fprintf(stderr, "cooperative launch failed: %s (grid %d)\n", hipGetErrorString(e), grid);
}
```

```cpp
#include <hip/hip_runtime.h>
#include <hip/hip_cooperative_groups.h>
#include <hip/hip_bf16.h>
#include <cstdio>
#include <cstdint>
#include <cstring>
#include <utility>
namespace cg = cooperative_groups;

typedef unsigned short bf16_t;
typedef unsigned long long u64;

constexpr int D = 1024, NB = 4, S = 4096, T = NB * S, DFF = 4096;
constexpr int NSA_IN = 2608, NSA_P = 2816, DIFF_IN = 3072;
constexpr float EPS = 1e-6f;
constexpr float C2 = 0.125f * 1.4426950408889634f;
constexpr int NTHR = 512;
constexpr int LDS_BYTES = 147456;

constexpr size_t MiB = 1u << 20;
constexpr size_t WS_CTL = 0, CTL_ZERO_BYTES = 1 * MiB;
constexpr int CW_BAR = 4096;
constexpr int MISC_OFF = LDS_BYTES - 64;
constexpr size_t WS_MOD = 1 * MiB;
constexpr size_t WS_ROPE = 2 * MiB;
constexpr size_t WS_SMALL = 3 * MiB;
constexpr size_t WS_WT = 4 * MiB;
constexpr size_t WT_LAYER = 24 * MiB, WT_OUT = 6 * MiB, WT_MI = 8 * MiB, WT_MO = 16 * MiB;
constexpr size_t WS_H = 104 * MiB;
constexpr size_t WS_PROJ = 136 * MiB;
constexpr size_t WS_ATT = 232 * MiB;
constexpr size_t WS_OC = 328 * MiB;
constexpr size_t WS_KCMP = 360 * MiB;
constexpr size_t WS_VCMP = 361 * MiB;
constexpr size_t WS_SEL = 362 * MiB;
constexpr size_t WS_HID = 136 * MiB;
constexpr size_t WS_END = 364 * MiB;

struct Params {
  const float* x; const float* c; const int* pos; const float* ln_mix_g; const float* ln_mlp_g;
  const float* w_ada; const float* b_ada; const float* w_mlp_in; const float* w_mlp_out;
  const float* nsa_w_in; const float* nsa_b_gate; const float* nsa_q_gain; const float* nsa_k_gain;
  const float* nsa_pe_k; const float* nsa_w_ck1; const float* nsa_w_ck2; const float* nsa_pe_v; const float* nsa_w_cv1; const float* nsa_w_cv2; const float* nsa_w_out;
  const float* diff_w_in; const float* diff_q_gain; const float* diff_k_gain; const float* diff_lq1; const float* diff_lk1; const float* diff_lq2; const float* diff_lk2; const float* diff_subln_g; const float* diff_w_out;
  float* out; unsigned char* ws; int ph_lo, ph_hi;
};

typedef __attribute__((address_space(4))) const unsigned char* kptr_t;
template <class Tp> __device__ __forceinline__ Tp karg_load(unsigned off) {
  asm volatile("" : "+s"(off));
  kptr_t kp = (kptr_t)__builtin_amdgcn_kernarg_segment_ptr();
  return *(const __attribute__((address_space(4))) Tp*)(kp + off);
}
__device__ __forceinline__ int tid_() { int t = (int)threadIdx.x; asm volatile("" : "+v"(t)); return t; }
__device__ __forceinline__ int bid_() { int t = (int)blockIdx.x; asm volatile("" : "+s"(t)); return t; }
__device__ __forceinline__ int gdim_() { int t = (int)gridDim.x; asm volatile("" : "+s"(t)); return t; }
#define P(m) karg_load<decltype(Params::m)>((unsigned)offsetof(Params, m))
__device__ __forceinline__ float bf2f(unsigned v) { return __uint_as_float(v << 16); }
__device__ __forceinline__ unsigned f2bf(float f) { unsigned u = __float_as_uint(f); return (u + 0x7fffu + ((u >> 16) & 1u)) >> 16; }
__device__ __forceinline__ unsigned pk2(float lo, float hi) { return f2bf(lo) | (f2bf(hi) << 16); }
__device__ __forceinline__ void unpack8(const uint4 v, float* f) {
  f[0] = bf2f(v.x & 0xffffu); f[1] = bf2f(v.x >> 16); f[2] = bf2f(v.y & 0xffffu); f[3] = bf2f(v.y >> 16);
  f[4] = bf2f(v.z & 0xffffu); f[5] = bf2f(v.z >> 16); f[6] = bf2f(v.w & 0xffffu); f[7] = bf2f(v.w >> 16);
}
__device__ __forceinline__ uint4 pack8(const float* f) { uint4 v; v.x = pk2(f[0], f[1]); v.y = pk2(f[2], f[3]); v.z = pk2(f[4], f[5]); v.w = pk2(f[6], f[7]); return v; }
__device__ __forceinline__ float wave_sum(float v) {
#pragma unroll
  for (int o = 1; o < 64; o <<= 1) v += __shfl_xor(v, o);
  return v;
}
__device__ __forceinline__ float lam_init_of(int j) { return j == 0 ? 0.35550906759096934f : 0.5560582041556406f; }

namespace pg8 {
#define PG8_LAS __attribute__((address_space(3)))
typedef unsigned short bf16_t;
typedef short bf16x8 __attribute__((ext_vector_type(8)));
typedef float f32x4 __attribute__((ext_vector_type(4)));
typedef unsigned u32x4 __attribute__((ext_vector_type(4)));
constexpr int BM = 256, BK = 64, HALF = 128, HTB = HALF * BK * 2  , STAGE_BYTES = 8 * HTB, NXCD = 8, WGM = 8;

__host__ __device__ __forceinline__ int lds_byte(int r, int c) { const int st = (r >> 4) * 2 + (c >> 5), rr = r & 15, cc = c & 31, ob = rr * 64 + cc * 2; return st * 1024 + (ob ^ (((ob >> 9) & 1) << 5)); }
__host__ __device__ __forceinline__ void stage_rc(int b, int& R, int& C) { const int st = b / 1024, sb = b % 1024, swz = sb ^ (((sb >> 9) & 1) << 5); R = (st >> 1) * 16 + swz / 64; C = (st & 1) * 32 + (swz % 64) / 2; }
__host__ __device__ __forceinline__ int perm32(int rho) { const int n = rho >> 4, i = rho & 15; return 8 * (i >> 2) + 4 * n + (i & 3); }

struct Unit { int pm, pn; };
struct Gemm { const bf16_t* A; const bf16_t* Bt; int M, N, K; };

struct StaticOrder {
    int nM, nN, nwg, G, c;
    __host__ __device__ void init(int M, int N, int G_, int c_) { nM = M / BM; nN = N / BM; nwg = nM * nN; G = G_; c = c_; }
    __host__ __device__ bool next(int i, Unit& u) const {
        const long L = (long)i * G + c; if (L >= nwg) return false;
        int wgid = (int)L; { const int q = nwg / NXCD, r = nwg % NXCD, xcd = wgid % NXCD, off = wgid / NXCD; wgid = (xcd < r ? xcd * (q + 1) : r * (q + 1) + (xcd - r) * q) + off; }
        const int nig = WGM * nN, gid = wgid / nig, fm = gid * WGM, gsz = (nM - fm) < WGM ? (nM - fm) : WGM;
        u.pm = fm + ((wgid % nig) % gsz); u.pn = (wgid % nig) / gsz; return true;
    }
    __device__ __forceinline__ void a_ready(const Unit&) const {}
    __device__ __forceinline__ void done(const Unit&) const {}
};


__device__ __forceinline__ unsigned cvt_pk_bf16(float lo, float hi) { unsigned r; asm volatile("v_cvt_pk_bf16_f32 %0, %1, %2" : "=v"(r) : "v"(lo), "v"(hi)); return r; }
template <int ACT  > struct EpiBf16 {
    static constexpr bool PERM = true, AFTER_DRAIN = false;
    bf16_t* O; int ldc;
    __device__ __forceinline__ void operator()(const f32x4 (&acc)[2][2][4][2], const Unit& u, int wr, int wc, int fr, int fq) const {
        const int row0 = u.pm * BM + wr * 64 + fr; const int col0 = u.pn * BM + wc * 32 + 8 * fq;
#pragma unroll
        for (int ai = 0; ai < 2; ++ai)
#pragma unroll
            for (int m = 0; m < 4; ++m) { bf16_t* rowp = O + (size_t)(row0 + ai * HALF + m * 16) * ldc + col0;
#pragma unroll
                for (int bj = 0; bj < 2; ++bj) { f32x4 v0 = acc[ai][bj][m][0], v1 = acc[ai][bj][m][1];
                    if (ACT == 2) {
#pragma unroll
                        for (int e = 0; e < 4; ++e) { float a = v0[e] > 0.f ? v0[e] : 0.f; v0[e] = a * a; float b = v1[e] > 0.f ? v1[e] : 0.f; v1[e] = b * b; } }
                    u32x4 w; w.x = cvt_pk_bf16(v0[0], v0[1]); w.y = cvt_pk_bf16(v0[2], v0[3]); w.z = cvt_pk_bf16(v1[0], v1[1]); w.w = cvt_pk_bf16(v1[2], v1[3]);
                    *(u32x4*)(rowp + bj * HALF) = w; } }
    }
};
struct EpiResid {
    static constexpr bool PERM = false, AFTER_DRAIN = false;
    const float* xin; float* xout; const float* gate;
    __device__ __forceinline__ void operator()(const f32x4 (&acc)[2][2][4][2], const Unit& u, int wr, int wc, int fr, int fq) const {
        const int col0 = u.pn * BM + wc * 32 + 4 * fq; const int b = (u.pm * BM) >> 12;
        f32x4 gv[2][2];
#pragma unroll
        for (int bj = 0; bj < 2; ++bj)
#pragma unroll
            for (int n = 0; n < 2; ++n) gv[bj][n] = *(const f32x4*)(gate + (size_t)b * 6144 + col0 + bj * HALF + n * 16);
#pragma unroll
        for (int ai = 0; ai < 2; ++ai)
#pragma unroll
            for (int m = 0; m < 4; ++m) { const size_t off = (size_t)(u.pm * BM + ai * HALF + wr * 64 + m * 16 + fr) * 1024 + col0;
#pragma unroll
                for (int bj = 0; bj < 2; ++bj)
#pragma unroll
                    for (int n = 0; n < 2; ++n) { const f32x4 xi = *(const f32x4*)(xin + off + bj * HALF + n * 16); *(f32x4*)(xout + off + bj * HALF + n * 16) = xi + gv[bj][n] * acc[ai][bj][m][n]; }
                if (m & 1) asm volatile("" ::: "memory"); }
    }
};

template <class Epi, class Sched, bool ALIGN_EPI = false, bool SP2 = false>
__device__ __forceinline__ void gemm_phase(PG8_LAS unsigned char* lds, const Gemm g, const Sched& S, const Epi& E) {
    const int tid = tid_(), wid = __builtin_amdgcn_readfirstlane(tid >> 6), lane = tid & 63, wr = wid >> 2, wc = wid & 3, fr = lane & 15, fq = lane >> 4;
    const int K = g.K, nt = K / BK;
    unsigned voffA[2], voffB[2];
#pragma unroll
    for (int i = 0; i < 2; ++i) { int R, C; stage_rc(tid * 16 + i * 8192, R, C); const int Rb = Epi::PERM ? ((R & ~31) + perm32(R & 31)) : R;
        voffA[i] = (unsigned)(R * K + C) * 2u; voffB[i] = (unsigned)(Rb * K + C) * 2u; }
    const size_t kstep = (size_t)(BK * 2);
    const size_t hstep = (size_t)HALF * K * 2;
    const size_t tstep = 2 * hstep;
    const unsigned ldsw = (unsigned)wid * 1024u;
    const int aoff = lds_byte(wr * 64 + fr, fq * 8), boff = lds_byte(wc * 32 + fr, fq * 8);
#define PG8_SA(b, h) (((b) * 2 + (h)) * HTB)
#define PG8_SB(b, h) ((4 + (b) * 2 + (h)) * HTB)
#define PG8_STAGE(bufoff, gbase, voff) do { _Pragma("unroll") for (int _i = 0; _i < 2; ++_i) \
        __builtin_amdgcn_global_load_lds((const unsigned*)((const char*)(gbase) + (voff)[_i]), (PG8_LAS unsigned*)(lds + (bufoff) + ldsw + _i * 8192), 16, 0, 0); } while (0)
#define PG8_LDA(dst, b, h) do { _Pragma("unroll") for (int m = 0; m < 4; ++m) _Pragma("unroll") for (int k = 0; k < 2; ++k) dst[m][k] = *(const PG8_LAS bf16x8*)(lds + PG8_SA(b, h) + aoff + m * 2048 + k * 1024); } while (0)
#define PG8_LDB(dst, b, h) do { _Pragma("unroll") for (int n = 0; n < 2; ++n) _Pragma("unroll") for (int k = 0; k < 2; ++k) dst[n][k] = *(const PG8_LAS bf16x8*)(lds + PG8_SB(b, h) + boff + n * 2048 + k * 1024); } while (0)
#define PG8_MMA(ai, bj, At, Bt) do { __builtin_amdgcn_s_setprio(1); _Pragma("unroll") for (int m = 0; m < 4; ++m) _Pragma("unroll") for (int n = 0; n < 2; ++n) _Pragma("unroll") for (int k = 0; k < 2; ++k) \
        acc[ai][bj][m][n] = __builtin_amdgcn_mfma_f32_16x16x32_bf16(Bt[n][k], At[m][k], acc[ai][bj][m][n], 0, 0, 0); __builtin_amdgcn_s_setprio(0); } while (0)
#define PG8_WAIT_V(n) asm volatile("s_waitcnt vmcnt(" #n ")" ::: "memory")
#define PG8_WAIT_L(n) asm volatile("s_waitcnt lgkmcnt(" #n ")" ::: "memory")
#define PG8_BAR __builtin_amdgcn_s_barrier()
#define PG8_SCHED __builtin_amdgcn_sched_barrier(0)
    Unit cur, nxt; int ui = 0;
    if (!S.next(0, cur)) return;
    f32x4 acc[2][2][4][2];
#pragma unroll
    for (int a = 0; a < 2; ++a)
#pragma unroll
        for (int b = 0; b < 2; ++b)
#pragma unroll
            for (int m = 0; m < 4; ++m)
#pragma unroll
                for (int n = 0; n < 2; ++n) acc[a][b][m][n] = (f32x4){0.f, 0.f, 0.f, 0.f};
    bf16x8 At[4][2], B0[2][2], B1[2][2];
    const char* cA = (const char*)g.A + (size_t)cur.pm * tstep; const char* cB = (const char*)g.Bt + (size_t)cur.pn * tstep;
    S.a_ready(cur);
    if constexpr (SP2) {
        PG8_STAGE(PG8_SB(0, 0), cB, voffB); PG8_STAGE(PG8_SB(0, 1), cB + hstep, voffB); PG8_STAGE(PG8_SA(0, 0), cA, voffA); PG8_STAGE(PG8_SA(0, 1), cA + hstep, voffA);
        if (wr == 1) PG8_BAR;
        PG8_WAIT_V(2); PG8_BAR;
        PG8_STAGE(PG8_SB(1, 0), cB + kstep, voffB); PG8_STAGE(PG8_SA(1, 0), cA + kstep, voffA); PG8_STAGE(PG8_SB(1, 1), cB + hstep + kstep, voffB);
        PG8_WAIT_V(6); PG8_BAR;
    } else {
        PG8_STAGE(PG8_SB(0, 0), cB, voffB); PG8_STAGE(PG8_SA(0, 0), cA, voffA); PG8_STAGE(PG8_SB(0, 1), cB + hstep, voffB); PG8_STAGE(PG8_SA(0, 1), cA + hstep, voffA);
        if (wr == 1) PG8_BAR;
        PG8_WAIT_V(4); PG8_BAR;
        PG8_STAGE(PG8_SB(1, 0), cB + kstep, voffB); PG8_STAGE(PG8_SA(1, 0), cA + kstep, voffA); PG8_STAGE(PG8_SB(1, 1), cB + hstep + kstep, voffB);
        PG8_WAIT_V(6); PG8_BAR;
    }
    for (;;) {
        const bool has_next = S.next(ui + 1, nxt);
        const char* nA = has_next ? (const char*)g.A + (size_t)nxt.pm * tstep : cA; const char* nB = has_next ? (const char*)g.Bt + (size_t)nxt.pn * tstep : cB;
        for (int t = 0; t < nt; t += 2) {
            const bool last = (t == nt - 2);
            const char* a1 = cA + (size_t)(t + 1) * kstep;
            const char* a2 = last ? nA : cA + (size_t)(t + 2) * kstep; const char* b2 = last ? nB : cB + (size_t)(t + 2) * kstep;
            const char* a3 = a2 + kstep; const char* b3 = b2 + kstep;
            if (last && has_next) S.a_ready(nxt);
            if constexpr (SP2) {
            PG8_LDB(B0, 0, 0); PG8_LDB(B1, 0, 1); PG8_SCHED; PG8_LDA(At, 0, 0); PG8_STAGE(PG8_SA(1, 1), a1 + hstep, voffA);
            PG8_WAIT_V(8); PG8_WAIT_L(0); PG8_BAR; PG8_MMA(0, 0, At, B0); PG8_MMA(0, 1, At, B1); PG8_BAR; PG8_SCHED;
            PG8_LDA(At, 0, 1); PG8_STAGE(PG8_SB(0, 0), b2, voffB); PG8_STAGE(PG8_SB(0, 1), b2 + hstep, voffB); PG8_STAGE(PG8_SA(0, 0), a2, voffA);
            PG8_WAIT_V(8); PG8_WAIT_L(0); PG8_BAR; PG8_MMA(1, 0, At, B0); PG8_MMA(1, 1, At, B1); PG8_BAR; PG8_SCHED;
            PG8_LDB(B0, 1, 0); PG8_LDB(B1, 1, 1); PG8_SCHED; PG8_LDA(At, 1, 0); PG8_STAGE(PG8_SA(0, 1), a2 + hstep, voffA);
            PG8_WAIT_V(8); PG8_WAIT_L(0); PG8_BAR; PG8_MMA(0, 0, At, B0); PG8_MMA(0, 1, At, B1); PG8_BAR; PG8_SCHED;
            PG8_LDA(At, 1, 1); PG8_STAGE(PG8_SB(1, 0), b3, voffB); PG8_STAGE(PG8_SB(1, 1), b3 + hstep, voffB); PG8_STAGE(PG8_SA(1, 0), a3, voffA);
            PG8_WAIT_V(8); PG8_WAIT_L(0); PG8_BAR; PG8_MMA(1, 0, At, B0); PG8_MMA(1, 1, At, B1); PG8_BAR; PG8_SCHED;
            } else {
            PG8_LDB(B0, 0, 0); PG8_SCHED; PG8_LDA(At, 0, 0); PG8_STAGE(PG8_SA(1, 1), a1 + hstep, voffA);
            PG8_WAIT_L(8); PG8_BAR; PG8_WAIT_L(0); PG8_MMA(0, 0, At, B0); PG8_BAR; PG8_SCHED;
            PG8_LDB(B1, 0, 1); PG8_STAGE(PG8_SB(0, 0), b2, voffB);
            PG8_BAR; PG8_WAIT_L(0); PG8_MMA(0, 1, At, B1); PG8_BAR;
            PG8_LDA(At, 0, 1); PG8_STAGE(PG8_SA(0, 0), a2, voffA);
            PG8_BAR; PG8_WAIT_L(0); PG8_MMA(1, 0, At, B0); PG8_BAR; PG8_SCHED;
            PG8_STAGE(PG8_SB(0, 1), b2 + hstep, voffB);
            PG8_WAIT_V(6); PG8_BAR; PG8_MMA(1, 1, At, B1); PG8_BAR;
            PG8_LDB(B0, 1, 0); PG8_SCHED; PG8_LDA(At, 1, 0); PG8_STAGE(PG8_SA(0, 1), a2 + hstep, voffA);
            PG8_WAIT_L(8); PG8_BAR; PG8_WAIT_L(0); PG8_MMA(0, 0, At, B0); PG8_BAR; PG8_SCHED;
            PG8_LDB(B1, 1, 1); PG8_STAGE(PG8_SB(1, 0), b3, voffB);
            PG8_BAR; PG8_WAIT_L(0); PG8_MMA(0, 1, At, B1); PG8_BAR;
            PG8_LDA(At, 1, 1); PG8_STAGE(PG8_SA(1, 0), a3, voffA);
            PG8_BAR; PG8_WAIT_L(0); PG8_MMA(1, 0, At, B0); PG8_BAR; PG8_SCHED;
            PG8_STAGE(PG8_SB(1, 1), b3 + hstep, voffB);
            PG8_WAIT_V(6); PG8_BAR; PG8_MMA(1, 1, At, B1); PG8_BAR;
            }
        }
        if constexpr (ALIGN_EPI) { if (wr == 0) PG8_BAR; }
        if constexpr (!Epi::AFTER_DRAIN) { E(acc, cur, wr, wc, fr, fq); S.done(cur); }
        if (!has_next) break;
#pragma unroll
        for (int a = 0; a < 2; ++a)
#pragma unroll
            for (int b = 0; b < 2; ++b)
#pragma unroll
                for (int m = 0; m < 4; ++m)
#pragma unroll
                    for (int n = 0; n < 2; ++n) acc[a][b][m][n] = (f32x4){0.f, 0.f, 0.f, 0.f};
        cur = nxt; cA = nA; cB = nB; ++ui;
        if constexpr (ALIGN_EPI) { if (wr == 1) PG8_BAR; }
    }
    PG8_WAIT_V(0);
    if constexpr (!ALIGN_EPI) { if (wr == 0) PG8_BAR; }
    PG8_BAR;
    if constexpr (Epi::AFTER_DRAIN) { E.fused(acc, cur, wr, wc, fr, fq, lds, wid, lane); S.done(cur); }
#undef PG8_SA
#undef PG8_SB
#undef PG8_STAGE
#undef PG8_LDA
#undef PG8_LDB
#undef PG8_MMA
#undef PG8_WAIT_V
#undef PG8_WAIT_L
#undef PG8_BAR
#undef PG8_SCHED
}
}

namespace attn_body {
using bf16=__hip_bfloat16;
using bf16x8=__attribute__((ext_vector_type(8)))short;
using s16x4=__attribute__((ext_vector_type(4)))short;
using f32x16=__attribute__((ext_vector_type(16)))float;
using u32x4=__attribute__((ext_vector_type(4)))unsigned;
constexpr int D=64;
constexpr int NW=8,QBLK=32,QB=QBLK*NW,KVBLK=64;
__device__ __forceinline__ int crow(int r,int hi){return (r&3)+8*(r>>2)+4*hi;}
#define SBAR() __builtin_amdgcn_sched_barrier(0)
__device__ __forceinline__ void cmask(f32x16&p0,f32x16&p1,int jb,int qrel,int hi){
  const float NEG=-INFINITY; int kb=64*jb+4*hi;
  #pragma unroll
  for(int r=0;r<16;++r){int kv=kb+(r&3)+8*(r>>2); if(kv>qrel)p0[r]=NEG; if(kv+32>qrel)p1[r]=NEG;}
}

__device__ __forceinline__ void lmask(f32x16&p0,f32x16&p1,int t,int qrel,int hi){
  const float NEG=-30000.f; int kb=64*t+4*hi;
  #pragma unroll
  for(int r=0;r<16;++r){int kv=kb+(r&3)+8*(r>>2); if(kv<=qrel)p0[r]=NEG; if(kv+32<=qrel)p1[r]=NEG;}
}
__device__ __forceinline__ void smask(f32x16&p0,f32x16&p1,bool on){
  const float NEG=-INFINITY;
  #pragma unroll
  for(int r=0;r<16;++r){ p0[r]=on?p0[r]:NEG; p1[r]=on?p1[r]:NEG; }
}
constexpr int NSLOT=3, SLOTB=8192;
constexpr int LDS_K=0, LDS_V=NSLOT*SLOTB, LDS_WS=2*NSLOT*SLOTB, LDS_OST=LDS_WS+NW*64*4, LDS_BYTES=LDS_OST+NW*4096;
constexpr float C2=0.125f*1.4426950408889634f;
__device__ __forceinline__ void glds16(const void*gsrc,unsigned lds_dst){unsigned keep;
  asm volatile("s_mov_b32 %0, m0\n\ts_mov_b32 m0, %2\n\ts_nop 0\n\tglobal_load_lds_dwordx4 %1, off\n\ts_mov_b32 m0, %0":"=&s"(keep):"v"(gsrc),"s"(lds_dst):"memory");}
__device__ __forceinline__ float max3f(float a,float b,float c){float r;asm("v_max3_f32 %0, %1, %2, %3":"=v"(r):"v"(a),"v"(b),"v"(c));return r;}
__device__ __forceinline__ float max2f(float a,float b){float r;asm("v_max_f32_e32 %0, %1, %2":"=v"(r):"v"(a),"v"(b));return r;}
__device__ __forceinline__ float fadd_s(float a,float b){float r;asm("v_add_f32_e32 %0, %1, %2":"=v"(r):"v"(a),"v"(b));return r;}
__device__ __forceinline__ float fsub_s(float a,float b){float r;asm("v_sub_f32_e32 %0, %1, %2":"=v"(r):"v"(a),"v"(b));return r;}
typedef float f32x2_t __attribute__((ext_vector_type(2))); typedef __bf16 bf16x2_t __attribute__((ext_vector_type(2)));
__device__ __forceinline__ unsigned cvtpk_s(float lo,float hi){f32x2_t v={lo,hi};bf16x2_t b=__builtin_convertvector(v,bf16x2_t);return __builtin_bit_cast(unsigned,b);}
#define WAIT_BAR(N) asm volatile("s_waitcnt vmcnt(" #N ") lgkmcnt(0)\n\ts_barrier":::"memory")

__device__ __forceinline__ void qkt(f32x16&p0,f32x16&p1,const char*Kslot,const bf16x8*qr,const f32x16&negm,int r32,int hi){
  const char*kb=Kslot+hi*1024+r32*16;
  #pragma unroll
  for(int d0=0;d0<4;++d0){
    const bf16x8 b0=*reinterpret_cast<const bf16x8*>(kb+d0*2048);
    const bf16x8 b1=*reinterpret_cast<const bf16x8*>(kb+d0*2048+512);
    if(d0==0){p0=__builtin_amdgcn_mfma_f32_32x32x16_bf16(b0,qr[0],negm,0,0,0);p1=__builtin_amdgcn_mfma_f32_32x32x16_bf16(b1,qr[0],negm,0,0,0);}
    else{p0=__builtin_amdgcn_mfma_f32_32x32x16_bf16(b0,qr[d0],p0,0,0,0);p1=__builtin_amdgcn_mfma_f32_32x32x16_bf16(b1,qr[d0],p1,0,0,0);}}
}
typedef __attribute__((address_space(3))) const char* lds_cptr;
typedef short v4i16_t __attribute__((ext_vector_type(4)));
__device__ __forceinline__ void kload8(bf16x8*kf,lds_cptr kp){
  kf[0]=*(const __attribute__((address_space(3))) bf16x8*)(kp);      kf[1]=*(const __attribute__((address_space(3))) bf16x8*)(kp+512);
  kf[2]=*(const __attribute__((address_space(3))) bf16x8*)(kp+2048); kf[3]=*(const __attribute__((address_space(3))) bf16x8*)(kp+2560);
  kf[4]=*(const __attribute__((address_space(3))) bf16x8*)(kp+4096); kf[5]=*(const __attribute__((address_space(3))) bf16x8*)(kp+4608);
  kf[6]=*(const __attribute__((address_space(3))) bf16x8*)(kp+6144); kf[7]=*(const __attribute__((address_space(3))) bf16x8*)(kp+6656);
}
__device__ __forceinline__ void kload2(bf16x8*kf,lds_cptr kp,int j){ kf[2*j]=*(const __attribute__((address_space(3))) bf16x8*)(kp+j*2048); kf[2*j+1]=*(const __attribute__((address_space(3))) bf16x8*)(kp+j*2048+512); }
__device__ __forceinline__ s16x4 vtr(lds_cptr p){ return __builtin_bit_cast(s16x4,__builtin_amdgcn_ds_read_tr16_b64_v4i16((__attribute__((address_space(3))) v4i16_t*)p)); }
__device__ __forceinline__ float rowmax(const f32x16&p0,const f32x16&p1){
  float a=max3f(p0[0],p0[1],p1[0]),b=max3f(p0[2],p0[3],p1[1]);a=max3f(a,p1[2],p1[3]);
  #pragma unroll
  for(int r=4;r<16;r+=4){a=max3f(a,p0[r],p0[r+1]);b=max3f(b,p0[r+2],p0[r+3]);a=max3f(a,p1[r],p1[r+1]);b=max3f(b,p1[r+2],p1[r+3]);}
  const float m=max2f(a,b);
  auto rr=__builtin_amdgcn_permlane32_swap(__float_as_uint(m),__float_as_uint(m),false,false);
  return max2f(__uint_as_float(rr[0]),__uint_as_float(rr[1]));
}
__device__ __forceinline__ void pv(f32x16*o,int vb,bf16x8 pa0,bf16x8 pa1,bf16x8 pa2,bf16x8 pa3){
  #pragma unroll
  for(int d0=0;d0<2;++d0){s16x4 lo[4],hi[4];
    #pragma unroll
    for(int ks=0;ks<4;++ks){
      asm volatile("ds_read_b64_tr_b16 %0,%1 offset:%c2":"=&v"(lo[ks]):"v"(vb),"i"(d0*4096+ks*1024):"memory");
      asm volatile("ds_read_b64_tr_b16 %0,%1 offset:%c2":"=&v"(hi[ks]):"v"(vb),"i"(d0*4096+ks*1024+512):"memory");}
    asm volatile("s_waitcnt lgkmcnt(0)":::"memory");SBAR();
    #define PK(k) (bf16x8){lo[k][0],lo[k][1],lo[k][2],lo[k][3],hi[k][0],hi[k][1],hi[k][2],hi[k][3]}
    o[d0]=__builtin_amdgcn_mfma_f32_32x32x16_bf16(pa0,PK(0),o[d0],0,0,0);
    o[d0]=__builtin_amdgcn_mfma_f32_32x32x16_bf16(pa1,PK(1),o[d0],0,0,0);
    o[d0]=__builtin_amdgcn_mfma_f32_32x32x16_bf16(pa2,PK(2),o[d0],0,0,0);
    o[d0]=__builtin_amdgcn_mfma_f32_32x32x16_bf16(pa3,PK(3),o[d0],0,0,0);
    #undef PK
  }
}

#ifndef ATTN_STORE16
#define ATTN_STORE16(p,v) (*(u32x4*)(p)=(v))
#endif
template<int THRL,int MODE> __device__ __forceinline__ void attn_unit(long rowbase,int qb,const bf16*Qh,int ldq,const bf16*__restrict__ Kh0,const bf16*__restrict__ Vh0,int ldkv,bf16*Oh,int ldo,const unsigned long long*selrow,char*shm){
  const int tid=tid_(),lane=tid&63,r32=lane&31,hi=lane>>5; const int wid=__builtin_amdgcn_readfirstlane(tid>>6);
  const int q0=qb*QB;
  int t_lo=0; bool lower=false; if(MODE==2){ if(qb>=2){ t_lo=4*qb-8; lower=true; } }
  const bf16*Qw=Qh+(rowbase+q0+wid*QBLK)*ldq;
  const bf16*Kh=Kh0+(rowbase+(long)t_lo*KVBLK)*ldkv,*Vh=Vh0+(rowbase+(long)t_lo*KVBLK)*ldkv;
  const unsigned lds0=(unsigned)(uintptr_t)shm;
  float*wsf=(float*)(shm+LDS_WS)+wid*64;
  const bf16*ksrc=Kh+(long)lane*ldkv+wid*8;
  const bf16*vsrc=Vh+(long)(16*(wid&3)+(lane>>2))*ldkv+(wid>>2)*32+(lane&3)*8;
  const unsigned kdst=lds0+LDS_K+wid*1024, vdst=lds0+LDS_V+wid*1024;
  #define DMA_K(t,slot) glds16(ksrc+(long)(t)*KVBLK*ldkv,(unsigned)__builtin_amdgcn_readfirstlane(kdst+(slot)))
  #define DMA_V(t,slot) glds16(vsrc+(long)(t)*KVBLK*ldkv,(unsigned)__builtin_amdgcn_readfirstlane(vdst+(slot)))
  const int vb0=(int)(lds0+LDS_V)+((lane>>4)&1)*32+(lane&3)*8+(4*hi+((lane&15)>>2))*64;
  const char*Kbase=shm+LDS_K; bf16x8 kf[8];
  const lds_cptr shm3=(lds_cptr)shm; const lds_cptr kp0=shm3+LDS_K+hi*1024+r32*16; const lds_cptr vp0=shm3+LDS_V+((lane>>4)&1)*32+(lane&3)*8+(4*hi+((lane&15)>>2))*64;
  const int NT=(q0+QB)/KVBLK-t_lo;
  DMA_K(0,0);DMA_V(0,0);DMA_K(1,SLOTB);
  bf16x8 qr[4];
  #pragma unroll
  for(int d0=0;d0<4;++d0)qr[d0]=*reinterpret_cast<const bf16x8*>(&Qw[(long)r32*ldq+d0*16+hi*8]);
  float mhat=0.f,l_reg=0.f;f32x16 o[2];o[0]=f32x16{};o[1]=f32x16{};f32x16 negm=f32x16{};asm volatile("":"+v"(negm));
  const int qrel=wid*QBLK+r32;
  unsigned long long msk=0ull; if(MODE==1) msk=selrow[q0+qrel];
  #define XMASK(P0,P1,t) do{ if(MODE==1) smask(P0,P1,((msk>>(t))&1ull)!=0ull); if(MODE==2){ if(lower&&(t)<4) lmask(P0,P1,(t),qrel,hi); } }while(0)
  #define CMASK(P0,P1,t) do{ XMASK(P0,P1,t); int jb_=(t)-(NT-4); if(jb_>=0)cmask(P0,P1,jb_,qrel,hi);}while(0)
  bool resc=false;
  #define START(P0,P1) do{ const float rm=rowmax(P0,P1); resc=false; \
    { const float dl=rm; mhat=fadd_s(mhat,dl); \
      _Pragma("unroll") for(int r=0;r<16;++r){P0[r]=fsub_s(P0[r],dl);P1[r]=fsub_s(P1[r],dl);} \
      _Pragma("unroll") for(int r=0;r<16;++r)negm[r]=-mhat; asm volatile("":"+v"(negm)); } \
    _Pragma("unroll") for(int r=0;r<16;++r)P0[r]=__builtin_amdgcn_exp2f(P0[r]); }while(0)
  #define RESC() do{ if(resc){ asm volatile("s_waitcnt lgkmcnt(0)":::"memory"); \
      _Pragma("unroll") for(int d_=0;d_<2;++d_) _Pragma("unroll") for(int r=0;r<16;++r)o[d_][r]*=wsf[crow(r,hi)]; } }while(0)
  f32x16 pA0,pA1,pB0,pB1;
  int sl_prev=0,sl_cur=0,sl_next=SLOTB;
  #define ROT() do{sl_prev=sl_cur;sl_cur=sl_next;sl_next=(sl_next==(NSLOT-1)*SLOTB)?0:sl_next+SLOTB;}while(0)
  DMA_K(2,2*SLOTB);
  WAIT_BAR(3);
  qkt(pA0,pA1,Kbase,qr,negm,r32,hi);asm volatile("s_nop 15\n\ts_nop 7":"+v"(pA0),"+v"(pA1));CMASK(pA0,pA1,0);
  START(pA0,pA1);
  _Pragma("unroll") for(int r=0;r<16;++r)pA1[r]=__builtin_amdgcn_exp2f(pA1[r]);
  WAIT_BAR(0);
  DMA_K(3,0);DMA_V(1,SLOTB);
  ROT();
  kload8(kf,kp0+sl_cur);
  WAIT_BAR(2);
  s16x4 vlo[8],vhi[8]; u32x4 pw0,pw1,pw2,pw3;
  #define PKW(P,B) cvtpk_s(P[B],P[B+1])
  #define PAF(k) __builtin_bit_cast(bf16x8,pw##k)
  #define VFR(i) (bf16x8){vlo[i][0],vlo[i][1],vlo[i][2],vlo[i][3],vhi[i][0],vhi[i][1],vhi[i][2],vhi[i][3]}
  #define PIN(x) asm volatile("":"+v"(x))
  #define MX3(a,b,c) __builtin_fmaxf(__builtin_fmaxf((a),(b)),(c))
  #define GAPA(MF,A0,A1,A2,A3,W0,W1,PW) do{ MF; sacc+=A0; sacc+=A1; sacc+=A2; sacc+=A3; PIN(sacc); W0; W1; PIN(PW); SBAR(); }while(0)
  #define EX(v) __builtin_amdgcn_exp2f(v)
  #define GAPB(MF,X,B) do{ MF; X[B]=EX(X[B]); X[B+1]=EX(X[B+1]); X[B+2]=EX(X[B+2]); X[B+3]=EX(X[B+3]); PIN(X); SBAR(); }while(0)
  #define VRD(i) do{ vlo[i]=vtr(vp_+(((i)>>2)*4096+((i)&3)*1024)); vhi[i]=vtr(vp_+(((i)>>2)*4096+((i)&3)*1024+512)); }while(0)
  #define KRD(G,j) do{ if(G){ kload2(kf,kp0+sl_next,j); SBAR(); } }while(0)
  #define STEP(C0,C1,P0,P1,t,GK,GV,GL) do{ SBAR(); \
    const lds_cptr vp_=vp0+sl_prev; \
    VRD(0); SBAR(); float sacc=(P0[0]+P0[1]); \
    GAPA(C0=__builtin_amdgcn_mfma_f32_32x32x16_bf16(kf[0],qr[0],negm,0,0,0), P0[2],P0[3],P0[4],P0[5],     pw0[0]=PKW(P0,0), pw0[1]=PKW(P0,2), pw0); \
    VRD(4); SBAR(); GAPA(C1=__builtin_amdgcn_mfma_f32_32x32x16_bf16(kf[1],qr[0],negm,0,0,0), P0[6],P0[7],P0[8],P0[9],     pw0[2]=PKW(P0,4), pw0[3]=PKW(P0,6), pw0); \
    VRD(1); SBAR(); GAPA(C0=__builtin_amdgcn_mfma_f32_32x32x16_bf16(kf[2],qr[1],C0,0,0,0),   P0[10],P0[11],P0[12],P0[13], pw1[0]=PKW(P0,8), pw1[1]=PKW(P0,10), pw1); \
    VRD(5); SBAR(); GAPA(C1=__builtin_amdgcn_mfma_f32_32x32x16_bf16(kf[3],qr[1],C1,0,0,0),   P0[14],P0[15],P1[0],P1[1],   pw1[2]=PKW(P0,12),pw1[3]=PKW(P0,14), pw1); \
    VRD(2); SBAR(); GAPA(C0=__builtin_amdgcn_mfma_f32_32x32x16_bf16(kf[4],qr[2],C0,0,0,0),   P1[2],P1[3],P1[4],P1[5],     pw2[0]=PKW(P1,0), pw2[1]=PKW(P1,2), pw2); \
    VRD(6); SBAR(); GAPA(C1=__builtin_amdgcn_mfma_f32_32x32x16_bf16(kf[5],qr[2],C1,0,0,0),   P1[6],P1[7],P1[8],P1[9],     pw2[2]=PKW(P1,4), pw2[3]=PKW(P1,6), pw2); \
    VRD(3); SBAR(); GAPA(C0=__builtin_amdgcn_mfma_f32_32x32x16_bf16(kf[6],qr[3],C0,0,0,0),   P1[10],P1[11],P1[12],P1[13], pw3[0]=PKW(P1,8), pw3[1]=PKW(P1,10), pw3); \
    VRD(7); SBAR(); GAPA(C1=__builtin_amdgcn_mfma_f32_32x32x16_bf16(kf[7],qr[3],C1,0,0,0),   P1[14],P1[15],0.f,0.f,       pw3[2]=PKW(P1,12),pw3[3]=PKW(P1,14), pw3); \
    l_reg+=sacc; \
    if(GK){DMA_K((t)+3,sl_cur);} if(GV){DMA_V((t)+1,sl_next);} \
    CMASK(C0,C1,t); \
    { float a=MX3(C0[0],C0[1],C1[0]),b=MX3(C0[2],C0[3],C1[1]); a=MX3(a,C1[2],C1[3]); \
      _Pragma("unroll") for(int r=4;r<16;r+=4){a=MX3(a,C0[r],C0[r+1]);b=MX3(b,C0[r+2],C0[r+3]);a=MX3(a,C1[r],C1[r+1]);b=MX3(b,C1[r+2],C1[r+3]);} \
      float rm=__builtin_fmaxf(a,b); { auto rr=__builtin_amdgcn_permlane32_swap(__float_as_uint(rm),__float_as_uint(rm),false,false); rm=__builtin_fmaxf(__uint_as_float(rr[0]),__uint_as_float(rr[1])); } \
      resc=false; \
      if(__builtin_expect(__any(rm>(float)THRL),0)){ const float dl=__builtin_fmaxf(rm,0.f); mhat+=dl; \
        _Pragma("unroll") for(int r=0;r<16;++r){C0[r]-=dl;C1[r]-=dl;} \
        _Pragma("unroll") for(int r=0;r<16;++r)negm[r]=-mhat; asm volatile("":"+v"(negm)); \
        const float f=__builtin_amdgcn_exp2f(-dl); l_reg*=f; if(hi==0)wsf[r32]=f; resc=true; } } \
    SBAR(); \
    GAPB(o[0]=__builtin_amdgcn_mfma_f32_32x32x16_bf16(PAF(0),VFR(0),o[0],0,0,0), C0,0); \
    GAPB(o[1]=__builtin_amdgcn_mfma_f32_32x32x16_bf16(PAF(0),VFR(4),o[1],0,0,0), C0,4); \
    KRD(GL,0); GAPB(o[0]=__builtin_amdgcn_mfma_f32_32x32x16_bf16(PAF(1),VFR(1),o[0],0,0,0), C0,8); \
    KRD(GL,1); GAPB(o[1]=__builtin_amdgcn_mfma_f32_32x32x16_bf16(PAF(1),VFR(5),o[1],0,0,0), C0,12); \
    KRD(GL,2); GAPB(o[0]=__builtin_amdgcn_mfma_f32_32x32x16_bf16(PAF(2),VFR(2),o[0],0,0,0), C1,0); \
    KRD(GL,3); GAPB(o[1]=__builtin_amdgcn_mfma_f32_32x32x16_bf16(PAF(2),VFR(6),o[1],0,0,0), C1,4); \
    GAPB(o[0]=__builtin_amdgcn_mfma_f32_32x32x16_bf16(PAF(3),VFR(3),o[0],0,0,0), C1,8); \
    GAPB(o[1]=__builtin_amdgcn_mfma_f32_32x32x16_bf16(PAF(3),VFR(7),o[1],0,0,0), C1,12); \
    }while(0)
  int t=1;
  #undef CMASK
  #define CMASK(P0,P1,t) XMASK(P0,P1,t)
  for(;t+5<NT;t+=2){
    STEP(pB0,pB1,pA0,pA1,t,true,true,true);     WAIT_BAR(2); RESC(); ROT();
    STEP(pA0,pA1,pB0,pB1,t+1,true,true,true);   WAIT_BAR(2); RESC(); ROT();
  }
  #undef CMASK
  #define CMASK(P0,P1,t) do{ XMASK(P0,P1,t); int jb_=(t)-(NT-4); if(jb_>=0)cmask(P0,P1,jb_,qrel,hi);}while(0)
  #define ENDW(tt) do{ if((tt)+3<NT){WAIT_BAR(2);} else if((tt)+2<NT){WAIT_BAR(1);} else {WAIT_BAR(0);} }while(0)
  for(;t+1<NT;t+=2){
    STEP(pB0,pB1,pA0,pA1,t,(t+3<NT),(t+1<NT),(t+1<NT));       ENDW(t);   RESC(); ROT();
    STEP(pA0,pA1,pB0,pB1,t+1,(t+4<NT),(t+2<NT),(t+2<NT));     ENDW(t+1); RESC(); ROT();
  }
  STEP(pB0,pB1,pA0,pA1,NT-1,false,false,false); RESC();
  { float sacc=pB0[0]+pB0[1]; _Pragma("unroll") for(int r=2;r<16;++r)sacc+=pB0[r]; _Pragma("unroll") for(int r=0;r<16;++r)sacc+=pB1[r]; l_reg+=sacc;
    pw0=(u32x4){PKW(pB0,0),PKW(pB0,2),PKW(pB0,4),PKW(pB0,6)};pw1=(u32x4){PKW(pB0,8),PKW(pB0,10),PKW(pB0,12),PKW(pB0,14)};pw2=(u32x4){PKW(pB1,0),PKW(pB1,2),PKW(pB1,4),PKW(pB1,6)};pw3=(u32x4){PKW(pB1,8),PKW(pB1,10),PKW(pB1,12),PKW(pB1,14)};
    SBAR(); pv(o,vb0+sl_cur,PAF(0),PAF(1),PAF(2),PAF(3)); }
  #undef PKW
  #undef PAF
  #undef VFR
  #undef PIN
  #undef MX3
  #undef GAPA
  #undef GAPB
  #undef EX
  #undef VRD
  #undef KRD
  #undef STEP
  #undef ENDW
  {auto rr=__builtin_amdgcn_permlane32_swap(__float_as_uint(l_reg),__float_as_uint(l_reg),false,false);l_reg=__uint_as_float(rr[0])+__uint_as_float(rr[1]);}
  if(hi==0)wsf[32+r32]=l_reg;asm volatile("s_waitcnt lgkmcnt(0)":::"memory");
  float rli[16];
  #pragma unroll
  for(int r=0;r<16;++r)rli[r]=__builtin_amdgcn_rcpf(wsf[32+crow(r,hi)]);
  bf16*Ow=Oh+(rowbase+q0+wid*QBLK)*ldo;
  { bf16*stg=(bf16*)(shm+LDS_OST)+wid*2048;
    #pragma unroll
    for(int r=0;r<16;++r){const int orow=crow(r,hi);
      #pragma unroll
      for(int d0=0;d0<2;++d0)stg[orow*64+d0*32+r32]=__float2bfloat16(o[d0][r]*rli[r]);}
    asm volatile("s_waitcnt lgkmcnt(0)":::"memory");
    #pragma unroll
    for(int i=0;i<4;++i){const int row=i*8+(lane>>3),ch=lane&7; const u32x4 v=*(const u32x4*)(stg+row*64+ch*8); ATTN_STORE16(Ow+(long)row*ldo+ch*8,v);} }
  asm volatile("s_waitcnt lgkmcnt(0)\n\ts_barrier":::"memory");
  #undef DMA_K
  #undef DMA_V
  #undef CMASK
  #undef XMASK
  #undef START
  #undef RESC
  #undef ROT
}
constexpr int ATTN_LDS_BYTES=LDS_BYTES;
#undef SBAR
#undef WAIT_BAR
}

__device__ __forceinline__ void ph_attn_diff_fast(unsigned char* lds) {
  using namespace attn_body;
  const bf16* PROJ = (const bf16*)(P(ws) + WS_PROJ); bf16* ATT = (bf16*)(P(ws) + WS_ATT);
  const int G = gdim_(), bx = bid_(); const int v0 = (G % 8 == 0) ? (bx % 8) * (G / 8) + bx / 8 : bx;
  for (int vcu = v0; vcu < 256; vcu += G) {
    const int bhp = vcu >> 1, half = bhp & 1, c = (bhp >> 1) & 1, h8 = (bhp >> 2) & 7, b = bhp >> 5;
#pragma unroll 1
    for (int i = 0; i < 8; ++i) { const int sp = 4 * (vcu & 1) + (i >> 1); const int qb = (i & 1) ? 15 - sp : sp;
      attn_unit<8, 0>((long)b * S, qb, PROJ + (h8 * 2 + c) * 64, DIFF_IN, PROJ + 1024 + (h8 * 2 + c) * 64, PROJ + 2048 + h8 * 128 + half * 64, DIFF_IN,
                      ATT + c * 1024 + h8 * 128 + half * 64, 2048, nullptr, (char*)lds); }
  }
}
__device__ __forceinline__ void ph_attn_sel_fast(unsigned char* lds) {
  using namespace attn_body;
  const bf16* PROJ = (const bf16*)(P(ws) + WS_PROJ); bf16* OSEL = (bf16*)(P(ws) + WS_ATT + 32 * MiB);
  const u64* SEL = (const u64*)(P(ws) + WS_SEL);
  const int G = gdim_(), bx = bid_(); const int v0 = (G % 8 == 0) ? (bx % 8) * (G / 8) + bx / 8 : bx;
  for (int vcu = v0; vcu < 256; vcu += G) {
    const int bh = vcu >> 2, hd = bh & 15, b = bh >> 4, g = hd >> 2;
#pragma unroll 1
    for (int i = 0; i < 4; ++i) { const int sp = 2 * (vcu & 3) + (i >> 1); const int qb = (i & 1) ? 15 - sp : sp;
      attn_unit<8, 1>((long)b * S, qb, PROJ + hd * 64, NSA_P, PROJ + 1536 + g * 64, PROJ + 1792 + g * 64, NSA_P, OSEL + hd * 64, 1024, SEL + (size_t)(b * 4 + g) * S, (char*)lds); }
  }
}
__device__ __forceinline__ void ph_attn_win_fast(unsigned char* lds) {
  using namespace attn_body;
  const bf16* PROJ = (const bf16*)(P(ws) + WS_PROJ); bf16* OWIN = (bf16*)(P(ws) + WS_ATT + 64 * MiB);
  const int G = gdim_(), bx = bid_(); const int v0 = (G % 8 == 0) ? (bx % 8) * (G / 8) + bx / 8 : bx;
  for (int vcu = v0; vcu < 256; vcu += G) {
    const int bh = vcu >> 2, hd = bh & 15, b = bh >> 4, g = hd >> 2;
#pragma unroll 1
    for (int i = 0; i < 4; ++i) { const int qb = (vcu & 3) + 4 * i;
      attn_unit<8, 2>((long)b * S, qb, PROJ + hd * 64, NSA_P, PROJ + 2048 + g * 64, PROJ + 2304 + g * 64, NSA_P, OWIN + hd * 64, 1024, nullptr, (char*)lds); }
  }
}

#define XB_TMO      128
#define XB_XCNT(j)  (256  + 64 * (j))
#define XB_XSUB(j)  (1280 + 64 * (j))
#define XB_XGEN(j)  (2304 + 64 * (j))
#define XB_TOP      3328
#define XB_TOPGEN   3392
#define XCD_BAR_WORDS 3456
#define XB_SPIN_CAP (1u << 18)

__device__ __forceinline__ unsigned xb_ld(unsigned* p)              { return __hip_atomic_load(p, __ATOMIC_RELAXED, __HIP_MEMORY_SCOPE_AGENT); }
__device__ __forceinline__ unsigned xb_add(unsigned* p, unsigned v) { return __hip_atomic_fetch_add(p, v, __ATOMIC_RELAXED, __HIP_MEMORY_SCOPE_AGENT); }
__device__ __forceinline__ unsigned xb_xcc_id() { return (unsigned)__builtin_amdgcn_s_getreg((3 << 11) | 20) & 0xFu; }
#define XB_SPIN(cond, bar) do { unsigned _sp = 0; while (cond) { __builtin_amdgcn_s_sleep(1); \
    if ((++_sp & 255u) == 0u) { if (xb_ld(&(bar)[XB_TMO])) break; if (_sp > XB_SPIN_CAP) { atomicAdd(&(bar)[XB_TMO], 1u); break; } } } } while (0)

struct XcdBarrier {
    unsigned* bar; unsigned x;
    volatile __attribute__((address_space(3))) unsigned* st;
};

__device__ __forceinline__ XcdBarrier xcd_barrier_post(unsigned* bar, volatile __attribute__((address_space(3))) unsigned* st) {
    XcdBarrier b; b.bar = bar; b.x = xb_xcc_id(); b.st = st;
    if (tid_() == 0) (void)xb_add(&bar[XB_XCNT(b.x)], 1u);
    return b;
}
__device__ __forceinline__ void xcd_barrier_complete(unsigned* bar, unsigned x, unsigned& nloc, unsigned& nx) {
    const unsigned G = gridDim.x * gridDim.y * gridDim.z;
    unsigned sum, cnt, mine, sp = 0u;
    for (;;) {
        sum = 0u; cnt = 0u; mine = 0u;
#pragma unroll
        for (unsigned j = 0; j < 16; ++j) { const unsigned c = xb_ld(&bar[XB_XCNT(j)]); sum += c; cnt += (c > 0u) ? 1u : 0u; mine = (j == x) ? c : mine; }
        if (sum == G) break;
        __builtin_amdgcn_s_sleep(1);
        if ((++sp & 255u) == 0u) { if (xb_ld(&bar[XB_TMO])) break; if (sp > XB_SPIN_CAP) { atomicAdd(&bar[XB_TMO], 1u); break; } }
    }
    nloc = mine > 0u ? mine : 1u; nx = cnt > 0u ? cnt : 1u;
}

__device__ __forceinline__ void xcd_barrier(const XcdBarrier& b) {
    asm volatile("s_waitcnt vmcnt(0)" ::: "memory");
    __syncthreads();
    if (tid_() == 0) {
        unsigned* bar = b.bar;
        __builtin_amdgcn_s_waitcnt(0);
        unsigned nloc = b.st[0], nx = b.st[1];
        if (nloc == 0u) { xcd_barrier_complete(bar, b.x, nloc, nx); b.st[0] = nloc; b.st[1] = nx; }
        const unsigned old = xb_add(&bar[XB_XSUB(b.x)], 1u);
        const unsigned gen = old / nloc;
        if (old + 1u == (gen + 1u) * nloc) {
            __builtin_amdgcn_fence(__ATOMIC_RELEASE, "agent");
            asm volatile("s_waitcnt vmcnt(0)" ::: "memory");
            const unsigned og = xb_add(&bar[XB_TOP], 1u);
            const unsigned tg = og / nx;
            if (og + 1u == (tg + 1u) * nx) xb_add(&bar[XB_TOPGEN], 1u);
            else XB_SPIN(xb_ld(&bar[XB_TOPGEN]) == tg, bar);
            __builtin_amdgcn_fence(__ATOMIC_ACQUIRE, "agent");
            xb_add(&bar[XB_XGEN(b.x)], 1u);
            asm volatile("s_waitcnt vmcnt(0)" ::: "memory");
        } else {
            XB_SPIN(xb_ld(&bar[XB_XGEN(b.x)]) == gen, bar);
            __builtin_amdgcn_fence(__ATOMIC_ACQUIRE, "agent");
            asm volatile("s_waitcnt vmcnt(0)" ::: "memory");
        }
    }
    __syncthreads();
}

__device__ __forceinline__ void ph_prologue(unsigned char* lds) {
  const int tid = tid_();
  float* silu = (float*)lds;
  float* red = silu + 4096;
  float* MOD = (float*)(P(ws) + WS_MOD);
  for (int i = tid; i < 4096; i += NTHR) { const float v = P(c)[i]; silu[i] = v / (1.f + expf(-v)); }
  __syncthreads();
  for (int item = bid_(); item < 4 * 48; item += gdim_()) {
    const int l = item / 48, nc = item % 48, cc = tid & 127, ks = tid >> 7;
    const float* w = P(w_ada) + ((size_t)l * 1024 + ks * 256) * 6144 + nc * 128 + cc;
    float a0 = 0.f, a1 = 0.f, a2 = 0.f, a3 = 0.f;
#pragma unroll 8
    for (int k = 0; k < 256; ++k) { const float wv = w[(size_t)k * 6144]; const int kk = ks * 256 + k;
      a0 += silu[kk] * wv; a1 += silu[1024 + kk] * wv; a2 += silu[2048 + kk] * wv; a3 += silu[3072 + kk] * wv; }
    red[(ks * 4 + 0) * 128 + cc] = a0; red[(ks * 4 + 1) * 128 + cc] = a1; red[(ks * 4 + 2) * 128 + cc] = a2; red[(ks * 4 + 3) * 128 + cc] = a3;
    __syncthreads();
    { const int b = tid >> 7;
      const float s = red[(0 * 4 + b) * 128 + cc] + red[(1 * 4 + b) * 128 + cc] + red[(2 * 4 + b) * 128 + cc] + red[(3 * 4 + b) * 128 + cc];
      MOD[(size_t)(l * 4 + b) * 6144 + nc * 128 + cc] = s + P(b_ada)[l * 6144 + nc * 128 + cc]; }
    __syncthreads();
  }
  float* rope = (float*)(P(ws) + WS_ROPE);
  for (int m = bid_() * NTHR + tid; m < T; m += gdim_() * NTHR) {
    const float fp = (float)P(pos)[m];
    const float INV[8] = {1.0f, 0.1939227432012558f, 0.03760603070259094f, 0.007292664609849453f, 0.0014142135623842478f, 0.00027424818836152554f, 5.3182957344688475e-05f, 1.0313385246263351e-05f};
#pragma unroll
    for (int i = 0; i < 8; ++i) {
      const float ang = fp * INV[i];
      const double a = (double)ang; const double kq = rint(a * 0.63661977236758134308); const double r = a - kq * 1.57079632679489661923;
      const int q = (int)((long long)kq & 3ll);
      const double r2 = r * r;
      const double sr = r * (1.0 + r2 * (-1.0 / 6 + r2 * (1.0 / 120 + r2 * (-1.0 / 5040 + r2 * (1.0 / 362880 + r2 * (-1.0 / 39916800 + r2 * (1.0 / 6227020800.0)))))));
      const double cr = 1.0 + r2 * (-0.5 + r2 * (1.0 / 24 + r2 * (-1.0 / 720 + r2 * (1.0 / 40320 + r2 * (-1.0 / 3628800 + r2 * (1.0 / 479001600.0))))));
      const double sn = (q == 0) ? sr : (q == 1) ? cr : (q == 2) ? -sr : -cr;
      const double cs = (q == 0) ? cr : (q == 1) ? -sr : (q == 2) ? -cr : sr;
      rope[(size_t)m * 16 + i] = (float)cs; rope[(size_t)m * 16 + 8 + i] = (float)sn;
    }
  }
  if (bid_() == 0 && tid < 2) {
    const int j = tid; float s1 = 0.f, s2 = 0.f;
    for (int i = 0; i < 64; ++i) { s1 += P(diff_lq1)[j * 64 + i] * P(diff_lk1)[j * 64 + i]; s2 += P(diff_lq2)[j * 64 + i] * P(diff_lk2)[j * 64 + i]; }
    ((float*)(P(ws) + WS_SMALL))[j] = expf(s1) - expf(s2) + lam_init_of(j);
  }
}


__device__ __forceinline__ void transpose_item(const float* W, int K, int N, int Npad, bf16_t* WT, float* scr, int item, int lane) {
  const int nblk = Npad / 32, kb = item / nblk, nb = item % nblk, k0 = 64 * kb, n0 = 32 * nb;
  const int ncol = n0 + (lane & 31); const bool ok = ncol < N;
#pragma unroll 8
  for (int i = 0; i < 32; ++i) { const int kk = 2 * i + (lane >> 5); scr[kk * 33 + (lane & 31)] = ok ? W[(size_t)(k0 + kk) * N + ncol] : 0.f; }
  asm volatile("s_waitcnt lgkmcnt(0)" ::: "memory");
  const int c = lane & 7;
#pragma unroll
  for (int j = 0; j < 4; ++j) { const int n = (lane >> 3) + 8 * j; const float* sp = scr + (8 * c) * 33 + n;
    uint4 o; o.x = pk2(sp[0 * 33], sp[1 * 33]); o.y = pk2(sp[2 * 33], sp[3 * 33]); o.z = pk2(sp[4 * 33], sp[5 * 33]); o.w = pk2(sp[6 * 33], sp[7 * 33]);
    *(uint4*)(WT + (size_t)(n0 + n) * K + k0 + 8 * c) = o; }
  asm volatile("s_waitcnt lgkmcnt(0)" ::: "memory");
}
__device__ __forceinline__ void ph_weights(unsigned char* lds) {
  const int tid = tid_(), lane = tid & 63, wave = tid >> 6;
  float* scr = (float*)(lds + wave * 16384);
  const int gw = bid_() * 8 + wave, NGW = gdim_() * 8;
  for (int it = gw; it < 4 * 6144; it += NGW) {
    const int i = it / 6144; int r = it % 6144; const int j = i >> 1; const bool nsa = (i & 1) == 0;
    bf16_t* base = (bf16_t*)(P(ws) + WS_WT + (size_t)i * WT_LAYER);
    const int n_in = nsa ? 16 * (NSA_P / 32) : 16 * (DIFF_IN / 32);
    if (r < n_in) { if (nsa) transpose_item(P(nsa_w_in) + (size_t)j * D * NSA_IN, D, NSA_IN, NSA_P, base, scr, r, lane); else transpose_item(P(diff_w_in) + (size_t)j * D * DIFF_IN, D, DIFF_IN, DIFF_IN, base, scr, r, lane); continue; }
    r -= n_in;
    if (r < 512) { transpose_item((nsa ? P(nsa_w_out) : P(diff_w_out)) + (size_t)j * D * D, D, D, D, base + WT_OUT / 2, scr, r, lane); continue; }
    r -= 512;
    if (r < 2048) { transpose_item(P(w_mlp_in) + (size_t)i * D * DFF, D, DFF, DFF, base + WT_MI / 2, scr, r, lane); continue; }
    r -= 2048;
    if (r < 2048) transpose_item(P(w_mlp_out) + (size_t)i * DFF * D, DFF, D, D, base + WT_MO / 2, scr, r, lane);
  }
}

__device__ __forceinline__ void ph_norm(const float* xin, const float* gvec, const float* mod  , int sh_off, int sc_off, bf16_t* H) {
  const int tid = tid_(), lane = tid & 63, wave = tid >> 6;
  for (int m = bid_() * 8 + wave; m < T; m += gdim_() * 8) {
    const int b = m >> 12;
    const float4* xr = (const float4*)(xin + (size_t)m * D) + lane;
    float4 v[4]; float ss = 0.f;
#pragma unroll
    for (int j = 0; j < 4; ++j) { v[j] = xr[64 * j]; ss += (v[j].x * v[j].x + v[j].y * v[j].y) + (v[j].z * v[j].z + v[j].w * v[j].w); }
    ss = wave_sum(ss);
    const float rstd = 1.0f / sqrtf(ss * (1.0f / D) + EPS);
#pragma unroll
    for (int j = 0; j < 4; ++j) {
      const int col = 4 * lane + 256 * j;
      const float4 g = *(const float4*)(gvec + col), sc = *(const float4*)(mod + (size_t)b * 6144 + sc_off + col), sh = *(const float4*)(mod + (size_t)b * 6144 + sh_off + col);
      const float h0 = v[j].x * rstd * g.x * (1.f + sc.x) + sh.x, h1 = v[j].y * rstd * g.y * (1.f + sc.y) + sh.y;
      const float h2 = v[j].z * rstd * g.z * (1.f + sc.z) + sh.z, h3 = v[j].w * rstd * g.w * (1.f + sc.w) + sh.w;
      uint2 o; o.x = pk2(h0, h1); o.y = pk2(h2, h3);
      *(uint2*)(H + (size_t)m * D + col) = o;
    }
  }
}

struct EpiStore { bf16_t* O; int ld; int relu2;
  __device__ __forceinline__ void operator()(int row, int col, const float* v) const {
    float a = v[0], b = v[1], c = v[2], d = v[3];
    if (relu2) { a = fmaxf(a, 0.f); a *= a; b = fmaxf(b, 0.f); b *= b; c = fmaxf(c, 0.f); c *= c; d = fmaxf(d, 0.f); d *= d; }
    uint2 o; o.x = pk2(a, b); o.y = pk2(c, d); *(uint2*)(O + (size_t)row * ld + col) = o; } };
struct EpiResid { const float* xin; float* xout; const float* gate;
  __device__ __forceinline__ void operator()(int row, int col, const float* v) const {
    const int b = row >> 12; const float4 g = *(const float4*)(gate + (size_t)b * 6144 + col); const float4 xi = *(const float4*)(xin + (size_t)row * D + col);
    float4 o; o.x = xi.x + g.x * v[0]; o.y = xi.y + g.y * v[1]; o.z = xi.z + g.z * v[2]; o.w = xi.w + g.w * v[3];
    *(float4*)(xout + (size_t)row * D + col) = o; } };

template <class Epi>
__device__ __forceinline__ void gemm_naive(const bf16_t* A, int lda, const float* W, int N, int K, unsigned char* lds, const Epi& E) {
  asm volatile("" : "+s"(N), "+s"(K), "+s"(lda));
  float* As = (float*)lds;
  float* Bs = As + 16 * 132;
  const int tid = tid_(), tx = tid & 31, ty = tid >> 5;
  const int nN = (N + 127) / 128, nM = T / 128;
  const int ar = tid >> 2, ak = (tid & 3) * 4, bk = tid >> 5, bc = (tid & 31) * 4;
  for (int u = bid_(); u < nM * nN; u += gdim_()) {
    const int pm = u / nN, pn = u % nN;
    float acc[8][4];
#pragma unroll
    for (int i = 0; i < 8; ++i) { acc[i][0] = 0.f; acc[i][1] = 0.f; acc[i][2] = 0.f; acc[i][3] = 0.f; }
    const bf16_t* Ap = A + (size_t)(pm * 128 + ar) * lda + ak;
    const int wcol = pn * 128 + bc; const bool bok = wcol < N;
    const float* Wp = W + (size_t)bk * N + (bok ? wcol : 0);
    for (int k0 = 0; k0 < K; k0 += 16) {
      const uint2 av = *(const uint2*)(Ap + k0);
      float4 bv = *(const float4*)(Wp + (size_t)k0 * N);
      if (!bok) bv = make_float4(0.f, 0.f, 0.f, 0.f);
      __syncthreads();
      As[(ak + 0) * 132 + ar] = bf2f(av.x & 0xffffu); As[(ak + 1) * 132 + ar] = bf2f(av.x >> 16);
      As[(ak + 2) * 132 + ar] = bf2f(av.y & 0xffffu); As[(ak + 3) * 132 + ar] = bf2f(av.y >> 16);
      *(float4*)(Bs + bk * 128 + bc) = bv;
      __syncthreads();
#pragma unroll
      for (int k = 0; k < 16; ++k) {
        const float4 a0 = *(const float4*)(As + k * 132 + ty * 8), a1 = *(const float4*)(As + k * 132 + ty * 8 + 4);
        const float4 b = *(const float4*)(Bs + k * 128 + tx * 4);
        const float a[8] = {a0.x, a0.y, a0.z, a0.w, a1.x, a1.y, a1.z, a1.w};
#pragma unroll
        for (int i = 0; i < 8; ++i) { acc[i][0] += a[i] * b.x; acc[i][1] += a[i] * b.y; acc[i][2] += a[i] * b.z; acc[i][3] += a[i] * b.w; }
      }
    }
    const int col = pn * 128 + tx * 4;
    if (col < N) {
#pragma unroll
      for (int i = 0; i < 8; ++i) E(pm * 128 + ty * 8 + i, col, acc[i]);
    }
  }
}

__device__ __forceinline__ void head_norm_rope(const float* v, const float* gain, const float* cs  , int sub, float* vn, float* vr) {
  float ss = 0.f;
#pragma unroll
  for (int i = 0; i < 8; ++i) ss += v[i] * v[i];
  ss += __shfl_xor(ss, 1); ss += __shfl_xor(ss, 2); ss += __shfl_xor(ss, 4);
  const float rstd = 1.0f / sqrtf(ss * (1.0f / 64.0f) + EPS);
#pragma unroll
  for (int i = 0; i < 8; ++i) vn[i] = v[i] * rstd * gain[sub * 8 + i];
#pragma unroll
  for (int i = 0; i < 8; ++i) {
    const float other = __shfl_xor(vn[i], 1);
    const float c = cs[i], s = cs[8 + i];
    float r = vn[i];
    if (sub == 0) r = vn[i] * c - other * s;
    else if (sub == 1) r = vn[i] * c + other * s;
    vr[i] = r;
  }
}

__device__ __forceinline__ void ph_post_diff(int j, bf16_t* PROJ) {
  const int tid = tid_(), lane = tid & 63, wave = tid >> 6, sub = lane & 7;
  const float* rope = (const float*)(P(ws) + WS_ROPE);
  for (int m = bid_() * 8 + wave; m < T; m += gdim_() * 8) {
    const float* cs = rope + (size_t)m * 16;
#pragma unroll
    for (int it = 0; it < 4; ++it) {
      bf16_t* ptr = PROJ + (size_t)m * DIFF_IN + it * 512 + lane * 8;
      float v[8], vn[8], vr[8]; unpack8(*(const uint4*)ptr, v);
      const float* gain = (it < 2) ? (P(diff_q_gain) + j * 64) : (P(diff_k_gain) + j * 64);
      head_norm_rope(v, gain, cs, sub, vn, vr);
      const float sc = (it < 2) ? C2 : 1.0f;
#pragma unroll
      for (int i = 0; i < 8; ++i) vr[i] *= sc;
      *(uint4*)ptr = pack8(vr);
    }
  }
}
__device__ __forceinline__ void ph_post_nsa(int j, bf16_t* PROJ, bf16_t* QC) {
  const int tid = tid_(), lane = tid & 63, wave = tid >> 6, sub = lane & 7;
  const float* rope = (const float*)(P(ws) + WS_ROPE);
  for (int m = bid_() * 8 + wave; m < T; m += gdim_() * 8) {
    const float* cs = rope + (size_t)m * 16;
#pragma unroll
    for (int it = 0; it < 2; ++it) {
      bf16_t* ptr = PROJ + (size_t)m * NSA_P + it * 512 + lane * 8;
      float v[8], vn[8], vr[8]; unpack8(*(const uint4*)ptr, v);
      head_norm_rope(v, P(nsa_q_gain) + j * 64, cs, sub, vn, vr);
#pragma unroll
      for (int i = 0; i < 8; ++i) { vr[i] *= C2; vn[i] *= C2; }
      *(uint4*)ptr = pack8(vr);
      *(uint4*)(QC + (size_t)m * D + it * 512 + lane * 8) = pack8(vn);
    }
    {
      const int hi = lane >> 5;
      bf16_t* ptr = PROJ + (size_t)m * NSA_P + (hi ? 2048 : 1536) + (lane & 31) * 8;
      float v[8], vn[8], vr[8]; unpack8(*(const uint4*)ptr, v);
      head_norm_rope(v, P(nsa_k_gain) + j * 192 + (hi ? 128 : 64), cs, sub, vn, vr);
      *(uint4*)ptr = pack8(vr);
    }
  }
}

template <int DV, int MODE>
__device__ __forceinline__ void attn_naive_unit(int b, int qc, const bf16_t* Qp, int ldq, const bf16_t* Kp, const bf16_t* Vp, int ldkv, bf16_t* Op, int ldo, const u64* selmask, unsigned char* lds) {
  constexpr int DVS = DV / 8;
  float* Ks = (float*)lds;
  float* Vs = Ks + 64 * 64;
  const int tid = tid_(), qi = tid & 63, sl = tid >> 6;
  const int qabs = qc * 64 + qi;
  const size_t rowq = (size_t)b * S + qabs;
  float q[64];
#pragma unroll
  for (int i = 0; i < 8; ++i) unpack8(*(const uint4*)(Qp + rowq * ldq + i * 8), q + i * 8);
  float m = -INFINITY, l = 0.f, o[DVS];
#pragma unroll
  for (int i = 0; i < DVS; ++i) o[i] = 0.f;
  u64 msk = 0ull; if (MODE == 1) msk = selmask[qabs];
  const int t_lo = (MODE == 2) ? (qc > 8 ? qc - 8 : 0) : 0;
  for (int tt = t_lo; tt <= qc; ++tt) {
    __syncthreads();
    { const int key = tid >> 3, ch = tid & 7; float f[8];
      unpack8(*(const uint4*)(Kp + ((size_t)b * S + tt * 64 + key) * ldkv + ch * 8), f);
#pragma unroll
      for (int i = 0; i < 8; ++i) Ks[key * 64 + ch * 8 + i] = f[i];
#pragma unroll
      for (int r = 0; r < DV / 64; ++r) {
        unpack8(*(const uint4*)(Vp + ((size_t)b * S + tt * 64 + key) * ldkv + r * 64 + ch * 8), f);
#pragma unroll
        for (int i = 0; i < 8; ++i) Vs[key * DV + r * 64 + ch * 8 + i] = f[i];
      } }
    __syncthreads();
    const bool tile_on = (MODE == 1) ? (((msk >> tt) & 1ull) != 0ull) : true;
    if (tile_on) {
      for (int jk = 0; jk < 64; ++jk) {
        const int key = tt * 64 + jk;
        bool valid = key <= qabs; if (MODE == 2) valid = valid && (key > qabs - 512);
        if (valid) {
          float s = 0.f;
#pragma unroll
          for (int d = 0; d < 64; d += 4) { const float4 kk = *(const float4*)(Ks + jk * 64 + d); s += q[d] * kk.x + q[d + 1] * kk.y + q[d + 2] * kk.z + q[d + 3] * kk.w; }
          const float mn = fmaxf(m, s); const float sc = exp2f(m - mn), pp = exp2f(s - mn);
          l = l * sc + pp;
#pragma unroll
          for (int i = 0; i < DVS; ++i) o[i] = o[i] * sc + pp * Vs[jk * DV + sl * DVS + i];
          m = mn;
        }
      }
    }
  }
  const float inv = l > 0.f ? 1.0f / l : 0.f;
  bf16_t* op = Op + rowq * ldo + sl * DVS;
  if (DVS == 8) { float r[8];
#pragma unroll
    for (int i = 0; i < 8; ++i) r[i] = o[i] * inv;
    *(uint4*)op = pack8(r);
  } else {
#pragma unroll
    for (int h2 = 0; h2 < DVS / 8; ++h2) { float r[8];
#pragma unroll
      for (int i = 0; i < 8; ++i) r[i] = o[h2 * 8 + i] * inv;
      *(uint4*)(op + h2 * 8) = pack8(r); }
  }
}

__device__ __forceinline__ void ph_attn_diff(unsigned char* lds) {
  const bf16_t* PROJ = (const bf16_t*)(P(ws) + WS_PROJ); bf16_t* ATT = (bf16_t*)(P(ws) + WS_ATT);
  const int NU = NB * 64 * 16;
  for (int u = bid_(); u < NU; u += gdim_()) {
    const int vh = u & 15, qc = 63 - ((u >> 4) & 63), b = u >> 10;
    const int h8 = vh >> 1, c = vh & 1;
    attn_naive_unit<128, 0>(b, qc, PROJ + vh * 64, DIFF_IN, PROJ + 1024 + vh * 64, PROJ + 2048 + h8 * 128, DIFF_IN, ATT + c * 1024 + h8 * 128, 2048, nullptr, lds);
  }
}
__device__ __forceinline__ void ph_attn_sel(unsigned char* lds) {
  const bf16_t* PROJ = (const bf16_t*)(P(ws) + WS_PROJ); bf16_t* OSEL = (bf16_t*)(P(ws) + WS_ATT + 32 * MiB);
  const u64* SEL = (const u64*)(P(ws) + WS_SEL);
  const int NU = NB * 64 * 16;
  for (int u = bid_(); u < NU; u += gdim_()) {
    const int hd = u & 15, qc = 63 - ((u >> 4) & 63), b = u >> 10, g = hd >> 2;
    attn_naive_unit<64, 1>(b, qc, PROJ + hd * 64, NSA_P, PROJ + 1536 + g * 64, PROJ + 1792 + g * 64, NSA_P, OSEL + hd * 64, D, SEL + (size_t)(b * 4 + g) * S, lds);
  }
}
__device__ __forceinline__ void ph_attn_win(unsigned char* lds) {
  const bf16_t* PROJ = (const bf16_t*)(P(ws) + WS_PROJ); bf16_t* OWIN = (bf16_t*)(P(ws) + WS_ATT + 64 * MiB);
  const int NU = NB * 64 * 16;
  for (int u = bid_(); u < NU; u += gdim_()) {
    const int hd = u & 15, qc = (u >> 4) & 63, b = u >> 10, g = hd >> 2;
    attn_naive_unit<64, 2>(b, qc, PROJ + hd * 64, NSA_P, PROJ + 2048 + g * 64, PROJ + 2304 + g * 64, NSA_P, OWIN + hd * 64, D, nullptr, lds);
  }
}

__device__ __forceinline__ void ph_compress(int j, unsigned char* lds) {
  const bf16_t* PROJ = (const bf16_t*)(P(ws) + WS_PROJ);
  float* z = (float*)lds;
  float* red = z + 2048;
  float* hid = red + 512;
  float* red2 = hid + 128;
  const int tid = tid_();
  const int NI = NB * 4 * 255 * 2;
  for (int it = bid_(); it < NI; it += gdim_()) {
    const int kv = it & 1, c = (it >> 1) % 255, bg = (it >> 1) / 255, b = bg >> 2, g = bg & 3;
    const float* pe = (kv ? P(nsa_pe_v) : P(nsa_pe_k)) + j * 2048;
    const float* w1 = (kv ? P(nsa_w_cv1) : P(nsa_w_ck1)) + (size_t)j * 2048 * 128;
    const float* w2 = (kv ? P(nsa_w_cv2) : P(nsa_w_ck2)) + (size_t)j * 128 * 64;
    const int colbase = (kv ? 1280 : 1024) + g * 64;
    __syncthreads();
    {
      const int l = tid >> 4, d4 = (tid & 15) * 4;
      const uint2 sv = *(const uint2*)(PROJ + ((size_t)b * S + 16 * c + l) * NSA_P + colbase + d4);
      z[l * 64 + d4 + 0] = bf2f(sv.x & 0xffffu) + pe[l * 64 + d4 + 0]; z[l * 64 + d4 + 1] = bf2f(sv.x >> 16) + pe[l * 64 + d4 + 1];
      z[l * 64 + d4 + 2] = bf2f(sv.y & 0xffffu) + pe[l * 64 + d4 + 2]; z[l * 64 + d4 + 3] = bf2f(sv.y >> 16) + pe[l * 64 + d4 + 3]; }
    __syncthreads();
    { const int n = tid & 127, ks = tid >> 7; float a = 0.f;
      const float* wp = w1 + (size_t)(ks * 512) * 128 + n;
#pragma unroll 8
      for (int k = 0; k < 512; ++k) a += z[ks * 512 + k] * wp[(size_t)k * 128];
      red[ks * 128 + n] = a; }
    __syncthreads();
    if (tid < 128) { const float hsum = red[tid] + red[128 + tid] + red[256 + tid] + red[384 + tid]; hid[tid] = hsum / (1.f + expf(-hsum)); }
    __syncthreads();
    { const int e = tid & 63, sp = tid >> 6; float a = 0.f;
#pragma unroll
      for (int h = 0; h < 16; ++h) a += hid[sp * 16 + h] * w2[(sp * 16 + h) * 64 + e];
      red2[sp * 64 + e] = a; }
    __syncthreads();
    if (tid < 64) {
      float o = 0.f;
#pragma unroll
      for (int sp = 0; sp < 8; ++sp) o += red2[sp * 64 + tid];
      if (kv == 0) { const float ss = wave_sum(o * o); o = o * (1.0f / sqrtf(ss * (1.0f / 64.0f) + EPS)) * P(nsa_k_gain)[j * 192 + tid]; }
      float* dst = (float*)(P(ws) + (kv ? WS_VCMP : WS_KCMP));
      dst[((size_t)bg * 256 + c) * 64 + tid] = o;
    }
  }
}

__device__ __forceinline__ void ph_cmp_attn(unsigned char* lds) {
  float* Kc = (float*)lds;
  float* Pm = Kc + 256 * 65;
  float* imp = Pm + 32 * 256;
  unsigned* selb = (unsigned*)(imp + 8 * 64);
  const bf16_t* QC = (const bf16_t*)(P(ws) + WS_OC);
  const float* KCMP = (const float*)(P(ws) + WS_KCMP); const float* VCMP = (const float*)(P(ws) + WS_VCMP);
  bf16_t* OCMP = (bf16_t*)(P(ws) + WS_ATT);
  u64* SEL = (u64*)(P(ws) + WS_SEL);
  const int tid = tid_();
  const int NU = NB * 4 * 512;
  for (int u = bid_(); u < NU; u += gdim_()) {
    const int qc8 = u & 511, bg = u >> 9, b = bg >> 2, g = bg & 3;
    const int t0 = qc8 * 8;
    int ncv = (t0 + 7 >= 31) ? ((t0 + 7 - 31) / 16 + 1) : 0; if (ncv > 255) ncv = 255;
    __syncthreads();
    for (int i = tid; i < ncv * 64; i += NTHR) Kc[(i >> 6) * 65 + (i & 63)] = KCMP[(size_t)bg * 256 * 64 + i];
    if (tid < 16) selb[tid] = 0u;
    __syncthreads();
    const int r = tid >> 4, sub = tid & 15, qi = r >> 2, hh = r & 3, t = t0 + qi;
    {
      float q[64];
      const bf16_t* qp = QC + ((size_t)b * S + t) * D + (g * 4 + hh) * 64;
#pragma unroll
      for (int i = 0; i < 8; ++i) unpack8(*(const uint4*)(qp + i * 8), q + i * 8);
      float mx = -INFINITY;
#pragma unroll 1
      for (int i = 0; i < 16; ++i) {
        const int c = sub + 16 * i; float a = -INFINITY;
        if (c < ncv && 16 * c + 31 <= t) { a = 0.f;
#pragma unroll
          for (int d = 0; d < 64; ++d) a += q[d] * Kc[c * 65 + d]; }
        Pm[r * 256 + c] = a; mx = fmaxf(mx, a);
      }
      mx = fmaxf(mx, __shfl_xor(mx, 1)); mx = fmaxf(mx, __shfl_xor(mx, 2)); mx = fmaxf(mx, __shfl_xor(mx, 4)); mx = fmaxf(mx, __shfl_xor(mx, 8));
      float sum = 0.f;
#pragma unroll 1
      for (int i = 0; i < 16; ++i) { const float sv = Pm[r * 256 + sub + 16 * i]; const float e = (sv == -INFINITY) ? 0.f : exp2f(sv - mx); Pm[r * 256 + sub + 16 * i] = e; sum += e; }
      sum += __shfl_xor(sum, 1); sum += __shfl_xor(sum, 2); sum += __shfl_xor(sum, 4); sum += __shfl_xor(sum, 8);
      const float inv = sum > 0.f ? 1.0f / sum : 0.f;
#pragma unroll 1
      for (int i = 0; i < 16; ++i) Pm[r * 256 + sub + 16 * i] *= inv;
    }
    __syncthreads();
    {
      float o0 = 0.f, o1 = 0.f, o2 = 0.f, o3 = 0.f;
      const float* vb = VCMP + (size_t)bg * 256 * 64 + sub * 4;
      for (int c = 0; c < ncv; ++c) { const float pr = Pm[r * 256 + c]; const float4 v0 = *(const float4*)(vb + c * 64);
        o0 += pr * v0.x; o1 += pr * v0.y; o2 += pr * v0.z; o3 += pr * v0.w; }
      uint2 ov; ov.x = pk2(o0, o1); ov.y = pk2(o2, o3);
      *(uint2*)(OCMP + ((size_t)b * S + t) * D + (g * 4 + hh) * 64 + sub * 4) = ov;
    }
    {
      const int qi2 = tid >> 6, sb = tid & 63, tq = t0 + qi2, bt = tq >> 6;
      float v = 0.f;
      const int c_lo = (4 * sb - 1 < 0) ? 0 : 4 * sb - 1, c_hi = (4 * sb + 3 > 254) ? 254 : 4 * sb + 3;
      for (int h = 0; h < 4; ++h) for (int c = c_lo; c <= c_hi; ++c) v += Pm[(qi2 * 4 + h) * 256 + c];
      const bool forced = (sb == 0) || (sb == bt) || (sb == bt - 1), valid = sb <= bt;
      imp[qi2 * 64 + sb] = forced ? 1e6f : (valid ? v : -1.0f);
    }
    __syncthreads();
    {
      const int qi2 = tid >> 6, sb = tid & 63;
      const float v = imp[qi2 * 64 + sb]; int cnt = 0;
      for (int s2 = 0; s2 < 64; ++s2) { const float w = imp[qi2 * 64 + s2]; cnt += (w > v || (w == v && s2 < sb)) ? 1 : 0; }
      if (cnt < 16) atomicOr(&selb[qi2 * 2 + (sb >> 5)], 1u << (sb & 31));
    }
    __syncthreads();
    if (tid < 8) SEL[(size_t)bg * S + t0 + tid] = (u64)selb[tid * 2] | ((u64)selb[tid * 2 + 1] << 32);
  }
}

__device__ __forceinline__ void ph_combine_nsa(int j) {
  const bf16_t* PROJ = (const bf16_t*)(P(ws) + WS_PROJ);
  const bf16_t* OCMP = (const bf16_t*)(P(ws) + WS_ATT); const bf16_t* OSEL = OCMP + (size_t)T * D; const bf16_t* OWIN = OSEL + (size_t)T * D;
  bf16_t* OC = (bf16_t*)(P(ws) + WS_OC);
  for (size_t i = (size_t)bid_() * NTHR + tid_(); i < (size_t)T * 128; i += (size_t)gdim_() * NTHR) {
    const size_t m = i >> 7; const int cg8 = (int)(i & 127), hd = cg8 >> 3;
    float gt[3];
#pragma unroll
    for (int r = 0; r < 3; ++r) { const float gl = bf2f(PROJ[m * NSA_P + 2560 + hd * 3 + r]) + P(nsa_b_gate)[j * 48 + hd * 3 + r]; gt[r] = 1.0f / (1.0f + expf(-gl)); }
    float a[8], bb[8], cc[8], o[8];
    unpack8(*(const uint4*)(OCMP + m * D + cg8 * 8), a); unpack8(*(const uint4*)(OSEL + m * D + cg8 * 8), bb); unpack8(*(const uint4*)(OWIN + m * D + cg8 * 8), cc);
#pragma unroll
    for (int k = 0; k < 8; ++k) o[k] = gt[0] * a[k] + gt[1] * bb[k] + gt[2] * cc[k];
    *(uint4*)(OC + m * D + cg8 * 8) = pack8(o);
  }
}
__device__ __forceinline__ void ph_combine_diff(int j) {
  const bf16_t* ATT = (const bf16_t*)(P(ws) + WS_ATT); bf16_t* OC = (bf16_t*)(P(ws) + WS_OC);
  const float lam = ((const float*)(P(ws) + WS_SMALL))[j]; const float osc = 1.0f - lam_init_of(j);
  const int tid = tid_(), lane = tid & 63, wave = tid >> 6;
  for (int m = bid_() * 8 + wave; m < T; m += gdim_() * 8) {
#pragma unroll
    for (int it = 0; it < 2; ++it) {
      const int col = it * 512 + lane * 8;
      float a[8], b2[8], o[8]; unpack8(*(const uint4*)(ATT + (size_t)m * 2048 + col), a); unpack8(*(const uint4*)(ATT + (size_t)m * 2048 + 1024 + col), b2);
      float ss = 0.f;
#pragma unroll
      for (int k = 0; k < 8; ++k) { o[k] = a[k] - lam * b2[k]; ss += o[k] * o[k]; }
      ss += __shfl_xor(ss, 1); ss += __shfl_xor(ss, 2); ss += __shfl_xor(ss, 4); ss += __shfl_xor(ss, 8);
      const float rstd = 1.0f / sqrtf(ss * (1.0f / 128.0f) + EPS);
#pragma unroll
      for (int k = 0; k < 8; ++k) o[k] = o[k] * rstd * P(diff_subln_g)[j * 128 + (col & 127) + k] * osc;
      *(uint4*)(OC + (size_t)m * D + col) = pack8(o);
    }
  }
}

constexpr int N_PHASES = 1 + 4 * 10;
template <int PH> __device__ __forceinline__ void run_phase(unsigned char* lds, int lo, int hi, const XcdBarrier& bar) {
  if (PH < lo || PH >= hi) return;
  bool did = true;
  if constexpr (PH == 0) { ph_prologue(lds); __syncthreads(); ph_weights(lds); }
  else {
    constexpr int i = (PH - 1) / 10, lp = (PH - 1) % 10, j = i >> 1; constexpr bool nsa = (i & 1) == 0;
    float* MOD = (float*)(P(ws) + WS_MOD);
    bf16_t* H = (bf16_t*)(P(ws) + WS_H); bf16_t* PROJ = (bf16_t*)(P(ws) + WS_PROJ); bf16_t* OC = (bf16_t*)(P(ws) + WS_OC); bf16_t* HID = (bf16_t*)(P(ws) + WS_HID);
    const float* mod = MOD + (size_t)i * 4 * 6144;
    const float* xcur = (i == 0 && lp < 7) ? P(x) : P(out);
    if constexpr (lp == 0) ph_norm(xcur, P(ln_mix_g) + i * D, mod, 0, 1024, H);
    const bf16_t* WTL = (const bf16_t*)(P(ws) + WS_WT + (size_t)i * WT_LAYER);
    PG8_LAS unsigned char* l3 = (PG8_LAS unsigned char*)lds;
    if constexpr (lp == 1) {
      constexpr int N = nsa ? NSA_P : DIFF_IN;
      pg8::Gemm g{H, WTL, T, N, D}; pg8::StaticOrder S; S.init(T, N, gdim_(), bid_());
      pg8::EpiBf16<0> E{PROJ, N};
      pg8::gemm_phase<pg8::EpiBf16<0>, pg8::StaticOrder, true, true>(l3, g, S, E);
    }
    if constexpr (lp == 2) { if constexpr (nsa) { ph_post_nsa(j, PROJ, OC); ph_compress(j, lds); } else ph_post_diff(j, PROJ); }
    if constexpr (lp == 3) { if constexpr (nsa) { ph_cmp_attn(lds); __syncthreads(); ph_attn_win_fast(lds); } else ph_attn_diff_fast(lds); }
    if constexpr (lp == 4) { if constexpr (nsa) ph_attn_sel_fast(lds); else did = false; }
    if constexpr (lp == 5) { if constexpr (nsa) ph_combine_nsa(j); else ph_combine_diff(j); }
    if constexpr (lp == 6) {
      pg8::Gemm g{OC, WTL + WT_OUT / 2, T, D, D}; pg8::StaticOrder S; S.init(T, D, gdim_(), bid_());
      pg8::EpiResid E{xcur, P(out), mod + 2048};
      pg8::gemm_phase<pg8::EpiResid, pg8::StaticOrder, true, true>(l3, g, S, E);
    }
    if constexpr (lp == 7) ph_norm(P(out), P(ln_mlp_g) + i * D, mod, 3072, 4096, H);
    if constexpr (lp == 8) {
      pg8::Gemm g{H, WTL + WT_MI / 2, T, DFF, D}; pg8::StaticOrder S; S.init(T, DFF, gdim_(), bid_());
      pg8::EpiBf16<2> E{HID, DFF};
      pg8::gemm_phase<pg8::EpiBf16<2>, pg8::StaticOrder, true, true>(l3, g, S, E);
    }
    if constexpr (lp == 9) {
      pg8::Gemm g{HID, WTL + WT_MO / 2, T, D, DFF}; pg8::StaticOrder S; S.init(T, D, gdim_(), bid_());
      pg8::EpiResid E{P(out), P(out), mod + 5120};
      pg8::gemm_phase<pg8::EpiResid, pg8::StaticOrder, true, true>(l3, g, S, E);
    }
  }
  if (did && PH + 1 < hi) { if (PH == 0) cg::this_grid().sync(); else xcd_barrier(bar); }
}
template <int... I> __device__ __forceinline__ void run_all(std::integer_sequence<int, I...>, unsigned char* lds, int lo, int hi, const XcdBarrier& bar) { (run_phase<I>(lds, lo, hi, bar), ...); }
__global__ void __launch_bounds__(NTHR) fwd_kernel(Params p) {
  extern __shared__ __attribute__((aligned(16))) unsigned char lds[];
  volatile __attribute__((address_space(3))) unsigned* misc = (volatile __attribute__((address_space(3))) unsigned*)((__attribute__((address_space(3))) unsigned char*)lds + MISC_OFF);
  if (tid_() < 16) misc[tid_()] = 0u;
  __syncthreads();
  const XcdBarrier bar = xcd_barrier_post((unsigned*)(P(ws) + WS_CTL) + CW_BAR, misc);
  run_all(std::make_integer_sequence<int, N_PHASES>{}, lds, p.ph_lo, p.ph_hi, bar);
}

extern "C" void kernel_launch(void* const* d_in, const int* in_sizes, int n_in, void* d_out, int out_size, void* d_ws, size_t ws_size, hipStream_t stream) {
  static int grid = 0;
  if (grid == 0) {
    if (n_in != 29 || out_size != T * D || ws_size < WS_END) { fprintf(stderr, "kernel_launch: unexpected problem (n_in %d, out %d, ws %zu)\n", n_in, out_size, ws_size); grid = -1; return; }
    int dev = 0, cus = 0, per_cu = 0;
    hipGetDevice(&dev); hipDeviceGetAttribute(&cus, hipDeviceAttributeMultiprocessorCount, dev);
    hipFuncSetAttribute((const void*)fwd_kernel, hipFuncAttributeMaxDynamicSharedMemorySize, LDS_BYTES);
    hipOccupancyMaxActiveBlocksPerMultiprocessor(&per_cu, (const void*)fwd_kernel, NTHR, LDS_BYTES);
    if (per_cu < 1) { fprintf(stderr, "kernel_launch: occupancy query says %d blocks/CU\n", per_cu); per_cu = 1; }
    grid = cus * 1;
    (void)hipGetLastError();
  }
  if (grid < 0) return;
  if (hipMemsetAsync((char*)d_ws + WS_CTL, 0, CTL_ZERO_BYTES, stream) != hipSuccess) { fprintf(stderr, "kernel_launch: memset failed\n"); return; }
  Params p{};
  memcpy((void*)&p, (const void*)d_in, 29 * sizeof(void*));
  p.out = (float*)d_out; p.ws = (unsigned char*)d_ws; p.ph_lo = 0; p.ph_hi = N_PHASES;
  void* args[] = {&p};
  hipError_t e = hipLaunchCooperativeKernel((const void*)fwd_kernel, dim3(grid), dim3(NTHR), args, LDS_BYTES, stream);
  if (e != hipSuccess) fprintf(stderr, "cooperative launch failed: %s (grid %d)\n", hipGetErrorString(e), grid);
}
```

```cpp
#include <hip/hip_runtime.h>
#include <hip/hip_cooperative_groups.h>
#include <hip/hip_bf16.h>
#include <cstdio>
#include <cstdint>
#include <cstring>
#include <utility>
namespace cg = cooperative_groups;

typedef unsigned short bf16_t;
typedef unsigned long long u64;

constexpr int D = 1024, NB = 4, S = 4096, T = NB * S, DFF = 4096;
constexpr int NSA_IN = 2608, NSA_P = 2816, DIFF_IN = 3072;
constexpr float EPS = 1e-6f;
constexpr float C2 = 0.125f * 1.4426950408889634f;
constexpr int NTHR = 512;
constexpr int LDS_BYTES = 147456;

constexpr size_t MiB = 1u << 20;
constexpr size_t WS_CTL = 0, CTL_ZERO_BYTES = 1 * MiB;
constexpr int CW_BAR = 4096;
constexpr int MISC_OFF = LDS_BYTES - 64;
constexpr size_t WS_MOD = 1 * MiB;
constexpr size_t WS_ROPE = 2 * MiB;
constexpr size_t WS_SMALL = 3 * MiB;
constexpr size_t WS_WT = 4 * MiB;
constexpr size_t WT_LAYER = 24 * MiB, WT_OUT = 6 * MiB, WT_MI = 8 * MiB, WT_MO = 16 * MiB;
constexpr size_t WS_W1T = 100 * MiB;
constexpr size_t WS_H = 104 * MiB;
constexpr size_t WS_PROJ = 136 * MiB;
constexpr size_t WS_ATT = 232 * MiB;
constexpr size_t WS_OC = 328 * MiB;
constexpr size_t WS_KCMP = 360 * MiB;
constexpr size_t WS_VCMP = 361 * MiB;
constexpr size_t WS_SEL = 362 * MiB;
constexpr size_t WS_HID = 136 * MiB;
constexpr size_t WS_END = 364 * MiB;

struct Params {
  const float* x; const float* c; const int* pos; const float* ln_mix_g; const float* ln_mlp_g;
  const float* w_ada; const float* b_ada; const float* w_mlp_in; const float* w_mlp_out;
  const float* nsa_w_in; const float* nsa_b_gate; const float* nsa_q_gain; const float* nsa_k_gain;
  const float* nsa_pe_k; const float* nsa_w_ck1; const float* nsa_w_ck2; const float* nsa_pe_v; const float* nsa_w_cv1; const float* nsa_w_cv2; const float* nsa_w_out;
  const float* diff_w_in; const float* diff_q_gain; const float* diff_k_gain; const float* diff_lq1; const float* diff_lk1; const float* diff_lq2; const float* diff_lk2; const float* diff_subln_g; const float* diff_w_out;
  float* out; unsigned char* ws; int ph_lo, ph_hi;
};

typedef __attribute__((address_space(4))) const unsigned char* kptr_t;
template <class Tp> __device__ __forceinline__ Tp karg_load(unsigned off) {
  asm volatile("" : "+s"(off));
  kptr_t kp = (kptr_t)__builtin_amdgcn_kernarg_segment_ptr();
  return *(const __attribute__((address_space(4))) Tp*)(kp + off);
}
__device__ __forceinline__ int tid_() { int t = (int)threadIdx.x; asm volatile("" : "+v"(t)); return t; }
__device__ __forceinline__ int bid_() { int t = (int)blockIdx.x; asm volatile("" : "+s"(t)); return t; }
__device__ __forceinline__ int gdim_() { int t = (int)gridDim.x; asm volatile("" : "+s"(t)); return t; }
#define P(m) karg_load<decltype(Params::m)>((unsigned)offsetof(Params, m))
__device__ __forceinline__ float bf2f(unsigned v) { return __uint_as_float(v << 16); }
__device__ __forceinline__ unsigned f2bf(float f) { unsigned u = __float_as_uint(f); return (u + 0x7fffu + ((u >> 16) & 1u)) >> 16; }
__device__ __forceinline__ unsigned pk2(float lo, float hi) { return f2bf(lo) | (f2bf(hi) << 16); }
__device__ __forceinline__ void unpack8(const uint4 v, float* f) {
  f[0] = bf2f(v.x & 0xffffu); f[1] = bf2f(v.x >> 16); f[2] = bf2f(v.y & 0xffffu); f[3] = bf2f(v.y >> 16);
  f[4] = bf2f(v.z & 0xffffu); f[5] = bf2f(v.z >> 16); f[6] = bf2f(v.w & 0xffffu); f[7] = bf2f(v.w >> 16);
}
__device__ __forceinline__ uint4 pack8(const float* f) { uint4 v; v.x = pk2(f[0], f[1]); v.y = pk2(f[2], f[3]); v.z = pk2(f[4], f[5]); v.w = pk2(f[6], f[7]); return v; }
__device__ __forceinline__ float wave_sum(float v) {
#pragma unroll
  for (int o = 1; o < 64; o <<= 1) v += __shfl_xor(v, o);
  return v;
}
__device__ __forceinline__ float lam_init_of(int j) { return j == 0 ? 0.35550906759096934f : 0.5560582041556406f; }

namespace pg8 {
#define PG8_LAS __attribute__((address_space(3)))
typedef unsigned short bf16_t;
typedef short bf16x8 __attribute__((ext_vector_type(8)));
typedef float f32x4 __attribute__((ext_vector_type(4)));
typedef unsigned u32x4 __attribute__((ext_vector_type(4)));
constexpr int BM = 256, BK = 64, HALF = 128, HTB = HALF * BK * 2  , STAGE_BYTES = 8 * HTB, NXCD = 8, WGM = 8;

__host__ __device__ __forceinline__ int lds_byte(int r, int c) { const int st = (r >> 4) * 2 + (c >> 5), rr = r & 15, cc = c & 31, ob = rr * 64 + cc * 2; return st * 1024 + (ob ^ (((ob >> 9) & 1) << 5)); }
__host__ __device__ __forceinline__ void stage_rc(int b, int& R, int& C) { const int st = b / 1024, sb = b % 1024, swz = sb ^ (((sb >> 9) & 1) << 5); R = (st >> 1) * 16 + swz / 64; C = (st & 1) * 32 + (swz % 64) / 2; }
__host__ __device__ __forceinline__ int perm32(int rho) { const int n = rho >> 4, i = rho & 15; return 8 * (i >> 2) + 4 * n + (i & 3); }

struct Unit { int pm, pn; };
struct Gemm { const bf16_t* A; const bf16_t* Bt; int M, N, K; };

struct StaticOrder {
    int nM, nN, nwg, G, c;
    __host__ __device__ void init(int M, int N, int G_, int c_) { nM = M / BM; nN = N / BM; nwg = nM * nN; G = G_; c = c_; }
    __host__ __device__ bool next(int i, Unit& u) const {
        const long L = (long)i * G + c; if (L >= nwg) return false;
        int wgid = (int)L; { const int q = nwg / NXCD, r = nwg % NXCD, xcd = wgid % NXCD, off = wgid / NXCD; wgid = (xcd < r ? xcd * (q + 1) : r * (q + 1) + (xcd - r) * q) + off; }
        const int nig = WGM * nN, gid = wgid / nig, fm = gid * WGM, gsz = (nM - fm) < WGM ? (nM - fm) : WGM;
        u.pm = fm + ((wgid % nig) % gsz); u.pn = (wgid % nig) / gsz; return true;
    }
    __device__ __forceinline__ void a_ready(const Unit&) const {}
    __device__ __forceinline__ void done(const Unit&) const {}
};


__device__ __forceinline__ unsigned cvt_pk_bf16(float lo, float hi) { unsigned r; asm volatile("v_cvt_pk_bf16_f32 %0, %1, %2" : "=v"(r) : "v"(lo), "v"(hi)); return r; }
template <int ACT  > struct EpiBf16 {
    static constexpr bool PERM = true, AFTER_DRAIN = false;
    bf16_t* O; int ldc;
    __device__ __forceinline__ void operator()(const f32x4 (&acc)[2][2][4][2], const Unit& u, int wr, int wc, int fr, int fq) const {
        const int row0 = u.pm * BM + wr * 64 + fr; const int col0 = u.pn * BM + wc * 32 + 8 * fq;
#pragma unroll
        for (int ai = 0; ai < 2; ++ai)
#pragma unroll
            for (int m = 0; m < 4; ++m) { bf16_t* rowp = O + (size_t)(row0 + ai * HALF + m * 16) * ldc + col0;
#pragma unroll
                for (int bj = 0; bj < 2; ++bj) { f32x4 v0 = acc[ai][bj][m][0], v1 = acc[ai][bj][m][1];
                    if (ACT == 2) {
#pragma unroll
                        for (int e = 0; e < 4; ++e) { float a = v0[e] > 0.f ? v0[e] : 0.f; v0[e] = a * a; float b = v1[e] > 0.f ? v1[e] : 0.f; v1[e] = b * b; } }
                    u32x4 w; w.x = cvt_pk_bf16(v0[0], v0[1]); w.y = cvt_pk_bf16(v0[2], v0[3]); w.z = cvt_pk_bf16(v1[0], v1[1]); w.w = cvt_pk_bf16(v1[2], v1[3]);
                    *(u32x4*)(rowp + bj * HALF) = w; } }
    }
};
struct EpiResid {
    static constexpr bool PERM = false, AFTER_DRAIN = false;
    const float* xin; float* xout; const float* gate;
    __device__ __forceinline__ void operator()(const f32x4 (&acc)[2][2][4][2], const Unit& u, int wr, int wc, int fr, int fq) const {
        const int col0 = u.pn * BM + wc * 32 + 4 * fq; const int b = (u.pm * BM) >> 12;
        f32x4 gv[2][2];
#pragma unroll
        for (int bj = 0; bj < 2; ++bj)
#pragma unroll
            for (int n = 0; n < 2; ++n) gv[bj][n] = *(const f32x4*)(gate + (size_t)b * 6144 + col0 + bj * HALF + n * 16);
#pragma unroll
        for (int ai = 0; ai < 2; ++ai)
#pragma unroll
            for (int m = 0; m < 4; ++m) { const size_t off = (size_t)(u.pm * BM + ai * HALF + wr * 64 + m * 16 + fr) * 1024 + col0;
#pragma unroll
                for (int bj = 0; bj < 2; ++bj)
#pragma unroll
                    for (int n = 0; n < 2; ++n) { const f32x4 xi = *(const f32x4*)(xin + off + bj * HALF + n * 16); *(f32x4*)(xout + off + bj * HALF + n * 16) = xi + gv[bj][n] * acc[ai][bj][m][n]; }
                if (m & 1) asm volatile("" ::: "memory"); }
    }
};

template <class Epi, class Sched, bool ALIGN_EPI = false, bool SP2 = false>
__device__ __forceinline__ void gemm_phase(PG8_LAS unsigned char* lds, const Gemm g, const Sched& S, const Epi& E) {
    const int tid = tid_(), wid = __builtin_amdgcn_readfirstlane(tid >> 6), lane = tid & 63, wr = wid >> 2, wc = wid & 3, fr = lane & 15, fq = lane >> 4;
    const int K = g.K, nt = K / BK;
    unsigned voffA[2], voffB[2];
#pragma unroll
    for (int i = 0; i < 2; ++i) { int R, C; stage_rc(tid * 16 + i * 8192, R, C); const int Rb = Epi::PERM ? ((R & ~31) + perm32(R & 31)) : R;
        voffA[i] = (unsigned)(R * K + C) * 2u; voffB[i] = (unsigned)(Rb * K + C) * 2u; }
    const size_t kstep = (size_t)(BK * 2);
    const size_t hstep = (size_t)HALF * K * 2;
    const size_t tstep = 2 * hstep;
    const unsigned ldsw = (unsigned)wid * 1024u;
    const int aoff = lds_byte(wr * 64 + fr, fq * 8), boff = lds_byte(wc * 32 + fr, fq * 8);
#define PG8_SA(b, h) (((b) * 2 + (h)) * HTB)
#define PG8_SB(b, h) ((4 + (b) * 2 + (h)) * HTB)
#define PG8_STAGE(bufoff, gbase, voff) do { _Pragma("unroll") for (int _i = 0; _i < 2; ++_i) \
        __builtin_amdgcn_global_load_lds((const unsigned*)((const char*)(gbase) + (voff)[_i]), (PG8_LAS unsigned*)(lds + (bufoff) + ldsw + _i * 8192), 16, 0, 0); } while (0)
#define PG8_LDA(dst, b, h) do { _Pragma("unroll") for (int m = 0; m < 4; ++m) _Pragma("unroll") for (int k = 0; k < 2; ++k) dst[m][k] = *(const PG8_LAS bf16x8*)(lds + PG8_SA(b, h) + aoff + m * 2048 + k * 1024); } while (0)
#define PG8_LDB(dst, b, h) do { _Pragma("unroll") for (int n = 0; n < 2; ++n) _Pragma("unroll") for (int k = 0; k < 2; ++k) dst[n][k] = *(const PG8_LAS bf16x8*)(lds + PG8_SB(b, h) + boff + n * 2048 + k * 1024); } while (0)
#define PG8_MMA(ai, bj, At, Bt) do { __builtin_amdgcn_s_setprio(1); _Pragma("unroll") for (int m = 0; m < 4; ++m) _Pragma("unroll") for (int n = 0; n < 2; ++n) _Pragma("unroll") for (int k = 0; k < 2; ++k) \
        acc[ai][bj][m][n] = __builtin_amdgcn_mfma_f32_16x16x32_bf16(Bt[n][k], At[m][k], acc[ai][bj][m][n], 0, 0, 0); __builtin_amdgcn_s_setprio(0); } while (0)
#define PG8_WAIT_V(n) asm volatile("s_waitcnt vmcnt(" #n ")" ::: "memory")
#define PG8_WAIT_L(n) asm volatile("s_waitcnt lgkmcnt(" #n ")" ::: "memory")
#define PG8_BAR __builtin_amdgcn_s_barrier()
#define PG8_SCHED __builtin_amdgcn_sched_barrier(0)
    Unit cur, nxt; int ui = 0;
    if (!S.next(0, cur)) return;
    f32x4 acc[2][2][4][2];
#pragma unroll
    for (int a = 0; a < 2; ++a)
#pragma unroll
        for (int b = 0; b < 2; ++b)
#pragma unroll
            for (int m = 0; m < 4; ++m)
#pragma unroll
                for (int n = 0; n < 2; ++n) acc[a][b][m][n] = (f32x4){0.f, 0.f, 0.f, 0.f};
    bf16x8 At[4][2], B0[2][2], B1[2][2];
    const char* cA = (const char*)g.A + (size_t)cur.pm * tstep; const char* cB = (const char*)g.Bt + (size_t)cur.pn * tstep;
    S.a_ready(cur);
    if constexpr (SP2) {
        PG8_STAGE(PG8_SB(0, 0), cB, voffB); PG8_STAGE(PG8_SB(0, 1), cB + hstep, voffB); PG8_STAGE(PG8_SA(0, 0), cA, voffA); PG8_STAGE(PG8_SA(0, 1), cA + hstep, voffA);
        if (wr == 1) PG8_BAR;
        PG8_WAIT_V(2); PG8_BAR;
        PG8_STAGE(PG8_SB(1, 0), cB + kstep, voffB); PG8_STAGE(PG8_SA(1, 0), cA + kstep, voffA); PG8_STAGE(PG8_SB(1, 1), cB + hstep + kstep, voffB);
        PG8_WAIT_V(6); PG8_BAR;
    } else {
        PG8_STAGE(PG8_SB(0, 0), cB, voffB); PG8_STAGE(PG8_SA(0, 0), cA, voffA); PG8_STAGE(PG8_SB(0, 1), cB + hstep, voffB); PG8_STAGE(PG8_SA(0, 1), cA + hstep, voffA);
        if (wr == 1) PG8_BAR;
        PG8_WAIT_V(4); PG8_BAR;
        PG8_STAGE(PG8_SB(1, 0), cB + kstep, voffB); PG8_STAGE(PG8_SA(1, 0), cA + kstep, voffA); PG8_STAGE(PG8_SB(1, 1), cB + hstep + kstep, voffB);
        PG8_WAIT_V(6); PG8_BAR;
    }
    for (;;) {
        const bool has_next = S.next(ui + 1, nxt);
        const char* nA = has_next ? (const char*)g.A + (size_t)nxt.pm * tstep : cA; const char* nB = has_next ? (const char*)g.Bt + (size_t)nxt.pn * tstep : cB;
        for (int t = 0; t < nt; t += 2) {
            const bool last = (t == nt - 2);
            const char* a1 = cA + (size_t)(t + 1) * kstep;
            const char* a2 = last ? nA : cA + (size_t)(t + 2) * kstep; const char* b2 = last ? nB : cB + (size_t)(t + 2) * kstep;
            const char* a3 = a2 + kstep; const char* b3 = b2 + kstep;
            if (last && has_next) S.a_ready(nxt);
            if constexpr (SP2) {
            PG8_LDB(B0, 0, 0); PG8_LDB(B1, 0, 1); PG8_SCHED; PG8_LDA(At, 0, 0); PG8_STAGE(PG8_SA(1, 1), a1 + hstep, voffA);
            PG8_WAIT_V(8); PG8_WAIT_L(0); PG8_BAR; PG8_MMA(0, 0, At, B0); PG8_MMA(0, 1, At, B1); PG8_BAR; PG8_SCHED;
            PG8_LDA(At, 0, 1); PG8_STAGE(PG8_SB(0, 0), b2, voffB); PG8_STAGE(PG8_SB(0, 1), b2 + hstep, voffB); PG8_STAGE(PG8_SA(0, 0), a2, voffA);
            PG8_WAIT_V(8); PG8_WAIT_L(0); PG8_BAR; PG8_MMA(1, 0, At, B0); PG8_MMA(1, 1, At, B1); PG8_BAR; PG8_SCHED;
            PG8_LDB(B0, 1, 0); PG8_LDB(B1, 1, 1); PG8_SCHED; PG8_LDA(At, 1, 0); PG8_STAGE(PG8_SA(0, 1), a2 + hstep, voffA);
            PG8_WAIT_V(8); PG8_WAIT_L(0); PG8_BAR; PG8_MMA(0, 0, At, B0); PG8_MMA(0, 1, At, B1); PG8_BAR; PG8_SCHED;
            PG8_LDA(At, 1, 1); PG8_STAGE(PG8_SB(1, 0), b3, voffB); PG8_STAGE(PG8_SB(1, 1), b3 + hstep, voffB); PG8_STAGE(PG8_SA(1, 0), a3, voffA);
            PG8_WAIT_V(8); PG8_WAIT_L(0); PG8_BAR; PG8_MMA(1, 0, At, B0); PG8_MMA(1, 1, At, B1); PG8_BAR; PG8_SCHED;
            } else {
            PG8_LDB(B0, 0, 0); PG8_SCHED; PG8_LDA(At, 0, 0); PG8_STAGE(PG8_SA(1, 1), a1 + hstep, voffA);
            PG8_WAIT_L(8); PG8_BAR; PG8_WAIT_L(0); PG8_MMA(0, 0, At, B0); PG8_BAR; PG8_SCHED;
            PG8_LDB(B1, 0, 1); PG8_STAGE(PG8_SB(0, 0), b2, voffB);
            PG8_BAR; PG8_WAIT_L(0); PG8_MMA(0, 1, At, B1); PG8_BAR;
            PG8_LDA(At, 0, 1); PG8_STAGE(PG8_SA(0, 0), a2, voffA);
            PG8_BAR; PG8_WAIT_L(0); PG8_MMA(1, 0, At, B0); PG8_BAR; PG8_SCHED;
            PG8_STAGE(PG8_SB(0, 1), b2 + hstep, voffB);
            PG8_WAIT_V(6); PG8_BAR; PG8_MMA(1, 1, At, B1); PG8_BAR;
            PG8_LDB(B0, 1, 0); PG8_SCHED; PG8_LDA(At, 1, 0); PG8_STAGE(PG8_SA(0, 1), a2 + hstep, voffA);
            PG8_WAIT_L(8); PG8_BAR; PG8_WAIT_L(0); PG8_MMA(0, 0, At, B0); PG8_BAR; PG8_SCHED;
            PG8_LDB(B1, 1, 1); PG8_STAGE(PG8_SB(1, 0), b3, voffB);
            PG8_BAR; PG8_WAIT_L(0); PG8_MMA(0, 1, At, B1); PG8_BAR;
            PG8_LDA(At, 1, 1); PG8_STAGE(PG8_SA(1, 0), a3, voffA);
            PG8_BAR; PG8_WAIT_L(0); PG8_MMA(1, 0, At, B0); PG8_BAR; PG8_SCHED;
            PG8_STAGE(PG8_SB(1, 1), b3 + hstep, voffB);
            PG8_WAIT_V(6); PG8_BAR; PG8_MMA(1, 1, At, B1); PG8_BAR;
            }
        }
        if constexpr (ALIGN_EPI) { if (wr == 0) PG8_BAR; }
        if constexpr (!Epi::AFTER_DRAIN) { E(acc, cur, wr, wc, fr, fq); S.done(cur); }
        if (!has_next) break;
#pragma unroll
        for (int a = 0; a < 2; ++a)
#pragma unroll
            for (int b = 0; b < 2; ++b)
#pragma unroll
                for (int m = 0; m < 4; ++m)
#pragma unroll
                    for (int n = 0; n < 2; ++n) acc[a][b][m][n] = (f32x4){0.f, 0.f, 0.f, 0.f};
        cur = nxt; cA = nA; cB = nB; ++ui;
        if constexpr (ALIGN_EPI) { if (wr == 1) PG8_BAR; }
    }
    PG8_WAIT_V(0);
    if constexpr (!ALIGN_EPI) { if (wr == 0) PG8_BAR; }
    PG8_BAR;
    if constexpr (Epi::AFTER_DRAIN) { E.fused(acc, cur, wr, wc, fr, fq, lds, wid, lane); S.done(cur); }
#undef PG8_SA
#undef PG8_SB
#undef PG8_STAGE
#undef PG8_LDA
#undef PG8_LDB
#undef PG8_MMA
#undef PG8_WAIT_V
#undef PG8_WAIT_L
#undef PG8_BAR
#undef PG8_SCHED
}
}

namespace attn_body {
using bf16=__hip_bfloat16;
using bf16x8=__attribute__((ext_vector_type(8)))short;
using s16x4=__attribute__((ext_vector_type(4)))short;
using f32x16=__attribute__((ext_vector_type(16)))float;
using u32x4=__attribute__((ext_vector_type(4)))unsigned;
constexpr int D=64;
constexpr int NW=8,QBLK=32,QB=QBLK*NW,KVBLK=64;
__device__ __forceinline__ int crow(int r,int hi){return (r&3)+8*(r>>2)+4*hi;}
#define SBAR() __builtin_amdgcn_sched_barrier(0)
__device__ __forceinline__ void cmask(f32x16&p0,f32x16&p1,int jb,int qrel,int hi){
  const float NEG=-INFINITY; int kb=64*jb+4*hi;
  #pragma unroll
  for(int r=0;r<16;++r){int kv=kb+(r&3)+8*(r>>2); if(kv>qrel)p0[r]=NEG; if(kv+32>qrel)p1[r]=NEG;}
}

__device__ __forceinline__ void lmask(f32x16&p0,f32x16&p1,int t,int qrel,int hi){
  const float NEG=-30000.f; int kb=64*t+4*hi;
  #pragma unroll
  for(int r=0;r<16;++r){int kv=kb+(r&3)+8*(r>>2); if(kv<=qrel)p0[r]=NEG; if(kv+32<=qrel)p1[r]=NEG;}
}
__device__ __forceinline__ void smask(f32x16&p0,f32x16&p1,bool on){
  const float NEG=-INFINITY;
  #pragma unroll
  for(int r=0;r<16;++r){ p0[r]=on?p0[r]:NEG; p1[r]=on?p1[r]:NEG; }
}
constexpr int NSLOT=3, SLOTB=8192;
constexpr int LDS_K=0, LDS_V=NSLOT*SLOTB, LDS_WS=2*NSLOT*SLOTB, LDS_OST=LDS_WS+NW*64*4, LDS_BYTES=LDS_OST+NW*4096;
constexpr float C2=0.125f*1.4426950408889634f;
__device__ __forceinline__ void glds16(const void*gsrc,unsigned lds_dst){unsigned keep;
  asm volatile("s_mov_b32 %0, m0\n\ts_mov_b32 m0, %2\n\ts_nop 0\n\tglobal_load_lds_dwordx4 %1, off\n\ts_mov_b32 m0, %0":"=&s"(keep):"v"(gsrc),"s"(lds_dst):"memory");}
__device__ __forceinline__ float max3f(float a,float b,float c){float r;asm("v_max3_f32 %0, %1, %2, %3":"=v"(r):"v"(a),"v"(b),"v"(c));return r;}
__device__ __forceinline__ float max2f(float a,float b){float r;asm("v_max_f32_e32 %0, %1, %2":"=v"(r):"v"(a),"v"(b));return r;}
__device__ __forceinline__ float fadd_s(float a,float b){float r;asm("v_add_f32_e32 %0, %1, %2":"=v"(r):"v"(a),"v"(b));return r;}
__device__ __forceinline__ float fsub_s(float a,float b){float r;asm("v_sub_f32_e32 %0, %1, %2":"=v"(r):"v"(a),"v"(b));return r;}
typedef float f32x2_t __attribute__((ext_vector_type(2))); typedef __bf16 bf16x2_t __attribute__((ext_vector_type(2)));
__device__ __forceinline__ unsigned cvtpk_s(float lo,float hi){f32x2_t v={lo,hi};bf16x2_t b=__builtin_convertvector(v,bf16x2_t);return __builtin_bit_cast(unsigned,b);}
#define WAIT_BAR(N) asm volatile("s_waitcnt vmcnt(" #N ") lgkmcnt(0)\n\ts_barrier":::"memory")

__device__ __forceinline__ void qkt(f32x16&p0,f32x16&p1,const char*Kslot,const bf16x8*qr,const f32x16&negm,int r32,int hi){
  const char*kb=Kslot+hi*1024+r32*16;
  #pragma unroll
  for(int d0=0;d0<4;++d0){
    const bf16x8 b0=*reinterpret_cast<const bf16x8*>(kb+d0*2048);
    const bf16x8 b1=*reinterpret_cast<const bf16x8*>(kb+d0*2048+512);
    if(d0==0){p0=__builtin_amdgcn_mfma_f32_32x32x16_bf16(b0,qr[0],negm,0,0,0);p1=__builtin_amdgcn_mfma_f32_32x32x16_bf16(b1,qr[0],negm,0,0,0);}
    else{p0=__builtin_amdgcn_mfma_f32_32x32x16_bf16(b0,qr[d0],p0,0,0,0);p1=__builtin_amdgcn_mfma_f32_32x32x16_bf16(b1,qr[d0],p1,0,0,0);}}
}
typedef __attribute__((address_space(3))) const char* lds_cptr;
typedef short v4i16_t __attribute__((ext_vector_type(4)));
__device__ __forceinline__ void kload8(bf16x8*kf,lds_cptr kp){
  kf[0]=*(const __attribute__((address_space(3))) bf16x8*)(kp);      kf[1]=*(const __attribute__((address_space(3))) bf16x8*)(kp+512);
  kf[2]=*(const __attribute__((address_space(3))) bf16x8*)(kp+2048); kf[3]=*(const __attribute__((address_space(3))) bf16x8*)(kp+2560);
  kf[4]=*(const __attribute__((address_space(3))) bf16x8*)(kp+4096); kf[5]=*(const __attribute__((address_space(3))) bf16x8*)(kp+4608);
  kf[6]=*(const __attribute__((address_space(3))) bf16x8*)(kp+6144); kf[7]=*(const __attribute__((address_space(3))) bf16x8*)(kp+6656);
}
__device__ __forceinline__ void kload2(bf16x8*kf,lds_cptr kp,int j){ kf[2*j]=*(const __attribute__((address_space(3))) bf16x8*)(kp+j*2048); kf[2*j+1]=*(const __attribute__((address_space(3))) bf16x8*)(kp+j*2048+512); }
__device__ __forceinline__ s16x4 vtr(lds_cptr p){ return __builtin_bit_cast(s16x4,__builtin_amdgcn_ds_read_tr16_b64_v4i16((__attribute__((address_space(3))) v4i16_t*)p)); }
__device__ __forceinline__ float rowmax(const f32x16&p0,const f32x16&p1){
  float a=max3f(p0[0],p0[1],p1[0]),b=max3f(p0[2],p0[3],p1[1]);a=max3f(a,p1[2],p1[3]);
  #pragma unroll
  for(int r=4;r<16;r+=4){a=max3f(a,p0[r],p0[r+1]);b=max3f(b,p0[r+2],p0[r+3]);a=max3f(a,p1[r],p1[r+1]);b=max3f(b,p1[r+2],p1[r+3]);}
  const float m=max2f(a,b);
  auto rr=__builtin_amdgcn_permlane32_swap(__float_as_uint(m),__float_as_uint(m),false,false);
  return max2f(__uint_as_float(rr[0]),__uint_as_float(rr[1]));
}
__device__ __forceinline__ void pv(f32x16*o,int vb,bf16x8 pa0,bf16x8 pa1,bf16x8 pa2,bf16x8 pa3){
  #pragma unroll
  for(int d0=0;d0<2;++d0){s16x4 lo[4],hi[4];
    #pragma unroll
    for(int ks=0;ks<4;++ks){
      asm volatile("ds_read_b64_tr_b16 %0,%1 offset:%c2":"=&v"(lo[ks]):"v"(vb),"i"(d0*4096+ks*1024):"memory");
      asm volatile("ds_read_b64_tr_b16 %0,%1 offset:%c2":"=&v"(hi[ks]):"v"(vb),"i"(d0*4096+ks*1024+512):"memory");}
    asm volatile("s_waitcnt lgkmcnt(0)":::"memory");SBAR();
    #define PK(k) (bf16x8){lo[k][0],lo[k][1],lo[k][2],lo[k][3],hi[k][0],hi[k][1],hi[k][2],hi[k][3]}
    o[d0]=__builtin_amdgcn_mfma_f32_32x32x16_bf16(pa0,PK(0),o[d0],0,0,0);
    o[d0]=__builtin_amdgcn_mfma_f32_32x32x16_bf16(pa1,PK(1),o[d0],0,0,0);
    o[d0]=__builtin_amdgcn_mfma_f32_32x32x16_bf16(pa2,PK(2),o[d0],0,0,0);
    o[d0]=__builtin_amdgcn_mfma_f32_32x32x16_bf16(pa3,PK(3),o[d0],0,0,0);
    #undef PK
  }
}

#ifndef ATTN_STORE16
#define ATTN_STORE16(p,v) (*(u32x4*)(p)=(v))
#endif
template<int THRL,int MODE> __device__ __forceinline__ void attn_unit(long rowbase,int qb,const bf16*Qh,int ldq,const bf16*__restrict__ Kh0,const bf16*__restrict__ Vh0,int ldkv,bf16*Oh,int ldo,const unsigned long long*selrow,char*shm){
  const int tid=tid_(),lane=tid&63,r32=lane&31,hi=lane>>5; const int wid=__builtin_amdgcn_readfirstlane(tid>>6);
  const int q0=qb*QB;
  int t_lo=0; bool lower=false; if(MODE==2){ if(qb>=2){ t_lo=4*qb-8; lower=true; } }
  const bf16*Qw=Qh+(rowbase+q0+wid*QBLK)*ldq;
  const bf16*Kh=Kh0+(rowbase+(long)t_lo*KVBLK)*ldkv,*Vh=Vh0+(rowbase+(long)t_lo*KVBLK)*ldkv;
  const unsigned lds0=(unsigned)(uintptr_t)shm;
  float*wsf=(float*)(shm+LDS_WS)+wid*64;
  const bf16*ksrc=Kh+(long)lane*ldkv+wid*8;
  const bf16*vsrc=Vh+(long)(16*(wid&3)+(lane>>2))*ldkv+(wid>>2)*32+(lane&3)*8;
  const unsigned kdst=lds0+LDS_K+wid*1024, vdst=lds0+LDS_V+wid*1024;
  #define DMA_K(t,slot) glds16(ksrc+(long)(t)*KVBLK*ldkv,(unsigned)__builtin_amdgcn_readfirstlane(kdst+(slot)))
  #define DMA_V(t,slot) glds16(vsrc+(long)(t)*KVBLK*ldkv,(unsigned)__builtin_amdgcn_readfirstlane(vdst+(slot)))
  const int vb0=(int)(lds0+LDS_V)+((lane>>4)&1)*32+(lane&3)*8+(4*hi+((lane&15)>>2))*64;
  const char*Kbase=shm+LDS_K; bf16x8 kf[8];
  const lds_cptr shm3=(lds_cptr)shm; const lds_cptr kp0=shm3+LDS_K+hi*1024+r32*16; const lds_cptr vp0=shm3+LDS_V+((lane>>4)&1)*32+(lane&3)*8+(4*hi+((lane&15)>>2))*64;
  const int NT=(q0+QB)/KVBLK-t_lo;
  DMA_K(0,0);DMA_V(0,0);DMA_K(1,SLOTB);
  bf16x8 qr[4];
  #pragma unroll
  for(int d0=0;d0<4;++d0)qr[d0]=*reinterpret_cast<const bf16x8*>(&Qw[(long)r32*ldq+d0*16+hi*8]);
  float mhat=0.f,l_reg=0.f;f32x16 o[2];o[0]=f32x16{};o[1]=f32x16{};f32x16 negm=f32x16{};asm volatile("":"+v"(negm));
  const int qrel=wid*QBLK+r32;
  unsigned long long msk=0ull; if(MODE==1) msk=selrow[q0+qrel];
  #define XMASK(P0,P1,t) do{ if(MODE==1) smask(P0,P1,((msk>>(t))&1ull)!=0ull); if(MODE==2){ if(lower&&(t)<4) lmask(P0,P1,(t),qrel,hi); } }while(0)
  #define CMASK(P0,P1,t) do{ XMASK(P0,P1,t); int jb_=(t)-(NT-4); if(jb_>=0)cmask(P0,P1,jb_,qrel,hi);}while(0)
  bool resc=false;
  #define START(P0,P1) do{ const float rm=rowmax(P0,P1); resc=false; \
    { const float dl=rm; mhat=fadd_s(mhat,dl); \
      _Pragma("unroll") for(int r=0;r<16;++r){P0[r]=fsub_s(P0[r],dl);P1[r]=fsub_s(P1[r],dl);} \
      _Pragma("unroll") for(int r=0;r<16;++r)negm[r]=-mhat; asm volatile("":"+v"(negm)); } \
    _Pragma("unroll") for(int r=0;r<16;++r)P0[r]=__builtin_amdgcn_exp2f(P0[r]); }while(0)
  #define RESC() do{ if(resc){ asm volatile("s_waitcnt lgkmcnt(0)":::"memory"); \
      _Pragma("unroll") for(int d_=0;d_<2;++d_) _Pragma("unroll") for(int r=0;r<16;++r)o[d_][r]*=wsf[crow(r,hi)]; } }while(0)
  f32x16 pA0,pA1,pB0,pB1;
  int sl_prev=0,sl_cur=0,sl_next=SLOTB;
  #define ROT() do{sl_prev=sl_cur;sl_cur=sl_next;sl_next=(sl_next==(NSLOT-1)*SLOTB)?0:sl_next+SLOTB;}while(0)
  DMA_K(2,2*SLOTB);
  WAIT_BAR(3);
  qkt(pA0,pA1,Kbase,qr,negm,r32,hi);asm volatile("s_nop 15\n\ts_nop 7":"+v"(pA0),"+v"(pA1));CMASK(pA0,pA1,0);
  START(pA0,pA1);
  _Pragma("unroll") for(int r=0;r<16;++r)pA1[r]=__builtin_amdgcn_exp2f(pA1[r]);
  WAIT_BAR(0);
  DMA_K(3,0);DMA_V(1,SLOTB);
  ROT();
  kload8(kf,kp0+sl_cur);
  WAIT_BAR(2);
  s16x4 vlo[8],vhi[8]; u32x4 pw0,pw1,pw2,pw3;
  #define PKW(P,B) cvtpk_s(P[B],P[B+1])
  #define PAF(k) __builtin_bit_cast(bf16x8,pw##k)
  #define VFR(i) (bf16x8){vlo[i][0],vlo[i][1],vlo[i][2],vlo[i][3],vhi[i][0],vhi[i][1],vhi[i][2],vhi[i][3]}
  #define PIN(x) asm volatile("":"+v"(x))
  #define MX3(a,b,c) __builtin_fmaxf(__builtin_fmaxf((a),(b)),(c))
  #define GAPA(MF,A0,A1,A2,A3,W0,W1,PW) do{ MF; sacc+=A0; sacc+=A1; sacc+=A2; sacc+=A3; PIN(sacc); W0; W1; PIN(PW); SBAR(); }while(0)
  #define EX(v) __builtin_amdgcn_exp2f(v)
  #define GAPB(MF,X,B) do{ MF; X[B]=EX(X[B]); X[B+1]=EX(X[B+1]); X[B+2]=EX(X[B+2]); X[B+3]=EX(X[B+3]); PIN(X); SBAR(); }while(0)
  #define VRD(i) do{ vlo[i]=vtr(vp_+(((i)>>2)*4096+((i)&3)*1024)); vhi[i]=vtr(vp_+(((i)>>2)*4096+((i)&3)*1024+512)); }while(0)
  #define KRD(G,j) do{ if(G){ kload2(kf,kp0+sl_next,j); SBAR(); } }while(0)
  #define STEP(C0,C1,P0,P1,t,GK,GV,GL) do{ SBAR(); \
    const lds_cptr vp_=vp0+sl_prev; \
    VRD(0); SBAR(); float sacc=(P0[0]+P0[1]); \
    GAPA(C0=__builtin_amdgcn_mfma_f32_32x32x16_bf16(kf[0],qr[0],negm,0,0,0), P0[2],P0[3],P0[4],P0[5],     pw0[0]=PKW(P0,0), pw0[1]=PKW(P0,2), pw0); \
    VRD(4); SBAR(); GAPA(C1=__builtin_amdgcn_mfma_f32_32x32x16_bf16(kf[1],qr[0],negm,0,0,0), P0[6],P0[7],P0[8],P0[9],     pw0[2]=PKW(P0,4), pw0[3]=PKW(P0,6), pw0); \
    VRD(1); SBAR(); GAPA(C0=__builtin_amdgcn_mfma_f32_32x32x16_bf16(kf[2],qr[1],C0,0,0,0),   P0[10],P0[11],P0[12],P0[13], pw1[0]=PKW(P0,8), pw1[1]=PKW(P0,10), pw1); \
    VRD(5); SBAR(); GAPA(C1=__builtin_amdgcn_mfma_f32_32x32x16_bf16(kf[3],qr[1],C1,0,0,0),   P0[14],P0[15],P1[0],P1[1],   pw1[2]=PKW(P0,12),pw1[3]=PKW(P0,14), pw1); \
    VRD(2); SBAR(); GAPA(C0=__builtin_amdgcn_mfma_f32_32x32x16_bf16(kf[4],qr[2],C0,0,0,0),   P1[2],P1[3],P1[4],P1[5],     pw2[0]=PKW(P1,0), pw2[1]=PKW(P1,2), pw2); \
    VRD(6); SBAR(); GAPA(C1=__builtin_amdgcn_mfma_f32_32x32x16_bf16(kf[5],qr[2],C1,0,0,0),   P1[6],P1[7],P1[8],P1[9],     pw2[2]=PKW(P1,4), pw2[3]=PKW(P1,6), pw2); \
    VRD(3); SBAR(); GAPA(C0=__builtin_amdgcn_mfma_f32_32x32x16_bf16(kf[6],qr[3],C0,0,0,0),   P1[10],P1[11],P1[12],P1[13], pw3[0]=PKW(P1,8), pw3[1]=PKW(P1,10), pw3); \
    VRD(7); SBAR(); GAPA(C1=__builtin_amdgcn_mfma_f32_32x32x16_bf16(kf[7],qr[3],C1,0,0,0),   P1[14],P1[15],0.f,0.f,       pw3[2]=PKW(P1,12),pw3[3]=PKW(P1,14), pw3); \
    l_reg+=sacc; \
    if(GK){DMA_K((t)+3,sl_cur);} if(GV){DMA_V((t)+1,sl_next);} \
    CMASK(C0,C1,t); \
    { float a=MX3(C0[0],C0[1],C1[0]),b=MX3(C0[2],C0[3],C1[1]); a=MX3(a,C1[2],C1[3]); \
      _Pragma("unroll") for(int r=4;r<16;r+=4){a=MX3(a,C0[r],C0[r+1]);b=MX3(b,C0[r+2],C0[r+3]);a=MX3(a,C1[r],C1[r+1]);b=MX3(b,C1[r+2],C1[r+3]);} \
      float rm=__builtin_fmaxf(a,b); { auto rr=__builtin_amdgcn_permlane32_swap(__float_as_uint(rm),__float_as_uint(rm),false,false); rm=__builtin_fmaxf(__uint_as_float(rr[0]),__uint_as_float(rr[1])); } \
      resc=false; \
      if(__builtin_expect(__any(rm>(float)THRL),0)){ const float dl=__builtin_fmaxf(rm,0.f); mhat+=dl; \
        _Pragma("unroll") for(int r=0;r<16;++r){C0[r]-=dl;C1[r]-=dl;} \
        _Pragma("unroll") for(int r=0;r<16;++r)negm[r]=-mhat; asm volatile("":"+v"(negm)); \
        const float f=__builtin_amdgcn_exp2f(-dl); l_reg*=f; if(hi==0)wsf[r32]=f; resc=true; } } \
    SBAR(); \
    GAPB(o[0]=__builtin_amdgcn_mfma_f32_32x32x16_bf16(PAF(0),VFR(0),o[0],0,0,0), C0,0); \
    GAPB(o[1]=__builtin_amdgcn_mfma_f32_32x32x16_bf16(PAF(0),VFR(4),o[1],0,0,0), C0,4); \
    KRD(GL,0); GAPB(o[0]=__builtin_amdgcn_mfma_f32_32x32x16_bf16(PAF(1),VFR(1),o[0],0,0,0), C0,8); \
    KRD(GL,1); GAPB(o[1]=__builtin_amdgcn_mfma_f32_32x32x16_bf16(PAF(1),VFR(5),o[1],0,0,0), C0,12); \
    KRD(GL,2); GAPB(o[0]=__builtin_amdgcn_mfma_f32_32x32x16_bf16(PAF(2),VFR(2),o[0],0,0,0), C1,0); \
    KRD(GL,3); GAPB(o[1]=__builtin_amdgcn_mfma_f32_32x32x16_bf16(PAF(2),VFR(6),o[1],0,0,0), C1,4); \
    GAPB(o[0]=__builtin_amdgcn_mfma_f32_32x32x16_bf16(PAF(3),VFR(3),o[0],0,0,0), C1,8); \
    GAPB(o[1]=__builtin_amdgcn_mfma_f32_32x32x16_bf16(PAF(3),VFR(7),o[1],0,0,0), C1,12); \
    }while(0)
  int t=1;
  #undef CMASK
  #define CMASK(P0,P1,t) XMASK(P0,P1,t)
  for(;t+5<NT;t+=2){
    STEP(pB0,pB1,pA0,pA1,t,true,true,true);     WAIT_BAR(2); RESC(); ROT();
    STEP(pA0,pA1,pB0,pB1,t+1,true,true,true);   WAIT_BAR(2); RESC(); ROT();
  }
  #undef CMASK
  #define CMASK(P0,P1,t) do{ XMASK(P0,P1,t); int jb_=(t)-(NT-4); if(jb_>=0)cmask(P0,P1,jb_,qrel,hi);}while(0)
  #define ENDW(tt) do{ if((tt)+3<NT){WAIT_BAR(2);} else if((tt)+2<NT){WAIT_BAR(1);} else {WAIT_BAR(0);} }while(0)
  for(;t+1<NT;t+=2){
    STEP(pB0,pB1,pA0,pA1,t,(t+3<NT),(t+1<NT),(t+1<NT));       ENDW(t);   RESC(); ROT();
    STEP(pA0,pA1,pB0,pB1,t+1,(t+4<NT),(t+2<NT),(t+2<NT));     ENDW(t+1); RESC(); ROT();
  }
  STEP(pB0,pB1,pA0,pA1,NT-1,false,false,false); RESC();
  { float sacc=pB0[0]+pB0[1]; _Pragma("unroll") for(int r=2;r<16;++r)sacc+=pB0[r]; _Pragma("unroll") for(int r=0;r<16;++r)sacc+=pB1[r]; l_reg+=sacc;
    pw0=(u32x4){PKW(pB0,0),PKW(pB0,2),PKW(pB0,4),PKW(pB0,6)};pw1=(u32x4){PKW(pB0,8),PKW(pB0,10),PKW(pB0,12),PKW(pB0,14)};pw2=(u32x4){PKW(pB1,0),PKW(pB1,2),PKW(pB1,4),PKW(pB1,6)};pw3=(u32x4){PKW(pB1,8),PKW(pB1,10),PKW(pB1,12),PKW(pB1,14)};
    SBAR(); pv(o,vb0+sl_cur,PAF(0),PAF(1),PAF(2),PAF(3)); }
  #undef PKW
  #undef PAF
  #undef VFR
  #undef PIN
  #undef MX3
  #undef GAPA
  #undef GAPB
  #undef EX
  #undef VRD
  #undef KRD
  #undef STEP
  #undef ENDW
  {auto rr=__builtin_amdgcn_permlane32_swap(__float_as_uint(l_reg),__float_as_uint(l_reg),false,false);l_reg=__uint_as_float(rr[0])+__uint_as_float(rr[1]);}
  if(hi==0)wsf[32+r32]=l_reg;asm volatile("s_waitcnt lgkmcnt(0)":::"memory");
  float rli[16];
  #pragma unroll
  for(int r=0;r<16;++r)rli[r]=__builtin_amdgcn_rcpf(wsf[32+crow(r,hi)]);
  bf16*Ow=Oh+(rowbase+q0+wid*QBLK)*ldo;
  { bf16*stg=(bf16*)(shm+LDS_OST)+wid*2048;
    #pragma unroll
    for(int r=0;r<16;++r){const int orow=crow(r,hi);
      #pragma unroll
      for(int d0=0;d0<2;++d0)stg[orow*64+d0*32+r32]=__float2bfloat16(o[d0][r]*rli[r]);}
    asm volatile("s_waitcnt lgkmcnt(0)":::"memory");
    #pragma unroll
    for(int i=0;i<4;++i){const int row=i*8+(lane>>3),ch=lane&7; const u32x4 v=*(const u32x4*)(stg+row*64+ch*8); ATTN_STORE16(Ow+(long)row*ldo+ch*8,v);} }
  asm volatile("s_waitcnt lgkmcnt(0)\n\ts_barrier":::"memory");
  #undef DMA_K
  #undef DMA_V
  #undef CMASK
  #undef XMASK
  #undef START
  #undef RESC
  #undef ROT
}
constexpr int ATTN_LDS_BYTES=LDS_BYTES;
#undef SBAR
#undef WAIT_BAR
}

__device__ __forceinline__ void ph_attn_diff_fast(unsigned char* lds) {
  using namespace attn_body;
  const bf16* PROJ = (const bf16*)(P(ws) + WS_PROJ); bf16* ATT = (bf16*)(P(ws) + WS_ATT);
  const int G = gdim_(), bx = bid_(); const int v0 = (G % 8 == 0) ? (bx % 8) * (G / 8) + bx / 8 : bx;
  for (int vcu = v0; vcu < 256; vcu += G) {
    const int bhp = vcu >> 1, half = bhp & 1, c = (bhp >> 1) & 1, h8 = (bhp >> 2) & 7, b = bhp >> 5;
#pragma unroll 1
    for (int i = 0; i < 8; ++i) { const int sp = 4 * (vcu & 1) + (i >> 1); const int qb = (i & 1) ? 15 - sp : sp;
      attn_unit<8, 0>((long)b * S, qb, PROJ + (h8 * 2 + c) * 64, DIFF_IN, PROJ + 1024 + (h8 * 2 + c) * 64, PROJ + 2048 + h8 * 128 + half * 64, DIFF_IN,
                      ATT + c * 1024 + h8 * 128 + half * 64, 2048, nullptr, (char*)lds); }
  }
}
__device__ __forceinline__ void ph_attn_sel_fast(unsigned char* lds) {
  using namespace attn_body;
  const bf16* PROJ = (const bf16*)(P(ws) + WS_PROJ); bf16* OSEL = (bf16*)(P(ws) + WS_ATT + 32 * MiB);
  const u64* SEL = (const u64*)(P(ws) + WS_SEL);
  const int G = gdim_(), bx = bid_(); const int v0 = (G % 8 == 0) ? (bx % 8) * (G / 8) + bx / 8 : bx;
  for (int vcu = v0; vcu < 256; vcu += G) {
    const int bh = vcu >> 2, hd = bh & 15, b = bh >> 4, g = hd >> 2;
#pragma unroll 1
    for (int i = 0; i < 4; ++i) { const int sp = 2 * (vcu & 3) + (i >> 1); const int qb = (i & 1) ? 15 - sp : sp;
      attn_unit<8, 1>((long)b * S, qb, PROJ + hd * 64, NSA_P, PROJ + 1536 + g * 64, PROJ + 1792 + g * 64, NSA_P, OSEL + hd * 64, 1024, SEL + (size_t)(b * 4 + g) * S, (char*)lds); }
  }
}
__device__ __forceinline__ void ph_attn_win_fast(unsigned char* lds) {
  using namespace attn_body;
  const bf16* PROJ = (const bf16*)(P(ws) + WS_PROJ); bf16* OWIN = (bf16*)(P(ws) + WS_ATT + 64 * MiB);
  const int G = gdim_(), bx = bid_(); const int v0 = (G % 8 == 0) ? (bx % 8) * (G / 8) + bx / 8 : bx;
  for (int vcu = v0; vcu < 256; vcu += G) {
    const int bh = vcu >> 2, hd = bh & 15, b = bh >> 4, g = hd >> 2;
#pragma unroll 1
    for (int i = 0; i < 4; ++i) { const int qb = (vcu & 3) + 4 * i;
      attn_unit<8, 2>((long)b * S, qb, PROJ + hd * 64, NSA_P, PROJ + 2048 + g * 64, PROJ + 2304 + g * 64, NSA_P, OWIN + hd * 64, 1024, nullptr, (char*)lds); }
  }
}

#define XB_TMO      128
#define XB_XCNT(j)  (256  + 64 * (j))
#define XB_XSUB(j)  (1280 + 64 * (j))
#define XB_XGEN(j)  (2304 + 64 * (j))
#define XB_TOP      3328
#define XB_TOPGEN   3392
#define XCD_BAR_WORDS 3456
#define XB_SPIN_CAP (1u << 18)

__device__ __forceinline__ unsigned xb_ld(unsigned* p)              { return __hip_atomic_load(p, __ATOMIC_RELAXED, __HIP_MEMORY_SCOPE_AGENT); }
__device__ __forceinline__ unsigned xb_add(unsigned* p, unsigned v) { return __hip_atomic_fetch_add(p, v, __ATOMIC_RELAXED, __HIP_MEMORY_SCOPE_AGENT); }
__device__ __forceinline__ unsigned xb_xcc_id() { return (unsigned)__builtin_amdgcn_s_getreg((3 << 11) | 20) & 0xFu; }
#define XB_SPIN(cond, bar) do { unsigned _sp = 0; while (cond) { __builtin_amdgcn_s_sleep(1); \
    if ((++_sp & 255u) == 0u) { if (xb_ld(&(bar)[XB_TMO])) break; if (_sp > XB_SPIN_CAP) { atomicAdd(&(bar)[XB_TMO], 1u); break; } } } } while (0)

struct XcdBarrier {
    unsigned* bar; unsigned x;
    volatile __attribute__((address_space(3))) unsigned* st;
};

__device__ __forceinline__ XcdBarrier xcd_barrier_post(unsigned* bar, volatile __attribute__((address_space(3))) unsigned* st) {
    XcdBarrier b; b.bar = bar; b.x = xb_xcc_id(); b.st = st;
    if (tid_() == 0) (void)xb_add(&bar[XB_XCNT(b.x)], 1u);
    return b;
}
__device__ __forceinline__ void xcd_barrier_complete(unsigned* bar, unsigned x, unsigned& nloc, unsigned& nx) {
    const unsigned G = gridDim.x * gridDim.y * gridDim.z;
    unsigned sum, cnt, mine, sp = 0u;
    for (;;) {
        sum = 0u; cnt = 0u; mine = 0u;
#pragma unroll
        for (unsigned j = 0; j < 16; ++j) { const unsigned c = xb_ld(&bar[XB_XCNT(j)]); sum += c; cnt += (c > 0u) ? 1u : 0u; mine = (j == x) ? c : mine; }
        if (sum == G) break;
        __builtin_amdgcn_s_sleep(1);
        if ((++sp & 255u) == 0u) { if (xb_ld(&bar[XB_TMO])) break; if (sp > XB_SPIN_CAP) { atomicAdd(&bar[XB_TMO], 1u); break; } }
    }
    nloc = mine > 0u ? mine : 1u; nx = cnt > 0u ? cnt : 1u;
}

__device__ __forceinline__ void xcd_barrier(const XcdBarrier& b) {
    asm volatile("s_waitcnt vmcnt(0)" ::: "memory");
    __syncthreads();
    if (tid_() == 0) {
        unsigned* bar = b.bar;
        __builtin_amdgcn_s_waitcnt(0);
        unsigned nloc = b.st[0], nx = b.st[1];
        if (nloc == 0u) { xcd_barrier_complete(bar, b.x, nloc, nx); b.st[0] = nloc; b.st[1] = nx; }
        const unsigned old = xb_add(&bar[XB_XSUB(b.x)], 1u);
        const unsigned gen = old / nloc;
        if (old + 1u == (gen + 1u) * nloc) {
            __builtin_amdgcn_fence(__ATOMIC_RELEASE, "agent");
            asm volatile("s_waitcnt vmcnt(0)" ::: "memory");
            const unsigned og = xb_add(&bar[XB_TOP], 1u);
            const unsigned tg = og / nx;
            if (og + 1u == (tg + 1u) * nx) xb_add(&bar[XB_TOPGEN], 1u);
            else XB_SPIN(xb_ld(&bar[XB_TOPGEN]) == tg, bar);
            __builtin_amdgcn_fence(__ATOMIC_ACQUIRE, "agent");
            xb_add(&bar[XB_XGEN(b.x)], 1u);
            asm volatile("s_waitcnt vmcnt(0)" ::: "memory");
        } else {
            XB_SPIN(xb_ld(&bar[XB_XGEN(b.x)]) == gen, bar);
            __builtin_amdgcn_fence(__ATOMIC_ACQUIRE, "agent");
            asm volatile("s_waitcnt vmcnt(0)" ::: "memory");
        }
    }
    __syncthreads();
}

__device__ __forceinline__ void ph_prologue(unsigned char* lds) {
  const int tid = tid_();
  float* silu = (float*)lds;
  float* red = silu + 4096;
  float* MOD = (float*)(P(ws) + WS_MOD);
  for (int i = tid; i < 4096; i += NTHR) { const float v = P(c)[i]; silu[i] = v / (1.f + expf(-v)); }
  __syncthreads();
  for (int item = bid_(); item < 4 * 48; item += gdim_()) {
    const int l = item / 48, nc = item % 48, cc = tid & 127, ks = tid >> 7;
    const float* w = P(w_ada) + ((size_t)l * 1024 + ks * 256) * 6144 + nc * 128 + cc;
    float a0 = 0.f, a1 = 0.f, a2 = 0.f, a3 = 0.f;
#pragma unroll 8
    for (int k = 0; k < 256; ++k) { const float wv = w[(size_t)k * 6144]; const int kk = ks * 256 + k;
      a0 += silu[kk] * wv; a1 += silu[1024 + kk] * wv; a2 += silu[2048 + kk] * wv; a3 += silu[3072 + kk] * wv; }
    red[(ks * 4 + 0) * 128 + cc] = a0; red[(ks * 4 + 1) * 128 + cc] = a1; red[(ks * 4 + 2) * 128 + cc] = a2; red[(ks * 4 + 3) * 128 + cc] = a3;
    __syncthreads();
    { const int b = tid >> 7;
      const float s = red[(0 * 4 + b) * 128 + cc] + red[(1 * 4 + b) * 128 + cc] + red[(2 * 4 + b) * 128 + cc] + red[(3 * 4 + b) * 128 + cc];
      MOD[(size_t)(l * 4 + b) * 6144 + nc * 128 + cc] = s + P(b_ada)[l * 6144 + nc * 128 + cc]; }
    __syncthreads();
  }
  float* rope = (float*)(P(ws) + WS_ROPE);
  for (int m = bid_() * NTHR + tid; m < T; m += gdim_() * NTHR) {
    const float fp = (float)P(pos)[m];
    const float INV[8] = {1.0f, 0.1939227432012558f, 0.03760603070259094f, 0.007292664609849453f, 0.0014142135623842478f, 0.00027424818836152554f, 5.3182957344688475e-05f, 1.0313385246263351e-05f};
#pragma unroll
    for (int i = 0; i < 8; ++i) {
      const float ang = fp * INV[i];
      const double a = (double)ang; const double kq = rint(a * 0.63661977236758134308); const double r = a - kq * 1.57079632679489661923;
      const int q = (int)((long long)kq & 3ll);
      const double r2 = r * r;
      const double sr = r * (1.0 + r2 * (-1.0 / 6 + r2 * (1.0 / 120 + r2 * (-1.0 / 5040 + r2 * (1.0 / 362880 + r2 * (-1.0 / 39916800 + r2 * (1.0 / 6227020800.0)))))));
      const double cr = 1.0 + r2 * (-0.5 + r2 * (1.0 / 24 + r2 * (-1.0 / 720 + r2 * (1.0 / 40320 + r2 * (-1.0 / 3628800 + r2 * (1.0 / 479001600.0))))));
      const double sn = (q == 0) ? sr : (q == 1) ? cr : (q == 2) ? -sr : -cr;
      const double cs = (q == 0) ? cr : (q == 1) ? -sr : (q == 2) ? -cr : sr;
      rope[(size_t)m * 16 + i] = (float)cs; rope[(size_t)m * 16 + 8 + i] = (float)sn;
    }
  }
  if (bid_() == 0 && tid < 2) {
    const int j = tid; float s1 = 0.f, s2 = 0.f;
    for (int i = 0; i < 64; ++i) { s1 += P(diff_lq1)[j * 64 + i] * P(diff_lk1)[j * 64 + i]; s2 += P(diff_lq2)[j * 64 + i] * P(diff_lk2)[j * 64 + i]; }
    ((float*)(P(ws) + WS_SMALL))[j] = expf(s1) - expf(s2) + lam_init_of(j);
  }
}


__device__ __forceinline__ void transpose_item(const float* W, int K, int N, int Npad, bf16_t* WT, float* scr, int item, int lane) {
  const int nblk = Npad / 32, kb = item / nblk, nb = item % nblk, k0 = 64 * kb, n0 = 32 * nb;
  const int ncol = n0 + (lane & 31); const bool ok = ncol < N;
#pragma unroll 8
  for (int i = 0; i < 32; ++i) { const int kk = 2 * i + (lane >> 5); scr[kk * 33 + (lane & 31)] = ok ? W[(size_t)(k0 + kk) * N + ncol] : 0.f; }
  asm volatile("s_waitcnt lgkmcnt(0)" ::: "memory");
  const int c = lane & 7;
#pragma unroll
  for (int j = 0; j < 4; ++j) { const int n = (lane >> 3) + 8 * j; const float* sp = scr + (8 * c) * 33 + n;
    uint4 o; o.x = pk2(sp[0 * 33], sp[1 * 33]); o.y = pk2(sp[2 * 33], sp[3 * 33]); o.z = pk2(sp[4 * 33], sp[5 * 33]); o.w = pk2(sp[6 * 33], sp[7 * 33]);
    *(uint4*)(WT + (size_t)(n0 + n) * K + k0 + 8 * c) = o; }
  asm volatile("s_waitcnt lgkmcnt(0)" ::: "memory");
}
__device__ __forceinline__ void ph_weights(unsigned char* lds) {
  const int tid = tid_(), lane = tid & 63, wave = tid >> 6;
  float* scr = (float*)(lds + wave * 16384);
  const int gw = bid_() * 8 + wave, NGW = gdim_() * 8;
  for (int it = gw; it < 4 * 6144; it += NGW) {
    const int i = it / 6144; int r = it % 6144; const int j = i >> 1; const bool nsa = (i & 1) == 0;
    bf16_t* base = (bf16_t*)(P(ws) + WS_WT + (size_t)i * WT_LAYER);
    const int n_in = nsa ? 16 * (NSA_P / 32) : 16 * (DIFF_IN / 32);
    if (r < n_in) { if (nsa) transpose_item(P(nsa_w_in) + (size_t)j * D * NSA_IN, D, NSA_IN, NSA_P, base, scr, r, lane); else transpose_item(P(diff_w_in) + (size_t)j * D * DIFF_IN, D, DIFF_IN, DIFF_IN, base, scr, r, lane); continue; }
    r -= n_in;
    if (r < 512) { transpose_item((nsa ? P(nsa_w_out) : P(diff_w_out)) + (size_t)j * D * D, D, D, D, base + WT_OUT / 2, scr, r, lane); continue; }
    r -= 512;
    if (r < 2048) { transpose_item(P(w_mlp_in) + (size_t)i * D * DFF, D, DFF, DFF, base + WT_MI / 2, scr, r, lane); continue; }
    r -= 2048;
    if (r < 2048) transpose_item(P(w_mlp_out) + (size_t)i * DFF * D, DFF, D, D, base + WT_MO / 2, scr, r, lane);
  }
  for (int it = gw; it < 4 * 128; it += NGW) {
    const int jk = it >> 7, jj = jk >> 1, kv = jk & 1;
    transpose_item((kv ? P(nsa_w_cv1) : P(nsa_w_ck1)) + (size_t)jj * 2048 * 128, 2048, 128, 128, (bf16_t*)(P(ws) + WS_W1T) + (size_t)jk * 128 * 2048, scr, it & 127, lane);
  }
}
__device__ __forceinline__ void ph_cmp_bias(unsigned char* lds) {
  float* red = (float*)lds;
  const int tid = tid_(), n = tid & 127, ks = tid >> 7;
  for (int jk = bid_(); jk < 4; jk += gdim_()) {
    const int jj = jk >> 1, kv = jk & 1;
    const float* pe = (kv ? P(nsa_pe_v) : P(nsa_pe_k)) + jj * 2048; const float* w1 = (kv ? P(nsa_w_cv1) : P(nsa_w_ck1)) + (size_t)jj * 2048 * 128;
    float a = 0.f;
#pragma unroll 16
    for (int k = ks * 512; k < ks * 512 + 512; ++k) a += pe[k] * w1[(size_t)k * 128 + n];
    __syncthreads();
    red[ks * 128 + n] = a;
    __syncthreads();
    if (tid < 128) ((float*)(P(ws) + WS_SMALL))[64 + jk * 128 + tid] = red[tid] + red[128 + tid] + red[256 + tid] + red[384 + tid];
  }
}

__device__ __forceinline__ void ph_norm(const float* xin, const float* gvec, const float* mod  , int sh_off, int sc_off, bf16_t* H) {
  const int tid = tid_(), lane = tid & 63, wave = tid >> 6;
  for (int m = bid_() * 8 + wave; m < T; m += gdim_() * 8) {
    const int b = m >> 12;
    const float4* xr = (const float4*)(xin + (size_t)m * D) + lane;
    float4 v[4]; float ss = 0.f;
#pragma unroll
    for (int j = 0; j < 4; ++j) { v[j] = xr[64 * j]; ss += (v[j].x * v[j].x + v[j].y * v[j].y) + (v[j].z * v[j].z + v[j].w * v[j].w); }
    ss = wave_sum(ss);
    const float rstd = 1.0f / sqrtf(ss * (1.0f / D) + EPS);
#pragma unroll
    for (int j = 0; j < 4; ++j) {
      const int col = 4 * lane + 256 * j;
      const float4 g = *(const float4*)(gvec + col), sc = *(const float4*)(mod + (size_t)b * 6144 + sc_off + col), sh = *(const float4*)(mod + (size_t)b * 6144 + sh_off + col);
      const float h0 = v[j].x * rstd * g.x * (1.f + sc.x) + sh.x, h1 = v[j].y * rstd * g.y * (1.f + sc.y) + sh.y;
      const float h2 = v[j].z * rstd * g.z * (1.f + sc.z) + sh.z, h3 = v[j].w * rstd * g.w * (1.f + sc.w) + sh.w;
      uint2 o; o.x = pk2(h0, h1); o.y = pk2(h2, h3);
      *(uint2*)(H + (size_t)m * D + col) = o;
    }
  }
}

struct EpiStore { bf16_t* O; int ld; int relu2;
  __device__ __forceinline__ void operator()(int row, int col, const float* v) const {
    float a = v[0], b = v[1], c = v[2], d = v[3];
    if (relu2) { a = fmaxf(a, 0.f); a *= a; b = fmaxf(b, 0.f); b *= b; c = fmaxf(c, 0.f); c *= c; d = fmaxf(d, 0.f); d *= d; }
    uint2 o; o.x = pk2(a, b); o.y = pk2(c, d); *(uint2*)(O + (size_t)row * ld + col) = o; } };
struct EpiResid { const float* xin; float* xout; const float* gate;
  __device__ __forceinline__ void operator()(int row, int col, const float* v) const {
    const int b = row >> 12; const float4 g = *(const float4*)(gate + (size_t)b * 6144 + col); const float4 xi = *(const float4*)(xin + (size_t)row * D + col);
    float4 o; o.x = xi.x + g.x * v[0]; o.y = xi.y + g.y * v[1]; o.z = xi.z + g.z * v[2]; o.w = xi.w + g.w * v[3];
    *(float4*)(xout + (size_t)row * D + col) = o; } };

template <class Epi>
__device__ __forceinline__ void gemm_naive(const bf16_t* A, int lda, const float* W, int N, int K, unsigned char* lds, const Epi& E) {
  asm volatile("" : "+s"(N), "+s"(K), "+s"(lda));
  float* As = (float*)lds;
  float* Bs = As + 16 * 132;
  const int tid = tid_(), tx = tid & 31, ty = tid >> 5;
  const int nN = (N + 127) / 128, nM = T / 128;
  const int ar = tid >> 2, ak = (tid & 3) * 4, bk = tid >> 5, bc = (tid & 31) * 4;
  for (int u = bid_(); u < nM * nN; u += gdim_()) {
    const int pm = u / nN, pn = u % nN;
    float acc[8][4];
#pragma unroll
    for (int i = 0; i < 8; ++i) { acc[i][0] = 0.f; acc[i][1] = 0.f; acc[i][2] = 0.f; acc[i][3] = 0.f; }
    const bf16_t* Ap = A + (size_t)(pm * 128 + ar) * lda + ak;
    const int wcol = pn * 128 + bc; const bool bok = wcol < N;
    const float* Wp = W + (size_t)bk * N + (bok ? wcol : 0);
    for (int k0 = 0; k0 < K; k0 += 16) {
      const uint2 av = *(const uint2*)(Ap + k0);
      float4 bv = *(const float4*)(Wp + (size_t)k0 * N);
      if (!bok) bv = make_float4(0.f, 0.f, 0.f, 0.f);
      __syncthreads();
      As[(ak + 0) * 132 + ar] = bf2f(av.x & 0xffffu); As[(ak + 1) * 132 + ar] = bf2f(av.x >> 16);
      As[(ak + 2) * 132 + ar] = bf2f(av.y & 0xffffu); As[(ak + 3) * 132 + ar] = bf2f(av.y >> 16);
      *(float4*)(Bs + bk * 128 + bc) = bv;
      __syncthreads();
#pragma unroll
      for (int k = 0; k < 16; ++k) {
        const float4 a0 = *(const float4*)(As + k * 132 + ty * 8), a1 = *(const float4*)(As + k * 132 + ty * 8 + 4);
        const float4 b = *(const float4*)(Bs + k * 128 + tx * 4);
        const float a[8] = {a0.x, a0.y, a0.z, a0.w, a1.x, a1.y, a1.z, a1.w};
#pragma unroll
        for (int i = 0; i < 8; ++i) { acc[i][0] += a[i] * b.x; acc[i][1] += a[i] * b.y; acc[i][2] += a[i] * b.z; acc[i][3] += a[i] * b.w; }
      }
    }
    const int col = pn * 128 + tx * 4;
    if (col < N) {
#pragma unroll
      for (int i = 0; i < 8; ++i) E(pm * 128 + ty * 8 + i, col, acc[i]);
    }
  }
}

__device__ __forceinline__ void head_norm_rope(const float* v, const float* gain, const float* cs  , int sub, float* vn, float* vr) {
  float ss = 0.f;
#pragma unroll
  for (int i = 0; i < 8; ++i) ss += v[i] * v[i];
  ss += __shfl_xor(ss, 1); ss += __shfl_xor(ss, 2); ss += __shfl_xor(ss, 4);
  const float rstd = 1.0f / sqrtf(ss * (1.0f / 64.0f) + EPS);
#pragma unroll
  for (int i = 0; i < 8; ++i) vn[i] = v[i] * rstd * gain[sub * 8 + i];
#pragma unroll
  for (int i = 0; i < 8; ++i) {
    const float other = __shfl_xor(vn[i], 1);
    const float c = cs[i], s = cs[8 + i];
    float r = vn[i];
    if (sub == 0) r = vn[i] * c - other * s;
    else if (sub == 1) r = vn[i] * c + other * s;
    vr[i] = r;
  }
}

__device__ __forceinline__ void ph_post_diff(int j, bf16_t* PROJ) {
  const int tid = tid_(), lane = tid & 63, wave = tid >> 6, sub = lane & 7;
  const float* rope = (const float*)(P(ws) + WS_ROPE);
  for (int m = bid_() * 8 + wave; m < T; m += gdim_() * 8) {
    const float* cs = rope + (size_t)m * 16;
#pragma unroll
    for (int it = 0; it < 4; ++it) {
      bf16_t* ptr = PROJ + (size_t)m * DIFF_IN + it * 512 + lane * 8;
      float v[8], vn[8], vr[8]; unpack8(*(const uint4*)ptr, v);
      const float* gain = (it < 2) ? (P(diff_q_gain) + j * 64) : (P(diff_k_gain) + j * 64);
      head_norm_rope(v, gain, cs, sub, vn, vr);
      const float sc = (it < 2) ? C2 : 1.0f;
#pragma unroll
      for (int i = 0; i < 8; ++i) vr[i] *= sc;
      *(uint4*)ptr = pack8(vr);
    }
  }
}
__device__ __forceinline__ void ph_post_nsa(int j, bf16_t* PROJ, bf16_t* QC) {
  const int tid = tid_(), lane = tid & 63, wave = tid >> 6, sub = lane & 7;
  const float* rope = (const float*)(P(ws) + WS_ROPE);
  for (int m = bid_() * 8 + wave; m < T; m += gdim_() * 8) {
    const float* cs = rope + (size_t)m * 16;
#pragma unroll
    for (int it = 0; it < 2; ++it) {
      bf16_t* ptr = PROJ + (size_t)m * NSA_P + it * 512 + lane * 8;
      float v[8], vn[8], vr[8]; unpack8(*(const uint4*)ptr, v);
      head_norm_rope(v, P(nsa_q_gain) + j * 64, cs, sub, vn, vr);
#pragma unroll
      for (int i = 0; i < 8; ++i) { vr[i] *= C2; vn[i] *= C2; }
      *(uint4*)ptr = pack8(vr);
      *(uint4*)(QC + (size_t)m * D + it * 512 + lane * 8) = pack8(vn);
    }
    {
      const int hi = lane >> 5;
      bf16_t* ptr = PROJ + (size_t)m * NSA_P + (hi ? 2048 : 1536) + (lane & 31) * 8;
      float v[8], vn[8], vr[8]; unpack8(*(const uint4*)ptr, v);
      head_norm_rope(v, P(nsa_k_gain) + j * 192 + (hi ? 128 : 64), cs, sub, vn, vr);
      *(uint4*)ptr = pack8(vr);
    }
  }
}

template <int DV, int MODE>
__device__ __forceinline__ void attn_naive_unit(int b, int qc, const bf16_t* Qp, int ldq, const bf16_t* Kp, const bf16_t* Vp, int ldkv, bf16_t* Op, int ldo, const u64* selmask, unsigned char* lds) {
  constexpr int DVS = DV / 8;
  float* Ks = (float*)lds;
  float* Vs = Ks + 64 * 64;
  const int tid = tid_(), qi = tid & 63, sl = tid >> 6;
  const int qabs = qc * 64 + qi;
  const size_t rowq = (size_t)b * S + qabs;
  float q[64];
#pragma unroll
  for (int i = 0; i < 8; ++i) unpack8(*(const uint4*)(Qp + rowq * ldq + i * 8), q + i * 8);
  float m = -INFINITY, l = 0.f, o[DVS];
#pragma unroll
  for (int i = 0; i < DVS; ++i) o[i] = 0.f;
  u64 msk = 0ull; if (MODE == 1) msk = selmask[qabs];
  const int t_lo = (MODE == 2) ? (qc > 8 ? qc - 8 : 0) : 0;
  for (int tt = t_lo; tt <= qc; ++tt) {
    __syncthreads();
    { const int key = tid >> 3, ch = tid & 7; float f[8];
      unpack8(*(const uint4*)(Kp + ((size_t)b * S + tt * 64 + key) * ldkv + ch * 8), f);
#pragma unroll
      for (int i = 0; i < 8; ++i) Ks[key * 64 + ch * 8 + i] = f[i];
#pragma unroll
      for (int r = 0; r < DV / 64; ++r) {
        unpack8(*(const uint4*)(Vp + ((size_t)b * S + tt * 64 + key) * ldkv + r * 64 + ch * 8), f);
#pragma unroll
        for (int i = 0; i < 8; ++i) Vs[key * DV + r * 64 + ch * 8 + i] = f[i];
      } }
    __syncthreads();
    const bool tile_on = (MODE == 1) ? (((msk >> tt) & 1ull) != 0ull) : true;
    if (tile_on) {
      for (int jk = 0; jk < 64; ++jk) {
        const int key = tt * 64 + jk;
        bool valid = key <= qabs; if (MODE == 2) valid = valid && (key > qabs - 512);
        if (valid) {
          float s = 0.f;
#pragma unroll
          for (int d = 0; d < 64; d += 4) { const float4 kk = *(const float4*)(Ks + jk * 64 + d); s += q[d] * kk.x + q[d + 1] * kk.y + q[d + 2] * kk.z + q[d + 3] * kk.w; }
          const float mn = fmaxf(m, s); const float sc = exp2f(m - mn), pp = exp2f(s - mn);
          l = l * sc + pp;
#pragma unroll
          for (int i = 0; i < DVS; ++i) o[i] = o[i] * sc + pp * Vs[jk * DV + sl * DVS + i];
          m = mn;
        }
      }
    }
  }
  const float inv = l > 0.f ? 1.0f / l : 0.f;
  bf16_t* op = Op + rowq * ldo + sl * DVS;
  if (DVS == 8) { float r[8];
#pragma unroll
    for (int i = 0; i < 8; ++i) r[i] = o[i] * inv;
    *(uint4*)op = pack8(r);
  } else {
#pragma unroll
    for (int h2 = 0; h2 < DVS / 8; ++h2) { float r[8];
#pragma unroll
      for (int i = 0; i < 8; ++i) r[i] = o[h2 * 8 + i] * inv;
      *(uint4*)(op + h2 * 8) = pack8(r); }
  }
}

__device__ __forceinline__ void ph_attn_diff(unsigned char* lds) {
  const bf16_t* PROJ = (const bf16_t*)(P(ws) + WS_PROJ); bf16_t* ATT = (bf16_t*)(P(ws) + WS_ATT);
  const int NU = NB * 64 * 16;
  for (int u = bid_(); u < NU; u += gdim_()) {
    const int vh = u & 15, qc = 63 - ((u >> 4) & 63), b = u >> 10;
    const int h8 = vh >> 1, c = vh & 1;
    attn_naive_unit<128, 0>(b, qc, PROJ + vh * 64, DIFF_IN, PROJ + 1024 + vh * 64, PROJ + 2048 + h8 * 128, DIFF_IN, ATT + c * 1024 + h8 * 128, 2048, nullptr, lds);
  }
}
__device__ __forceinline__ void ph_attn_sel(unsigned char* lds) {
  const bf16_t* PROJ = (const bf16_t*)(P(ws) + WS_PROJ); bf16_t* OSEL = (bf16_t*)(P(ws) + WS_ATT + 32 * MiB);
  const u64* SEL = (const u64*)(P(ws) + WS_SEL);
  const int NU = NB * 64 * 16;
  for (int u = bid_(); u < NU; u += gdim_()) {
    const int hd = u & 15, qc = 63 - ((u >> 4) & 63), b = u >> 10, g = hd >> 2;
    attn_naive_unit<64, 1>(b, qc, PROJ + hd * 64, NSA_P, PROJ + 1536 + g * 64, PROJ + 1792 + g * 64, NSA_P, OSEL + hd * 64, D, SEL + (size_t)(b * 4 + g) * S, lds);
  }
}
__device__ __forceinline__ void ph_attn_win(unsigned char* lds) {
  const bf16_t* PROJ = (const bf16_t*)(P(ws) + WS_PROJ); bf16_t* OWIN = (bf16_t*)(P(ws) + WS_ATT + 64 * MiB);
  const int NU = NB * 64 * 16;
  for (int u = bid_(); u < NU; u += gdim_()) {
    const int hd = u & 15, qc = (u >> 4) & 63, b = u >> 10, g = hd >> 2;
    attn_naive_unit<64, 2>(b, qc, PROJ + hd * 64, NSA_P, PROJ + 2048 + g * 64, PROJ + 2304 + g * 64, NSA_P, OWIN + hd * 64, D, nullptr, lds);
  }
}

__device__ __forceinline__ void ph_compress(int j, unsigned char* lds) {
  typedef short bf16x8_t __attribute__((ext_vector_type(8))); typedef float f32x16_t __attribute__((ext_vector_type(16)));
  const bf16_t* PROJ = (const bf16_t*)(P(ws) + WS_PROJ);
  unsigned char* Xb = lds;
  float* part = (float*)(lds + 67584);
  float* hid = part + 2 * 32 * 128;
  const int tid = tid_(), lane = tid & 63, wave = tid >> 6, r = lane & 31, h = lane >> 5, nb = wave & 3, kh = wave >> 2;
  for (int it = bid_(); it < 256; it += gdim_()) {
    const int rt = it & 7, kv = (it >> 3) & 1, bg = it >> 4, b = bg >> 2, g = bg & 3;
    const bf16_t* W1T = (const bf16_t*)(P(ws) + WS_W1T) + (size_t)(j * 2 + kv) * 128 * 2048;
    const float* w2 = (kv ? P(nsa_w_cv2) : P(nsa_w_ck2)) + (size_t)j * 128 * 64;
    const int colbase = (kv ? 1280 : 1024) + g * 64;
    __syncthreads();
    for (int i = tid; i < 528 * 8; i += NTHR) { const int tk = i >> 3, ch = i & 7, tok = 512 * rt + tk;
      uint4 v = make_uint4(0u, 0u, 0u, 0u); if (tok < S) v = *(const uint4*)(PROJ + ((size_t)b * S + tok) * NSA_P + colbase + ch * 8);
      *(uint4*)(Xb + tk * 128 + ((ch ^ ((tk >> 4) & 7)) * 16)) = v; }
    __syncthreads();
    f32x16_t acc;
#pragma unroll
    for (int q = 0; q < 16; ++q) acc[q] = 0.f;
    const bf16_t* wrow = W1T + (size_t)(nb * 32 + r) * 2048 + 8 * h;
#pragma unroll 2
    for (int l = 16 * kh; l < 16 * kh + 16; ++l) {
      const int tk = 16 * r + l; const unsigned char* xr = Xb + tk * 128; const int sw = (tk >> 4) & 7;
#pragma unroll
      for (int dq = 0; dq < 4; ++dq) {
        const bf16x8_t av = *(const bf16x8_t*)(xr + (((2 * dq + h) ^ sw) * 16));
        const bf16x8_t bv = *(const bf16x8_t*)(wrow + l * 64 + 16 * dq);
        acc = __builtin_amdgcn_mfma_f32_32x32x16_bf16(av, bv, acc, 0, 0, 0);
      }
    }
#pragma unroll
    for (int q = 0; q < 16; ++q) part[(kh * 32 + ((q & 3) + 8 * (q >> 2) + 4 * h)) * 128 + nb * 32 + r] = acc[q];
    __syncthreads();
    const float* CB = (const float*)(P(ws) + WS_SMALL) + 64 + (j * 2 + kv) * 128;
    for (int i = tid; i < 32 * 128; i += NTHR) { const float hs = part[i] + part[4096 + i] + CB[i & 127]; hid[i] = hs / (1.f + expf(-hs)); }
    __syncthreads();
    { const int e = tid & 63, rq = tid >> 6; float o0 = 0.f, o1 = 0.f, o2 = 0.f, o3 = 0.f;
      for (int hh = 0; hh < 128; ++hh) { const float wv = w2[hh * 64 + e];
        o0 += hid[(rq * 4 + 0) * 128 + hh] * wv; o1 += hid[(rq * 4 + 1) * 128 + hh] * wv; o2 += hid[(rq * 4 + 2) * 128 + hh] * wv; o3 += hid[(rq * 4 + 3) * 128 + hh] * wv; }
      float ov[4] = {o0, o1, o2, o3};
      float* dst = (float*)(P(ws) + (kv ? WS_VCMP : WS_KCMP));
#pragma unroll
      for (int rr = 0; rr < 4; ++rr) { const int c = 32 * rt + rq * 4 + rr; float v = ov[rr];
        if (kv == 0) { const float ss = wave_sum(v * v); v = v * (1.0f / sqrtf(ss * (1.0f / 64.0f) + EPS)) * P(nsa_k_gain)[j * 192 + e]; }
        if (c < 255) dst[((size_t)bg * 256 + c) * 64 + e] = v; }
    }
  }
}

__device__ __forceinline__ void ph_cmp_attn(unsigned char* lds) {
  float* Kc = (float*)lds;
  float* Pm = Kc + 256 * 65;
  float* imp = Pm + 32 * 256;
  unsigned* selb = (unsigned*)(imp + 8 * 64);
  const bf16_t* QC = (const bf16_t*)(P(ws) + WS_OC);
  const float* KCMP = (const float*)(P(ws) + WS_KCMP); const float* VCMP = (const float*)(P(ws) + WS_VCMP);
  bf16_t* OCMP = (bf16_t*)(P(ws) + WS_ATT);
  u64* SEL = (u64*)(P(ws) + WS_SEL);
  const int tid = tid_();
  const int NU = NB * 4 * 512;
  for (int u = bid_(); u < NU; u += gdim_()) {
    const int qc8 = u & 511, bg = u >> 9, b = bg >> 2, g = bg & 3;
    const int t0 = qc8 * 8;
    int ncv = (t0 + 7 >= 31) ? ((t0 + 7 - 31) / 16 + 1) : 0; if (ncv > 255) ncv = 255;
    __syncthreads();
    for (int i = tid; i < ncv * 64; i += NTHR) Kc[(i >> 6) * 65 + (i & 63)] = KCMP[(size_t)bg * 256 * 64 + i];
    if (tid < 16) selb[tid] = 0u;
    __syncthreads();
    const int r = tid >> 4, sub = tid & 15, qi = r >> 2, hh = r & 3, t = t0 + qi;
    {
      float q[64];
      const bf16_t* qp = QC + ((size_t)b * S + t) * D + (g * 4 + hh) * 64;
#pragma unroll
      for (int i = 0; i < 8; ++i) unpack8(*(const uint4*)(qp + i * 8), q + i * 8);
      float mx = -INFINITY;
#pragma unroll 1
      for (int i = 0; i < 16; ++i) {
        const int c = sub + 16 * i; float a = -INFINITY;
        if (c < ncv && 16 * c + 31 <= t) { a = 0.f;
#pragma unroll
          for (int d = 0; d < 64; ++d) a += q[d] * Kc[c * 65 + d]; }
        Pm[r * 256 + c] = a; mx = fmaxf(mx, a);
      }
      mx = fmaxf(mx, __shfl_xor(mx, 1)); mx = fmaxf(mx, __shfl_xor(mx, 2)); mx = fmaxf(mx, __shfl_xor(mx, 4)); mx = fmaxf(mx, __shfl_xor(mx, 8));
      float sum = 0.f;
#pragma unroll 1
      for (int i = 0; i < 16; ++i) { const float sv = Pm[r * 256 + sub + 16 * i]; const float e = (sv == -INFINITY) ? 0.f : exp2f(sv - mx); Pm[r * 256 + sub + 16 * i] = e; sum += e; }
      sum += __shfl_xor(sum, 1); sum += __shfl_xor(sum, 2); sum += __shfl_xor(sum, 4); sum += __shfl_xor(sum, 8);
      const float inv = sum > 0.f ? 1.0f / sum : 0.f;
#pragma unroll 1
      for (int i = 0; i < 16; ++i) Pm[r * 256 + sub + 16 * i] *= inv;
    }
    __syncthreads();
    {
      float o0 = 0.f, o1 = 0.f, o2 = 0.f, o3 = 0.f;
      const float* vb = VCMP + (size_t)bg * 256 * 64 + sub * 4;
      for (int c = 0; c < ncv; ++c) { const float pr = Pm[r * 256 + c]; const float4 v0 = *(const float4*)(vb + c * 64);
        o0 += pr * v0.x; o1 += pr * v0.y; o2 += pr * v0.z; o3 += pr * v0.w; }
      uint2 ov; ov.x = pk2(o0, o1); ov.y = pk2(o2, o3);
      *(uint2*)(OCMP + ((size_t)b * S + t) * D + (g * 4 + hh) * 64 + sub * 4) = ov;
    }
    {
      const int qi2 = tid >> 6, sb = tid & 63, tq = t0 + qi2, bt = tq >> 6;
      float v = 0.f;
      const int c_lo = (4 * sb - 1 < 0) ? 0 : 4 * sb - 1, c_hi = (4 * sb + 3 > 254) ? 254 : 4 * sb + 3;
      for (int h = 0; h < 4; ++h) for (int c = c_lo; c <= c_hi; ++c) v += Pm[(qi2 * 4 + h) * 256 + c];
      const bool forced = (sb == 0) || (sb == bt) || (sb == bt - 1), valid = sb <= bt;
      imp[qi2 * 64 + sb] = forced ? 1e6f : (valid ? v : -1.0f);
    }
    __syncthreads();
    {
      const int qi2 = tid >> 6, sb = tid & 63;
      const float v = imp[qi2 * 64 + sb]; int cnt = 0;
      for (int s2 = 0; s2 < 64; ++s2) { const float w = imp[qi2 * 64 + s2]; cnt += (w > v || (w == v && s2 < sb)) ? 1 : 0; }
      if (cnt < 16) atomicOr(&selb[qi2 * 2 + (sb >> 5)], 1u << (sb & 31));
    }
    __syncthreads();
    if (tid < 8) SEL[(size_t)bg * S + t0 + tid] = (u64)selb[tid * 2] | ((u64)selb[tid * 2 + 1] << 32);
  }
}

__device__ __forceinline__ void ph_combine_nsa(int j) {
  const bf16_t* PROJ = (const bf16_t*)(P(ws) + WS_PROJ);
  const bf16_t* OCMP = (const bf16_t*)(P(ws) + WS_ATT); const bf16_t* OSEL = OCMP + (size_t)T * D; const bf16_t* OWIN = OSEL + (size_t)T * D;
  bf16_t* OC = (bf16_t*)(P(ws) + WS_OC);
  for (size_t i = (size_t)bid_() * NTHR + tid_(); i < (size_t)T * 128; i += (size_t)gdim_() * NTHR) {
    const size_t m = i >> 7; const int cg8 = (int)(i & 127), hd = cg8 >> 3;
    float gt[3];
#pragma unroll
    for (int r = 0; r < 3; ++r) { const float gl = bf2f(PROJ[m * NSA_P + 2560 + hd * 3 + r]) + P(nsa_b_gate)[j * 48 + hd * 3 + r]; gt[r] = 1.0f / (1.0f + expf(-gl)); }
    float a[8], bb[8], cc[8], o[8];
    unpack8(*(const uint4*)(OCMP + m * D + cg8 * 8), a); unpack8(*(const uint4*)(OSEL + m * D + cg8 * 8), bb); unpack8(*(const uint4*)(OWIN + m * D + cg8 * 8), cc);
#pragma unroll
    for (int k = 0; k < 8; ++k) o[k] = gt[0] * a[k] + gt[1] * bb[k] + gt[2] * cc[k];
    *(uint4*)(OC + m * D + cg8 * 8) = pack8(o);
  }
}
__device__ __forceinline__ void ph_combine_diff(int j) {
  const bf16_t* ATT = (const bf16_t*)(P(ws) + WS_ATT); bf16_t* OC = (bf16_t*)(P(ws) + WS_OC);
  const float lam = ((const float*)(P(ws) + WS_SMALL))[j]; const float osc = 1.0f - lam_init_of(j);
  const int tid = tid_(), lane = tid & 63, wave = tid >> 6;
  for (int m = bid_() * 8 + wave; m < T; m += gdim_() * 8) {
#pragma unroll
    for (int it = 0; it < 2; ++it) {
      const int col = it * 512 + lane * 8;
      float a[8], b2[8], o[8]; unpack8(*(const uint4*)(ATT + (size_t)m * 2048 + col), a); unpack8(*(const uint4*)(ATT + (size_t)m * 2048 + 1024 + col), b2);
      float ss = 0.f;
#pragma unroll
      for (int k = 0; k < 8; ++k) { o[k] = a[k] - lam * b2[k]; ss += o[k] * o[k]; }
      ss += __shfl_xor(ss, 1); ss += __shfl_xor(ss, 2); ss += __shfl_xor(ss, 4); ss += __shfl_xor(ss, 8);
      const float rstd = 1.0f / sqrtf(ss * (1.0f / 128.0f) + EPS);
#pragma unroll
      for (int k = 0; k < 8; ++k) o[k] = o[k] * rstd * P(diff_subln_g)[j * 128 + (col & 127) + k] * osc;
      *(uint4*)(OC + (size_t)m * D + col) = pack8(o);
    }
  }
}

constexpr int N_PHASES = 1 + 4 * 10;
template <int PH> __device__ __forceinline__ void run_phase(unsigned char* lds, int lo, int hi, const XcdBarrier& bar) {
  if (PH < lo || PH >= hi) return;
  bool did = true;
  if constexpr (PH == 0) { ph_prologue(lds); __syncthreads(); ph_cmp_bias(lds); __syncthreads(); ph_weights(lds); }
  else {
    constexpr int i = (PH - 1) / 10, lp = (PH - 1) % 10, j = i >> 1; constexpr bool nsa = (i & 1) == 0;
    float* MOD = (float*)(P(ws) + WS_MOD);
    bf16_t* H = (bf16_t*)(P(ws) + WS_H); bf16_t* PROJ = (bf16_t*)(P(ws) + WS_PROJ); bf16_t* OC = (bf16_t*)(P(ws) + WS_OC); bf16_t* HID = (bf16_t*)(P(ws) + WS_HID);
    const float* mod = MOD + (size_t)i * 4 * 6144;
    const float* xcur = (i == 0 && lp < 7) ? P(x) : P(out);
    if constexpr (lp == 0) ph_norm(xcur, P(ln_mix_g) + i * D, mod, 0, 1024, H);
    const bf16_t* WTL = (const bf16_t*)(P(ws) + WS_WT + (size_t)i * WT_LAYER);
    PG8_LAS unsigned char* l3 = (PG8_LAS unsigned char*)lds;
    if constexpr (lp == 1) {
      constexpr int N = nsa ? NSA_P : DIFF_IN;
      pg8::Gemm g{H, WTL, T, N, D}; pg8::StaticOrder S; S.init(T, N, gdim_(), bid_());
      pg8::EpiBf16<0> E{PROJ, N};
      pg8::gemm_phase<pg8::EpiBf16<0>, pg8::StaticOrder, true, true>(l3, g, S, E);
    }
    if constexpr (lp == 2) { if constexpr (nsa) { ph_post_nsa(j, PROJ, OC); ph_compress(j, lds); } else ph_post_diff(j, PROJ); }
    if constexpr (lp == 3) { if constexpr (nsa) { ph_cmp_attn(lds); __syncthreads(); ph_attn_win_fast(lds); } else ph_attn_diff_fast(lds); }
    if constexpr (lp == 4) { if constexpr (nsa) ph_attn_sel_fast(lds); else did = false; }
    if constexpr (lp == 5) { if constexpr (nsa) ph_combine_nsa(j); else ph_combine_diff(j); }
    if constexpr (lp == 6) {
      pg8::Gemm g{OC, WTL + WT_OUT / 2, T, D, D}; pg8::StaticOrder S; S.init(T, D, gdim_(), bid_());
      pg8::EpiResid E{xcur, P(out), mod + 2048};
      pg8::gemm_phase<pg8::EpiResid, pg8::StaticOrder, true, true>(l3, g, S, E);
    }
    if constexpr (lp == 7) ph_norm(P(out), P(ln_mlp_g) + i * D, mod, 3072, 4096, H);
    if constexpr (lp == 8) {
      pg8::Gemm g{H, WTL + WT_MI / 2, T, DFF, D}; pg8::StaticOrder S; S.init(T, DFF, gdim_(), bid_());
      pg8::EpiBf16<2> E{HID, DFF};
      pg8::gemm_phase<pg8::EpiBf16<2>, pg8::StaticOrder, true, true>(l3, g, S, E);
    }
    if constexpr (lp == 9) {
      pg8::Gemm g{HID, WTL + WT_MO / 2, T, D, DFF}; pg8::StaticOrder S; S.init(T, D, gdim_(), bid_());
      pg8::EpiResid E{P(out), P(out), mod + 5120};
      pg8::gemm_phase<pg8::EpiResid, pg8::StaticOrder, true, true>(l3, g, S, E);
    }
  }
  if (did && PH + 1 < hi) { if (PH == 0) cg::this_grid().sync(); else xcd_barrier(bar); }
}
template <int... I> __device__ __forceinline__ void run_all(std::integer_sequence<int, I...>, unsigned char* lds, int lo, int hi, const XcdBarrier& bar) { (run_phase<I>(lds, lo, hi, bar), ...); }
__global__ void __launch_bounds__(NTHR) fwd_kernel(Params p) {
  extern __shared__ __attribute__((aligned(16))) unsigned char lds[];
  volatile __attribute__((address_space(3))) unsigned* misc = (volatile __attribute__((address_space(3))) unsigned*)((__attribute__((address_space(3))) unsigned char*)lds + MISC_OFF);
  if (tid_() < 16) misc[tid_()] = 0u;
  __syncthreads();
  const XcdBarrier bar = xcd_barrier_post((unsigned*)(P(ws) + WS_CTL) + CW_BAR, misc);
  run_all(std::make_integer_sequence<int, N_PHASES>{}, lds, p.ph_lo, p.ph_hi, bar);
}

extern "C" void kernel_launch(void* const* d_in, const int* in_sizes, int n_in, void* d_out, int out_size, void* d_ws, size_t ws_size, hipStream_t stream) {
  static int grid = 0;
  if (grid == 0) {
    if (n_in != 29 || out_size != T * D || ws_size < WS_END) { fprintf(stderr, "kernel_launch: unexpected problem (n_in %d, out %d, ws %zu)\n", n_in, out_size, ws_size); grid = -1; return; }
    int dev = 0, cus = 0, per_cu = 0;
    hipGetDevice(&dev); hipDeviceGetAttribute(&cus, hipDeviceAttributeMultiprocessorCount, dev);
    hipFuncSetAttribute((const void*)fwd_kernel, hipFuncAttributeMaxDynamicSharedMemorySize, LDS_BYTES);
    hipOccupancyMaxActiveBlocksPerMultiprocessor(&per_cu, (const void*)fwd_kernel, NTHR, LDS_BYTES);
    if (per_cu < 1) { fprintf(stderr, "kernel_launch: occupancy query says %d blocks/CU\n", per_cu); per_cu = 1; }
    grid = cus * 1;
    (void)hipGetLastError();
  }
  if (grid < 0) return;
  if (hipMemsetAsync((char*)d_ws + WS_CTL, 0, CTL_ZERO_BYTES, stream) != hipSuccess) { fprintf(stderr, "kernel_launch: memset failed\n"); return; }
  Params p{};
  memcpy((void*)&p, (const void*)d_in, 29 * sizeof(void*));
  p.out = (float*)d_out; p.ws = (unsigned char*)d_ws; p.ph_lo = 0; p.ph_hi = N_PHASES;
  void* args[] = {&p};
  hipError_t e = hipLaunchCooperativeKernel((const void*)fwd_kernel, dim3(grid), dim3(NTHR), args, LDS_BYTES, stream);
  if (e != hipSuccess) fprintf(stderr, "cooperative launch failed: %s (grid %d)\n", hipGetErrorString(e), grid);
}
```

```cpp
#include <hip/hip_runtime.h>
#include <hip/hip_cooperative_groups.h>
#include <hip/hip_bf16.h>
#include <cstdio>
#include <cstdint>
#include <cstring>
#include <utility>
namespace cg = cooperative_groups;

typedef unsigned short bf16_t;
typedef unsigned long long u64;

constexpr int D = 1024, NB = 4, S = 4096, T = NB * S, DFF = 4096;
constexpr int NSA_IN = 2608, NSA_P = 2816, DIFF_IN = 3072;
constexpr float EPS = 1e-6f;
constexpr float C2 = 0.125f * 1.4426950408889634f;
constexpr int NTHR = 512;
constexpr int LDS_BYTES = 147456;

constexpr size_t MiB = 1u << 20;
constexpr size_t WS_CTL = 0, CTL_ZERO_BYTES = 1 * MiB;
constexpr int CW_BAR = 4096;
constexpr int MISC_OFF = LDS_BYTES - 64;
constexpr size_t WS_MOD = 1 * MiB;
constexpr size_t WS_ROPE = 2 * MiB;
constexpr size_t WS_SMALL = 3 * MiB;
constexpr size_t WS_WT = 4 * MiB;
constexpr size_t WT_LAYER = 24 * MiB, WT_OUT = 6 * MiB, WT_MI = 8 * MiB, WT_MO = 16 * MiB;
constexpr size_t WS_W1T = 100 * MiB;
constexpr size_t WS_H = 104 * MiB;
constexpr size_t WS_PROJ = 136 * MiB;
constexpr size_t WS_ATT = 232 * MiB;
constexpr size_t WS_OC = 328 * MiB;
constexpr size_t WS_KCMP = 360 * MiB;
constexpr size_t WS_VCMP = 361 * MiB;
constexpr size_t WS_SEL = 362 * MiB;
constexpr size_t WS_HID = 136 * MiB;
constexpr size_t WS_END = 364 * MiB;

struct Params {
  const float* x; const float* c; const int* pos; const float* ln_mix_g; const float* ln_mlp_g;
  const float* w_ada; const float* b_ada; const float* w_mlp_in; const float* w_mlp_out;
  const float* nsa_w_in; const float* nsa_b_gate; const float* nsa_q_gain; const float* nsa_k_gain;
  const float* nsa_pe_k; const float* nsa_w_ck1; const float* nsa_w_ck2; const float* nsa_pe_v; const float* nsa_w_cv1; const float* nsa_w_cv2; const float* nsa_w_out;
  const float* diff_w_in; const float* diff_q_gain; const float* diff_k_gain; const float* diff_lq1; const float* diff_lk1; const float* diff_lq2; const float* diff_lk2; const float* diff_subln_g; const float* diff_w_out;
  float* out; unsigned char* ws; int ph_lo, ph_hi;
};

typedef __attribute__((address_space(4))) const unsigned char* kptr_t;
template <class Tp> __device__ __forceinline__ Tp karg_load(unsigned off) {
  asm volatile("" : "+s"(off));
  kptr_t kp = (kptr_t)__builtin_amdgcn_kernarg_segment_ptr();
  return *(const __attribute__((address_space(4))) Tp*)(kp + off);
}
__device__ __forceinline__ int tid_() { int t = (int)threadIdx.x; asm volatile("" : "+v"(t)); return t; }
__device__ __forceinline__ int bid_() { int t = (int)blockIdx.x; asm volatile("" : "+s"(t)); return t; }
__device__ __forceinline__ int gdim_() { int t = (int)gridDim.x; asm volatile("" : "+s"(t)); return t; }
#define P(m) karg_load<decltype(Params::m)>((unsigned)offsetof(Params, m))
__device__ __forceinline__ float bf2f(unsigned v) { return __uint_as_float(v << 16); }
__device__ __forceinline__ unsigned f2bf(float f) { unsigned u = __float_as_uint(f); return (u + 0x7fffu + ((u >> 16) & 1u)) >> 16; }
__device__ __forceinline__ unsigned pk2(float lo, float hi) { return f2bf(lo) | (f2bf(hi) << 16); }
__device__ __forceinline__ void unpack8(const uint4 v, float* f) {
  f[0] = bf2f(v.x & 0xffffu); f[1] = bf2f(v.x >> 16); f[2] = bf2f(v.y & 0xffffu); f[3] = bf2f(v.y >> 16);
  f[4] = bf2f(v.z & 0xffffu); f[5] = bf2f(v.z >> 16); f[6] = bf2f(v.w & 0xffffu); f[7] = bf2f(v.w >> 16);
}
__device__ __forceinline__ uint4 pack8(const float* f) { uint4 v; v.x = pk2(f[0], f[1]); v.y = pk2(f[2], f[3]); v.z = pk2(f[4], f[5]); v.w = pk2(f[6], f[7]); return v; }
__device__ __forceinline__ float wave_sum(float v) {
#pragma unroll
  for (int o = 1; o < 64; o <<= 1) v += __shfl_xor(v, o);
  return v;
}
__device__ __forceinline__ float lam_init_of(int j) { return j == 0 ? 0.35550906759096934f : 0.5560582041556406f; }

namespace pg8 {
#define PG8_LAS __attribute__((address_space(3)))
typedef unsigned short bf16_t;
typedef short bf16x8 __attribute__((ext_vector_type(8)));
typedef float f32x4 __attribute__((ext_vector_type(4)));
typedef unsigned u32x4 __attribute__((ext_vector_type(4)));
constexpr int BM = 256, BK = 64, HALF = 128, HTB = HALF * BK * 2  , STAGE_BYTES = 8 * HTB, NXCD = 8, WGM = 8;

__host__ __device__ __forceinline__ int lds_byte(int r, int c) { const int st = (r >> 4) * 2 + (c >> 5), rr = r & 15, cc = c & 31, ob = rr * 64 + cc * 2; return st * 1024 + (ob ^ (((ob >> 9) & 1) << 5)); }
__host__ __device__ __forceinline__ void stage_rc(int b, int& R, int& C) { const int st = b / 1024, sb = b % 1024, swz = sb ^ (((sb >> 9) & 1) << 5); R = (st >> 1) * 16 + swz / 64; C = (st & 1) * 32 + (swz % 64) / 2; }
__host__ __device__ __forceinline__ int perm32(int rho) { const int n = rho >> 4, i = rho & 15; return 8 * (i >> 2) + 4 * n + (i & 3); }

struct Unit { int pm, pn; };
struct Gemm { const bf16_t* A; const bf16_t* Bt; int M, N, K; };

struct StaticOrder {
    int nM, nN, nwg, G, c;
    __host__ __device__ void init(int M, int N, int G_, int c_) { nM = M / BM; nN = N / BM; nwg = nM * nN; G = G_; c = c_; }
    __host__ __device__ bool next(int i, Unit& u) const {
        const long L = (long)i * G + c; if (L >= nwg) return false;
        int wgid = (int)L; { const int q = nwg / NXCD, r = nwg % NXCD, xcd = wgid % NXCD, off = wgid / NXCD; wgid = (xcd < r ? xcd * (q + 1) : r * (q + 1) + (xcd - r) * q) + off; }
        const int nig = WGM * nN, gid = wgid / nig, fm = gid * WGM, gsz = (nM - fm) < WGM ? (nM - fm) : WGM;
        u.pm = fm + ((wgid % nig) % gsz); u.pn = (wgid % nig) / gsz; return true;
    }
    __device__ __forceinline__ void a_ready(const Unit&) const {}
    __device__ __forceinline__ void done(const Unit&) const {}
};


__device__ __forceinline__ unsigned cvt_pk_bf16(float lo, float hi) { unsigned r; asm volatile("v_cvt_pk_bf16_f32 %0, %1, %2" : "=v"(r) : "v"(lo), "v"(hi)); return r; }
template <int ACT  > struct EpiBf16 {
    static constexpr bool PERM = true, AFTER_DRAIN = false;
    bf16_t* O; int ldc;
    __device__ __forceinline__ void operator()(const f32x4 (&acc)[2][2][4][2], const Unit& u, int wr, int wc, int fr, int fq) const {
        const int row0 = u.pm * BM + wr * 64 + fr; const int col0 = u.pn * BM + wc * 32 + 8 * fq;
#pragma unroll
        for (int ai = 0; ai < 2; ++ai)
#pragma unroll
            for (int m = 0; m < 4; ++m) { bf16_t* rowp = O + (size_t)(row0 + ai * HALF + m * 16) * ldc + col0;
#pragma unroll
                for (int bj = 0; bj < 2; ++bj) { f32x4 v0 = acc[ai][bj][m][0], v1 = acc[ai][bj][m][1];
                    if (ACT == 2) {
#pragma unroll
                        for (int e = 0; e < 4; ++e) { float a = v0[e] > 0.f ? v0[e] : 0.f; v0[e] = a * a; float b = v1[e] > 0.f ? v1[e] : 0.f; v1[e] = b * b; } }
                    u32x4 w; w.x = cvt_pk_bf16(v0[0], v0[1]); w.y = cvt_pk_bf16(v0[2], v0[3]); w.z = cvt_pk_bf16(v1[0], v1[1]); w.w = cvt_pk_bf16(v1[2], v1[3]);
                    *(u32x4*)(rowp + bj * HALF) = w; } }
    }
};
struct EpiResid {
    static constexpr bool PERM = false, AFTER_DRAIN = false;
    const float* xin; float* xout; const float* gate;
    __device__ __forceinline__ void operator()(const f32x4 (&acc)[2][2][4][2], const Unit& u, int wr, int wc, int fr, int fq) const {
        const int col0 = u.pn * BM + wc * 32 + 4 * fq; const int b = (u.pm * BM) >> 12;
        f32x4 gv[2][2];
#pragma unroll
        for (int bj = 0; bj < 2; ++bj)
#pragma unroll
            for (int n = 0; n < 2; ++n) gv[bj][n] = *(const f32x4*)(gate + (size_t)b * 6144 + col0 + bj * HALF + n * 16);
#pragma unroll
        for (int ai = 0; ai < 2; ++ai)
#pragma unroll
            for (int m = 0; m < 4; ++m) { const size_t off = (size_t)(u.pm * BM + ai * HALF + wr * 64 + m * 16 + fr) * 1024 + col0;
#pragma unroll
                for (int bj = 0; bj < 2; ++bj)
#pragma unroll
                    for (int n = 0; n < 2; ++n) { const f32x4 xi = *(const f32x4*)(xin + off + bj * HALF + n * 16); *(f32x4*)(xout + off + bj * HALF + n * 16) = xi + gv[bj][n] * acc[ai][bj][m][n]; }
                if (m & 1) asm volatile("" ::: "memory"); }
    }
};

template <class Epi, class Sched, bool ALIGN_EPI = false, bool SP2 = false>
__device__ __forceinline__ void gemm_phase(PG8_LAS unsigned char* lds, const Gemm g, const Sched& S, const Epi& E) {
    const int tid = tid_(), wid = __builtin_amdgcn_readfirstlane(tid >> 6), lane = tid & 63, wr = wid >> 2, wc = wid & 3, fr = lane & 15, fq = lane >> 4;
    const int K = g.K, nt = K / BK;
    unsigned voffA[2], voffB[2];
#pragma unroll
    for (int i = 0; i < 2; ++i) { int R, C; stage_rc(tid * 16 + i * 8192, R, C); const int Rb = Epi::PERM ? ((R & ~31) + perm32(R & 31)) : R;
        voffA[i] = (unsigned)(R * K + C) * 2u; voffB[i] = (unsigned)(Rb * K + C) * 2u; }
    const size_t kstep = (size_t)(BK * 2);
    const size_t hstep = (size_t)HALF * K * 2;
    const size_t tstep = 2 * hstep;
    const unsigned ldsw = (unsigned)wid * 1024u;
    const int aoff = lds_byte(wr * 64 + fr, fq * 8), boff = lds_byte(wc * 32 + fr, fq * 8);
#define PG8_SA(b, h) (((b) * 2 + (h)) * HTB)
#define PG8_SB(b, h) ((4 + (b) * 2 + (h)) * HTB)
#define PG8_STAGE(bufoff, gbase, voff) do { _Pragma("unroll") for (int _i = 0; _i < 2; ++_i) \
        __builtin_amdgcn_global_load_lds((const unsigned*)((const char*)(gbase) + (voff)[_i]), (PG8_LAS unsigned*)(lds + (bufoff) + ldsw + _i * 8192), 16, 0, 0); } while (0)
#define PG8_LDA(dst, b, h) do { _Pragma("unroll") for (int m = 0; m < 4; ++m) _Pragma("unroll") for (int k = 0; k < 2; ++k) dst[m][k] = *(const PG8_LAS bf16x8*)(lds + PG8_SA(b, h) + aoff + m * 2048 + k * 1024); } while (0)
#define PG8_LDB(dst, b, h) do { _Pragma("unroll") for (int n = 0; n < 2; ++n) _Pragma("unroll") for (int k = 0; k < 2; ++k) dst[n][k] = *(const PG8_LAS bf16x8*)(lds + PG8_SB(b, h) + boff + n * 2048 + k * 1024); } while (0)
#define PG8_MMA(ai, bj, At, Bt) do { __builtin_amdgcn_s_setprio(1); _Pragma("unroll") for (int m = 0; m < 4; ++m) _Pragma("unroll") for (int n = 0; n < 2; ++n) _Pragma("unroll") for (int k = 0; k < 2; ++k) \
        acc[ai][bj][m][n] = __builtin_amdgcn_mfma_f32_16x16x32_bf16(Bt[n][k], At[m][k], acc[ai][bj][m][n], 0, 0, 0); __builtin_amdgcn_s_setprio(0); } while (0)
#define PG8_WAIT_V(n) asm volatile("s_waitcnt vmcnt(" #n ")" ::: "memory")
#define PG8_WAIT_L(n) asm volatile("s_waitcnt lgkmcnt(" #n ")" ::: "memory")
#define PG8_BAR __builtin_amdgcn_s_barrier()
#define PG8_SCHED __builtin_amdgcn_sched_barrier(0)
    Unit cur, nxt; int ui = 0;
    if (!S.next(0, cur)) return;
    f32x4 acc[2][2][4][2];
#pragma unroll
    for (int a = 0; a < 2; ++a)
#pragma unroll
        for (int b = 0; b < 2; ++b)
#pragma unroll
            for (int m = 0; m < 4; ++m)
#pragma unroll
                for (int n = 0; n < 2; ++n) acc[a][b][m][n] = (f32x4){0.f, 0.f, 0.f, 0.f};
    bf16x8 At[4][2], B0[2][2], B1[2][2];
    const char* cA = (const char*)g.A + (size_t)cur.pm * tstep; const char* cB = (const char*)g.Bt + (size_t)cur.pn * tstep;
    S.a_ready(cur);
    if constexpr (SP2) {
        PG8_STAGE(PG8_SB(0, 0), cB, voffB); PG8_STAGE(PG8_SB(0, 1), cB + hstep, voffB); PG8_STAGE(PG8_SA(0, 0), cA, voffA); PG8_STAGE(PG8_SA(0, 1), cA + hstep, voffA);
        if (wr == 1) PG8_BAR;
        PG8_WAIT_V(2); PG8_BAR;
        PG8_STAGE(PG8_SB(1, 0), cB + kstep, voffB); PG8_STAGE(PG8_SA(1, 0), cA + kstep, voffA); PG8_STAGE(PG8_SB(1, 1), cB + hstep + kstep, voffB);
        PG8_WAIT_V(6); PG8_BAR;
    } else {
        PG8_STAGE(PG8_SB(0, 0), cB, voffB); PG8_STAGE(PG8_SA(0, 0), cA, voffA); PG8_STAGE(PG8_SB(0, 1), cB + hstep, voffB); PG8_STAGE(PG8_SA(0, 1), cA + hstep, voffA);
        if (wr == 1) PG8_BAR;
        PG8_WAIT_V(4); PG8_BAR;
        PG8_STAGE(PG8_SB(1, 0), cB + kstep, voffB); PG8_STAGE(PG8_SA(1, 0), cA + kstep, voffA); PG8_STAGE(PG8_SB(1, 1), cB + hstep + kstep, voffB);
        PG8_WAIT_V(6); PG8_BAR;
    }
    for (;;) {
        const bool has_next = S.next(ui + 1, nxt);
        const char* nA = has_next ? (const char*)g.A + (size_t)nxt.pm * tstep : cA; const char* nB = has_next ? (const char*)g.Bt + (size_t)nxt.pn * tstep : cB;
        for (int t = 0; t < nt; t += 2) {
            const bool last = (t == nt - 2);
            const char* a1 = cA + (size_t)(t + 1) * kstep;
            const char* a2 = last ? nA : cA + (size_t)(t + 2) * kstep; const char* b2 = last ? nB : cB + (size_t)(t + 2) * kstep;
            const char* a3 = a2 + kstep; const char* b3 = b2 + kstep;
            if (last && has_next) S.a_ready(nxt);
            if constexpr (SP2) {
            PG8_LDB(B0, 0, 0); PG8_LDB(B1, 0, 1); PG8_SCHED; PG8_LDA(At, 0, 0); PG8_STAGE(PG8_SA(1, 1), a1 + hstep, voffA);
            PG8_WAIT_V(8); PG8_WAIT_L(0); PG8_BAR; PG8_MMA(0, 0, At, B0); PG8_MMA(0, 1, At, B1); PG8_BAR; PG8_SCHED;
            PG8_LDA(At, 0, 1); PG8_STAGE(PG8_SB(0, 0), b2, voffB); PG8_STAGE(PG8_SB(0, 1), b2 + hstep, voffB); PG8_STAGE(PG8_SA(0, 0), a2, voffA);
            PG8_WAIT_V(8); PG8_WAIT_L(0); PG8_BAR; PG8_MMA(1, 0, At, B0); PG8_MMA(1, 1, At, B1); PG8_BAR; PG8_SCHED;
            PG8_LDB(B0, 1, 0); PG8_LDB(B1, 1, 1); PG8_SCHED; PG8_LDA(At, 1, 0); PG8_STAGE(PG8_SA(0, 1), a2 + hstep, voffA);
            PG8_WAIT_V(8); PG8_WAIT_L(0); PG8_BAR; PG8_MMA(0, 0, At, B0); PG8_MMA(0, 1, At, B1); PG8_BAR; PG8_SCHED;
            PG8_LDA(At, 1, 1); PG8_STAGE(PG8_SB(1, 0), b3, voffB); PG8_STAGE(PG8_SB(1, 1), b3 + hstep, voffB); PG8_STAGE(PG8_SA(1, 0), a3, voffA);
            PG8_WAIT_V(8); PG8_WAIT_L(0); PG8_BAR; PG8_MMA(1, 0, At, B0); PG8_MMA(1, 1, At, B1); PG8_BAR; PG8_SCHED;
            } else {
            PG8_LDB(B0, 0, 0); PG8_SCHED; PG8_LDA(At, 0, 0); PG8_STAGE(PG8_SA(1, 1), a1 + hstep, voffA);
            PG8_WAIT_L(8); PG8_BAR; PG8_WAIT_L(0); PG8_MMA(0, 0, At, B0); PG8_BAR; PG8_SCHED;
            PG8_LDB(B1, 0, 1); PG8_STAGE(PG8_SB(0, 0), b2, voffB);
            PG8_BAR; PG8_WAIT_L(0); PG8_MMA(0, 1, At, B1); PG8_BAR;
            PG8_LDA(At, 0, 1); PG8_STAGE(PG8_SA(0, 0), a2, voffA);
            PG8_BAR; PG8_WAIT_L(0); PG8_MMA(1, 0, At, B0); PG8_BAR; PG8_SCHED;
            PG8_STAGE(PG8_SB(0, 1), b2 + hstep, voffB);
            PG8_WAIT_V(6); PG8_BAR; PG8_MMA(1, 1, At, B1); PG8_BAR;
            PG8_LDB(B0, 1, 0); PG8_SCHED; PG8_LDA(At, 1, 0); PG8_STAGE(PG8_SA(0, 1), a2 + hstep, voffA);
            PG8_WAIT_L(8); PG8_BAR; PG8_WAIT_L(0); PG8_MMA(0, 0, At, B0); PG8_BAR; PG8_SCHED;
            PG8_LDB(B1, 1, 1); PG8_STAGE(PG8_SB(1, 0), b3, voffB);
            PG8_BAR; PG8_WAIT_L(0); PG8_MMA(0, 1, At, B1); PG8_BAR;
            PG8_LDA(At, 1, 1); PG8_STAGE(PG8_SA(1, 0), a3, voffA);
            PG8_BAR; PG8_WAIT_L(0); PG8_MMA(1, 0, At, B0); PG8_BAR; PG8_SCHED;
            PG8_STAGE(PG8_SB(1, 1), b3 + hstep, voffB);
            PG8_WAIT_V(6); PG8_BAR; PG8_MMA(1, 1, At, B1); PG8_BAR;
            }
        }
        if constexpr (ALIGN_EPI) { if (wr == 0) PG8_BAR; }
        if constexpr (!Epi::AFTER_DRAIN) { E(acc, cur, wr, wc, fr, fq); S.done(cur); }
        if (!has_next) break;
#pragma unroll
        for (int a = 0; a < 2; ++a)
#pragma unroll
            for (int b = 0; b < 2; ++b)
#pragma unroll
                for (int m = 0; m < 4; ++m)
#pragma unroll
                    for (int n = 0; n < 2; ++n) acc[a][b][m][n] = (f32x4){0.f, 0.f, 0.f, 0.f};
        cur = nxt; cA = nA; cB = nB; ++ui;
        if constexpr (ALIGN_EPI) { if (wr == 1) PG8_BAR; }
    }
    PG8_WAIT_V(0);
    if constexpr (!ALIGN_EPI) { if (wr == 0) PG8_BAR; }
    PG8_BAR;
    if constexpr (Epi::AFTER_DRAIN) { E.fused(acc, cur, wr, wc, fr, fq, lds, wid, lane); S.done(cur); }
#undef PG8_SA
#undef PG8_SB
#undef PG8_STAGE
#undef PG8_LDA
#undef PG8_LDB
#undef PG8_MMA
#undef PG8_WAIT_V
#undef PG8_WAIT_L
#undef PG8_BAR
#undef PG8_SCHED
}
}

namespace attn_body {
using bf16=__hip_bfloat16;
using bf16x8=__attribute__((ext_vector_type(8)))short;
using s16x4=__attribute__((ext_vector_type(4)))short;
using f32x16=__attribute__((ext_vector_type(16)))float;
using u32x4=__attribute__((ext_vector_type(4)))unsigned;
constexpr int D=64;
constexpr int NW=8,QBLK=32,QB=QBLK*NW,KVBLK=64;
__device__ __forceinline__ int crow(int r,int hi){return (r&3)+8*(r>>2)+4*hi;}
#define SBAR() __builtin_amdgcn_sched_barrier(0)
__device__ __forceinline__ void cmask(f32x16&p0,f32x16&p1,int jb,int qrel,int hi){
  const float NEG=-INFINITY; int kb=64*jb+4*hi;
  #pragma unroll
  for(int r=0;r<16;++r){int kv=kb+(r&3)+8*(r>>2); if(kv>qrel)p0[r]=NEG; if(kv+32>qrel)p1[r]=NEG;}
}

__device__ __forceinline__ void lmask(f32x16&p0,f32x16&p1,int t,int qrel,int hi){
  const float NEG=-30000.f; int kb=64*t+4*hi;
  #pragma unroll
  for(int r=0;r<16;++r){int kv=kb+(r&3)+8*(r>>2); if(kv<=qrel)p0[r]=NEG; if(kv+32<=qrel)p1[r]=NEG;}
}
__device__ __forceinline__ void smask(f32x16&p0,f32x16&p1,bool on){
  const float NEG=-INFINITY;
  #pragma unroll
  for(int r=0;r<16;++r){ p0[r]=on?p0[r]:NEG; p1[r]=on?p1[r]:NEG; }
}
constexpr int NSLOT=3, SLOTB=8192;
constexpr int LDS_K=0, LDS_V=NSLOT*SLOTB, LDS_WS=2*NSLOT*SLOTB, LDS_OST=LDS_WS+NW*64*4, LDS_BYTES=LDS_OST+NW*4096;
constexpr float C2=0.125f*1.4426950408889634f;
__device__ __forceinline__ void glds16(const void*gsrc,unsigned lds_dst){unsigned keep;
  asm volatile("s_mov_b32 %0, m0\n\ts_mov_b32 m0, %2\n\ts_nop 0\n\tglobal_load_lds_dwordx4 %1, off\n\ts_mov_b32 m0, %0":"=&s"(keep):"v"(gsrc),"s"(lds_dst):"memory");}
__device__ __forceinline__ float max3f(float a,float b,float c){float r;asm("v_max3_f32 %0, %1, %2, %3":"=v"(r):"v"(a),"v"(b),"v"(c));return r;}
__device__ __forceinline__ float max2f(float a,float b){float r;asm("v_max_f32_e32 %0, %1, %2":"=v"(r):"v"(a),"v"(b));return r;}
__device__ __forceinline__ float fadd_s(float a,float b){float r;asm("v_add_f32_e32 %0, %1, %2":"=v"(r):"v"(a),"v"(b));return r;}
__device__ __forceinline__ float fsub_s(float a,float b){float r;asm("v_sub_f32_e32 %0, %1, %2":"=v"(r):"v"(a),"v"(b));return r;}
typedef float f32x2_t __attribute__((ext_vector_type(2))); typedef __bf16 bf16x2_t __attribute__((ext_vector_type(2)));
__device__ __forceinline__ unsigned cvtpk_s(float lo,float hi){f32x2_t v={lo,hi};bf16x2_t b=__builtin_convertvector(v,bf16x2_t);return __builtin_bit_cast(unsigned,b);}
#define WAIT_BAR(N) asm volatile("s_waitcnt vmcnt(" #N ") lgkmcnt(0)\n\ts_barrier":::"memory")

__device__ __forceinline__ void qkt(f32x16&p0,f32x16&p1,const char*Kslot,const bf16x8*qr,const f32x16&negm,int r32,int hi){
  const char*kb=Kslot+hi*1024+r32*16;
  #pragma unroll
  for(int d0=0;d0<4;++d0){
    const bf16x8 b0=*reinterpret_cast<const bf16x8*>(kb+d0*2048);
    const bf16x8 b1=*reinterpret_cast<const bf16x8*>(kb+d0*2048+512);
    if(d0==0){p0=__builtin_amdgcn_mfma_f32_32x32x16_bf16(b0,qr[0],negm,0,0,0);p1=__builtin_amdgcn_mfma_f32_32x32x16_bf16(b1,qr[0],negm,0,0,0);}
    else{p0=__builtin_amdgcn_mfma_f32_32x32x16_bf16(b0,qr[d0],p0,0,0,0);p1=__builtin_amdgcn_mfma_f32_32x32x16_bf16(b1,qr[d0],p1,0,0,0);}}
}
typedef __attribute__((address_space(3))) const char* lds_cptr;
typedef short v4i16_t __attribute__((ext_vector_type(4)));
__device__ __forceinline__ void kload8(bf16x8*kf,lds_cptr kp){
  kf[0]=*(const __attribute__((address_space(3))) bf16x8*)(kp);      kf[1]=*(const __attribute__((address_space(3))) bf16x8*)(kp+512);
  kf[2]=*(const __attribute__((address_space(3))) bf16x8*)(kp+2048); kf[3]=*(const __attribute__((address_space(3))) bf16x8*)(kp+2560);
  kf[4]=*(const __attribute__((address_space(3))) bf16x8*)(kp+4096); kf[5]=*(const __attribute__((address_space(3))) bf16x8*)(kp+4608);
  kf[6]=*(const __attribute__((address_space(3))) bf16x8*)(kp+6144); kf[7]=*(const __attribute__((address_space(3))) bf16x8*)(kp+6656);
}
__device__ __forceinline__ void kload2(bf16x8*kf,lds_cptr kp,int j){ kf[2*j]=*(const __attribute__((address_space(3))) bf16x8*)(kp+j*2048); kf[2*j+1]=*(const __attribute__((address_space(3))) bf16x8*)(kp+j*2048+512); }
__device__ __forceinline__ s16x4 vtr(lds_cptr p){ return __builtin_bit_cast(s16x4,__builtin_amdgcn_ds_read_tr16_b64_v4i16((__attribute__((address_space(3))) v4i16_t*)p)); }
__device__ __forceinline__ float rowmax(const f32x16&p0,const f32x16&p1){
  float a=max3f(p0[0],p0[1],p1[0]),b=max3f(p0[2],p0[3],p1[1]);a=max3f(a,p1[2],p1[3]);
  #pragma unroll
  for(int r=4;r<16;r+=4){a=max3f(a,p0[r],p0[r+1]);b=max3f(b,p0[r+2],p0[r+3]);a=max3f(a,p1[r],p1[r+1]);b=max3f(b,p1[r+2],p1[r+3]);}
  const float m=max2f(a,b);
  auto rr=__builtin_amdgcn_permlane32_swap(__float_as_uint(m),__float_as_uint(m),false,false);
  return max2f(__uint_as_float(rr[0]),__uint_as_float(rr[1]));
}
__device__ __forceinline__ void pv(f32x16*o,int vb,bf16x8 pa0,bf16x8 pa1,bf16x8 pa2,bf16x8 pa3){
  #pragma unroll
  for(int d0=0;d0<2;++d0){s16x4 lo[4],hi[4];
    #pragma unroll
    for(int ks=0;ks<4;++ks){
      asm volatile("ds_read_b64_tr_b16 %0,%1 offset:%c2":"=&v"(lo[ks]):"v"(vb),"i"(d0*4096+ks*1024):"memory");
      asm volatile("ds_read_b64_tr_b16 %0,%1 offset:%c2":"=&v"(hi[ks]):"v"(vb),"i"(d0*4096+ks*1024+512):"memory");}
    asm volatile("s_waitcnt lgkmcnt(0)":::"memory");SBAR();
    #define PK(k) (bf16x8){lo[k][0],lo[k][1],lo[k][2],lo[k][3],hi[k][0],hi[k][1],hi[k][2],hi[k][3]}
    o[d0]=__builtin_amdgcn_mfma_f32_32x32x16_bf16(pa0,PK(0),o[d0],0,0,0);
    o[d0]=__builtin_amdgcn_mfma_f32_32x32x16_bf16(pa1,PK(1),o[d0],0,0,0);
    o[d0]=__builtin_amdgcn_mfma_f32_32x32x16_bf16(pa2,PK(2),o[d0],0,0,0);
    o[d0]=__builtin_amdgcn_mfma_f32_32x32x16_bf16(pa3,PK(3),o[d0],0,0,0);
    #undef PK
  }
}

#ifndef ATTN_STORE16
#define ATTN_STORE16(p,v) (*(u32x4*)(p)=(v))
#endif
template<int THRL,int MODE> __device__ __forceinline__ void attn_unit(long rowbase,int qb,const bf16*Qh,int ldq,const bf16*__restrict__ Kh0,const bf16*__restrict__ Vh0,int ldkv,bf16*Oh,int ldo,const unsigned long long*selrow,char*shm){
  const int tid=tid_(),lane=tid&63,r32=lane&31,hi=lane>>5; const int wid=__builtin_amdgcn_readfirstlane(tid>>6);
  const int q0=qb*QB;
  int t_lo=0; bool lower=false; if(MODE==2){ if(qb>=2){ t_lo=4*qb-8; lower=true; } }
  const bf16*Qw=Qh+(rowbase+q0+wid*QBLK)*ldq;
  const bf16*Kh=Kh0+(rowbase+(long)t_lo*KVBLK)*ldkv,*Vh=Vh0+(rowbase+(long)t_lo*KVBLK)*ldkv;
  const unsigned lds0=(unsigned)(uintptr_t)shm;
  float*wsf=(float*)(shm+LDS_WS)+wid*64;
  const bf16*ksrc=Kh+(long)lane*ldkv+wid*8;
  const bf16*vsrc=Vh+(long)(16*(wid&3)+(lane>>2))*ldkv+(wid>>2)*32+(lane&3)*8;
  const unsigned kdst=lds0+LDS_K+wid*1024, vdst=lds0+LDS_V+wid*1024;
  #define DMA_K(t,slot) glds16(ksrc+(long)(t)*KVBLK*ldkv,(unsigned)__builtin_amdgcn_readfirstlane(kdst+(slot)))
  #define DMA_V(t,slot) glds16(vsrc+(long)(t)*KVBLK*ldkv,(unsigned)__builtin_amdgcn_readfirstlane(vdst+(slot)))
  const int vb0=(int)(lds0+LDS_V)+((lane>>4)&1)*32+(lane&3)*8+(4*hi+((lane&15)>>2))*64;
  const char*Kbase=shm+LDS_K; bf16x8 kf[8];
  const lds_cptr shm3=(lds_cptr)shm; const lds_cptr kp0=shm3+LDS_K+hi*1024+r32*16; const lds_cptr vp0=shm3+LDS_V+((lane>>4)&1)*32+(lane&3)*8+(4*hi+((lane&15)>>2))*64;
  const int NT=(q0+QB)/KVBLK-t_lo;
  DMA_K(0,0);DMA_V(0,0);DMA_K(1,SLOTB);
  bf16x8 qr[4];
  #pragma unroll
  for(int d0=0;d0<4;++d0)qr[d0]=*reinterpret_cast<const bf16x8*>(&Qw[(long)r32*ldq+d0*16+hi*8]);
  float mhat=0.f,l_reg=0.f;f32x16 o[2];o[0]=f32x16{};o[1]=f32x16{};f32x16 negm=f32x16{};asm volatile("":"+v"(negm));
  const int qrel=wid*QBLK+r32;
  unsigned long long msk=0ull; if(MODE==1) msk=selrow[q0+qrel];
  #define XMASK(P0,P1,t) do{ if(MODE==1) smask(P0,P1,((msk>>(t))&1ull)!=0ull); if(MODE==2){ if(lower&&(t)<4) lmask(P0,P1,(t),qrel,hi); } }while(0)
  #define CMASK(P0,P1,t) do{ XMASK(P0,P1,t); int jb_=(t)-(NT-4); if(jb_>=0)cmask(P0,P1,jb_,qrel,hi);}while(0)
  bool resc=false;
  #define START(P0,P1) do{ const float rm=rowmax(P0,P1); resc=false; \
    { const float dl=rm; mhat=fadd_s(mhat,dl); \
      _Pragma("unroll") for(int r=0;r<16;++r){P0[r]=fsub_s(P0[r],dl);P1[r]=fsub_s(P1[r],dl);} \
      _Pragma("unroll") for(int r=0;r<16;++r)negm[r]=-mhat; asm volatile("":"+v"(negm)); } \
    _Pragma("unroll") for(int r=0;r<16;++r)P0[r]=__builtin_amdgcn_exp2f(P0[r]); }while(0)
  #define RESC() do{ if(resc){ asm volatile("s_waitcnt lgkmcnt(0)":::"memory"); \
      _Pragma("unroll") for(int d_=0;d_<2;++d_) _Pragma("unroll") for(int r=0;r<16;++r)o[d_][r]*=wsf[crow(r,hi)]; } }while(0)
  f32x16 pA0,pA1,pB0,pB1;
  int sl_prev=0,sl_cur=0,sl_next=SLOTB;
  #define ROT() do{sl_prev=sl_cur;sl_cur=sl_next;sl_next=(sl_next==(NSLOT-1)*SLOTB)?0:sl_next+SLOTB;}while(0)
  DMA_K(2,2*SLOTB);
  WAIT_BAR(3);
  qkt(pA0,pA1,Kbase,qr,negm,r32,hi);asm volatile("s_nop 15\n\ts_nop 7":"+v"(pA0),"+v"(pA1));CMASK(pA0,pA1,0);
  START(pA0,pA1);
  _Pragma("unroll") for(int r=0;r<16;++r)pA1[r]=__builtin_amdgcn_exp2f(pA1[r]);
  WAIT_BAR(0);
  DMA_K(3,0);DMA_V(1,SLOTB);
  ROT();
  kload8(kf,kp0+sl_cur);
  WAIT_BAR(2);
  s16x4 vlo[8],vhi[8]; u32x4 pw0,pw1,pw2,pw3;
  #define PKW(P,B) cvtpk_s(P[B],P[B+1])
  #define PAF(k) __builtin_bit_cast(bf16x8,pw##k)
  #define VFR(i) (bf16x8){vlo[i][0],vlo[i][1],vlo[i][2],vlo[i][3],vhi[i][0],vhi[i][1],vhi[i][2],vhi[i][3]}
  #define PIN(x) asm volatile("":"+v"(x))
  #define MX3(a,b,c) __builtin_fmaxf(__builtin_fmaxf((a),(b)),(c))
  #define GAPA(MF,A0,A1,A2,A3,W0,W1,PW) do{ MF; sacc+=A0; sacc+=A1; sacc+=A2; sacc+=A3; PIN(sacc); W0; W1; PIN(PW); SBAR(); }while(0)
  #define EX(v) __builtin_amdgcn_exp2f(v)
  #define GAPB(MF,X,B) do{ MF; X[B]=EX(X[B]); X[B+1]=EX(X[B+1]); X[B+2]=EX(X[B+2]); X[B+3]=EX(X[B+3]); PIN(X); SBAR(); }while(0)
  #define VRD(i) do{ vlo[i]=vtr(vp_+(((i)>>2)*4096+((i)&3)*1024)); vhi[i]=vtr(vp_+(((i)>>2)*4096+((i)&3)*1024+512)); }while(0)
  #define KRD(G,j) do{ if(G){ kload2(kf,kp0+sl_next,j); SBAR(); } }while(0)
  #define STEP(C0,C1,P0,P1,t,GK,GV,GL) do{ SBAR(); \
    const lds_cptr vp_=vp0+sl_prev; \
    VRD(0); SBAR(); float sacc=(P0[0]+P0[1]); \
    GAPA(C0=__builtin_amdgcn_mfma_f32_32x32x16_bf16(kf[0],qr[0],negm,0,0,0), P0[2],P0[3],P0[4],P0[5],     pw0[0]=PKW(P0,0), pw0[1]=PKW(P0,2), pw0); \
    VRD(4); SBAR(); GAPA(C1=__builtin_amdgcn_mfma_f32_32x32x16_bf16(kf[1],qr[0],negm,0,0,0), P0[6],P0[7],P0[8],P0[9],     pw0[2]=PKW(P0,4), pw0[3]=PKW(P0,6), pw0); \
    VRD(1); SBAR(); GAPA(C0=__builtin_amdgcn_mfma_f32_32x32x16_bf16(kf[2],qr[1],C0,0,0,0),   P0[10],P0[11],P0[12],P0[13], pw1[0]=PKW(P0,8), pw1[1]=PKW(P0,10), pw1); \
    VRD(5); SBAR(); GAPA(C1=__builtin_amdgcn_mfma_f32_32x32x16_bf16(kf[3],qr[1],C1,0,0,0),   P0[14],P0[15],P1[0],P1[1],   pw1[2]=PKW(P0,12),pw1[3]=PKW(P0,14), pw1); \
    VRD(2); SBAR(); GAPA(C0=__builtin_amdgcn_mfma_f32_32x32x16_bf16(kf[4],qr[2],C0,0,0,0),   P1[2],P1[3],P1[4],P1[5],     pw2[0]=PKW(P1,0), pw2[1]=PKW(P1,2), pw2); \
    VRD(6); SBAR(); GAPA(C1=__builtin_amdgcn_mfma_f32_32x32x16_bf16(kf[5],qr[2],C1,0,0,0),   P1[6],P1[7],P1[8],P1[9],     pw2[2]=PKW(P1,4), pw2[3]=PKW(P1,6), pw2); \
    VRD(3); SBAR(); GAPA(C0=__builtin_amdgcn_mfma_f32_32x32x16_bf16(kf[6],qr[3],C0,0,0,0),   P1[10],P1[11],P1[12],P1[13], pw3[0]=PKW(P1,8), pw3[1]=PKW(P1,10), pw3); \
    VRD(7); SBAR(); GAPA(C1=__builtin_amdgcn_mfma_f32_32x32x16_bf16(kf[7],qr[3],C1,0,0,0),   P1[14],P1[15],0.f,0.f,       pw3[2]=PKW(P1,12),pw3[3]=PKW(P1,14), pw3); \
    l_reg+=sacc; \
    if(GK){DMA_K((t)+3,sl_cur);} if(GV){DMA_V((t)+1,sl_next);} \
    CMASK(C0,C1,t); \
    { float a=MX3(C0[0],C0[1],C1[0]),b=MX3(C0[2],C0[3],C1[1]); a=MX3(a,C1[2],C1[3]); \
      _Pragma("unroll") for(int r=4;r<16;r+=4){a=MX3(a,C0[r],C0[r+1]);b=MX3(b,C0[r+2],C0[r+3]);a=MX3(a,C1[r],C1[r+1]);b=MX3(b,C1[r+2],C1[r+3]);} \
      float rm=__builtin_fmaxf(a,b); { auto rr=__builtin_amdgcn_permlane32_swap(__float_as_uint(rm),__float_as_uint(rm),false,false); rm=__builtin_fmaxf(__uint_as_float(rr[0]),__uint_as_float(rr[1])); } \
      resc=false; \
      if(__builtin_expect(__any(rm>(float)THRL),0)){ const float dl=__builtin_fmaxf(rm,0.f); mhat+=dl; \
        _Pragma("unroll") for(int r=0;r<16;++r){C0[r]-=dl;C1[r]-=dl;} \
        _Pragma("unroll") for(int r=0;r<16;++r)negm[r]=-mhat; asm volatile("":"+v"(negm)); \
        const float f=__builtin_amdgcn_exp2f(-dl); l_reg*=f; if(hi==0)wsf[r32]=f; resc=true; } } \
    SBAR(); \
    GAPB(o[0]=__builtin_amdgcn_mfma_f32_32x32x16_bf16(PAF(0),VFR(0),o[0],0,0,0), C0,0); \
    GAPB(o[1]=__builtin_amdgcn_mfma_f32_32x32x16_bf16(PAF(0),VFR(4),o[1],0,0,0), C0,4); \
    KRD(GL,0); GAPB(o[0]=__builtin_amdgcn_mfma_f32_32x32x16_bf16(PAF(1),VFR(1),o[0],0,0,0), C0,8); \
    KRD(GL,1); GAPB(o[1]=__builtin_amdgcn_mfma_f32_32x32x16_bf16(PAF(1),VFR(5),o[1],0,0,0), C0,12); \
    KRD(GL,2); GAPB(o[0]=__builtin_amdgcn_mfma_f32_32x32x16_bf16(PAF(2),VFR(2),o[0],0,0,0), C1,0); \
    KRD(GL,3); GAPB(o[1]=__builtin_amdgcn_mfma_f32_32x32x16_bf16(PAF(2),VFR(6),o[1],0,0,0), C1,4); \
    GAPB(o[0]=__builtin_amdgcn_mfma_f32_32x32x16_bf16(PAF(3),VFR(3),o[0],0,0,0), C1,8); \
    GAPB(o[1]=__builtin_amdgcn_mfma_f32_32x32x16_bf16(PAF(3),VFR(7),o[1],0,0,0), C1,12); \
    }while(0)
  int t=1;
  #undef CMASK
  #define CMASK(P0,P1,t) XMASK(P0,P1,t)
  for(;t+5<NT;t+=2){
    STEP(pB0,pB1,pA0,pA1,t,true,true,true);     WAIT_BAR(2); RESC(); ROT();
    STEP(pA0,pA1,pB0,pB1,t+1,true,true,true);   WAIT_BAR(2); RESC(); ROT();
  }
  #undef CMASK
  #define CMASK(P0,P1,t) do{ XMASK(P0,P1,t); int jb_=(t)-(NT-4); if(jb_>=0)cmask(P0,P1,jb_,qrel,hi);}while(0)
  #define ENDW(tt) do{ if((tt)+3<NT){WAIT_BAR(2);} else if((tt)+2<NT){WAIT_BAR(1);} else {WAIT_BAR(0);} }while(0)
  for(;t+1<NT;t+=2){
    STEP(pB0,pB1,pA0,pA1,t,(t+3<NT),(t+1<NT),(t+1<NT));       ENDW(t);   RESC(); ROT();
    STEP(pA0,pA1,pB0,pB1,t+1,(t+4<NT),(t+2<NT),(t+2<NT));     ENDW(t+1); RESC(); ROT();
  }
  STEP(pB0,pB1,pA0,pA1,NT-1,false,false,false); RESC();
  { float sacc=pB0[0]+pB0[1]; _Pragma("unroll") for(int r=2;r<16;++r)sacc+=pB0[r]; _Pragma("unroll") for(int r=0;r<16;++r)sacc+=pB1[r]; l_reg+=sacc;
    pw0=(u32x4){PKW(pB0,0),PKW(pB0,2),PKW(pB0,4),PKW(pB0,6)};pw1=(u32x4){PKW(pB0,8),PKW(pB0,10),PKW(pB0,12),PKW(pB0,14)};pw2=(u32x4){PKW(pB1,0),PKW(pB1,2),PKW(pB1,4),PKW(pB1,6)};pw3=(u32x4){PKW(pB1,8),PKW(pB1,10),PKW(pB1,12),PKW(pB1,14)};
    SBAR(); pv(o,vb0+sl_cur,PAF(0),PAF(1),PAF(2),PAF(3)); }
  #undef PKW
  #undef PAF
  #undef VFR
  #undef PIN
  #undef MX3
  #undef GAPA
  #undef GAPB
  #undef EX
  #undef VRD
  #undef KRD
  #undef STEP
  #undef ENDW
  {auto rr=__builtin_amdgcn_permlane32_swap(__float_as_uint(l_reg),__float_as_uint(l_reg),false,false);l_reg=__uint_as_float(rr[0])+__uint_as_float(rr[1]);}
  if(hi==0)wsf[32+r32]=l_reg;asm volatile("s_waitcnt lgkmcnt(0)":::"memory");
  float rli[16];
  #pragma unroll
  for(int r=0;r<16;++r)rli[r]=__builtin_amdgcn_rcpf(wsf[32+crow(r,hi)]);
  bf16*Ow=Oh+(rowbase+q0+wid*QBLK)*ldo;
  { bf16*stg=(bf16*)(shm+LDS_OST)+wid*2048;
    #pragma unroll
    for(int r=0;r<16;++r){const int orow=crow(r,hi);
      #pragma unroll
      for(int d0=0;d0<2;++d0)stg[orow*64+d0*32+r32]=__float2bfloat16(o[d0][r]*rli[r]);}
    asm volatile("s_waitcnt lgkmcnt(0)":::"memory");
    #pragma unroll
    for(int i=0;i<4;++i){const int row=i*8+(lane>>3),ch=lane&7; const u32x4 v=*(const u32x4*)(stg+row*64+ch*8); ATTN_STORE16(Ow+(long)row*ldo+ch*8,v);} }
  asm volatile("s_waitcnt lgkmcnt(0)\n\ts_barrier":::"memory");
  #undef DMA_K
  #undef DMA_V
  #undef CMASK
  #undef XMASK
  #undef START
  #undef RESC
  #undef ROT
}
constexpr int ATTN_LDS_BYTES=LDS_BYTES;
#undef SBAR
#undef WAIT_BAR
}

__device__ __forceinline__ void ph_attn_diff_fast(unsigned char* lds) {
  using namespace attn_body;
  const bf16* PROJ = (const bf16*)(P(ws) + WS_PROJ); bf16* ATT = (bf16*)(P(ws) + WS_ATT);
  const int G = gdim_(), bx = bid_(); const int v0 = (G % 8 == 0) ? (bx % 8) * (G / 8) + bx / 8 : bx;
  for (int vcu = v0; vcu < 256; vcu += G) {
    const int bhp = vcu >> 1, half = bhp & 1, c = (bhp >> 1) & 1, h8 = (bhp >> 2) & 7, b = bhp >> 5;
#pragma unroll 1
    for (int i = 0; i < 8; ++i) { const int sp = 4 * (vcu & 1) + (i >> 1); const int qb = (i & 1) ? 15 - sp : sp;
      attn_unit<8, 0>((long)b * S, qb, PROJ + (h8 * 2 + c) * 64, DIFF_IN, PROJ + 1024 + (h8 * 2 + c) * 64, PROJ + 2048 + h8 * 128 + half * 64, DIFF_IN,
                      ATT + c * 1024 + h8 * 128 + half * 64, 2048, nullptr, (char*)lds); }
  }
}
__device__ __forceinline__ void ph_attn_sel_fast(unsigned char* lds) {
  using namespace attn_body;
  const bf16* PROJ = (const bf16*)(P(ws) + WS_PROJ); bf16* OSEL = (bf16*)(P(ws) + WS_ATT + 32 * MiB);
  const u64* SEL = (const u64*)(P(ws) + WS_SEL);
  const int G = gdim_(), bx = bid_(); const int v0 = (G % 8 == 0) ? (bx % 8) * (G / 8) + bx / 8 : bx;
  for (int vcu = v0; vcu < 256; vcu += G) {
    const int bh = vcu >> 2, hd = bh & 15, b = bh >> 4, g = hd >> 2;
#pragma unroll 1
    for (int i = 0; i < 4; ++i) { const int sp = 2 * (vcu & 3) + (i >> 1); const int qb = (i & 1) ? 15 - sp : sp;
      attn_unit<8, 1>((long)b * S, qb, PROJ + hd * 64, NSA_P, PROJ + 1536 + g * 64, PROJ + 1792 + g * 64, NSA_P, OSEL + hd * 64, 1024, SEL + (size_t)(b * 4 + g) * S, (char*)lds); }
  }
}
__device__ __forceinline__ void ph_attn_win_fast(unsigned char* lds) {
  using namespace attn_body;
  const bf16* PROJ = (const bf16*)(P(ws) + WS_PROJ); bf16* OWIN = (bf16*)(P(ws) + WS_ATT + 64 * MiB);
  const int G = gdim_(), bx = bid_(); const int v0 = (G % 8 == 0) ? (bx % 8) * (G / 8) + bx / 8 : bx;
  for (int vcu = v0; vcu < 256; vcu += G) {
    const int bh = vcu >> 2, hd = bh & 15, b = bh >> 4, g = hd >> 2;
#pragma unroll 1
    for (int i = 0; i < 4; ++i) { const int qb = (vcu & 3) + 4 * i;
      attn_unit<8, 2>((long)b * S, qb, PROJ + hd * 64, NSA_P, PROJ + 2048 + g * 64, PROJ + 2304 + g * 64, NSA_P, OWIN + hd * 64, 1024, nullptr, (char*)lds); }
  }
}

#define XB_TMO      128
#define XB_XCNT(j)  (256  + 64 * (j))
#define XB_XSUB(j)  (1280 + 64 * (j))
#define XB_XGEN(j)  (2304 + 64 * (j))
#define XB_TOP      3328
#define XB_TOPGEN   3392
#define XCD_BAR_WORDS 3456
#define XB_SPIN_CAP (1u << 18)

__device__ __forceinline__ unsigned xb_ld(unsigned* p)              { return __hip_atomic_load(p, __ATOMIC_RELAXED, __HIP_MEMORY_SCOPE_AGENT); }
__device__ __forceinline__ unsigned xb_add(unsigned* p, unsigned v) { return __hip_atomic_fetch_add(p, v, __ATOMIC_RELAXED, __HIP_MEMORY_SCOPE_AGENT); }
__device__ __forceinline__ unsigned xb_xcc_id() { return (unsigned)__builtin_amdgcn_s_getreg((3 << 11) | 20) & 0xFu; }
#define XB_SPIN(cond, bar) do { unsigned _sp = 0; while (cond) { __builtin_amdgcn_s_sleep(1); \
    if ((++_sp & 255u) == 0u) { if (xb_ld(&(bar)[XB_TMO])) break; if (_sp > XB_SPIN_CAP) { atomicAdd(&(bar)[XB_TMO], 1u); break; } } } } while (0)

struct XcdBarrier {
    unsigned* bar; unsigned x;
    volatile __attribute__((address_space(3))) unsigned* st;
};

__device__ __forceinline__ XcdBarrier xcd_barrier_post(unsigned* bar, volatile __attribute__((address_space(3))) unsigned* st) {
    XcdBarrier b; b.bar = bar; b.x = xb_xcc_id(); b.st = st;
    if (tid_() == 0) (void)xb_add(&bar[XB_XCNT(b.x)], 1u);
    return b;
}
__device__ __forceinline__ void xcd_barrier_complete(unsigned* bar, unsigned x, unsigned& nloc, unsigned& nx) {
    const unsigned G = gridDim.x * gridDim.y * gridDim.z;
    unsigned sum, cnt, mine, sp = 0u;
    for (;;) {
        sum = 0u; cnt = 0u; mine = 0u;
#pragma unroll
        for (unsigned j = 0; j < 16; ++j) { const unsigned c = xb_ld(&bar[XB_XCNT(j)]); sum += c; cnt += (c > 0u) ? 1u : 0u; mine = (j == x) ? c : mine; }
        if (sum == G) break;
        __builtin_amdgcn_s_sleep(1);
        if ((++sp & 255u) == 0u) { if (xb_ld(&bar[XB_TMO])) break; if (sp > XB_SPIN_CAP) { atomicAdd(&bar[XB_TMO], 1u); break; } }
    }
    nloc = mine > 0u ? mine : 1u; nx = cnt > 0u ? cnt : 1u;
}

__device__ __forceinline__ void xcd_barrier(const XcdBarrier& b) {
    asm volatile("s_waitcnt vmcnt(0)" ::: "memory");
    __syncthreads();
    if (tid_() == 0) {
        unsigned* bar = b.bar;
        __builtin_amdgcn_s_waitcnt(0);
        unsigned nloc = b.st[0], nx = b.st[1];
        if (nloc == 0u) { xcd_barrier_complete(bar, b.x, nloc, nx); b.st[0] = nloc; b.st[1] = nx; }
        const unsigned old = xb_add(&bar[XB_XSUB(b.x)], 1u);
        const unsigned gen = old / nloc;
        if (old + 1u == (gen + 1u) * nloc) {
            __builtin_amdgcn_fence(__ATOMIC_RELEASE, "agent");
            asm volatile("s_waitcnt vmcnt(0)" ::: "memory");
            const unsigned og = xb_add(&bar[XB_TOP], 1u);
            const unsigned tg = og / nx;
            if (og + 1u == (tg + 1u) * nx) xb_add(&bar[XB_TOPGEN], 1u);
            else XB_SPIN(xb_ld(&bar[XB_TOPGEN]) == tg, bar);
            __builtin_amdgcn_fence(__ATOMIC_ACQUIRE, "agent");
            xb_add(&bar[XB_XGEN(b.x)], 1u);
            asm volatile("s_waitcnt vmcnt(0)" ::: "memory");
        } else {
            XB_SPIN(xb_ld(&bar[XB_XGEN(b.x)]) == gen, bar);
            __builtin_amdgcn_fence(__ATOMIC_ACQUIRE, "agent");
            asm volatile("s_waitcnt vmcnt(0)" ::: "memory");
        }
    }
    __syncthreads();
}

__device__ __forceinline__ void ph_prologue(unsigned char* lds) {
  const int tid = tid_();
  float* silu = (float*)lds;
  float* red = silu + 4096;
  float* MOD = (float*)(P(ws) + WS_MOD);
  for (int i = tid; i < 4096; i += NTHR) { const float v = P(c)[i]; silu[i] = v / (1.f + expf(-v)); }
  __syncthreads();
  for (int item = bid_(); item < 4 * 48; item += gdim_()) {
    const int l = item / 48, nc = item % 48, cc = tid & 127, ks = tid >> 7;
    const float* w = P(w_ada) + ((size_t)l * 1024 + ks * 256) * 6144 + nc * 128 + cc;
    float a0 = 0.f, a1 = 0.f, a2 = 0.f, a3 = 0.f;
#pragma unroll 8
    for (int k = 0; k < 256; ++k) { const float wv = w[(size_t)k * 6144]; const int kk = ks * 256 + k;
      a0 += silu[kk] * wv; a1 += silu[1024 + kk] * wv; a2 += silu[2048 + kk] * wv; a3 += silu[3072 + kk] * wv; }
    red[(ks * 4 + 0) * 128 + cc] = a0; red[(ks * 4 + 1) * 128 + cc] = a1; red[(ks * 4 + 2) * 128 + cc] = a2; red[(ks * 4 + 3) * 128 + cc] = a3;
    __syncthreads();
    { const int b = tid >> 7;
      const float s = red[(0 * 4 + b) * 128 + cc] + red[(1 * 4 + b) * 128 + cc] + red[(2 * 4 + b) * 128 + cc] + red[(3 * 4 + b) * 128 + cc];
      MOD[(size_t)(l * 4 + b) * 6144 + nc * 128 + cc] = s + P(b_ada)[l * 6144 + nc * 128 + cc]; }
    __syncthreads();
  }
  float* rope = (float*)(P(ws) + WS_ROPE);
  for (int m = bid_() * NTHR + tid; m < T; m += gdim_() * NTHR) {
    const float fp = (float)P(pos)[m];
    const float INV[8] = {1.0f, 0.1939227432012558f, 0.03760603070259094f, 0.007292664609849453f, 0.0014142135623842478f, 0.00027424818836152554f, 5.3182957344688475e-05f, 1.0313385246263351e-05f};
#pragma unroll
    for (int i = 0; i < 8; ++i) {
      const float ang = fp * INV[i];
      const double a = (double)ang; const double kq = rint(a * 0.63661977236758134308); const double r = a - kq * 1.57079632679489661923;
      const int q = (int)((long long)kq & 3ll);
      const double r2 = r * r;
      const double sr = r * (1.0 + r2 * (-1.0 / 6 + r2 * (1.0 / 120 + r2 * (-1.0 / 5040 + r2 * (1.0 / 362880 + r2 * (-1.0 / 39916800 + r2 * (1.0 / 6227020800.0)))))));
      const double cr = 1.0 + r2 * (-0.5 + r2 * (1.0 / 24 + r2 * (-1.0 / 720 + r2 * (1.0 / 40320 + r2 * (-1.0 / 3628800 + r2 * (1.0 / 479001600.0))))));
      const double sn = (q == 0) ? sr : (q == 1) ? cr : (q == 2) ? -sr : -cr;
      const double cs = (q == 0) ? cr : (q == 1) ? -sr : (q == 2) ? -cr : sr;
      rope[(size_t)m * 16 + i] = (float)cs; rope[(size_t)m * 16 + 8 + i] = (float)sn;
    }
  }
  if (bid_() == 0 && tid < 2) {
    const int j = tid; float s1 = 0.f, s2 = 0.f;
    for (int i = 0; i < 64; ++i) { s1 += P(diff_lq1)[j * 64 + i] * P(diff_lk1)[j * 64 + i]; s2 += P(diff_lq2)[j * 64 + i] * P(diff_lk2)[j * 64 + i]; }
    ((float*)(P(ws) + WS_SMALL))[j] = expf(s1) - expf(s2) + lam_init_of(j);
  }
}


__device__ __forceinline__ void transpose_item(const float* W, int K, int N, int Npad, bf16_t* WT, float* scr, int item, int lane) {
  const int nblk = Npad / 32, kb = item / nblk, nb = item % nblk, k0 = 64 * kb, n0 = 32 * nb;
  const int ncol = n0 + (lane & 31); const bool ok = ncol < N;
#pragma unroll 8
  for (int i = 0; i < 32; ++i) { const int kk = 2 * i + (lane >> 5); scr[kk * 33 + (lane & 31)] = ok ? W[(size_t)(k0 + kk) * N + ncol] : 0.f; }
  asm volatile("s_waitcnt lgkmcnt(0)" ::: "memory");
  const int c = lane & 7;
#pragma unroll
  for (int j = 0; j < 4; ++j) { const int n = (lane >> 3) + 8 * j; const float* sp = scr + (8 * c) * 33 + n;
    uint4 o; o.x = pk2(sp[0 * 33], sp[1 * 33]); o.y = pk2(sp[2 * 33], sp[3 * 33]); o.z = pk2(sp[4 * 33], sp[5 * 33]); o.w = pk2(sp[6 * 33], sp[7 * 33]);
    *(uint4*)(WT + (size_t)(n0 + n) * K + k0 + 8 * c) = o; }
  asm volatile("s_waitcnt lgkmcnt(0)" ::: "memory");
}
__device__ __forceinline__ void ph_weights(unsigned char* lds) {
  const int tid = tid_(), lane = tid & 63, wave = tid >> 6;
  float* scr = (float*)(lds + wave * 16384);
  const int gw = bid_() * 8 + wave, NGW = gdim_() * 8;
  for (int it = gw; it < 4 * 6144; it += NGW) {
    const int i = it / 6144; int r = it % 6144; const int j = i >> 1; const bool nsa = (i & 1) == 0;
    bf16_t* base = (bf16_t*)(P(ws) + WS_WT + (size_t)i * WT_LAYER);
    const int n_in = nsa ? 16 * (NSA_P / 32) : 16 * (DIFF_IN / 32);
    if (r < n_in) { if (nsa) transpose_item(P(nsa_w_in) + (size_t)j * D * NSA_IN, D, NSA_IN, NSA_P, base, scr, r, lane); else transpose_item(P(diff_w_in) + (size_t)j * D * DIFF_IN, D, DIFF_IN, DIFF_IN, base, scr, r, lane); continue; }
    r -= n_in;
    if (r < 512) { transpose_item((nsa ? P(nsa_w_out) : P(diff_w_out)) + (size_t)j * D * D, D, D, D, base + WT_OUT / 2, scr, r, lane); continue; }
    r -= 512;
    if (r < 2048) { transpose_item(P(w_mlp_in) + (size_t)i * D * DFF, D, DFF, DFF, base + WT_MI / 2, scr, r, lane); continue; }
    r -= 2048;
    if (r < 2048) transpose_item(P(w_mlp_out) + (size_t)i * DFF * D, DFF, D, D, base + WT_MO / 2, scr, r, lane);
  }
  for (int it = gw; it < 4 * 128; it += NGW) {
    const int jk = it >> 7, jj = jk >> 1, kv = jk & 1;
    transpose_item((kv ? P(nsa_w_cv1) : P(nsa_w_ck1)) + (size_t)jj * 2048 * 128, 2048, 128, 128, (bf16_t*)(P(ws) + WS_W1T) + (size_t)jk * 128 * 2048, scr, it & 127, lane);
  }
}
__device__ __forceinline__ void ph_cmp_bias(unsigned char* lds) {
  float* red = (float*)lds;
  const int tid = tid_(), n = tid & 127, ks = tid >> 7;
  for (int jk = bid_(); jk < 4; jk += gdim_()) {
    const int jj = jk >> 1, kv = jk & 1;
    const float* pe = (kv ? P(nsa_pe_v) : P(nsa_pe_k)) + jj * 2048; const float* w1 = (kv ? P(nsa_w_cv1) : P(nsa_w_ck1)) + (size_t)jj * 2048 * 128;
    float a = 0.f;
#pragma unroll 16
    for (int k = ks * 512; k < ks * 512 + 512; ++k) a += pe[k] * w1[(size_t)k * 128 + n];
    __syncthreads();
    red[ks * 128 + n] = a;
    __syncthreads();
    if (tid < 128) ((float*)(P(ws) + WS_SMALL))[64 + jk * 128 + tid] = red[tid] + red[128 + tid] + red[256 + tid] + red[384 + tid];
  }
}

__device__ __forceinline__ void ph_norm(const float* xin, const float* gvec, const float* mod  , int sh_off, int sc_off, bf16_t* H) {
  const int tid = tid_(), lane = tid & 63, wave = tid >> 6;
  for (int m = bid_() * 8 + wave; m < T; m += gdim_() * 8) {
    const int b = m >> 12;
    const float4* xr = (const float4*)(xin + (size_t)m * D) + lane;
    float4 v[4]; float ss = 0.f;
#pragma unroll
    for (int j = 0; j < 4; ++j) { v[j] = xr[64 * j]; ss += (v[j].x * v[j].x + v[j].y * v[j].y) + (v[j].z * v[j].z + v[j].w * v[j].w); }
    ss = wave_sum(ss);
    const float rstd = 1.0f / sqrtf(ss * (1.0f / D) + EPS);
#pragma unroll
    for (int j = 0; j < 4; ++j) {
      const int col = 4 * lane + 256 * j;
      const float4 g = *(const float4*)(gvec + col), sc = *(const float4*)(mod + (size_t)b * 6144 + sc_off + col), sh = *(const float4*)(mod + (size_t)b * 6144 + sh_off + col);
      const float h0 = v[j].x * rstd * g.x * (1.f + sc.x) + sh.x, h1 = v[j].y * rstd * g.y * (1.f + sc.y) + sh.y;
      const float h2 = v[j].z * rstd * g.z * (1.f + sc.z) + sh.z, h3 = v[j].w * rstd * g.w * (1.f + sc.w) + sh.w;
      uint2 o; o.x = pk2(h0, h1); o.y = pk2(h2, h3);
      *(uint2*)(H + (size_t)m * D + col) = o;
    }
  }
}

struct EpiStore { bf16_t* O; int ld; int relu2;
  __device__ __forceinline__ void operator()(int row, int col, const float* v) const {
    float a = v[0], b = v[1], c = v[2], d = v[3];
    if (relu2) { a = fmaxf(a, 0.f); a *= a; b = fmaxf(b, 0.f); b *= b; c = fmaxf(c, 0.f); c *= c; d = fmaxf(d, 0.f); d *= d; }
    uint2 o; o.x = pk2(a, b); o.y = pk2(c, d); *(uint2*)(O + (size_t)row * ld + col) = o; } };
struct EpiResid { const float* xin; float* xout; const float* gate;
  __device__ __forceinline__ void operator()(int row, int col, const float* v) const {
    const int b = row >> 12; const float4 g = *(const float4*)(gate + (size_t)b * 6144 + col); const float4 xi = *(const float4*)(xin + (size_t)row * D + col);
    float4 o; o.x = xi.x + g.x * v[0]; o.y = xi.y + g.y * v[1]; o.z = xi.z + g.z * v[2]; o.w = xi.w + g.w * v[3];
    *(float4*)(xout + (size_t)row * D + col) = o; } };

template <class Epi>
__device__ __forceinline__ void gemm_naive(const bf16_t* A, int lda, const float* W, int N, int K, unsigned char* lds, const Epi& E) {
  asm volatile("" : "+s"(N), "+s"(K), "+s"(lda));
  float* As = (float*)lds;
  float* Bs = As + 16 * 132;
  const int tid = tid_(), tx = tid & 31, ty = tid >> 5;
  const int nN = (N + 127) / 128, nM = T / 128;
  const int ar = tid >> 2, ak = (tid & 3) * 4, bk = tid >> 5, bc = (tid & 31) * 4;
  for (int u = bid_(); u < nM * nN; u += gdim_()) {
    const int pm = u / nN, pn = u % nN;
    float acc[8][4];
#pragma unroll
    for (int i = 0; i < 8; ++i) { acc[i][0] = 0.f; acc[i][1] = 0.f; acc[i][2] = 0.f; acc[i][3] = 0.f; }
    const bf16_t* Ap = A + (size_t)(pm * 128 + ar) * lda + ak;
    const int wcol = pn * 128 + bc; const bool bok = wcol < N;
    const float* Wp = W + (size_t)bk * N + (bok ? wcol : 0);
    for (int k0 = 0; k0 < K; k0 += 16) {
      const uint2 av = *(const uint2*)(Ap + k0);
      float4 bv = *(const float4*)(Wp + (size_t)k0 * N);
      if (!bok) bv = make_float4(0.f, 0.f, 0.f, 0.f);
      __syncthreads();
      As[(ak + 0) * 132 + ar] = bf2f(av.x & 0xffffu); As[(ak + 1) * 132 + ar] = bf2f(av.x >> 16);
      As[(ak + 2) * 132 + ar] = bf2f(av.y & 0xffffu); As[(ak + 3) * 132 + ar] = bf2f(av.y >> 16);
      *(float4*)(Bs + bk * 128 + bc) = bv;
      __syncthreads();
#pragma unroll
      for (int k = 0; k < 16; ++k) {
        const float4 a0 = *(const float4*)(As + k * 132 + ty * 8), a1 = *(const float4*)(As + k * 132 + ty * 8 + 4);
        const float4 b = *(const float4*)(Bs + k * 128 + tx * 4);
        const float a[8] = {a0.x, a0.y, a0.z, a0.w, a1.x, a1.y, a1.z, a1.w};
#pragma unroll
        for (int i = 0; i < 8; ++i) { acc[i][0] += a[i] * b.x; acc[i][1] += a[i] * b.y; acc[i][2] += a[i] * b.z; acc[i][3] += a[i] * b.w; }
      }
    }
    const int col = pn * 128 + tx * 4;
    if (col < N) {
#pragma unroll
      for (int i = 0; i < 8; ++i) E(pm * 128 + ty * 8 + i, col, acc[i]);
    }
  }
}

__device__ __forceinline__ void head_norm_rope(const float* v, const float* gain, const float* cs  , int sub, float* vn, float* vr) {
  float ss = 0.f;
#pragma unroll
  for (int i = 0; i < 8; ++i) ss += v[i] * v[i];
  ss += __shfl_xor(ss, 1); ss += __shfl_xor(ss, 2); ss += __shfl_xor(ss, 4);
  const float rstd = 1.0f / sqrtf(ss * (1.0f / 64.0f) + EPS);
#pragma unroll
  for (int i = 0; i < 8; ++i) vn[i] = v[i] * rstd * gain[sub * 8 + i];
#pragma unroll
  for (int i = 0; i < 8; ++i) {
    const float other = __shfl_xor(vn[i], 1);
    const float c = cs[i], s = cs[8 + i];
    float r = vn[i];
    if (sub == 0) r = vn[i] * c - other * s;
    else if (sub == 1) r = vn[i] * c + other * s;
    vr[i] = r;
  }
}

__device__ __forceinline__ void ph_post_diff(int j, bf16_t* PROJ) {
  const int tid = tid_(), lane = tid & 63, wave = tid >> 6, sub = lane & 7;
  const float* rope = (const float*)(P(ws) + WS_ROPE);
  for (int m = bid_() * 8 + wave; m < T; m += gdim_() * 8) {
    const float* cs = rope + (size_t)m * 16;
#pragma unroll
    for (int it = 0; it < 4; ++it) {
      bf16_t* ptr = PROJ + (size_t)m * DIFF_IN + it * 512 + lane * 8;
      float v[8], vn[8], vr[8]; unpack8(*(const uint4*)ptr, v);
      const float* gain = (it < 2) ? (P(diff_q_gain) + j * 64) : (P(diff_k_gain) + j * 64);
      head_norm_rope(v, gain, cs, sub, vn, vr);
      const float sc = (it < 2) ? C2 : 1.0f;
#pragma unroll
      for (int i = 0; i < 8; ++i) vr[i] *= sc;
      *(uint4*)ptr = pack8(vr);
    }
  }
}
__device__ __forceinline__ void ph_post_nsa(int j, bf16_t* PROJ, bf16_t* QC) {
  const int tid = tid_(), lane = tid & 63, wave = tid >> 6, sub = lane & 7;
  const float* rope = (const float*)(P(ws) + WS_ROPE);
  for (int m = bid_() * 8 + wave; m < T; m += gdim_() * 8) {
    const float* cs = rope + (size_t)m * 16;
#pragma unroll
    for (int it = 0; it < 2; ++it) {
      bf16_t* ptr = PROJ + (size_t)m * NSA_P + it * 512 + lane * 8;
      float v[8], vn[8], vr[8]; unpack8(*(const uint4*)ptr, v);
      head_norm_rope(v, P(nsa_q_gain) + j * 64, cs, sub, vn, vr);
#pragma unroll
      for (int i = 0; i < 8; ++i) { vr[i] *= C2; vn[i] *= C2; }
      *(uint4*)ptr = pack8(vr);
      *(uint4*)(QC + (size_t)m * D + it * 512 + lane * 8) = pack8(vn);
    }
    {
      const int hi = lane >> 5;
      bf16_t* ptr = PROJ + (size_t)m * NSA_P + (hi ? 2048 : 1536) + (lane & 31) * 8;
      float v[8], vn[8], vr[8]; unpack8(*(const uint4*)ptr, v);
      head_norm_rope(v, P(nsa_k_gain) + j * 192 + (hi ? 128 : 64), cs, sub, vn, vr);
      *(uint4*)ptr = pack8(vr);
    }
  }
}

template <int DV, int MODE>
__device__ __forceinline__ void attn_naive_unit(int b, int qc, const bf16_t* Qp, int ldq, const bf16_t* Kp, const bf16_t* Vp, int ldkv, bf16_t* Op, int ldo, const u64* selmask, unsigned char* lds) {
  constexpr int DVS = DV / 8;
  float* Ks = (float*)lds;
  float* Vs = Ks + 64 * 64;
  const int tid = tid_(), qi = tid & 63, sl = tid >> 6;
  const int qabs = qc * 64 + qi;
  const size_t rowq = (size_t)b * S + qabs;
  float q[64];
#pragma unroll
  for (int i = 0; i < 8; ++i) unpack8(*(const uint4*)(Qp + rowq * ldq + i * 8), q + i * 8);
  float m = -INFINITY, l = 0.f, o[DVS];
#pragma unroll
  for (int i = 0; i < DVS; ++i) o[i] = 0.f;
  u64 msk = 0ull; if (MODE == 1) msk = selmask[qabs];
  const int t_lo = (MODE == 2) ? (qc > 8 ? qc - 8 : 0) : 0;
  for (int tt = t_lo; tt <= qc; ++tt) {
    __syncthreads();
    { const int key = tid >> 3, ch = tid & 7; float f[8];
      unpack8(*(const uint4*)(Kp + ((size_t)b * S + tt * 64 + key) * ldkv + ch * 8), f);
#pragma unroll
      for (int i = 0; i < 8; ++i) Ks[key * 64 + ch * 8 + i] = f[i];
#pragma unroll
      for (int r = 0; r < DV / 64; ++r) {
        unpack8(*(const uint4*)(Vp + ((size_t)b * S + tt * 64 + key) * ldkv + r * 64 + ch * 8), f);
#pragma unroll
        for (int i = 0; i < 8; ++i) Vs[key * DV + r * 64 + ch * 8 + i] = f[i];
      } }
    __syncthreads();
    const bool tile_on = (MODE == 1) ? (((msk >> tt) & 1ull) != 0ull) : true;
    if (tile_on) {
      for (int jk = 0; jk < 64; ++jk) {
        const int key = tt * 64 + jk;
        bool valid = key <= qabs; if (MODE == 2) valid = valid && (key > qabs - 512);
        if (valid) {
          float s = 0.f;
#pragma unroll
          for (int d = 0; d < 64; d += 4) { const float4 kk = *(const float4*)(Ks + jk * 64 + d); s += q[d] * kk.x + q[d + 1] * kk.y + q[d + 2] * kk.z + q[d + 3] * kk.w; }
          const float mn = fmaxf(m, s); const float sc = exp2f(m - mn), pp = exp2f(s - mn);
          l = l * sc + pp;
#pragma unroll
          for (int i = 0; i < DVS; ++i) o[i] = o[i] * sc + pp * Vs[jk * DV + sl * DVS + i];
          m = mn;
        }
      }
    }
  }
  const float inv = l > 0.f ? 1.0f / l : 0.f;
  bf16_t* op = Op + rowq * ldo + sl * DVS;
  if (DVS == 8) { float r[8];
#pragma unroll
    for (int i = 0; i < 8; ++i) r[i] = o[i] * inv;
    *(uint4*)op = pack8(r);
  } else {
#pragma unroll
    for (int h2 = 0; h2 < DVS / 8; ++h2) { float r[8];
#pragma unroll
      for (int i = 0; i < 8; ++i) r[i] = o[h2 * 8 + i] * inv;
      *(uint4*)(op + h2 * 8) = pack8(r); }
  }
}

__device__ __forceinline__ void ph_attn_diff(unsigned char* lds) {
  const bf16_t* PROJ = (const bf16_t*)(P(ws) + WS_PROJ); bf16_t* ATT = (bf16_t*)(P(ws) + WS_ATT);
  const int NU = NB * 64 * 16;
  for (int u = bid_(); u < NU; u += gdim_()) {
    const int vh = u & 15, qc = 63 - ((u >> 4) & 63), b = u >> 10;
    const int h8 = vh >> 1, c = vh & 1;
    attn_naive_unit<128, 0>(b, qc, PROJ + vh * 64, DIFF_IN, PROJ + 1024 + vh * 64, PROJ + 2048 + h8 * 128, DIFF_IN, ATT + c * 1024 + h8 * 128, 2048, nullptr, lds);
  }
}
__device__ __forceinline__ void ph_attn_sel(unsigned char* lds) {
  const bf16_t* PROJ = (const bf16_t*)(P(ws) + WS_PROJ); bf16_t* OSEL = (bf16_t*)(P(ws) + WS_ATT + 32 * MiB);
  const u64* SEL = (const u64*)(P(ws) + WS_SEL);
  const int NU = NB * 64 * 16;
  for (int u = bid_(); u < NU; u += gdim_()) {
    const int hd = u & 15, qc = 63 - ((u >> 4) & 63), b = u >> 10, g = hd >> 2;
    attn_naive_unit<64, 1>(b, qc, PROJ + hd * 64, NSA_P, PROJ + 1536 + g * 64, PROJ + 1792 + g * 64, NSA_P, OSEL + hd * 64, D, SEL + (size_t)(b * 4 + g) * S, lds);
  }
}
__device__ __forceinline__ void ph_attn_win(unsigned char* lds) {
  const bf16_t* PROJ = (const bf16_t*)(P(ws) + WS_PROJ); bf16_t* OWIN = (bf16_t*)(P(ws) + WS_ATT + 64 * MiB);
  const int NU = NB * 64 * 16;
  for (int u = bid_(); u < NU; u += gdim_()) {
    const int hd = u & 15, qc = (u >> 4) & 63, b = u >> 10, g = hd >> 2;
    attn_naive_unit<64, 2>(b, qc, PROJ + hd * 64, NSA_P, PROJ + 2048 + g * 64, PROJ + 2304 + g * 64, NSA_P, OWIN + hd * 64, D, nullptr, lds);
  }
}

__device__ __forceinline__ void ph_compress(int j, unsigned char* lds) {
  typedef short bf16x8_t __attribute__((ext_vector_type(8))); typedef float f32x16_t __attribute__((ext_vector_type(16)));
  const bf16_t* PROJ = (const bf16_t*)(P(ws) + WS_PROJ);
  unsigned char* Xb = lds;
  float* part = (float*)(lds + 67584);
  float* hid = part + 2 * 32 * 128;
  const int tid = tid_(), lane = tid & 63, wave = tid >> 6, r = lane & 31, h = lane >> 5, nb = wave & 3, kh = wave >> 2;
  for (int it = bid_(); it < 256; it += gdim_()) {
    const int rt = it & 7, kv = (it >> 3) & 1, bg = it >> 4, b = bg >> 2, g = bg & 3;
    const bf16_t* W1T = (const bf16_t*)(P(ws) + WS_W1T) + (size_t)(j * 2 + kv) * 128 * 2048;
    const float* w2 = (kv ? P(nsa_w_cv2) : P(nsa_w_ck2)) + (size_t)j * 128 * 64;
    const int colbase = (kv ? 1280 : 1024) + g * 64;
    __syncthreads();
    for (int i = tid; i < 528 * 8; i += NTHR) { const int tk = i >> 3, ch = i & 7, tok = 512 * rt + tk;
      uint4 v = make_uint4(0u, 0u, 0u, 0u); if (tok < S) v = *(const uint4*)(PROJ + ((size_t)b * S + tok) * NSA_P + colbase + ch * 8);
      *(uint4*)(Xb + tk * 128 + ((ch ^ ((tk >> 4) & 7)) * 16)) = v; }
    __syncthreads();
    f32x16_t acc;
#pragma unroll
    for (int q = 0; q < 16; ++q) acc[q] = 0.f;
    const bf16_t* wrow = W1T + (size_t)(nb * 32 + r) * 2048 + 8 * h;
#pragma unroll 2
    for (int l = 16 * kh; l < 16 * kh + 16; ++l) {
      const int tk = 16 * r + l; const unsigned char* xr = Xb + tk * 128; const int sw = (tk >> 4) & 7;
#pragma unroll
      for (int dq = 0; dq < 4; ++dq) {
        const bf16x8_t av = *(const bf16x8_t*)(xr + (((2 * dq + h) ^ sw) * 16));
        const bf16x8_t bv = *(const bf16x8_t*)(wrow + l * 64 + 16 * dq);
        acc = __builtin_amdgcn_mfma_f32_32x32x16_bf16(av, bv, acc, 0, 0, 0);
      }
    }
#pragma unroll
    for (int q = 0; q < 16; ++q) part[(kh * 32 + ((q & 3) + 8 * (q >> 2) + 4 * h)) * 128 + nb * 32 + r] = acc[q];
    __syncthreads();
    const float* CB = (const float*)(P(ws) + WS_SMALL) + 64 + (j * 2 + kv) * 128;
    for (int i = tid; i < 32 * 128; i += NTHR) { const float hs = part[i] + part[4096 + i] + CB[i & 127]; hid[i] = hs / (1.f + expf(-hs)); }
    __syncthreads();
    { const int e = tid & 63, rq = tid >> 6; float o0 = 0.f, o1 = 0.f, o2 = 0.f, o3 = 0.f;
      for (int hh = 0; hh < 128; ++hh) { const float wv = w2[hh * 64 + e];
        o0 += hid[(rq * 4 + 0) * 128 + hh] * wv; o1 += hid[(rq * 4 + 1) * 128 + hh] * wv; o2 += hid[(rq * 4 + 2) * 128 + hh] * wv; o3 += hid[(rq * 4 + 3) * 128 + hh] * wv; }
      float ov[4] = {o0, o1, o2, o3};
      bf16_t* KC = (bf16_t*)(P(ws) + WS_KCMP);
      bf16_t* VT = (bf16_t*)(P(ws) + WS_VCMP);
#pragma unroll
      for (int rr = 0; rr < 4; ++rr) { const int c = 32 * rt + rq * 4 + rr; float v = ov[rr];
        if (kv == 0) { const float ss = wave_sum(v * v); v = v * (1.0f / sqrtf(ss * (1.0f / 64.0f) + EPS)) * P(nsa_k_gain)[j * 192 + e]; }
        if (c >= 255) v = 0.f;
        if (kv == 0) KC[((size_t)bg * 256 + c) * 64 + e] = (bf16_t)f2bf(v); else VT[((size_t)bg * 64 + e) * 256 + c] = (bf16_t)f2bf(v); }
    }
  }
}

__device__ __forceinline__ void ph_cmp_attn(unsigned char* lds) {
  typedef short bf16x8_t __attribute__((ext_vector_type(8))); typedef float f32x16_t __attribute__((ext_vector_type(16)));
  unsigned char* Kimg = lds;
  unsigned char* VTl = lds + 32768;
  float* IMP = (float*)(lds + 32768 + 33280);
  unsigned* selb = (unsigned*)(IMP + 64 * 64);
  const bf16_t* QC = (const bf16_t*)(P(ws) + WS_OC);
  const bf16_t* KC = (const bf16_t*)(P(ws) + WS_KCMP); const bf16_t* VT = (const bf16_t*)(P(ws) + WS_VCMP);
  bf16_t* OCMP = (bf16_t*)(P(ws) + WS_ATT);
  u64* SEL = (u64*)(P(ws) + WS_SEL);
  const int tid = tid_(), lane = tid & 63, wave = tid >> 6, r32 = lane & 31, hi = lane >> 5, hh = wave >> 1, qh = wave & 1;
  const int G = gdim_(), bx = bid_(); const int v0 = (G % 8 == 0) ? (bx % 8) * (G / 8) + bx / 8 : bx;
  for (int vcu = v0; vcu < 256; vcu += G) {
    const int bg = vcu >> 4, b = bg >> 2, g = bg & 3;
    __syncthreads();
    for (int i = tid; i < 2048; i += NTHR) { const int c = i >> 3, ch = i & 7; *(uint4*)(Kimg + ch * 4096 + c * 16) = *(const uint4*)(KC + ((size_t)bg * 256 + c) * 64 + ch * 8); }
    for (int i = tid; i < 4096; i += NTHR) { const int d = i >> 6, c8 = i & 63; *(uint2*)(VTl + d * 520 + c8 * 8) = *(const uint2*)(VT + ((size_t)bg * 64 + d) * 256 + c8 * 4); }
#pragma unroll 1
    for (int ui = 0; ui < 4; ++ui) {
      const int qc = (vcu & 15) + 16 * ui, t0 = qc * 64;
      __syncthreads();
      for (int i = tid; i < 64 * 64; i += NTHR) IMP[i] = 0.f;
      if (tid < 128) selb[tid] = 0u;
      const int t = t0 + 32 * qh + r32;
      bf16x8_t qr[4];
      { const bf16_t* qp = QC + ((size_t)b * S + t) * D + (g * 4 + hh) * 64 + hi * 8;
#pragma unroll
        for (int d0 = 0; d0 < 4; ++d0) qr[d0] = *(const bf16x8_t*)(qp + d0 * 16); }
      __syncthreads();
      const int nc = 4 * qc + 2 * qh + 1, nct = (nc + 31) >> 5;
#define CMP_TILE(PACC, ct) do { \
        _Pragma("unroll") for (int q = 0; q < 16; ++q) PACC[q] = 0.f; \
        _Pragma("unroll") for (int d0 = 0; d0 < 4; ++d0) { const bf16x8_t kf = *(const bf16x8_t*)(Kimg + (2 * d0 + hi) * 4096 + (32 * (ct) + r32) * 16); PACC = __builtin_amdgcn_mfma_f32_32x32x16_bf16(kf, qr[d0], PACC, 0, 0, 0); } \
        _Pragma("unroll") for (int q = 0; q < 16; ++q) { const int c = 32 * (ct) + (q & 3) + 8 * (q >> 2) + 4 * hi; const bool ok = (16 * c + 31 <= t) && (c < 255); PACC[q] = ok ? PACC[q] : -INFINITY; } } while (0)
      float mx = -INFINITY;
#pragma unroll 1
      for (int ct = 0; ct < nct; ++ct) { f32x16_t pacc; CMP_TILE(pacc, ct);
#pragma unroll
        for (int q = 0; q < 16; ++q) mx = fmaxf(mx, pacc[q]); }
      mx = fmaxf(mx, __shfl_xor(mx, 32));
      const float ms = (mx == -INFINITY) ? 0.f : mx;
      float sum = 0.f;
#pragma unroll 1
      for (int ct = 0; ct < nct; ++ct) { f32x16_t pacc; CMP_TILE(pacc, ct);
#pragma unroll
        for (int q = 0; q < 16; ++q) sum += exp2f(pacc[q] - ms); }
      sum += __shfl_xor(sum, 32);
      const float inv = sum > 0.f ? 1.0f / sum : 0.f;
      f32x16_t o0, o1;
#pragma unroll
      for (int q = 0; q < 16; ++q) { o0[q] = 0.f; o1[q] = 0.f; }
      float* improw = IMP + (32 * qh + r32) * 64;
#pragma unroll 1
      for (int ct = 0; ct < nct; ++ct) {
        f32x16_t pr; CMP_TILE(pr, ct);
#pragma unroll
        for (int q = 0; q < 16; ++q) pr[q] = exp2f(pr[q] - ms) * inv;
#pragma unroll
        for (int g4 = 0; g4 < 4; ++g4) { const int mi = 8 * ct + 2 * g4 + hi; const float last = pr[4 * g4 + 3];
          atomicAdd(improw + mi, (pr[4 * g4] + pr[4 * g4 + 1]) + (pr[4 * g4 + 2] + last));
          if (mi + 1 < 64) atomicAdd(improw + mi + 1, last); }
#pragma unroll
        for (int s2 = 0; s2 < 2; ++s2) {
          uint4 pw; pw.x = pg8::cvt_pk_bf16(pr[8 * s2 + 0], pr[8 * s2 + 1]); pw.y = pg8::cvt_pk_bf16(pr[8 * s2 + 2], pr[8 * s2 + 3]);
          pw.z = pg8::cvt_pk_bf16(pr[8 * s2 + 4], pr[8 * s2 + 5]); pw.w = pg8::cvt_pk_bf16(pr[8 * s2 + 6], pr[8 * s2 + 7]);
          const bf16x8_t pa = __builtin_bit_cast(bf16x8_t, pw);
          const int cb = (32 * ct + 16 * s2 + 4 * hi) * 2;
          { const uint2 lo = *(const uint2*)(VTl + r32 * 520 + cb), hi2 = *(const uint2*)(VTl + r32 * 520 + cb + 16);
            uint4 vv; vv.x = lo.x; vv.y = lo.y; vv.z = hi2.x; vv.w = hi2.y; o0 = __builtin_amdgcn_mfma_f32_32x32x16_bf16(pa, __builtin_bit_cast(bf16x8_t, vv), o0, 0, 0, 0); }
          { const uint2 lo = *(const uint2*)(VTl + (32 + r32) * 520 + cb), hi2 = *(const uint2*)(VTl + (32 + r32) * 520 + cb + 16);
            uint4 vv; vv.x = lo.x; vv.y = lo.y; vv.z = hi2.x; vv.w = hi2.y; o1 = __builtin_amdgcn_mfma_f32_32x32x16_bf16(pa, __builtin_bit_cast(bf16x8_t, vv), o1, 0, 0, 0); }
        }
      }
#undef CMP_TILE
      { bf16_t* op = OCMP + ((size_t)b * S + t0 + 32 * qh) * D + (g * 4 + hh) * 64 + r32;
#pragma unroll
        for (int q = 0; q < 16; ++q) { const int row = (q & 3) + 8 * (q >> 2) + 4 * hi; op[(size_t)row * D] = (bf16_t)f2bf(o0[q]); op[(size_t)row * D + 32] = (bf16_t)f2bf(o1[q]); } }
      __syncthreads();
      const int qi = tid >> 3, sub = tid & 7, tq = t0 + qi, bt = tq >> 6;
      float vals[8];
#pragma unroll
      for (int k = 0; k < 8; ++k) { const int sb = sub + 8 * k; const float v = IMP[qi * 64 + sb];
        const bool forced = (sb == 0) || (sb == bt) || (sb == bt - 1), valid = sb <= bt; vals[k] = forced ? 1e6f : (valid ? v : -1.0f); }
      __syncthreads();
#pragma unroll
      for (int k = 0; k < 8; ++k) IMP[qi * 64 + sub + 8 * k] = vals[k];
      __syncthreads();
      int cnt[8];
#pragma unroll
      for (int k = 0; k < 8; ++k) cnt[k] = 0;
      for (int s2 = 0; s2 < 64; ++s2) { const float w = IMP[qi * 64 + s2];
#pragma unroll
        for (int k = 0; k < 8; ++k) cnt[k] += (w > vals[k] || (w == vals[k] && s2 < sub + 8 * k)) ? 1 : 0; }
      unsigned lo = 0u, hi32 = 0u;
#pragma unroll
      for (int k = 0; k < 8; ++k) if (cnt[k] < 16) { const int sb = sub + 8 * k; if (sb < 32) lo |= 1u << sb; else hi32 |= 1u << (sb - 32); }
      if (lo) atomicOr(&selb[qi * 2], lo);
      if (hi32) atomicOr(&selb[qi * 2 + 1], hi32);
      __syncthreads();
      if (tid < 64) SEL[(size_t)bg * S + t0 + tid] = (u64)selb[tid * 2] | ((u64)selb[tid * 2 + 1] << 32);
    }
  }
}

__device__ __forceinline__ void ph_combine_nsa(int j) {
  const bf16_t* PROJ = (const bf16_t*)(P(ws) + WS_PROJ);
  const bf16_t* OCMP = (const bf16_t*)(P(ws) + WS_ATT); const bf16_t* OSEL = OCMP + (size_t)T * D; const bf16_t* OWIN = OSEL + (size_t)T * D;
  bf16_t* OC = (bf16_t*)(P(ws) + WS_OC);
  for (size_t i = (size_t)bid_() * NTHR + tid_(); i < (size_t)T * 128; i += (size_t)gdim_() * NTHR) {
    const size_t m = i >> 7; const int cg8 = (int)(i & 127), hd = cg8 >> 3;
    float gt[3];
#pragma unroll
    for (int r = 0; r < 3; ++r) { const float gl = bf2f(PROJ[m * NSA_P + 2560 + hd * 3 + r]) + P(nsa_b_gate)[j * 48 + hd * 3 + r]; gt[r] = 1.0f / (1.0f + expf(-gl)); }
    float a[8], bb[8], cc[8], o[8];
    unpack8(*(const uint4*)(OCMP + m * D + cg8 * 8), a); unpack8(*(const uint4*)(OSEL + m * D + cg8 * 8), bb); unpack8(*(const uint4*)(OWIN + m * D + cg8 * 8), cc);
#pragma unroll
    for (int k = 0; k < 8; ++k) o[k] = gt[0] * a[k] + gt[1] * bb[k] + gt[2] * cc[k];
    *(uint4*)(OC + m * D + cg8 * 8) = pack8(o);
  }
}
__device__ __forceinline__ void ph_combine_diff(int j) {
  const bf16_t* ATT = (const bf16_t*)(P(ws) + WS_ATT); bf16_t* OC = (bf16_t*)(P(ws) + WS_OC);
  const float lam = ((const float*)(P(ws) + WS_SMALL))[j]; const float osc = 1.0f - lam_init_of(j);
  const int tid = tid_(), lane = tid & 63, wave = tid >> 6;
  for (int m = bid_() * 8 + wave; m < T; m += gdim_() * 8) {
#pragma unroll
    for (int it = 0; it < 2; ++it) {
      const int col = it * 512 + lane * 8;
      float a[8], b2[8], o[8]; unpack8(*(const uint4*)(ATT + (size_t)m * 2048 + col), a); unpack8(*(const uint4*)(ATT + (size_t)m * 2048 + 1024 + col), b2);
      float ss = 0.f;
#pragma unroll
      for (int k = 0; k < 8; ++k) { o[k] = a[k] - lam * b2[k]; ss += o[k] * o[k]; }
      ss += __shfl_xor(ss, 1); ss += __shfl_xor(ss, 2); ss += __shfl_xor(ss, 4); ss += __shfl_xor(ss, 8);
      const float rstd = 1.0f / sqrtf(ss * (1.0f / 128.0f) + EPS);
#pragma unroll
      for (int k = 0; k < 8; ++k) o[k] = o[k] * rstd * P(diff_subln_g)[j * 128 + (col & 127) + k] * osc;
      *(uint4*)(OC + (size_t)m * D + col) = pack8(o);
    }
  }
}

constexpr int N_PHASES = 1 + 4 * 10;
template <int PH> __device__ __forceinline__ void run_phase(unsigned char* lds, int lo, int hi, const XcdBarrier& bar) {
  if (PH < lo || PH >= hi) return;
  bool did = true;
  if constexpr (PH == 0) { ph_prologue(lds); __syncthreads(); ph_cmp_bias(lds); __syncthreads(); ph_weights(lds); }
  else {
    constexpr int i = (PH - 1) / 10, lp = (PH - 1) % 10, j = i >> 1; constexpr bool nsa = (i & 1) == 0;
    float* MOD = (float*)(P(ws) + WS_MOD);
    bf16_t* H = (bf16_t*)(P(ws) + WS_H); bf16_t* PROJ = (bf16_t*)(P(ws) + WS_PROJ); bf16_t* OC = (bf16_t*)(P(ws) + WS_OC); bf16_t* HID = (bf16_t*)(P(ws) + WS_HID);
    const float* mod = MOD + (size_t)i * 4 * 6144;
    const float* xcur = (i == 0 && lp < 7) ? P(x) : P(out);
    if constexpr (lp == 0) ph_norm(xcur, P(ln_mix_g) + i * D, mod, 0, 1024, H);
    const bf16_t* WTL = (const bf16_t*)(P(ws) + WS_WT + (size_t)i * WT_LAYER);
    PG8_LAS unsigned char* l3 = (PG8_LAS unsigned char*)lds;
    if constexpr (lp == 1) {
      constexpr int N = nsa ? NSA_P : DIFF_IN;
      pg8::Gemm g{H, WTL, T, N, D}; pg8::StaticOrder S; S.init(T, N, gdim_(), bid_());
      pg8::EpiBf16<0> E{PROJ, N};
      pg8::gemm_phase<pg8::EpiBf16<0>, pg8::StaticOrder, true, true>(l3, g, S, E);
    }
    if constexpr (lp == 2) { if constexpr (nsa) { ph_post_nsa(j, PROJ, OC); ph_compress(j, lds); } else ph_post_diff(j, PROJ); }
    if constexpr (lp == 3) { if constexpr (nsa) { ph_cmp_attn(lds); __syncthreads(); ph_attn_win_fast(lds); } else ph_attn_diff_fast(lds); }
    if constexpr (lp == 4) { if constexpr (nsa) ph_attn_sel_fast(lds); else did = false; }
    if constexpr (lp == 5) { if constexpr (nsa) ph_combine_nsa(j); else ph_combine_diff(j); }
    if constexpr (lp == 6) {
      pg8::Gemm g{OC, WTL + WT_OUT / 2, T, D, D}; pg8::StaticOrder S; S.init(T, D, gdim_(), bid_());
      pg8::EpiResid E{xcur, P(out), mod + 2048};
      pg8::gemm_phase<pg8::EpiResid, pg8::StaticOrder, true, true>(l3, g, S, E);
    }
    if constexpr (lp == 7) ph_norm(P(out), P(ln_mlp_g) + i * D, mod, 3072, 4096, H);
    if constexpr (lp == 8) {
      pg8::Gemm g{H, WTL + WT_MI / 2, T, DFF, D}; pg8::StaticOrder S; S.init(T, DFF, gdim_(), bid_());
      pg8::EpiBf16<2> E{HID, DFF};
      pg8::gemm_phase<pg8::EpiBf16<2>, pg8::StaticOrder, true, true>(l3, g, S, E);
    }
    if constexpr (lp == 9) {
      pg8::Gemm g{HID, WTL + WT_MO / 2, T, D, DFF}; pg8::StaticOrder S; S.init(T, D, gdim_(), bid_());
      pg8::EpiResid E{P(out), P(out), mod + 5120};
      pg8::gemm_phase<pg8::EpiResid, pg8::StaticOrder, true, true>(l3, g, S, E);
    }
  }
  if (did && PH + 1 < hi) { if (PH == 0) cg::this_grid().sync(); else xcd_barrier(bar); }
}
template <int... I> __device__ __forceinline__ void run_all(std::integer_sequence<int, I...>, unsigned char* lds, int lo, int hi, const XcdBarrier& bar) { (run_phase<I>(lds, lo, hi, bar), ...); }
__global__ void __launch_bounds__(NTHR) fwd_kernel(Params p) {
  extern __shared__ __attribute__((aligned(16))) unsigned char lds[];
  volatile __attribute__((address_space(3))) unsigned* misc = (volatile __attribute__((address_space(3))) unsigned*)((__attribute__((address_space(3))) unsigned char*)lds + MISC_OFF);
  if (tid_() < 16) misc[tid_()] = 0u;
  __syncthreads();
  const XcdBarrier bar = xcd_barrier_post((unsigned*)(P(ws) + WS_CTL) + CW_BAR, misc);
  run_all(std::make_integer_sequence<int, N_PHASES>{}, lds, p.ph_lo, p.ph_hi, bar);
}

extern "C" void kernel_launch(void* const* d_in, const int* in_sizes, int n_in, void* d_out, int out_size, void* d_ws, size_t ws_size, hipStream_t stream) {
  static int grid = 0;
  if (grid == 0) {
    if (n_in != 29 || out_size != T * D || ws_size < WS_END) { fprintf(stderr, "kernel_launch: unexpected problem (n_in %d, out %d, ws %zu)\n", n_in, out_size, ws_size); grid = -1; return; }
    int dev = 0, cus = 0, per_cu = 0;
    hipGetDevice(&dev); hipDeviceGetAttribute(&cus, hipDeviceAttributeMultiprocessorCount, dev);
    hipFuncSetAttribute((const void*)fwd_kernel, hipFuncAttributeMaxDynamicSharedMemorySize, LDS_BYTES);
    hipOccupancyMaxActiveBlocksPerMultiprocessor(&per_cu, (const void*)fwd_kernel, NTHR, LDS_BYTES);
    if (per_cu < 1) { fprintf(stderr, "kernel_launch: occupancy query says %d blocks/CU\n", per_cu); per_cu = 1; }
    grid = cus * 1;
    (void)hipGetLastError();
  }
  if (grid < 0) return;
  if (hipMemsetAsync((char*)d_ws + WS_CTL, 0, CTL_ZERO_BYTES, stream) != hipSuccess) { fprintf(stderr, "kernel_launch: memset failed\n"); return; }
  Params p{};
  memcpy((void*)&p, (const void*)d_in, 29 * sizeof(void*));
  p.out = (float*)d_out; p.ws = (unsigned char*)d_ws; p.ph_lo = 0; p.ph_hi = N_PHASES;
  void* args[] = {&p};
  hipError_t e = hipLaunchCooperativeKernel((const void*)fwd_kernel, dim3(grid), dim3(NTHR), args, LDS_BYTES, stream);
  if (e != hipSuccess) fprintf(stderr, "cooperative launch failed: %s (grid %d)\n", hipGetErrorString(e), grid);
}
```

```cpp
#include <hip/hip_runtime.h>
#include <hip/hip_cooperative_groups.h>
#include <hip/hip_bf16.h>
#include <cstdio>
#include <cstdint>
#include <cstring>
#include <utility>
namespace cg = cooperative_groups;

typedef unsigned short bf16_t;
typedef unsigned long long u64;

constexpr int D = 1024, NB = 4, S = 4096, T = NB * S, DFF = 4096;
constexpr int NSA_IN = 2608, NSA_P = 2816, DIFF_IN = 3072;
constexpr float EPS = 1e-6f;
constexpr float C2 = 0.125f * 1.4426950408889634f;
constexpr int NTHR = 512;
constexpr int LDS_BYTES = 147456;

constexpr size_t MiB = 1u << 20;
constexpr size_t WS_CTL = 0, CTL_ZERO_BYTES = 1 * MiB;
constexpr int CW_BAR = 4096;
constexpr int MISC_OFF = LDS_BYTES - 64;
constexpr size_t WS_MOD = 1 * MiB;
constexpr size_t WS_ROPE = 2 * MiB;
constexpr size_t WS_SMALL = 3 * MiB;
constexpr size_t WS_WT = 4 * MiB;
constexpr size_t WT_LAYER = 24 * MiB, WT_OUT = 6 * MiB, WT_MI = 8 * MiB, WT_MO = 16 * MiB;
constexpr size_t WS_W1T = 100 * MiB;
constexpr size_t WS_H = 104 * MiB;
constexpr size_t WS_PROJ = 136 * MiB;
constexpr size_t WS_ATT = 232 * MiB;
constexpr size_t WS_OC = 328 * MiB;
constexpr size_t WS_KCMP = 360 * MiB;
constexpr size_t WS_VCMP = 361 * MiB;
constexpr size_t WS_SEL = 362 * MiB;
constexpr size_t WS_HID = 136 * MiB;
constexpr size_t WS_END = 364 * MiB;

struct Params {
  const float* x; const float* c; const int* pos; const float* ln_mix_g; const float* ln_mlp_g;
  const float* w_ada; const float* b_ada; const float* w_mlp_in; const float* w_mlp_out;
  const float* nsa_w_in; const float* nsa_b_gate; const float* nsa_q_gain; const float* nsa_k_gain;
  const float* nsa_pe_k; const float* nsa_w_ck1; const float* nsa_w_ck2; const float* nsa_pe_v; const float* nsa_w_cv1; const float* nsa_w_cv2; const float* nsa_w_out;
  const float* diff_w_in; const float* diff_q_gain; const float* diff_k_gain; const float* diff_lq1; const float* diff_lk1; const float* diff_lq2; const float* diff_lk2; const float* diff_subln_g; const float* diff_w_out;
  float* out; unsigned char* ws; int ph_lo, ph_hi;
};

typedef __attribute__((address_space(4))) const unsigned char* kptr_t;
template <class Tp> __device__ __forceinline__ Tp karg_load(unsigned off) {
  asm volatile("" : "+s"(off));
  kptr_t kp = (kptr_t)__builtin_amdgcn_kernarg_segment_ptr();
  return *(const __attribute__((address_space(4))) Tp*)(kp + off);
}
__device__ __forceinline__ int tid_() { int t = (int)threadIdx.x; asm volatile("" : "+v"(t)); return t; }
__device__ __forceinline__ int bid_() { int t = (int)blockIdx.x; asm volatile("" : "+s"(t)); return t; }
__device__ __forceinline__ int gdim_() { int t = (int)gridDim.x; asm volatile("" : "+s"(t)); return t; }
#define P(m) karg_load<decltype(Params::m)>((unsigned)offsetof(Params, m))
__device__ __forceinline__ float bf2f(unsigned v) { return __uint_as_float(v << 16); }
__device__ __forceinline__ unsigned f2bf(float f) { unsigned u = __float_as_uint(f); return (u + 0x7fffu + ((u >> 16) & 1u)) >> 16; }
__device__ __forceinline__ unsigned pk2(float lo, float hi) { return f2bf(lo) | (f2bf(hi) << 16); }
__device__ __forceinline__ void unpack8(const uint4 v, float* f) {
  f[0] = bf2f(v.x & 0xffffu); f[1] = bf2f(v.x >> 16); f[2] = bf2f(v.y & 0xffffu); f[3] = bf2f(v.y >> 16);
  f[4] = bf2f(v.z & 0xffffu); f[5] = bf2f(v.z >> 16); f[6] = bf2f(v.w & 0xffffu); f[7] = bf2f(v.w >> 16);
}
__device__ __forceinline__ uint4 pack8(const float* f) { uint4 v; v.x = pk2(f[0], f[1]); v.y = pk2(f[2], f[3]); v.z = pk2(f[4], f[5]); v.w = pk2(f[6], f[7]); return v; }
__device__ __forceinline__ float wave_sum(float v) {
#pragma unroll
  for (int o = 1; o < 64; o <<= 1) v += __shfl_xor(v, o);
  return v;
}
__device__ __forceinline__ float lam_init_of(int j) { return j == 0 ? 0.35550906759096934f : 0.5560582041556406f; }

namespace pg8 {
#define PG8_LAS __attribute__((address_space(3)))
typedef unsigned short bf16_t;
typedef short bf16x8 __attribute__((ext_vector_type(8)));
typedef float f32x4 __attribute__((ext_vector_type(4)));
typedef unsigned u32x4 __attribute__((ext_vector_type(4)));
constexpr int BM = 256, BK = 64, HALF = 128, HTB = HALF * BK * 2  , STAGE_BYTES = 8 * HTB, NXCD = 8, WGM = 8;

__host__ __device__ __forceinline__ int lds_byte(int r, int c) { const int st = (r >> 4) * 2 + (c >> 5), rr = r & 15, cc = c & 31, ob = rr * 64 + cc * 2; return st * 1024 + (ob ^ (((ob >> 9) & 1) << 5)); }
__host__ __device__ __forceinline__ void stage_rc(int b, int& R, int& C) { const int st = b / 1024, sb = b % 1024, swz = sb ^ (((sb >> 9) & 1) << 5); R = (st >> 1) * 16 + swz / 64; C = (st & 1) * 32 + (swz % 64) / 2; }
__host__ __device__ __forceinline__ int perm32(int rho) { const int n = rho >> 4, i = rho & 15; return 8 * (i >> 2) + 4 * n + (i & 3); }

struct Unit { int pm, pn; };
struct Gemm { const bf16_t* A; const bf16_t* Bt; int M, N, K; };

struct StaticOrder {
    int nM, nN, nwg, G, c;
    __host__ __device__ void init(int M, int N, int G_, int c_) { nM = M / BM; nN = N / BM; nwg = nM * nN; G = G_; c = c_; }
    __host__ __device__ bool next(int i, Unit& u) const {
        const long L = (long)i * G + c; if (L >= nwg) return false;
        int wgid = (int)L; { const int q = nwg / NXCD, r = nwg % NXCD, xcd = wgid % NXCD, off = wgid / NXCD; wgid = (xcd < r ? xcd * (q + 1) : r * (q + 1) + (xcd - r) * q) + off; }
        const int nig = WGM * nN, gid = wgid / nig, fm = gid * WGM, gsz = (nM - fm) < WGM ? (nM - fm) : WGM;
        u.pm = fm + ((wgid % nig) % gsz); u.pn = (wgid % nig) / gsz; return true;
    }
    __device__ __forceinline__ void a_ready(const Unit&) const {}
    __device__ __forceinline__ void done(const Unit&) const {}
};


__device__ __forceinline__ unsigned cvt_pk_bf16(float lo, float hi) { unsigned r; asm volatile("v_cvt_pk_bf16_f32 %0, %1, %2" : "=v"(r) : "v"(lo), "v"(hi)); return r; }
template <int ACT  > struct EpiBf16 {
    static constexpr bool PERM = true, AFTER_DRAIN = false;
    bf16_t* O; int ldc;
    __device__ __forceinline__ void operator()(const f32x4 (&acc)[2][2][4][2], const Unit& u, int wr, int wc, int fr, int fq) const {
        const int row0 = u.pm * BM + wr * 64 + fr; const int col0 = u.pn * BM + wc * 32 + 8 * fq;
#pragma unroll
        for (int ai = 0; ai < 2; ++ai)
#pragma unroll
            for (int m = 0; m < 4; ++m) { bf16_t* rowp = O + (size_t)(row0 + ai * HALF + m * 16) * ldc + col0;
#pragma unroll
                for (int bj = 0; bj < 2; ++bj) { f32x4 v0 = acc[ai][bj][m][0], v1 = acc[ai][bj][m][1];
                    if (ACT == 2) {
#pragma unroll
                        for (int e = 0; e < 4; ++e) { float a = v0[e] > 0.f ? v0[e] : 0.f; v0[e] = a * a; float b = v1[e] > 0.f ? v1[e] : 0.f; v1[e] = b * b; } }
                    u32x4 w; w.x = cvt_pk_bf16(v0[0], v0[1]); w.y = cvt_pk_bf16(v0[2], v0[3]); w.z = cvt_pk_bf16(v1[0], v1[1]); w.w = cvt_pk_bf16(v1[2], v1[3]);
                    *(u32x4*)(rowp + bj * HALF) = w; } }
    }
};
struct EpiResid {
    static constexpr bool PERM = false, AFTER_DRAIN = false;
    const float* xin; float* xout; const float* gate;
    __device__ __forceinline__ void operator()(const f32x4 (&acc)[2][2][4][2], const Unit& u, int wr, int wc, int fr, int fq) const {
        const int col0 = u.pn * BM + wc * 32 + 4 * fq; const int b = (u.pm * BM) >> 12;
        f32x4 gv[2][2];
#pragma unroll
        for (int bj = 0; bj < 2; ++bj)
#pragma unroll
            for (int n = 0; n < 2; ++n) gv[bj][n] = *(const f32x4*)(gate + (size_t)b * 6144 + col0 + bj * HALF + n * 16);
#pragma unroll
        for (int ai = 0; ai < 2; ++ai)
#pragma unroll
            for (int m = 0; m < 4; ++m) { const size_t off = (size_t)(u.pm * BM + ai * HALF + wr * 64 + m * 16 + fr) * 1024 + col0;
#pragma unroll
                for (int bj = 0; bj < 2; ++bj)
#pragma unroll
                    for (int n = 0; n < 2; ++n) { const f32x4 xi = *(const f32x4*)(xin + off + bj * HALF + n * 16); *(f32x4*)(xout + off + bj * HALF + n * 16) = xi + gv[bj][n] * acc[ai][bj][m][n]; }
                if (m & 1) asm volatile("" ::: "memory"); }
    }
};

template <class Epi, class Sched, bool ALIGN_EPI = false, bool SP2 = false>
__device__ __forceinline__ void gemm_phase(PG8_LAS unsigned char* lds, const Gemm g, const Sched& S, const Epi& E) {
    const int tid = tid_(), wid = __builtin_amdgcn_readfirstlane(tid >> 6), lane = tid & 63, wr = wid >> 2, wc = wid & 3, fr = lane & 15, fq = lane >> 4;
    const int K = g.K, nt = K / BK;
    unsigned voffA[2], voffB[2];
#pragma unroll
    for (int i = 0; i < 2; ++i) { int R, C; stage_rc(tid * 16 + i * 8192, R, C); const int Rb = Epi::PERM ? ((R & ~31) + perm32(R & 31)) : R;
        voffA[i] = (unsigned)(R * K + C) * 2u; voffB[i] = (unsigned)(Rb * K + C) * 2u; }
    const size_t kstep = (size_t)(BK * 2);
    const size_t hstep = (size_t)HALF * K * 2;
    const size_t tstep = 2 * hstep;
    const unsigned ldsw = (unsigned)wid * 1024u;
    const int aoff = lds_byte(wr * 64 + fr, fq * 8), boff = lds_byte(wc * 32 + fr, fq * 8);
#define PG8_SA(b, h) (((b) * 2 + (h)) * HTB)
#define PG8_SB(b, h) ((4 + (b) * 2 + (h)) * HTB)
#define PG8_STAGE(bufoff, gbase, voff) do { _Pragma("unroll") for (int _i = 0; _i < 2; ++_i) \
        __builtin_amdgcn_global_load_lds((const unsigned*)((const char*)(gbase) + (voff)[_i]), (PG8_LAS unsigned*)(lds + (bufoff) + ldsw + _i * 8192), 16, 0, 0); } while (0)
#define PG8_LDA(dst, b, h) do { _Pragma("unroll") for (int m = 0; m < 4; ++m) _Pragma("unroll") for (int k = 0; k < 2; ++k) dst[m][k] = *(const PG8_LAS bf16x8*)(lds + PG8_SA(b, h) + aoff + m * 2048 + k * 1024); } while (0)
#define PG8_LDB(dst, b, h) do { _Pragma("unroll") for (int n = 0; n < 2; ++n) _Pragma("unroll") for (int k = 0; k < 2; ++k) dst[n][k] = *(const PG8_LAS bf16x8*)(lds + PG8_SB(b, h) + boff + n * 2048 + k * 1024); } while (0)
#define PG8_MMA(ai, bj, At, Bt) do { __builtin_amdgcn_s_setprio(1); _Pragma("unroll") for (int m = 0; m < 4; ++m) _Pragma("unroll") for (int n = 0; n < 2; ++n) _Pragma("unroll") for (int k = 0; k < 2; ++k) \
        acc[ai][bj][m][n] = __builtin_amdgcn_mfma_f32_16x16x32_bf16(Bt[n][k], At[m][k], acc[ai][bj][m][n], 0, 0, 0); __builtin_amdgcn_s_setprio(0); } while (0)
#define PG8_WAIT_V(n) asm volatile("s_waitcnt vmcnt(" #n ")" ::: "memory")
#define PG8_WAIT_L(n) asm volatile("s_waitcnt lgkmcnt(" #n ")" ::: "memory")
#define PG8_BAR __builtin_amdgcn_s_barrier()
#define PG8_SCHED __builtin_amdgcn_sched_barrier(0)
    Unit cur, nxt; int ui = 0;
    if (!S.next(0, cur)) return;
    f32x4 acc[2][2][4][2];
#pragma unroll
    for (int a = 0; a < 2; ++a)
#pragma unroll
        for (int b = 0; b < 2; ++b)
#pragma unroll
            for (int m = 0; m < 4; ++m)
#pragma unroll
                for (int n = 0; n < 2; ++n) acc[a][b][m][n] = (f32x4){0.f, 0.f, 0.f, 0.f};
    bf16x8 At[4][2], B0[2][2], B1[2][2];
    const char* cA = (const char*)g.A + (size_t)cur.pm * tstep; const char* cB = (const char*)g.Bt + (size_t)cur.pn * tstep;
    S.a_ready(cur);
    if constexpr (SP2) {
        PG8_STAGE(PG8_SB(0, 0), cB, voffB); PG8_STAGE(PG8_SB(0, 1), cB + hstep, voffB); PG8_STAGE(PG8_SA(0, 0), cA, voffA); PG8_STAGE(PG8_SA(0, 1), cA + hstep, voffA);
        if (wr == 1) PG8_BAR;
        PG8_WAIT_V(2); PG8_BAR;
        PG8_STAGE(PG8_SB(1, 0), cB + kstep, voffB); PG8_STAGE(PG8_SA(1, 0), cA + kstep, voffA); PG8_STAGE(PG8_SB(1, 1), cB + hstep + kstep, voffB);
        PG8_WAIT_V(6); PG8_BAR;
    } else {
        PG8_STAGE(PG8_SB(0, 0), cB, voffB); PG8_STAGE(PG8_SA(0, 0), cA, voffA); PG8_STAGE(PG8_SB(0, 1), cB + hstep, voffB); PG8_STAGE(PG8_SA(0, 1), cA + hstep, voffA);
        if (wr == 1) PG8_BAR;
        PG8_WAIT_V(4); PG8_BAR;
        PG8_STAGE(PG8_SB(1, 0), cB + kstep, voffB); PG8_STAGE(PG8_SA(1, 0), cA + kstep, voffA); PG8_STAGE(PG8_SB(1, 1), cB + hstep + kstep, voffB);
        PG8_WAIT_V(6); PG8_BAR;
    }
    for (;;) {
        const bool has_next = S.next(ui + 1, nxt);
        const char* nA = has_next ? (const char*)g.A + (size_t)nxt.pm * tstep : cA; const char* nB = has_next ? (const char*)g.Bt + (size_t)nxt.pn * tstep : cB;
        for (int t = 0; t < nt; t += 2) {
            const bool last = (t == nt - 2);
            const char* a1 = cA + (size_t)(t + 1) * kstep;
            const char* a2 = last ? nA : cA + (size_t)(t + 2) * kstep; const char* b2 = last ? nB : cB + (size_t)(t + 2) * kstep;
            const char* a3 = a2 + kstep; const char* b3 = b2 + kstep;
            if (last && has_next) S.a_ready(nxt);
            if constexpr (SP2) {
            PG8_LDB(B0, 0, 0); PG8_LDB(B1, 0, 1); PG8_SCHED; PG8_LDA(At, 0, 0); PG8_STAGE(PG8_SA(1, 1), a1 + hstep, voffA);
            PG8_WAIT_V(8); PG8_WAIT_L(0); PG8_BAR; PG8_MMA(0, 0, At, B0); PG8_MMA(0, 1, At, B1); PG8_BAR; PG8_SCHED;
            PG8_LDA(At, 0, 1); PG8_STAGE(PG8_SB(0, 0), b2, voffB); PG8_STAGE(PG8_SB(0, 1), b2 + hstep, voffB); PG8_STAGE(PG8_SA(0, 0), a2, voffA);
            PG8_WAIT_V(8); PG8_WAIT_L(0); PG8_BAR; PG8_MMA(1, 0, At, B0); PG8_MMA(1, 1, At, B1); PG8_BAR; PG8_SCHED;
            PG8_LDB(B0, 1, 0); PG8_LDB(B1, 1, 1); PG8_SCHED; PG8_LDA(At, 1, 0); PG8_STAGE(PG8_SA(0, 1), a2 + hstep, voffA);
            PG8_WAIT_V(8); PG8_WAIT_L(0); PG8_BAR; PG8_MMA(0, 0, At, B0); PG8_MMA(0, 1, At, B1); PG8_BAR; PG8_SCHED;
            PG8_LDA(At, 1, 1); PG8_STAGE(PG8_SB(1, 0), b3, voffB); PG8_STAGE(PG8_SB(1, 1), b3 + hstep, voffB); PG8_STAGE(PG8_SA(1, 0), a3, voffA);
            PG8_WAIT_V(8); PG8_WAIT_L(0); PG8_BAR; PG8_MMA(1, 0, At, B0); PG8_MMA(1, 1, At, B1); PG8_BAR; PG8_SCHED;
            } else {
            PG8_LDB(B0, 0, 0); PG8_SCHED; PG8_LDA(At, 0, 0); PG8_STAGE(PG8_SA(1, 1), a1 + hstep, voffA);
            PG8_WAIT_L(8); PG8_BAR; PG8_WAIT_L(0); PG8_MMA(0, 0, At, B0); PG8_BAR; PG8_SCHED;
            PG8_LDB(B1, 0, 1); PG8_STAGE(PG8_SB(0, 0), b2, voffB);
            PG8_BAR; PG8_WAIT_L(0); PG8_MMA(0, 1, At, B1); PG8_BAR;
            PG8_LDA(At, 0, 1); PG8_STAGE(PG8_SA(0, 0), a2, voffA);
            PG8_BAR; PG8_WAIT_L(0); PG8_MMA(1, 0, At, B0); PG8_BAR; PG8_SCHED;
            PG8_STAGE(PG8_SB(0, 1), b2 + hstep, voffB);
            PG8_WAIT_V(6); PG8_BAR; PG8_MMA(1, 1, At, B1); PG8_BAR;
            PG8_LDB(B0, 1, 0); PG8_SCHED; PG8_LDA(At, 1, 0); PG8_STAGE(PG8_SA(0, 1), a2 + hstep, voffA);
            PG8_WAIT_L(8); PG8_BAR; PG8_WAIT_L(0); PG8_MMA(0, 0, At, B0); PG8_BAR; PG8_SCHED;
            PG8_LDB(B1, 1, 1); PG8_STAGE(PG8_SB(1, 0), b3, voffB);
            PG8_BAR; PG8_WAIT_L(0); PG8_MMA(0, 1, At, B1); PG8_BAR;
            PG8_LDA(At, 1, 1); PG8_STAGE(PG8_SA(1, 0), a3, voffA);
            PG8_BAR; PG8_WAIT_L(0); PG8_MMA(1, 0, At, B0); PG8_BAR; PG8_SCHED;
            PG8_STAGE(PG8_SB(1, 1), b3 + hstep, voffB);
            PG8_WAIT_V(6); PG8_BAR; PG8_MMA(1, 1, At, B1); PG8_BAR;
            }
        }
        if constexpr (ALIGN_EPI) { if (wr == 0) PG8_BAR; }
        if constexpr (!Epi::AFTER_DRAIN) { E(acc, cur, wr, wc, fr, fq); S.done(cur); }
        if (!has_next) break;
#pragma unroll
        for (int a = 0; a < 2; ++a)
#pragma unroll
            for (int b = 0; b < 2; ++b)
#pragma unroll
                for (int m = 0; m < 4; ++m)
#pragma unroll
                    for (int n = 0; n < 2; ++n) acc[a][b][m][n] = (f32x4){0.f, 0.f, 0.f, 0.f};
        cur = nxt; cA = nA; cB = nB; ++ui;
        if constexpr (ALIGN_EPI) { if (wr == 1) PG8_BAR; }
    }
    PG8_WAIT_V(0);
    if constexpr (!ALIGN_EPI) { if (wr == 0) PG8_BAR; }
    PG8_BAR;
    if constexpr (Epi::AFTER_DRAIN) { E.fused(acc, cur, wr, wc, fr, fq, lds, wid, lane); S.done(cur); }
#undef PG8_SA
#undef PG8_SB
#undef PG8_STAGE
#undef PG8_LDA
#undef PG8_LDB
#undef PG8_MMA
#undef PG8_WAIT_V
#undef PG8_WAIT_L
#undef PG8_BAR
#undef PG8_SCHED
}
}

namespace attn_body {
using bf16=__hip_bfloat16;
using bf16x8=__attribute__((ext_vector_type(8)))short;
using s16x4=__attribute__((ext_vector_type(4)))short;
using f32x16=__attribute__((ext_vector_type(16)))float;
using u32x4=__attribute__((ext_vector_type(4)))unsigned;
constexpr int D=64;
constexpr int NW=8,QBLK=32,QB=QBLK*NW,KVBLK=64;
__device__ __forceinline__ int crow(int r,int hi){return (r&3)+8*(r>>2)+4*hi;}
#define SBAR() __builtin_amdgcn_sched_barrier(0)
__device__ __forceinline__ void cmask(f32x16&p0,f32x16&p1,int jb,int qrel,int hi){
  const float NEG=-INFINITY; int kb=64*jb+4*hi;
  #pragma unroll
  for(int r=0;r<16;++r){int kv=kb+(r&3)+8*(r>>2); if(kv>qrel)p0[r]=NEG; if(kv+32>qrel)p1[r]=NEG;}
}

__device__ __forceinline__ void lmask(f32x16&p0,f32x16&p1,int t,int qrel,int hi){
  const float NEG=-30000.f; int kb=64*t+4*hi;
  #pragma unroll
  for(int r=0;r<16;++r){int kv=kb+(r&3)+8*(r>>2); if(kv<=qrel)p0[r]=NEG; if(kv+32<=qrel)p1[r]=NEG;}
}
__device__ __forceinline__ void smask(f32x16&p0,f32x16&p1,bool on){
  const float NEG=-INFINITY;
  #pragma unroll
  for(int r=0;r<16;++r){ p0[r]=on?p0[r]:NEG; p1[r]=on?p1[r]:NEG; }
}
constexpr int NSLOT=3, SLOTB=8192;
constexpr int LDS_K=0, LDS_V=NSLOT*SLOTB, LDS_WS=2*NSLOT*SLOTB, LDS_OST=LDS_WS+NW*64*4, LDS_BYTES=LDS_OST+NW*4096;
constexpr float C2=0.125f*1.4426950408889634f;
__device__ __forceinline__ void glds16(const void*gsrc,unsigned lds_dst){unsigned keep;
  asm volatile("s_mov_b32 %0, m0\n\ts_mov_b32 m0, %2\n\ts_nop 0\n\tglobal_load_lds_dwordx4 %1, off\n\ts_mov_b32 m0, %0":"=&s"(keep):"v"(gsrc),"s"(lds_dst):"memory");}
__device__ __forceinline__ float max3f(float a,float b,float c){float r;asm("v_max3_f32 %0, %1, %2, %3":"=v"(r):"v"(a),"v"(b),"v"(c));return r;}
__device__ __forceinline__ float max2f(float a,float b){float r;asm("v_max_f32_e32 %0, %1, %2":"=v"(r):"v"(a),"v"(b));return r;}
__device__ __forceinline__ float fadd_s(float a,float b){float r;asm("v_add_f32_e32 %0, %1, %2":"=v"(r):"v"(a),"v"(b));return r;}
__device__ __forceinline__ float fsub_s(float a,float b){float r;asm("v_sub_f32_e32 %0, %1, %2":"=v"(r):"v"(a),"v"(b));return r;}
typedef float f32x2_t __attribute__((ext_vector_type(2))); typedef __bf16 bf16x2_t __attribute__((ext_vector_type(2)));
__device__ __forceinline__ unsigned cvtpk_s(float lo,float hi){f32x2_t v={lo,hi};bf16x2_t b=__builtin_convertvector(v,bf16x2_t);return __builtin_bit_cast(unsigned,b);}
#define WAIT_BAR(N) asm volatile("s_waitcnt vmcnt(" #N ") lgkmcnt(0)\n\ts_barrier":::"memory")

__device__ __forceinline__ void qkt(f32x16&p0,f32x16&p1,const char*Kslot,const bf16x8*qr,const f32x16&negm,int r32,int hi){
  const char*kb=Kslot+hi*1024+r32*16;
  #pragma unroll
  for(int d0=0;d0<4;++d0){
    const bf16x8 b0=*reinterpret_cast<const bf16x8*>(kb+d0*2048);
    const bf16x8 b1=*reinterpret_cast<const bf16x8*>(kb+d0*2048+512);
    if(d0==0){p0=__builtin_amdgcn_mfma_f32_32x32x16_bf16(b0,qr[0],negm,0,0,0);p1=__builtin_amdgcn_mfma_f32_32x32x16_bf16(b1,qr[0],negm,0,0,0);}
    else{p0=__builtin_amdgcn_mfma_f32_32x32x16_bf16(b0,qr[d0],p0,0,0,0);p1=__builtin_amdgcn_mfma_f32_32x32x16_bf16(b1,qr[d0],p1,0,0,0);}}
}
typedef __attribute__((address_space(3))) const char* lds_cptr;
typedef short v4i16_t __attribute__((ext_vector_type(4)));
__device__ __forceinline__ void kload8(bf16x8*kf,lds_cptr kp){
  kf[0]=*(const __attribute__((address_space(3))) bf16x8*)(kp);      kf[1]=*(const __attribute__((address_space(3))) bf16x8*)(kp+512);
  kf[2]=*(const __attribute__((address_space(3))) bf16x8*)(kp+2048); kf[3]=*(const __attribute__((address_space(3))) bf16x8*)(kp+2560);
  kf[4]=*(const __attribute__((address_space(3))) bf16x8*)(kp+4096); kf[5]=*(const __attribute__((address_space(3))) bf16x8*)(kp+4608);
  kf[6]=*(const __attribute__((address_space(3))) bf16x8*)(kp+6144); kf[7]=*(const __attribute__((address_space(3))) bf16x8*)(kp+6656);
}
__device__ __forceinline__ void kload2(bf16x8*kf,lds_cptr kp,int j){ kf[2*j]=*(const __attribute__((address_space(3))) bf16x8*)(kp+j*2048); kf[2*j+1]=*(const __attribute__((address_space(3))) bf16x8*)(kp+j*2048+512); }
__device__ __forceinline__ s16x4 vtr(lds_cptr p){ return __builtin_bit_cast(s16x4,__builtin_amdgcn_ds_read_tr16_b64_v4i16((__attribute__((address_space(3))) v4i16_t*)p)); }
__device__ __forceinline__ float rowmax(const f32x16&p0,const f32x16&p1){
  float a=max3f(p0[0],p0[1],p1[0]),b=max3f(p0[2],p0[3],p1[1]);a=max3f(a,p1[2],p1[3]);
  #pragma unroll
  for(int r=4;r<16;r+=4){a=max3f(a,p0[r],p0[r+1]);b=max3f(b,p0[r+2],p0[r+3]);a=max3f(a,p1[r],p1[r+1]);b=max3f(b,p1[r+2],p1[r+3]);}
  const float m=max2f(a,b);
  auto rr=__builtin_amdgcn_permlane32_swap(__float_as_uint(m),__float_as_uint(m),false,false);
  return max2f(__uint_as_float(rr[0]),__uint_as_float(rr[1]));
}
__device__ __forceinline__ void pv(f32x16*o,int vb,bf16x8 pa0,bf16x8 pa1,bf16x8 pa2,bf16x8 pa3){
  #pragma unroll
  for(int d0=0;d0<2;++d0){s16x4 lo[4],hi[4];
    #pragma unroll
    for(int ks=0;ks<4;++ks){
      asm volatile("ds_read_b64_tr_b16 %0,%1 offset:%c2":"=&v"(lo[ks]):"v"(vb),"i"(d0*4096+ks*1024):"memory");
      asm volatile("ds_read_b64_tr_b16 %0,%1 offset:%c2":"=&v"(hi[ks]):"v"(vb),"i"(d0*4096+ks*1024+512):"memory");}
    asm volatile("s_waitcnt lgkmcnt(0)":::"memory");SBAR();
    #define PK(k) (bf16x8){lo[k][0],lo[k][1],lo[k][2],lo[k][3],hi[k][0],hi[k][1],hi[k][2],hi[k][3]}
    o[d0]=__builtin_amdgcn_mfma_f32_32x32x16_bf16(pa0,PK(0),o[d0],0,0,0);
    o[d0]=__builtin_amdgcn_mfma_f32_32x32x16_bf16(pa1,PK(1),o[d0],0,0,0);
    o[d0]=__builtin_amdgcn_mfma_f32_32x32x16_bf16(pa2,PK(2),o[d0],0,0,0);
    o[d0]=__builtin_amdgcn_mfma_f32_32x32x16_bf16(pa3,PK(3),o[d0],0,0,0);
    #undef PK
  }
}

#ifndef ATTN_STORE16
#define ATTN_STORE16(p,v) (*(u32x4*)(p)=(v))
#endif
template<int THRL,int MODE> __device__ __forceinline__ void attn_unit(long rowbase,int qb,const bf16*Qh,int ldq,const bf16*__restrict__ Kh0,const bf16*__restrict__ Vh0,int ldkv,bf16*Oh,int ldo,const unsigned long long*selrow,char*shm){
  const int tid=tid_(),lane=tid&63,r32=lane&31,hi=lane>>5; const int wid=__builtin_amdgcn_readfirstlane(tid>>6);
  const int q0=qb*QB;
  int t_lo=0; bool lower=false; if(MODE==2){ if(qb>=2){ t_lo=4*qb-8; lower=true; } }
  const bf16*Qw=Qh+(rowbase+q0+wid*QBLK)*ldq;
  const bf16*Kh=Kh0+(rowbase+(long)t_lo*KVBLK)*ldkv,*Vh=Vh0+(rowbase+(long)t_lo*KVBLK)*ldkv;
  const unsigned lds0=(unsigned)(uintptr_t)shm;
  float*wsf=(float*)(shm+LDS_WS)+wid*64;
  const bf16*ksrc=Kh+(long)lane*ldkv+wid*8;
  const bf16*vsrc=Vh+(long)(16*(wid&3)+(lane>>2))*ldkv+(wid>>2)*32+(lane&3)*8;
  const unsigned kdst=lds0+LDS_K+wid*1024, vdst=lds0+LDS_V+wid*1024;
  #define DMA_K(t,slot) glds16(ksrc+(long)(t)*KVBLK*ldkv,(unsigned)__builtin_amdgcn_readfirstlane(kdst+(slot)))
  #define DMA_V(t,slot) glds16(vsrc+(long)(t)*KVBLK*ldkv,(unsigned)__builtin_amdgcn_readfirstlane(vdst+(slot)))
  const int vb0=(int)(lds0+LDS_V)+((lane>>4)&1)*32+(lane&3)*8+(4*hi+((lane&15)>>2))*64;
  const char*Kbase=shm+LDS_K; bf16x8 kf[8];
  const lds_cptr shm3=(lds_cptr)shm; const lds_cptr kp0=shm3+LDS_K+hi*1024+r32*16; const lds_cptr vp0=shm3+LDS_V+((lane>>4)&1)*32+(lane&3)*8+(4*hi+((lane&15)>>2))*64;
  const int NT=(q0+QB)/KVBLK-t_lo;
  DMA_K(0,0);DMA_V(0,0);DMA_K(1,SLOTB);
  bf16x8 qr[4];
  #pragma unroll
  for(int d0=0;d0<4;++d0)qr[d0]=*reinterpret_cast<const bf16x8*>(&Qw[(long)r32*ldq+d0*16+hi*8]);
  float mhat=0.f,l_reg=0.f;f32x16 o[2];o[0]=f32x16{};o[1]=f32x16{};f32x16 negm=f32x16{};asm volatile("":"+v"(negm));
  const int qrel=wid*QBLK+r32;
  unsigned long long msk=0ull; if(MODE==1) msk=selrow[q0+qrel];
  #define XMASK(P0,P1,t) do{ if(MODE==1) smask(P0,P1,((msk>>(t))&1ull)!=0ull); if(MODE==2){ if(lower&&(t)<4) lmask(P0,P1,(t),qrel,hi); } }while(0)
  #define CMASK(P0,P1,t) do{ XMASK(P0,P1,t); int jb_=(t)-(NT-4); if(jb_>=0)cmask(P0,P1,jb_,qrel,hi);}while(0)
  bool resc=false;
  #define START(P0,P1) do{ const float rm=rowmax(P0,P1); resc=false; \
    { const float dl=rm; mhat=fadd_s(mhat,dl); \
      _Pragma("unroll") for(int r=0;r<16;++r){P0[r]=fsub_s(P0[r],dl);P1[r]=fsub_s(P1[r],dl);} \
      _Pragma("unroll") for(int r=0;r<16;++r)negm[r]=-mhat; asm volatile("":"+v"(negm)); } \
    _Pragma("unroll") for(int r=0;r<16;++r)P0[r]=__builtin_amdgcn_exp2f(P0[r]); }while(0)
  #define RESC() do{ if(resc){ asm volatile("s_waitcnt lgkmcnt(0)":::"memory"); \
      _Pragma("unroll") for(int d_=0;d_<2;++d_) _Pragma("unroll") for(int r=0;r<16;++r)o[d_][r]*=wsf[crow(r,hi)]; } }while(0)
  f32x16 pA0,pA1,pB0,pB1;
  int sl_prev=0,sl_cur=0,sl_next=SLOTB;
  #define ROT() do{sl_prev=sl_cur;sl_cur=sl_next;sl_next=(sl_next==(NSLOT-1)*SLOTB)?0:sl_next+SLOTB;}while(0)
  DMA_K(2,2*SLOTB);
  WAIT_BAR(3);
  qkt(pA0,pA1,Kbase,qr,negm,r32,hi);asm volatile("s_nop 15\n\ts_nop 7":"+v"(pA0),"+v"(pA1));CMASK(pA0,pA1,0);
  START(pA0,pA1);
  _Pragma("unroll") for(int r=0;r<16;++r)pA1[r]=__builtin_amdgcn_exp2f(pA1[r]);
  WAIT_BAR(0);
  DMA_K(3,0);DMA_V(1,SLOTB);
  ROT();
  kload8(kf,kp0+sl_cur);
  WAIT_BAR(2);
  s16x4 vlo[8],vhi[8]; u32x4 pw0,pw1,pw2,pw3;
  #define PKW(P,B) cvtpk_s(P[B],P[B+1])
  #define PAF(k) __builtin_bit_cast(bf16x8,pw##k)
  #define VFR(i) (bf16x8){vlo[i][0],vlo[i][1],vlo[i][2],vlo[i][3],vhi[i][0],vhi[i][1],vhi[i][2],vhi[i][3]}
  #define PIN(x) asm volatile("":"+v"(x))
  #define MX3(a,b,c) __builtin_fmaxf(__builtin_fmaxf((a),(b)),(c))
  #define GAPA(MF,A0,A1,A2,A3,W0,W1,PW) do{ MF; sacc+=A0; sacc+=A1; sacc+=A2; sacc+=A3; PIN(sacc); W0; W1; PIN(PW); SBAR(); }while(0)
  #define EX(v) __builtin_amdgcn_exp2f(v)
  #define GAPB(MF,X,B) do{ MF; X[B]=EX(X[B]); X[B+1]=EX(X[B+1]); X[B+2]=EX(X[B+2]); X[B+3]=EX(X[B+3]); PIN(X); SBAR(); }while(0)
  #define VRD(i) do{ vlo[i]=vtr(vp_+(((i)>>2)*4096+((i)&3)*1024)); vhi[i]=vtr(vp_+(((i)>>2)*4096+((i)&3)*1024+512)); }while(0)
  #define KRD(G,j) do{ if(G){ kload2(kf,kp0+sl_next,j); SBAR(); } }while(0)
  #define STEP(C0,C1,P0,P1,t,GK,GV,GL) do{ SBAR(); \
    const lds_cptr vp_=vp0+sl_prev; \
    VRD(0); SBAR(); float sacc=(P0[0]+P0[1]); \
    GAPA(C0=__builtin_amdgcn_mfma_f32_32x32x16_bf16(kf[0],qr[0],negm,0,0,0), P0[2],P0[3],P0[4],P0[5],     pw0[0]=PKW(P0,0), pw0[1]=PKW(P0,2), pw0); \
    VRD(4); SBAR(); GAPA(C1=__builtin_amdgcn_mfma_f32_32x32x16_bf16(kf[1],qr[0],negm,0,0,0), P0[6],P0[7],P0[8],P0[9],     pw0[2]=PKW(P0,4), pw0[3]=PKW(P0,6), pw0); \
    VRD(1); SBAR(); GAPA(C0=__builtin_amdgcn_mfma_f32_32x32x16_bf16(kf[2],qr[1],C0,0,0,0),   P0[10],P0[11],P0[12],P0[13], pw1[0]=PKW(P0,8), pw1[1]=PKW(P0,10), pw1); \
    VRD(5); SBAR(); GAPA(C1=__builtin_amdgcn_mfma_f32_32x32x16_bf16(kf[3],qr[1],C1,0,0,0),   P0[14],P0[15],P1[0],P1[1],   pw1[2]=PKW(P0,12),pw1[3]=PKW(P0,14), pw1); \
    VRD(2); SBAR(); GAPA(C0=__builtin_amdgcn_mfma_f32_32x32x16_bf16(kf[4],qr[2],C0,0,0,0),   P1[2],P1[3],P1[4],P1[5],     pw2[0]=PKW(P1,0), pw2[1]=PKW(P1,2), pw2); \
    VRD(6); SBAR(); GAPA(C1=__builtin_amdgcn_mfma_f32_32x32x16_bf16(kf[5],qr[2],C1,0,0,0),   P1[6],P1[7],P1[8],P1[9],     pw2[2]=PKW(P1,4), pw2[3]=PKW(P1,6), pw2); \
    VRD(3); SBAR(); GAPA(C0=__builtin_amdgcn_mfma_f32_32x32x16_bf16(kf[6],qr[3],C0,0,0,0),   P1[10],P1[11],P1[12],P1[13], pw3[0]=PKW(P1,8), pw3[1]=PKW(P1,10), pw3); \
    VRD(7); SBAR(); GAPA(C1=__builtin_amdgcn_mfma_f32_32x32x16_bf16(kf[7],qr[3],C1,0,0,0),   P1[14],P1[15],0.f,0.f,       pw3[2]=PKW(P1,12),pw3[3]=PKW(P1,14), pw3); \
    l_reg+=sacc; \
    if(GK){DMA_K((t)+3,sl_cur);} if(GV){DMA_V((t)+1,sl_next);} \
    CMASK(C0,C1,t); \
    { float a=MX3(C0[0],C0[1],C1[0]),b=MX3(C0[2],C0[3],C1[1]); a=MX3(a,C1[2],C1[3]); \
      _Pragma("unroll") for(int r=4;r<16;r+=4){a=MX3(a,C0[r],C0[r+1]);b=MX3(b,C0[r+2],C0[r+3]);a=MX3(a,C1[r],C1[r+1]);b=MX3(b,C1[r+2],C1[r+3]);} \
      float rm=__builtin_fmaxf(a,b); { auto rr=__builtin_amdgcn_permlane32_swap(__float_as_uint(rm),__float_as_uint(rm),false,false); rm=__builtin_fmaxf(__uint_as_float(rr[0]),__uint_as_float(rr[1])); } \
      resc=false; \
      if(__builtin_expect(__any(rm>(float)THRL),0)){ const float dl=__builtin_fmaxf(rm,0.f); mhat+=dl; \
        _Pragma("unroll") for(int r=0;r<16;++r){C0[r]-=dl;C1[r]-=dl;} \
        _Pragma("unroll") for(int r=0;r<16;++r)negm[r]=-mhat; asm volatile("":"+v"(negm)); \
        const float f=__builtin_amdgcn_exp2f(-dl); l_reg*=f; if(hi==0)wsf[r32]=f; resc=true; } } \
    SBAR(); \
    GAPB(o[0]=__builtin_amdgcn_mfma_f32_32x32x16_bf16(PAF(0),VFR(0),o[0],0,0,0), C0,0); \
    GAPB(o[1]=__builtin_amdgcn_mfma_f32_32x32x16_bf16(PAF(0),VFR(4),o[1],0,0,0), C0,4); \
    KRD(GL,0); GAPB(o[0]=__builtin_amdgcn_mfma_f32_32x32x16_bf16(PAF(1),VFR(1),o[0],0,0,0), C0,8); \
    KRD(GL,1); GAPB(o[1]=__builtin_amdgcn_mfma_f32_32x32x16_bf16(PAF(1),VFR(5),o[1],0,0,0), C0,12); \
    KRD(GL,2); GAPB(o[0]=__builtin_amdgcn_mfma_f32_32x32x16_bf16(PAF(2),VFR(2),o[0],0,0,0), C1,0); \
    KRD(GL,3); GAPB(o[1]=__builtin_amdgcn_mfma_f32_32x32x16_bf16(PAF(2),VFR(6),o[1],0,0,0), C1,4); \
    GAPB(o[0]=__builtin_amdgcn_mfma_f32_32x32x16_bf16(PAF(3),VFR(3),o[0],0,0,0), C1,8); \
    GAPB(o[1]=__builtin_amdgcn_mfma_f32_32x32x16_bf16(PAF(3),VFR(7),o[1],0,0,0), C1,12); \
    }while(0)
  int t=1;
  #undef CMASK
  #define CMASK(P0,P1,t) XMASK(P0,P1,t)
  for(;t+5<NT;t+=2){
    STEP(pB0,pB1,pA0,pA1,t,true,true,true);     WAIT_BAR(2); RESC(); ROT();
    STEP(pA0,pA1,pB0,pB1,t+1,true,true,true);   WAIT_BAR(2); RESC(); ROT();
  }
  #undef CMASK
  #define CMASK(P0,P1,t) do{ XMASK(P0,P1,t); int jb_=(t)-(NT-4); if(jb_>=0)cmask(P0,P1,jb_,qrel,hi);}while(0)
  #define ENDW(tt) do{ if((tt)+3<NT){WAIT_BAR(2);} else if((tt)+2<NT){WAIT_BAR(1);} else {WAIT_BAR(0);} }while(0)
  for(;t+1<NT;t+=2){
    STEP(pB0,pB1,pA0,pA1,t,(t+3<NT),(t+1<NT),(t+1<NT));       ENDW(t);   RESC(); ROT();
    STEP(pA0,pA1,pB0,pB1,t+1,(t+4<NT),(t+2<NT),(t+2<NT));     ENDW(t+1); RESC(); ROT();
  }
  STEP(pB0,pB1,pA0,pA1,NT-1,false,false,false); RESC();
  { float sacc=pB0[0]+pB0[1]; _Pragma("unroll") for(int r=2;r<16;++r)sacc+=pB0[r]; _Pragma("unroll") for(int r=0;r<16;++r)sacc+=pB1[r]; l_reg+=sacc;
    pw0=(u32x4){PKW(pB0,0),PKW(pB0,2),PKW(pB0,4),PKW(pB0,6)};pw1=(u32x4){PKW(pB0,8),PKW(pB0,10),PKW(pB0,12),PKW(pB0,14)};pw2=(u32x4){PKW(pB1,0),PKW(pB1,2),PKW(pB1,4),PKW(pB1,6)};pw3=(u32x4){PKW(pB1,8),PKW(pB1,10),PKW(pB1,12),PKW(pB1,14)};
    SBAR(); pv(o,vb0+sl_cur,PAF(0),PAF(1),PAF(2),PAF(3)); }
  #undef PKW
  #undef PAF
  #undef VFR
  #undef PIN
  #undef MX3
  #undef GAPA
  #undef GAPB
  #undef EX
  #undef VRD
  #undef KRD
  #undef STEP
  #undef ENDW
  {auto rr=__builtin_amdgcn_permlane32_swap(__float_as_uint(l_reg),__float_as_uint(l_reg),false,false);l_reg=__uint_as_float(rr[0])+__uint_as_float(rr[1]);}
  if(hi==0)wsf[32+r32]=l_reg;asm volatile("s_waitcnt lgkmcnt(0)":::"memory");
  float rli[16];
  #pragma unroll
  for(int r=0;r<16;++r)rli[r]=__builtin_amdgcn_rcpf(wsf[32+crow(r,hi)]);
  bf16*Ow=Oh+(rowbase+q0+wid*QBLK)*ldo;
  { bf16*stg=(bf16*)(shm+LDS_OST)+wid*2048;
    #pragma unroll
    for(int r=0;r<16;++r){const int orow=crow(r,hi);
      #pragma unroll
      for(int d0=0;d0<2;++d0)stg[orow*64+d0*32+r32]=__float2bfloat16(o[d0][r]*rli[r]);}
    asm volatile("s_waitcnt lgkmcnt(0)":::"memory");
    #pragma unroll
    for(int i=0;i<4;++i){const int row=i*8+(lane>>3),ch=lane&7; const u32x4 v=*(const u32x4*)(stg+row*64+ch*8); ATTN_STORE16(Ow+(long)row*ldo+ch*8,v);} }
  asm volatile("s_waitcnt lgkmcnt(0)\n\ts_barrier":::"memory");
  #undef DMA_K
  #undef DMA_V
  #undef CMASK
  #undef XMASK
  #undef START
  #undef RESC
  #undef ROT
}
constexpr int ATTN_LDS_BYTES=LDS_BYTES;
#undef SBAR
#undef WAIT_BAR
}

__device__ __forceinline__ void ph_attn_diff_fast(unsigned char* lds) {
  using namespace attn_body;
  const bf16* PROJ = (const bf16*)(P(ws) + WS_PROJ); bf16* ATT = (bf16*)(P(ws) + WS_ATT);
  const int G = gdim_(), bx = bid_(); const int v0 = (G % 8 == 0) ? (bx % 8) * (G / 8) + bx / 8 : bx;
  for (int vcu = v0; vcu < 256; vcu += G) {
    const int bhp = vcu >> 1, half = bhp & 1, c = (bhp >> 1) & 1, h8 = (bhp >> 2) & 7, b = bhp >> 5;
#pragma unroll 1
    for (int i = 0; i < 8; ++i) { const int sp = 4 * (vcu & 1) + (i >> 1); const int qb = (i & 1) ? 15 - sp : sp;
      attn_unit<8, 0>((long)b * S, qb, PROJ + (h8 * 2 + c) * 64, DIFF_IN, PROJ + 1024 + (h8 * 2 + c) * 64, PROJ + 2048 + h8 * 128 + half * 64, DIFF_IN,
                      ATT + c * 1024 + h8 * 128 + half * 64, 2048, nullptr, (char*)lds); }
  }
}
__device__ __forceinline__ void ph_attn_sel_fast(unsigned char* lds) {
  using namespace attn_body;
  const bf16* PROJ = (const bf16*)(P(ws) + WS_PROJ); bf16* OSEL = (bf16*)(P(ws) + WS_ATT + 32 * MiB);
  const u64* SEL = (const u64*)(P(ws) + WS_SEL);
  const int G = gdim_(), bx = bid_(); const int v0 = (G % 8 == 0) ? (bx % 8) * (G / 8) + bx / 8 : bx;
  for (int vcu = v0; vcu < 256; vcu += G) {
    const int bh = vcu >> 2, hd = bh & 15, b = bh >> 4, g = hd >> 2;
#pragma unroll 1
    for (int i = 0; i < 4; ++i) { const int sp = 2 * (vcu & 3) + (i >> 1); const int qb = (i & 1) ? 15 - sp : sp;
      attn_unit<8, 1>((long)b * S, qb, PROJ + hd * 64, NSA_P, PROJ + 1536 + g * 64, PROJ + 1792 + g * 64, NSA_P, OSEL + hd * 64, 1024, SEL + (size_t)(b * 4 + g) * S, (char*)lds); }
  }
}
__device__ __forceinline__ void ph_attn_win_fast(unsigned char* lds) {
  using namespace attn_body;
  const bf16* PROJ = (const bf16*)(P(ws) + WS_PROJ); bf16* OWIN = (bf16*)(P(ws) + WS_ATT + 64 * MiB);
  const int G = gdim_(), bx = bid_(); const int v0 = (G % 8 == 0) ? (bx % 8) * (G / 8) + bx / 8 : bx;
  for (int vcu = v0; vcu < 256; vcu += G) {
    const int bh = vcu >> 2, hd = bh & 15, b = bh >> 4, g = hd >> 2;
#pragma unroll 1
    for (int i = 0; i < 4; ++i) { const int qb = (vcu & 3) + 4 * i;
      attn_unit<8, 2>((long)b * S, qb, PROJ + hd * 64, NSA_P, PROJ + 2048 + g * 64, PROJ + 2304 + g * 64, NSA_P, OWIN + hd * 64, 1024, nullptr, (char*)lds); }
  }
}

#define XB_TMO      128
#define XB_XCNT(j)  (256  + 64 * (j))
#define XB_XSUB(j)  (1280 + 64 * (j))
#define XB_XGEN(j)  (2304 + 64 * (j))
#define XB_TOP      3328
#define XB_TOPGEN   3392
#define XCD_BAR_WORDS 3456
#define XB_SPIN_CAP (1u << 18)

__device__ __forceinline__ unsigned xb_ld(unsigned* p)              { return __hip_atomic_load(p, __ATOMIC_RELAXED, __HIP_MEMORY_SCOPE_AGENT); }
__device__ __forceinline__ unsigned xb_add(unsigned* p, unsigned v) { return __hip_atomic_fetch_add(p, v, __ATOMIC_RELAXED, __HIP_MEMORY_SCOPE_AGENT); }
__device__ __forceinline__ unsigned xb_xcc_id() { return (unsigned)__builtin_amdgcn_s_getreg((3 << 11) | 20) & 0xFu; }
#define XB_SPIN(cond, bar) do { unsigned _sp = 0; while (cond) { __builtin_amdgcn_s_sleep(1); \
    if ((++_sp & 255u) == 0u) { if (xb_ld(&(bar)[XB_TMO])) break; if (_sp > XB_SPIN_CAP) { atomicAdd(&(bar)[XB_TMO], 1u); break; } } } } while (0)

struct XcdBarrier {
    unsigned* bar; unsigned x;
    volatile __attribute__((address_space(3))) unsigned* st;
};

__device__ __forceinline__ XcdBarrier xcd_barrier_post(unsigned* bar, volatile __attribute__((address_space(3))) unsigned* st) {
    XcdBarrier b; b.bar = bar; b.x = xb_xcc_id(); b.st = st;
    if (tid_() == 0) (void)xb_add(&bar[XB_XCNT(b.x)], 1u);
    return b;
}
__device__ __forceinline__ void xcd_barrier_complete(unsigned* bar, unsigned x, unsigned& nloc, unsigned& nx) {
    const unsigned G = gridDim.x * gridDim.y * gridDim.z;
    unsigned sum, cnt, mine, sp = 0u;
    for (;;) {
        sum = 0u; cnt = 0u; mine = 0u;
#pragma unroll
        for (unsigned j = 0; j < 16; ++j) { const unsigned c = xb_ld(&bar[XB_XCNT(j)]); sum += c; cnt += (c > 0u) ? 1u : 0u; mine = (j == x) ? c : mine; }
        if (sum == G) break;
        __builtin_amdgcn_s_sleep(1);
        if ((++sp & 255u) == 0u) { if (xb_ld(&bar[XB_TMO])) break; if (sp > XB_SPIN_CAP) { atomicAdd(&bar[XB_TMO], 1u); break; } }
    }
    nloc = mine > 0u ? mine : 1u; nx = cnt > 0u ? cnt : 1u;
}

__device__ __forceinline__ void xcd_barrier(const XcdBarrier& b) {
    asm volatile("s_waitcnt vmcnt(0)" ::: "memory");
    __syncthreads();
    if (tid_() == 0) {
        unsigned* bar = b.bar;
        __builtin_amdgcn_s_waitcnt(0);
        unsigned nloc = b.st[0], nx = b.st[1];
        if (nloc == 0u) { xcd_barrier_complete(bar, b.x, nloc, nx); b.st[0] = nloc; b.st[1] = nx; }
        const unsigned old = xb_add(&bar[XB_XSUB(b.x)], 1u);
        const unsigned gen = old / nloc;
        if (old + 1u == (gen + 1u) * nloc) {
            __builtin_amdgcn_fence(__ATOMIC_RELEASE, "agent");
            asm volatile("s_waitcnt vmcnt(0)" ::: "memory");
            const unsigned og = xb_add(&bar[XB_TOP], 1u);
            const unsigned tg = og / nx;
            if (og + 1u == (tg + 1u) * nx) xb_add(&bar[XB_TOPGEN], 1u);
            else XB_SPIN(xb_ld(&bar[XB_TOPGEN]) == tg, bar);
            __builtin_amdgcn_fence(__ATOMIC_ACQUIRE, "agent");
            xb_add(&bar[XB_XGEN(b.x)], 1u);
            asm volatile("s_waitcnt vmcnt(0)" ::: "memory");
        } else {
            XB_SPIN(xb_ld(&bar[XB_XGEN(b.x)]) == gen, bar);
            __builtin_amdgcn_fence(__ATOMIC_ACQUIRE, "agent");
            asm volatile("s_waitcnt vmcnt(0)" ::: "memory");
        }
    }
    __syncthreads();
}

__device__ __forceinline__ void ph_prologue(unsigned char* lds) {
  const int tid = tid_();
  float* silu = (float*)lds;
  float* red = silu + 4096;
  float* MOD = (float*)(P(ws) + WS_MOD);
  for (int i = tid; i < 4096; i += NTHR) { const float v = P(c)[i]; silu[i] = v / (1.f + expf(-v)); }
  __syncthreads();
  for (int item = bid_(); item < 4 * 48; item += gdim_()) {
    const int l = item / 48, nc = item % 48, cc = tid & 127, ks = tid >> 7;
    const float* w = P(w_ada) + ((size_t)l * 1024 + ks * 256) * 6144 + nc * 128 + cc;
    float a0 = 0.f, a1 = 0.f, a2 = 0.f, a3 = 0.f;
#pragma unroll 8
    for (int k = 0; k < 256; ++k) { const float wv = w[(size_t)k * 6144]; const int kk = ks * 256 + k;
      a0 += silu[kk] * wv; a1 += silu[1024 + kk] * wv; a2 += silu[2048 + kk] * wv; a3 += silu[3072 + kk] * wv; }
    red[(ks * 4 + 0) * 128 + cc] = a0; red[(ks * 4 + 1) * 128 + cc] = a1; red[(ks * 4 + 2) * 128 + cc] = a2; red[(ks * 4 + 3) * 128 + cc] = a3;
    __syncthreads();
    { const int b = tid >> 7;
      const float s = red[(0 * 4 + b) * 128 + cc] + red[(1 * 4 + b) * 128 + cc] + red[(2 * 4 + b) * 128 + cc] + red[(3 * 4 + b) * 128 + cc];
      MOD[(size_t)(l * 4 + b) * 6144 + nc * 128 + cc] = s + P(b_ada)[l * 6144 + nc * 128 + cc]; }
    __syncthreads();
  }
  float* rope = (float*)(P(ws) + WS_ROPE);
  for (int m = bid_() * NTHR + tid; m < T; m += gdim_() * NTHR) {
    const float fp = (float)P(pos)[m];
    const float INV[8] = {1.0f, 0.1939227432012558f, 0.03760603070259094f, 0.007292664609849453f, 0.0014142135623842478f, 0.00027424818836152554f, 5.3182957344688475e-05f, 1.0313385246263351e-05f};
#pragma unroll
    for (int i = 0; i < 8; ++i) {
      const float ang = fp * INV[i];
      const double a = (double)ang; const double kq = rint(a * 0.63661977236758134308); const double r = a - kq * 1.57079632679489661923;
      const int q = (int)((long long)kq & 3ll);
      const double r2 = r * r;
      const double sr = r * (1.0 + r2 * (-1.0 / 6 + r2 * (1.0 / 120 + r2 * (-1.0 / 5040 + r2 * (1.0 / 362880 + r2 * (-1.0 / 39916800 + r2 * (1.0 / 6227020800.0)))))));
      const double cr = 1.0 + r2 * (-0.5 + r2 * (1.0 / 24 + r2 * (-1.0 / 720 + r2 * (1.0 / 40320 + r2 * (-1.0 / 3628800 + r2 * (1.0 / 479001600.0))))));
      const double sn = (q == 0) ? sr : (q == 1) ? cr : (q == 2) ? -sr : -cr;
      const double cs = (q == 0) ? cr : (q == 1) ? -sr : (q == 2) ? -cr : sr;
      rope[(size_t)m * 16 + i] = (float)cs; rope[(size_t)m * 16 + 8 + i] = (float)sn;
    }
  }
  if (bid_() == 0 && tid < 2) {
    const int j = tid; float s1 = 0.f, s2 = 0.f;
    for (int i = 0; i < 64; ++i) { s1 += P(diff_lq1)[j * 64 + i] * P(diff_lk1)[j * 64 + i]; s2 += P(diff_lq2)[j * 64 + i] * P(diff_lk2)[j * 64 + i]; }
    ((float*)(P(ws) + WS_SMALL))[j] = expf(s1) - expf(s2) + lam_init_of(j);
  }
}


__device__ __forceinline__ void transpose_item(const float* W, int K, int N, int Npad, bf16_t* WT, float* scr, int item, int lane) {
  const int nblk = Npad / 32, kb = item / nblk, nb = item % nblk, k0 = 64 * kb, n0 = 32 * nb;
  const int ncol = n0 + (lane & 31); const bool ok = ncol < N;
#pragma unroll 8
  for (int i = 0; i < 32; ++i) { const int kk = 2 * i + (lane >> 5); scr[kk * 33 + (lane & 31)] = ok ? W[(size_t)(k0 + kk) * N + ncol] : 0.f; }
  asm volatile("s_waitcnt lgkmcnt(0)" ::: "memory");
  const int c = lane & 7;
#pragma unroll
  for (int j = 0; j < 4; ++j) { const int n = (lane >> 3) + 8 * j; const float* sp = scr + (8 * c) * 33 + n;
    uint4 o; o.x = pk2(sp[0 * 33], sp[1 * 33]); o.y = pk2(sp[2 * 33], sp[3 * 33]); o.z = pk2(sp[4 * 33], sp[5 * 33]); o.w = pk2(sp[6 * 33], sp[7 * 33]);
    *(uint4*)(WT + (size_t)(n0 + n) * K + k0 + 8 * c) = o; }
  asm volatile("s_waitcnt lgkmcnt(0)" ::: "memory");
}
__device__ __forceinline__ void ph_weights(unsigned char* lds) {
  const int tid = tid_(), lane = tid & 63, wave = tid >> 6;
  float* scr = (float*)(lds + wave * 16384);
  const int gw = bid_() * 8 + wave, NGW = gdim_() * 8;
  for (int it = gw; it < 4 * 6144; it += NGW) {
    const int i = it / 6144; int r = it % 6144; const int j = i >> 1; const bool nsa = (i & 1) == 0;
    bf16_t* base = (bf16_t*)(P(ws) + WS_WT + (size_t)i * WT_LAYER);
    const int n_in = nsa ? 16 * (NSA_P / 32) : 16 * (DIFF_IN / 32);
    if (r < n_in) { if (nsa) transpose_item(P(nsa_w_in) + (size_t)j * D * NSA_IN, D, NSA_IN, NSA_P, base, scr, r, lane); else transpose_item(P(diff_w_in) + (size_t)j * D * DIFF_IN, D, DIFF_IN, DIFF_IN, base, scr, r, lane); continue; }
    r -= n_in;
    if (r < 512) { transpose_item((nsa ? P(nsa_w_out) : P(diff_w_out)) + (size_t)j * D * D, D, D, D, base + WT_OUT / 2, scr, r, lane); continue; }
    r -= 512;
    if (r < 2048) { transpose_item(P(w_mlp_in) + (size_t)i * D * DFF, D, DFF, DFF, base + WT_MI / 2, scr, r, lane); continue; }
    r -= 2048;
    if (r < 2048) transpose_item(P(w_mlp_out) + (size_t)i * DFF * D, DFF, D, D, base + WT_MO / 2, scr, r, lane);
  }
  for (int it = gw; it < 4 * 128; it += NGW) {
    const int jk = it >> 7, jj = jk >> 1, kv = jk & 1;
    transpose_item((kv ? P(nsa_w_cv1) : P(nsa_w_ck1)) + (size_t)jj * 2048 * 128, 2048, 128, 128, (bf16_t*)(P(ws) + WS_W1T) + (size_t)jk * 128 * 2048, scr, it & 127, lane);
  }
}
__device__ __forceinline__ void ph_cmp_bias(unsigned char* lds) {
  float* red = (float*)lds;
  const int tid = tid_(), n = tid & 127, ks = tid >> 7;
  for (int jk = bid_(); jk < 4; jk += gdim_()) {
    const int jj = jk >> 1, kv = jk & 1;
    const float* pe = (kv ? P(nsa_pe_v) : P(nsa_pe_k)) + jj * 2048; const float* w1 = (kv ? P(nsa_w_cv1) : P(nsa_w_ck1)) + (size_t)jj * 2048 * 128;
    float a = 0.f;
#pragma unroll 16
    for (int k = ks * 512; k < ks * 512 + 512; ++k) a += pe[k] * w1[(size_t)k * 128 + n];
    __syncthreads();
    red[ks * 128 + n] = a;
    __syncthreads();
    if (tid < 128) ((float*)(P(ws) + WS_SMALL))[64 + jk * 128 + tid] = red[tid] + red[128 + tid] + red[256 + tid] + red[384 + tid];
  }
}

__device__ __forceinline__ void ph_norm(const float* xin, const float* gvec, const float* mod  , int sh_off, int sc_off, bf16_t* H) {
  const int tid = tid_(), lane = tid & 63, wave = tid >> 6;
  for (int m = bid_() * 8 + wave; m < T; m += gdim_() * 8) {
    const int b = m >> 12;
    const float4* xr = (const float4*)(xin + (size_t)m * D) + lane;
    float4 v[4]; float ss = 0.f;
#pragma unroll
    for (int j = 0; j < 4; ++j) { v[j] = xr[64 * j]; ss += (v[j].x * v[j].x + v[j].y * v[j].y) + (v[j].z * v[j].z + v[j].w * v[j].w); }
    ss = wave_sum(ss);
    const float rstd = 1.0f / sqrtf(ss * (1.0f / D) + EPS);
#pragma unroll
    for (int j = 0; j < 4; ++j) {
      const int col = 4 * lane + 256 * j;
      const float4 g = *(const float4*)(gvec + col), sc = *(const float4*)(mod + (size_t)b * 6144 + sc_off + col), sh = *(const float4*)(mod + (size_t)b * 6144 + sh_off + col);
      const float h0 = v[j].x * rstd * g.x * (1.f + sc.x) + sh.x, h1 = v[j].y * rstd * g.y * (1.f + sc.y) + sh.y;
      const float h2 = v[j].z * rstd * g.z * (1.f + sc.z) + sh.z, h3 = v[j].w * rstd * g.w * (1.f + sc.w) + sh.w;
      uint2 o; o.x = pk2(h0, h1); o.y = pk2(h2, h3);
      *(uint2*)(H + (size_t)m * D + col) = o;
    }
  }
}

struct EpiStore { bf16_t* O; int ld; int relu2;
  __device__ __forceinline__ void operator()(int row, int col, const float* v) const {
    float a = v[0], b = v[1], c = v[2], d = v[3];
    if (relu2) { a = fmaxf(a, 0.f); a *= a; b = fmaxf(b, 0.f); b *= b; c = fmaxf(c, 0.f); c *= c; d = fmaxf(d, 0.f); d *= d; }
    uint2 o; o.x = pk2(a, b); o.y = pk2(c, d); *(uint2*)(O + (size_t)row * ld + col) = o; } };
struct EpiResid { const float* xin; float* xout; const float* gate;
  __device__ __forceinline__ void operator()(int row, int col, const float* v) const {
    const int b = row >> 12; const float4 g = *(const float4*)(gate + (size_t)b * 6144 + col); const float4 xi = *(const float4*)(xin + (size_t)row * D + col);
    float4 o; o.x = xi.x + g.x * v[0]; o.y = xi.y + g.y * v[1]; o.z = xi.z + g.z * v[2]; o.w = xi.w + g.w * v[3];
    *(float4*)(xout + (size_t)row * D + col) = o; } };

template <class Epi>
__device__ __forceinline__ void gemm_naive(const bf16_t* A, int lda, const float* W, int N, int K, unsigned char* lds, const Epi& E) {
  asm volatile("" : "+s"(N), "+s"(K), "+s"(lda));
  float* As = (float*)lds;
  float* Bs = As + 16 * 132;
  const int tid = tid_(), tx = tid & 31, ty = tid >> 5;
  const int nN = (N + 127) / 128, nM = T / 128;
  const int ar = tid >> 2, ak = (tid & 3) * 4, bk = tid >> 5, bc = (tid & 31) * 4;
  for (int u = bid_(); u < nM * nN; u += gdim_()) {
    const int pm = u / nN, pn = u % nN;
    float acc[8][4];
#pragma unroll
    for (int i = 0; i < 8; ++i) { acc[i][0] = 0.f; acc[i][1] = 0.f; acc[i][2] = 0.f; acc[i][3] = 0.f; }
    const bf16_t* Ap = A + (size_t)(pm * 128 + ar) * lda + ak;
    const int wcol = pn * 128 + bc; const bool bok = wcol < N;
    const float* Wp = W + (size_t)bk * N + (bok ? wcol : 0);
    for (int k0 = 0; k0 < K; k0 += 16) {
      const uint2 av = *(const uint2*)(Ap + k0);
      float4 bv = *(const float4*)(Wp + (size_t)k0 * N);
      if (!bok) bv = make_float4(0.f, 0.f, 0.f, 0.f);
      __syncthreads();
      As[(ak + 0) * 132 + ar] = bf2f(av.x & 0xffffu); As[(ak + 1) * 132 + ar] = bf2f(av.x >> 16);
      As[(ak + 2) * 132 + ar] = bf2f(av.y & 0xffffu); As[(ak + 3) * 132 + ar] = bf2f(av.y >> 16);
      *(float4*)(Bs + bk * 128 + bc) = bv;
      __syncthreads();
#pragma unroll
      for (int k = 0; k < 16; ++k) {
        const float4 a0 = *(const float4*)(As + k * 132 + ty * 8), a1 = *(const float4*)(As + k * 132 + ty * 8 + 4);
        const float4 b = *(const float4*)(Bs + k * 128 + tx * 4);
        const float a[8] = {a0.x, a0.y, a0.z, a0.w, a1.x, a1.y, a1.z, a1.w};
#pragma unroll
        for (int i = 0; i < 8; ++i) { acc[i][0] += a[i] * b.x; acc[i][1] += a[i] * b.y; acc[i][2] += a[i] * b.z; acc[i][3] += a[i] * b.w; }
      }
    }
    const int col = pn * 128 + tx * 4;
    if (col < N) {
#pragma unroll
      for (int i = 0; i < 8; ++i) E(pm * 128 + ty * 8 + i, col, acc[i]);
    }
  }
}

__device__ __forceinline__ void head_norm_rope(const float* v, const float* gain, const float* cs  , int sub, float* vn, float* vr) {
  float ss = 0.f;
#pragma unroll
  for (int i = 0; i < 8; ++i) ss += v[i] * v[i];
  ss += __shfl_xor(ss, 1); ss += __shfl_xor(ss, 2); ss += __shfl_xor(ss, 4);
  const float rstd = 1.0f / sqrtf(ss * (1.0f / 64.0f) + EPS);
#pragma unroll
  for (int i = 0; i < 8; ++i) vn[i] = v[i] * rstd * gain[sub * 8 + i];
#pragma unroll
  for (int i = 0; i < 8; ++i) {
    const float other = __shfl_xor(vn[i], 1);
    const float c = cs[i], s = cs[8 + i];
    float r = vn[i];
    if (sub == 0) r = vn[i] * c - other * s;
    else if (sub == 1) r = vn[i] * c + other * s;
    vr[i] = r;
  }
}

__device__ __forceinline__ void ph_post_diff(int j, bf16_t* PROJ) {
  const int tid = tid_(), lane = tid & 63, wave = tid >> 6, sub = lane & 7;
  const float* rope = (const float*)(P(ws) + WS_ROPE);
  for (int m = bid_() * 8 + wave; m < T; m += gdim_() * 8) {
    const float* cs = rope + (size_t)m * 16;
#pragma unroll
    for (int it = 0; it < 4; ++it) {
      bf16_t* ptr = PROJ + (size_t)m * DIFF_IN + it * 512 + lane * 8;
      float v[8], vn[8], vr[8]; unpack8(*(const uint4*)ptr, v);
      const float* gain = (it < 2) ? (P(diff_q_gain) + j * 64) : (P(diff_k_gain) + j * 64);
      head_norm_rope(v, gain, cs, sub, vn, vr);
      const float sc = (it < 2) ? C2 : 1.0f;
#pragma unroll
      for (int i = 0; i < 8; ++i) vr[i] *= sc;
      *(uint4*)ptr = pack8(vr);
    }
  }
}
__device__ __forceinline__ void ph_post_nsa(int j, bf16_t* PROJ, bf16_t* QC) {
  const int tid = tid_(), lane = tid & 63, wave = tid >> 6, sub = lane & 7;
  const float* rope = (const float*)(P(ws) + WS_ROPE);
  for (int m = bid_() * 8 + wave; m < T; m += gdim_() * 8) {
    const float* cs = rope + (size_t)m * 16;
#pragma unroll
    for (int it = 0; it < 2; ++it) {
      bf16_t* ptr = PROJ + (size_t)m * NSA_P + it * 512 + lane * 8;
      float v[8], vn[8], vr[8]; unpack8(*(const uint4*)ptr, v);
      head_norm_rope(v, P(nsa_q_gain) + j * 64, cs, sub, vn, vr);
#pragma unroll
      for (int i = 0; i < 8; ++i) { vr[i] *= C2; vn[i] *= C2; }
      *(uint4*)ptr = pack8(vr);
      *(uint4*)(QC + (size_t)m * D + it * 512 + lane * 8) = pack8(vn);
    }
    {
      const int hi = lane >> 5;
      bf16_t* ptr = PROJ + (size_t)m * NSA_P + (hi ? 2048 : 1536) + (lane & 31) * 8;
      float v[8], vn[8], vr[8]; unpack8(*(const uint4*)ptr, v);
      head_norm_rope(v, P(nsa_k_gain) + j * 192 + (hi ? 128 : 64), cs, sub, vn, vr);
      *(uint4*)ptr = pack8(vr);
    }
  }
}

template <int DV, int MODE>
__device__ __forceinline__ void attn_naive_unit(int b, int qc, const bf16_t* Qp, int ldq, const bf16_t* Kp, const bf16_t* Vp, int ldkv, bf16_t* Op, int ldo, const u64* selmask, unsigned char* lds) {
  constexpr int DVS = DV / 8;
  float* Ks = (float*)lds;
  float* Vs = Ks + 64 * 64;
  const int tid = tid_(), qi = tid & 63, sl = tid >> 6;
  const int qabs = qc * 64 + qi;
  const size_t rowq = (size_t)b * S + qabs;
  float q[64];
#pragma unroll
  for (int i = 0; i < 8; ++i) unpack8(*(const uint4*)(Qp + rowq * ldq + i * 8), q + i * 8);
  float m = -INFINITY, l = 0.f, o[DVS];
#pragma unroll
  for (int i = 0; i < DVS; ++i) o[i] = 0.f;
  u64 msk = 0ull; if (MODE == 1) msk = selmask[qabs];
  const int t_lo = (MODE == 2) ? (qc > 8 ? qc - 8 : 0) : 0;
  for (int tt = t_lo; tt <= qc; ++tt) {
    __syncthreads();
    { const int key = tid >> 3, ch = tid & 7; float f[8];
      unpack8(*(const uint4*)(Kp + ((size_t)b * S + tt * 64 + key) * ldkv + ch * 8), f);
#pragma unroll
      for (int i = 0; i < 8; ++i) Ks[key * 64 + ch * 8 + i] = f[i];
#pragma unroll
      for (int r = 0; r < DV / 64; ++r) {
        unpack8(*(const uint4*)(Vp + ((size_t)b * S + tt * 64 + key) * ldkv + r * 64 + ch * 8), f);
#pragma unroll
        for (int i = 0; i < 8; ++i) Vs[key * DV + r * 64 + ch * 8 + i] = f[i];
      } }
    __syncthreads();
    const bool tile_on = (MODE == 1) ? (((msk >> tt) & 1ull) != 0ull) : true;
    if (tile_on) {
      for (int jk = 0; jk < 64; ++jk) {
        const int key = tt * 64 + jk;
        bool valid = key <= qabs; if (MODE == 2) valid = valid && (key > qabs - 512);
        if (valid) {
          float s = 0.f;
#pragma unroll
          for (int d = 0; d < 64; d += 4) { const float4 kk = *(const float4*)(Ks + jk * 64 + d); s += q[d] * kk.x + q[d + 1] * kk.y + q[d + 2] * kk.z + q[d + 3] * kk.w; }
          const float mn = fmaxf(m, s); const float sc = exp2f(m - mn), pp = exp2f(s - mn);
          l = l * sc + pp;
#pragma unroll
          for (int i = 0; i < DVS; ++i) o[i] = o[i] * sc + pp * Vs[jk * DV + sl * DVS + i];
          m = mn;
        }
      }
    }
  }
  const float inv = l > 0.f ? 1.0f / l : 0.f;
  bf16_t* op = Op + rowq * ldo + sl * DVS;
  if (DVS == 8) { float r[8];
#pragma unroll
    for (int i = 0; i < 8; ++i) r[i] = o[i] * inv;
    *(uint4*)op = pack8(r);
  } else {
#pragma unroll
    for (int h2 = 0; h2 < DVS / 8; ++h2) { float r[8];
#pragma unroll
      for (int i = 0; i < 8; ++i) r[i] = o[h2 * 8 + i] * inv;
      *(uint4*)(op + h2 * 8) = pack8(r); }
  }
}

__device__ __forceinline__ void ph_attn_diff(unsigned char* lds) {
  const bf16_t* PROJ = (const bf16_t*)(P(ws) + WS_PROJ); bf16_t* ATT = (bf16_t*)(P(ws) + WS_ATT);
  const int NU = NB * 64 * 16;
  for (int u = bid_(); u < NU; u += gdim_()) {
    const int vh = u & 15, qc = 63 - ((u >> 4) & 63), b = u >> 10;
    const int h8 = vh >> 1, c = vh & 1;
    attn_naive_unit<128, 0>(b, qc, PROJ + vh * 64, DIFF_IN, PROJ + 1024 + vh * 64, PROJ + 2048 + h8 * 128, DIFF_IN, ATT + c * 1024 + h8 * 128, 2048, nullptr, lds);
  }
}
__device__ __forceinline__ void ph_attn_sel(unsigned char* lds) {
  const bf16_t* PROJ = (const bf16_t*)(P(ws) + WS_PROJ); bf16_t* OSEL = (bf16_t*)(P(ws) + WS_ATT + 32 * MiB);
  const u64* SEL = (const u64*)(P(ws) + WS_SEL);
  const int NU = NB * 64 * 16;
  for (int u = bid_(); u < NU; u += gdim_()) {
    const int hd = u & 15, qc = 63 - ((u >> 4) & 63), b = u >> 10, g = hd >> 2;
    attn_naive_unit<64, 1>(b, qc, PROJ + hd * 64, NSA_P, PROJ + 1536 + g * 64, PROJ + 1792 + g * 64, NSA_P, OSEL + hd * 64, D, SEL + (size_t)(b * 4 + g) * S, lds);
  }
}
__device__ __forceinline__ void ph_attn_win(unsigned char* lds) {
  const bf16_t* PROJ = (const bf16_t*)(P(ws) + WS_PROJ); bf16_t* OWIN = (bf16_t*)(P(ws) + WS_ATT + 64 * MiB);
  const int NU = NB * 64 * 16;
  for (int u = bid_(); u < NU; u += gdim_()) {
    const int hd = u & 15, qc = (u >> 4) & 63, b = u >> 10, g = hd >> 2;
    attn_naive_unit<64, 2>(b, qc, PROJ + hd * 64, NSA_P, PROJ + 2048 + g * 64, PROJ + 2304 + g * 64, NSA_P, OWIN + hd * 64, D, nullptr, lds);
  }
}

__device__ __forceinline__ void ph_compress(int j, unsigned char* lds) {
  typedef short bf16x8_t __attribute__((ext_vector_type(8))); typedef float f32x16_t __attribute__((ext_vector_type(16)));
  const bf16_t* PROJ = (const bf16_t*)(P(ws) + WS_PROJ);
  unsigned char* Xb = lds;
  float* part = (float*)(lds + 67584);
  float* hid = part + 2 * 32 * 128;
  const int tid = tid_(), lane = tid & 63, wave = tid >> 6, r = lane & 31, h = lane >> 5, nb = wave & 3, kh = wave >> 2;
  for (int it = bid_(); it < 256; it += gdim_()) {
    const int rt = it & 7, kv = (it >> 3) & 1, bg = it >> 4, b = bg >> 2, g = bg & 3;
    const bf16_t* W1T = (const bf16_t*)(P(ws) + WS_W1T) + (size_t)(j * 2 + kv) * 128 * 2048;
    const float* w2 = (kv ? P(nsa_w_cv2) : P(nsa_w_ck2)) + (size_t)j * 128 * 64;
    const int colbase = (kv ? 1280 : 1024) + g * 64;
    __syncthreads();
    for (int i = tid; i < 528 * 8; i += NTHR) { const int tk = i >> 3, ch = i & 7, tok = 512 * rt + tk;
      uint4 v = make_uint4(0u, 0u, 0u, 0u); if (tok < S) v = *(const uint4*)(PROJ + ((size_t)b * S + tok) * NSA_P + colbase + ch * 8);
      *(uint4*)(Xb + tk * 128 + ((ch ^ ((tk >> 4) & 7)) * 16)) = v; }
    __syncthreads();
    f32x16_t acc;
#pragma unroll
    for (int q = 0; q < 16; ++q) acc[q] = 0.f;
    const bf16_t* wrow = W1T + (size_t)(nb * 32 + r) * 2048 + 8 * h;
#pragma unroll 2
    for (int l = 16 * kh; l < 16 * kh + 16; ++l) {
      const int tk = 16 * r + l; const unsigned char* xr = Xb + tk * 128; const int sw = (tk >> 4) & 7;
#pragma unroll
      for (int dq = 0; dq < 4; ++dq) {
        const bf16x8_t av = *(const bf16x8_t*)(xr + (((2 * dq + h) ^ sw) * 16));
        const bf16x8_t bv = *(const bf16x8_t*)(wrow + l * 64 + 16 * dq);
        acc = __builtin_amdgcn_mfma_f32_32x32x16_bf16(av, bv, acc, 0, 0, 0);
      }
    }
#pragma unroll
    for (int q = 0; q < 16; ++q) part[(kh * 32 + ((q & 3) + 8 * (q >> 2) + 4 * h)) * 128 + nb * 32 + r] = acc[q];
    __syncthreads();
    const float* CB = (const float*)(P(ws) + WS_SMALL) + 64 + (j * 2 + kv) * 128;
    for (int i = tid; i < 32 * 128; i += NTHR) { const float hs = part[i] + part[4096 + i] + CB[i & 127]; hid[i] = hs / (1.f + expf(-hs)); }
    __syncthreads();
    { const int e = tid & 63, rq = tid >> 6; float o0 = 0.f, o1 = 0.f, o2 = 0.f, o3 = 0.f;
      for (int hh = 0; hh < 128; ++hh) { const float wv = w2[hh * 64 + e];
        o0 += hid[(rq * 4 + 0) * 128 + hh] * wv; o1 += hid[(rq * 4 + 1) * 128 + hh] * wv; o2 += hid[(rq * 4 + 2) * 128 + hh] * wv; o3 += hid[(rq * 4 + 3) * 128 + hh] * wv; }
      float ov[4] = {o0, o1, o2, o3};
      bf16_t* KC = (bf16_t*)(P(ws) + WS_KCMP);
      bf16_t* VT = (bf16_t*)(P(ws) + WS_VCMP);
#pragma unroll
      for (int rr = 0; rr < 4; ++rr) { const int c = 32 * rt + rq * 4 + rr; float v = ov[rr];
        if (kv == 0) { const float ss = wave_sum(v * v); v = v * (1.0f / sqrtf(ss * (1.0f / 64.0f) + EPS)) * P(nsa_k_gain)[j * 192 + e]; }
        if (c >= 255) v = 0.f;
        if (kv == 0) KC[((size_t)bg * 256 + c) * 64 + e] = (bf16_t)f2bf(v); else VT[((size_t)bg * 64 + e) * 256 + c] = (bf16_t)f2bf(v); }
    }
  }
}

__device__ __forceinline__ void ph_cmp_attn(unsigned char* lds) {
  typedef short bf16x8_t __attribute__((ext_vector_type(8))); typedef float f32x16_t __attribute__((ext_vector_type(16)));
  unsigned char* Kimg = lds;
  unsigned char* VTl = lds + 32768;
  float* IMP = (float*)(lds + 32768 + 33280);
  const bf16_t* QC = (const bf16_t*)(P(ws) + WS_OC);
  const bf16_t* KC = (const bf16_t*)(P(ws) + WS_KCMP); const bf16_t* VT = (const bf16_t*)(P(ws) + WS_VCMP);
  bf16_t* OCMP = (bf16_t*)(P(ws) + WS_ATT);
  u64* SEL = (u64*)(P(ws) + WS_SEL);
  const int tid = tid_(), lane = tid & 63, wave = tid >> 6, r32 = lane & 31, hi = lane >> 5, hh = wave >> 1, qh = wave & 1;
  const int G = gdim_(), bx = bid_(); const int v0 = (G % 8 == 0) ? (bx % 8) * (G / 8) + bx / 8 : bx;
  for (int vcu = v0; vcu < 256; vcu += G) {
    const int bg = vcu >> 4, b = bg >> 2, g = bg & 3;
    __syncthreads();
    for (int i = tid; i < 2048; i += NTHR) { const int c = i >> 3, ch = i & 7; *(uint4*)(Kimg + ch * 4096 + c * 16) = *(const uint4*)(KC + ((size_t)bg * 256 + c) * 64 + ch * 8); }
    for (int i = tid; i < 4096; i += NTHR) { const int d = i >> 6, c8 = i & 63; *(uint2*)(VTl + d * 520 + c8 * 8) = *(const uint2*)(VT + ((size_t)bg * 64 + d) * 256 + c8 * 4); }
#pragma unroll 1
    for (int ui = 0; ui < 4; ++ui) {
      const int qc = (vcu & 15) + 16 * ui, t0 = qc * 64;
      __syncthreads();
      for (int i = tid; i < 64 * 65; i += NTHR) IMP[i] = 0.f;
      const int t = t0 + 32 * qh + r32;
      bf16x8_t qr[4];
      { const bf16_t* qp = QC + ((size_t)b * S + t) * D + (g * 4 + hh) * 64 + hi * 8;
#pragma unroll
        for (int d0 = 0; d0 < 4; ++d0) qr[d0] = *(const bf16x8_t*)(qp + d0 * 16); }
      __syncthreads();
      const int nc = 4 * qc + 2 * qh + 1, nct = (nc + 31) >> 5;
      int climit = (t - 31) >> 4; if (climit > 254) climit = 254;
      const int cfull = (t0 + 32 * qh - 31) >> 4;
#define CMP_TILE(PACC, ct) do { \
        _Pragma("unroll") for (int q = 0; q < 16; ++q) PACC[q] = 0.f; \
        _Pragma("unroll") for (int d0 = 0; d0 < 4; ++d0) { const bf16x8_t kf = *(const bf16x8_t*)(Kimg + (2 * d0 + hi) * 4096 + (32 * (ct) + r32) * 16); PACC = __builtin_amdgcn_mfma_f32_32x32x16_bf16(kf, qr[d0], PACC, 0, 0, 0); } \
        if (32 * (ct) + 31 > cfull) { const int rel = climit - 32 * (ct) - 4 * hi; \
          _Pragma("unroll") for (int q = 0; q < 16; ++q) PACC[q] = (((q & 3) + 8 * (q >> 2)) <= rel) ? PACC[q] : -INFINITY; } } while (0)
      float mx = -INFINITY, sum = 0.f;
#pragma unroll 1
      for (int ct = 0; ct < nct; ++ct) { f32x16_t pacc; CMP_TILE(pacc, ct);
        float tm = pacc[0];
#pragma unroll
        for (int q = 1; q < 16; ++q) tm = fmaxf(tm, pacc[q]);
        const float mn = fmaxf(mx, tm), mns = (mn == -INFINITY) ? 0.f : mn;
        float ts = 0.f;
#pragma unroll
        for (int q = 0; q < 16; ++q) ts += __builtin_amdgcn_exp2f(pacc[q] - mns);
        sum = sum * __builtin_amdgcn_exp2f(mx - mns) + ts; mx = mn; }
      { const float mo = __shfl_xor(mx, 32), so = __shfl_xor(sum, 32); const float M = fmaxf(mx, mo), Ms = (M == -INFINITY) ? 0.f : M;
        sum = sum * __builtin_amdgcn_exp2f(mx - Ms) + so * __builtin_amdgcn_exp2f(mo - Ms); mx = Ms; }
      const float ms = mx;
      const float inv = sum > 0.f ? 1.0f / sum : 0.f;
      f32x16_t o0, o1;
#pragma unroll
      for (int q = 0; q < 16; ++q) { o0[q] = 0.f; o1[q] = 0.f; }
      float* improw = IMP + (32 * qh + r32) * 65;
#pragma unroll 1
      for (int ct = 0; ct < nct; ++ct) {
        f32x16_t pr; CMP_TILE(pr, ct);
#pragma unroll
        for (int q = 0; q < 16; ++q) pr[q] = __builtin_amdgcn_exp2f(pr[q] - ms) * inv;
#pragma unroll
        for (int g4 = 0; g4 < 4; ++g4) { const int mi = 8 * ct + 2 * g4 + hi; const float last = pr[4 * g4 + 3];
          atomicAdd(improw + mi, (pr[4 * g4] + pr[4 * g4 + 1]) + (pr[4 * g4 + 2] + last));
          if (mi + 1 < 64) atomicAdd(improw + mi + 1, last); }
#pragma unroll
        for (int s2 = 0; s2 < 2; ++s2) {
          uint4 pw; pw.x = pg8::cvt_pk_bf16(pr[8 * s2 + 0], pr[8 * s2 + 1]); pw.y = pg8::cvt_pk_bf16(pr[8 * s2 + 2], pr[8 * s2 + 3]);
          pw.z = pg8::cvt_pk_bf16(pr[8 * s2 + 4], pr[8 * s2 + 5]); pw.w = pg8::cvt_pk_bf16(pr[8 * s2 + 6], pr[8 * s2 + 7]);
          const bf16x8_t pa = __builtin_bit_cast(bf16x8_t, pw);
          const int cb = (32 * ct + 16 * s2 + 4 * hi) * 2;
          { const uint2 lo = *(const uint2*)(VTl + r32 * 520 + cb), hi2 = *(const uint2*)(VTl + r32 * 520 + cb + 16);
            uint4 vv; vv.x = lo.x; vv.y = lo.y; vv.z = hi2.x; vv.w = hi2.y; o0 = __builtin_amdgcn_mfma_f32_32x32x16_bf16(pa, __builtin_bit_cast(bf16x8_t, vv), o0, 0, 0, 0); }
          { const uint2 lo = *(const uint2*)(VTl + (32 + r32) * 520 + cb), hi2 = *(const uint2*)(VTl + (32 + r32) * 520 + cb + 16);
            uint4 vv; vv.x = lo.x; vv.y = lo.y; vv.z = hi2.x; vv.w = hi2.y; o1 = __builtin_amdgcn_mfma_f32_32x32x16_bf16(pa, __builtin_bit_cast(bf16x8_t, vv), o1, 0, 0, 0); }
        }
      }
#undef CMP_TILE
      { bf16_t* op = OCMP + ((size_t)b * S + t0 + 32 * qh) * D + (g * 4 + hh) * 64 + r32;
#pragma unroll
        for (int q = 0; q < 16; ++q) { const int row = (q & 3) + 8 * (q >> 2) + 4 * hi; op[(size_t)row * D] = (bf16_t)f2bf(o0[q]); op[(size_t)row * D + 32] = (bf16_t)f2bf(o1[q]); } }
      __syncthreads();
#pragma unroll 1
      for (int k8 = 0; k8 < 8; ++k8) {
        const int qi = wave * 8 + k8, tq = t0 + qi, bt = tq >> 6, sb = lane;
        const float v = IMP[qi * 65 + sb];
        const bool forced = (sb == 0) || (sb == bt) || (sb == bt - 1), valid = sb <= bt;
        const float vv = forced ? (1e6f + (float)(64 - sb)) : (valid ? v : (-1.0f - (float)sb));
        const unsigned bits = __float_as_uint(vv); const unsigned key = (bits & 0x80000000u) ? ~bits : (bits | 0x80000000u);
        unsigned prefix = 0u;
#pragma unroll 1
        for (int bit = 31; bit >= 0; --bit) { const unsigned cand = prefix | (1u << bit); const int cnt = __popcll(__ballot(key >= cand)); if (cnt >= 16) prefix = cand; }
        const u64 gt = __ballot(key > prefix); u64 eq = __ballot(key == prefix);
        int need = 16 - __popcll(gt); u64 m = gt;
        while (need > 0 && eq != 0ull) { const u64 low = eq & (0ull - eq); m |= low; eq ^= low; --need; }
        if (lane == 0) SEL[(size_t)bg * S + tq] = m;
      }
    }
  }
}

__device__ __forceinline__ void ph_combine_nsa(int j) {
  const bf16_t* PROJ = (const bf16_t*)(P(ws) + WS_PROJ);
  const bf16_t* OCMP = (const bf16_t*)(P(ws) + WS_ATT); const bf16_t* OSEL = OCMP + (size_t)T * D; const bf16_t* OWIN = OSEL + (size_t)T * D;
  bf16_t* OC = (bf16_t*)(P(ws) + WS_OC);
  for (size_t i = (size_t)bid_() * NTHR + tid_(); i < (size_t)T * 128; i += (size_t)gdim_() * NTHR) {
    const size_t m = i >> 7; const int cg8 = (int)(i & 127), hd = cg8 >> 3;
    float gt[3];
#pragma unroll
    for (int r = 0; r < 3; ++r) { const float gl = bf2f(PROJ[m * NSA_P + 2560 + hd * 3 + r]) + P(nsa_b_gate)[j * 48 + hd * 3 + r]; gt[r] = 1.0f / (1.0f + expf(-gl)); }
    float a[8], bb[8], cc[8], o[8];
    unpack8(*(const uint4*)(OCMP + m * D + cg8 * 8), a); unpack8(*(const uint4*)(OSEL + m * D + cg8 * 8), bb); unpack8(*(const uint4*)(OWIN + m * D + cg8 * 8), cc);
#pragma unroll
    for (int k = 0; k < 8; ++k) o[k] = gt[0] * a[k] + gt[1] * bb[k] + gt[2] * cc[k];
    *(uint4*)(OC + m * D + cg8 * 8) = pack8(o);
  }
}
__device__ __forceinline__ void ph_combine_diff(int j) {
  const bf16_t* ATT = (const bf16_t*)(P(ws) + WS_ATT); bf16_t* OC = (bf16_t*)(P(ws) + WS_OC);
  const float lam = ((const float*)(P(ws) + WS_SMALL))[j]; const float osc = 1.0f - lam_init_of(j);
  const int tid = tid_(), lane = tid & 63, wave = tid >> 6;
  for (int m = bid_() * 8 + wave; m < T; m += gdim_() * 8) {
#pragma unroll
    for (int it = 0; it < 2; ++it) {
      const int col = it * 512 + lane * 8;
      float a[8], b2[8], o[8]; unpack8(*(const uint4*)(ATT + (size_t)m * 2048 + col), a); unpack8(*(const uint4*)(ATT + (size_t)m * 2048 + 1024 + col), b2);
      float ss = 0.f;
#pragma unroll
      for (int k = 0; k < 8; ++k) { o[k] = a[k] - lam * b2[k]; ss += o[k] * o[k]; }
      ss += __shfl_xor(ss, 1); ss += __shfl_xor(ss, 2); ss += __shfl_xor(ss, 4); ss += __shfl_xor(ss, 8);
      const float rstd = 1.0f / sqrtf(ss * (1.0f / 128.0f) + EPS);
#pragma unroll
      for (int k = 0; k < 8; ++k) o[k] = o[k] * rstd * P(diff_subln_g)[j * 128 + (col & 127) + k] * osc;
      *(uint4*)(OC + (size_t)m * D + col) = pack8(o);
    }
  }
}

constexpr int N_PHASES = 1 + 4 * 10;
constexpr unsigned long long REPEAT_MASK = 0ull;
template <int PH> __device__ __forceinline__ bool phase_body(unsigned char* lds) {
  bool did = true;
  if constexpr (PH == 0) { ph_prologue(lds); __syncthreads(); ph_cmp_bias(lds); __syncthreads(); ph_weights(lds); }
  else {
    constexpr int i = (PH - 1) / 10, lp = (PH - 1) % 10, j = i >> 1; constexpr bool nsa = (i & 1) == 0;
    float* MOD = (float*)(P(ws) + WS_MOD);
    bf16_t* H = (bf16_t*)(P(ws) + WS_H); bf16_t* PROJ = (bf16_t*)(P(ws) + WS_PROJ); bf16_t* OC = (bf16_t*)(P(ws) + WS_OC); bf16_t* HID = (bf16_t*)(P(ws) + WS_HID);
    const float* mod = MOD + (size_t)i * 4 * 6144;
    const float* xcur = (i == 0 && lp < 7) ? P(x) : P(out);
    if constexpr (lp == 0) ph_norm(xcur, P(ln_mix_g) + i * D, mod, 0, 1024, H);
    const bf16_t* WTL = (const bf16_t*)(P(ws) + WS_WT + (size_t)i * WT_LAYER);
    PG8_LAS unsigned char* l3 = (PG8_LAS unsigned char*)lds;
    if constexpr (lp == 1) {
      constexpr int N = nsa ? NSA_P : DIFF_IN;
      pg8::Gemm g{H, WTL, T, N, D}; pg8::StaticOrder S; S.init(T, N, gdim_(), bid_());
      pg8::EpiBf16<0> E{PROJ, N};
      pg8::gemm_phase<pg8::EpiBf16<0>, pg8::StaticOrder, true, true>(l3, g, S, E);
    }
    if constexpr (lp == 2) { if constexpr (nsa) { ph_post_nsa(j, PROJ, OC); ph_compress(j, lds); } else ph_post_diff(j, PROJ); }
    if constexpr (lp == 3) { if constexpr (nsa) { ph_cmp_attn(lds); __syncthreads(); ph_attn_win_fast(lds); } else ph_attn_diff_fast(lds); }
    if constexpr (lp == 4) { if constexpr (nsa) ph_attn_sel_fast(lds); else did = false; }
    if constexpr (lp == 5) { if constexpr (nsa) ph_combine_nsa(j); else ph_combine_diff(j); }
    if constexpr (lp == 6) {
      pg8::Gemm g{OC, WTL + WT_OUT / 2, T, D, D}; pg8::StaticOrder S; S.init(T, D, gdim_(), bid_());
      pg8::EpiResid E{xcur, P(out), mod + 2048};
      pg8::gemm_phase<pg8::EpiResid, pg8::StaticOrder, true, true>(l3, g, S, E);
    }
    if constexpr (lp == 7) ph_norm(P(out), P(ln_mlp_g) + i * D, mod, 3072, 4096, H);
    if constexpr (lp == 8) {
      pg8::Gemm g{H, WTL + WT_MI / 2, T, DFF, D}; pg8::StaticOrder S; S.init(T, DFF, gdim_(), bid_());
      pg8::EpiBf16<2> E{HID, DFF};
      pg8::gemm_phase<pg8::EpiBf16<2>, pg8::StaticOrder, true, true>(l3, g, S, E);
    }
    if constexpr (lp == 9) {
      pg8::Gemm g{HID, WTL + WT_MO / 2, T, D, DFF}; pg8::StaticOrder S; S.init(T, D, gdim_(), bid_());
      pg8::EpiResid E{P(out), P(out), mod + 5120};
      pg8::gemm_phase<pg8::EpiResid, pg8::StaticOrder, true, true>(l3, g, S, E);
    }
  }
  return did;
}
template <int PH> __device__ __forceinline__ void run_phase(unsigned char* lds, int lo, int hi, const XcdBarrier& bar) {
  if (PH < lo || PH >= hi) return;
  const bool did = phase_body<PH>(lds);
  if constexpr (((REPEAT_MASK >> PH) & 1ull) != 0ull) { if (did) { if (PH == 0) cg::this_grid().sync(); else xcd_barrier(bar); phase_body<PH>(lds); } }
  if (did && PH + 1 < hi) { if (PH == 0) cg::this_grid().sync(); else xcd_barrier(bar); }
}
template <int... I> __device__ __forceinline__ void run_all(std::integer_sequence<int, I...>, unsigned char* lds, int lo, int hi, const XcdBarrier& bar) { (run_phase<I>(lds, lo, hi, bar), ...); }
__global__ void __launch_bounds__(NTHR) fwd_kernel(Params p) {
  extern __shared__ __attribute__((aligned(16))) unsigned char lds[];
  volatile __attribute__((address_space(3))) unsigned* misc = (volatile __attribute__((address_space(3))) unsigned*)((__attribute__((address_space(3))) unsigned char*)lds + MISC_OFF);
  if (tid_() < 16) misc[tid_()] = 0u;
  __syncthreads();
  const XcdBarrier bar = xcd_barrier_post((unsigned*)(P(ws) + WS_CTL) + CW_BAR, misc);
  run_all(std::make_integer_sequence<int, N_PHASES>{}, lds, p.ph_lo, p.ph_hi, bar);
}

extern "C" void kernel_launch(void* const* d_in, const int* in_sizes, int n_in, void* d_out, int out_size, void* d_ws, size_t ws_size, hipStream_t stream) {
  static int grid = 0;
  if (grid == 0) {
    if (n_in != 29 || out_size != T * D || ws_size < WS_END) { fprintf(stderr, "kernel_launch: unexpected problem (n_in %d, out %d, ws %zu)\n", n_in, out_size, ws_size); grid = -1; return; }
    int dev = 0, cus = 0, per_cu = 0;
    hipGetDevice(&dev); hipDeviceGetAttribute(&cus, hipDeviceAttributeMultiprocessorCount, dev);
    hipFuncSetAttribute((const void*)fwd_kernel, hipFuncAttributeMaxDynamicSharedMemorySize, LDS_BYTES);
    hipOccupancyMaxActiveBlocksPerMultiprocessor(&per_cu, (const void*)fwd_kernel, NTHR, LDS_BYTES);
    if (per_cu < 1) { fprintf(stderr, "kernel_launch: occupancy query says %d blocks/CU\n", per_cu); per_cu = 1; }
    grid = cus * 1;
    (void)hipGetLastError();
  }
  if (grid < 0) return;
  if (hipMemsetAsync((char*)d_ws + WS_CTL, 0, CTL_ZERO_BYTES, stream) != hipSuccess) { fprintf(stderr, "kernel_launch: memset failed\n"); return; }
  Params p{};
  memcpy((void*)&p, (const void*)d_in, 29 * sizeof(void*));
  p.out = (float*)d_out; p.ws = (unsigned char*)d_ws; p.ph_lo = 0; p.ph_hi = N_PHASES;
  void* args[] = {&p};
  hipError_t e = hipLaunchCooperativeKernel((const void*)fwd_kernel, dim3(grid), dim3(NTHR), args, LDS_BYTES, stream);
  if (e != hipSuccess) fprintf(stderr, "cooperative launch failed: %s (grid %d)\n", hipGetErrorString(e), grid);
}
```

```cpp
#include <hip/hip_runtime.h>
#include <hip/hip_cooperative_groups.h>
#include <hip/hip_bf16.h>
#include <cstdio>
#include <cstdint>
#include <cstring>
#include <utility>
namespace cg = cooperative_groups;

typedef unsigned short bf16_t;
typedef unsigned long long u64;

constexpr int D = 1024, NB = 4, S = 4096, T = NB * S, DFF = 4096;
constexpr int NSA_IN = 2608, NSA_P = 2816, DIFF_IN = 3072;
constexpr float EPS = 1e-6f;
constexpr float C2 = 0.125f * 1.4426950408889634f;
constexpr int NTHR = 512;
constexpr int LDS_BYTES = 147456;
constexpr unsigned long long REPEAT_MASK = 0ull;
constexpr int REPEAT_SUB = 0;

constexpr size_t MiB = 1u << 20;
constexpr size_t WS_CTL = 0, CTL_ZERO_BYTES = 1 * MiB;
constexpr int CW_BAR = 4096;
constexpr int MISC_OFF = LDS_BYTES - 64;
constexpr size_t WS_MOD = 1 * MiB;
constexpr size_t WS_ROPE = 2 * MiB;
constexpr size_t WS_SMALL = 3 * MiB;
constexpr size_t WS_WT = 4 * MiB;
constexpr size_t WT_LAYER = 24 * MiB, WT_OUT = 6 * MiB, WT_MI = 8 * MiB, WT_MO = 16 * MiB;
constexpr size_t WS_W1T = 100 * MiB;
constexpr size_t WS_H = 104 * MiB;
constexpr size_t WS_PROJ = 136 * MiB;
constexpr size_t WS_ATT = 232 * MiB;
constexpr size_t WS_OC = 328 * MiB;
constexpr size_t WS_KCMP = 360 * MiB;
constexpr size_t WS_VCMP = 361 * MiB;
constexpr size_t WS_SEL = 362 * MiB;
constexpr size_t WS_HID = 136 * MiB;
constexpr size_t WS_END = 364 * MiB;

struct Params {
  const float* x; const float* c; const int* pos; const float* ln_mix_g; const float* ln_mlp_g;
  const float* w_ada; const float* b_ada; const float* w_mlp_in; const float* w_mlp_out;
  const float* nsa_w_in; const float* nsa_b_gate; const float* nsa_q_gain; const float* nsa_k_gain;
  const float* nsa_pe_k; const float* nsa_w_ck1; const float* nsa_w_ck2; const float* nsa_pe_v; const float* nsa_w_cv1; const float* nsa_w_cv2; const float* nsa_w_out;
  const float* diff_w_in; const float* diff_q_gain; const float* diff_k_gain; const float* diff_lq1; const float* diff_lk1; const float* diff_lq2; const float* diff_lk2; const float* diff_subln_g; const float* diff_w_out;
  float* out; unsigned char* ws; int ph_lo, ph_hi;
};

typedef __attribute__((address_space(4))) const unsigned char* kptr_t;
template <class Tp> __device__ __forceinline__ Tp karg_load(unsigned off) {
  asm volatile("" : "+s"(off));
  kptr_t kp = (kptr_t)__builtin_amdgcn_kernarg_segment_ptr();
  return *(const __attribute__((address_space(4))) Tp*)(kp + off);
}
__device__ __forceinline__ int tid_() { int t = (int)threadIdx.x; asm volatile("" : "+v"(t)); return t; }
__device__ __forceinline__ int bid_() { int t = (int)blockIdx.x; asm volatile("" : "+s"(t)); return t; }
__device__ __forceinline__ int gdim_() { int t = (int)gridDim.x; asm volatile("" : "+s"(t)); return t; }
#define P(m) karg_load<decltype(Params::m)>((unsigned)offsetof(Params, m))
__device__ __forceinline__ float bf2f(unsigned v) { return __uint_as_float(v << 16); }
__device__ __forceinline__ unsigned f2bf(float f) { unsigned u = __float_as_uint(f); return (u + 0x7fffu + ((u >> 16) & 1u)) >> 16; }
__device__ __forceinline__ unsigned pk2(float lo, float hi) { return f2bf(lo) | (f2bf(hi) << 16); }
__device__ __forceinline__ void unpack8(const uint4 v, float* f) {
  f[0] = bf2f(v.x & 0xffffu); f[1] = bf2f(v.x >> 16); f[2] = bf2f(v.y & 0xffffu); f[3] = bf2f(v.y >> 16);
  f[4] = bf2f(v.z & 0xffffu); f[5] = bf2f(v.z >> 16); f[6] = bf2f(v.w & 0xffffu); f[7] = bf2f(v.w >> 16);
}
__device__ __forceinline__ uint4 pack8(const float* f) { uint4 v; v.x = pk2(f[0], f[1]); v.y = pk2(f[2], f[3]); v.z = pk2(f[4], f[5]); v.w = pk2(f[6], f[7]); return v; }
__device__ __forceinline__ float wave_sum(float v) {
#pragma unroll
  for (int o = 1; o < 64; o <<= 1) v += __shfl_xor(v, o);
  return v;
}
__device__ __forceinline__ float lam_init_of(int j) { return j == 0 ? 0.35550906759096934f : 0.5560582041556406f; }

namespace pg8 {
#define PG8_LAS __attribute__((address_space(3)))
typedef unsigned short bf16_t;
typedef short bf16x8 __attribute__((ext_vector_type(8)));
typedef float f32x4 __attribute__((ext_vector_type(4)));
typedef unsigned u32x4 __attribute__((ext_vector_type(4)));
constexpr int BM = 256, BK = 64, HALF = 128, HTB = HALF * BK * 2  , STAGE_BYTES = 8 * HTB, NXCD = 8, WGM = 8;

__host__ __device__ __forceinline__ int lds_byte(int r, int c) { const int st = (r >> 4) * 2 + (c >> 5), rr = r & 15, cc = c & 31, ob = rr * 64 + cc * 2; return st * 1024 + (ob ^ (((ob >> 9) & 1) << 5)); }
__host__ __device__ __forceinline__ void stage_rc(int b, int& R, int& C) { const int st = b / 1024, sb = b % 1024, swz = sb ^ (((sb >> 9) & 1) << 5); R = (st >> 1) * 16 + swz / 64; C = (st & 1) * 32 + (swz % 64) / 2; }
__host__ __device__ __forceinline__ int perm32(int rho) { const int n = rho >> 4, i = rho & 15; return 8 * (i >> 2) + 4 * n + (i & 3); }

struct Unit { int pm, pn; };
struct Gemm { const bf16_t* A; const bf16_t* Bt; int M, N, K; };

struct StaticOrder {
    int nM, nN, nwg, G, c;
    __host__ __device__ void init(int M, int N, int G_, int c_) { nM = M / BM; nN = N / BM; nwg = nM * nN; G = G_; c = c_; }
    __host__ __device__ bool next(int i, Unit& u) const {
        const long L = (long)i * G + c; if (L >= nwg) return false;
        int wgid = (int)L; { const int q = nwg / NXCD, r = nwg % NXCD, xcd = wgid % NXCD, off = wgid / NXCD; wgid = (xcd < r ? xcd * (q + 1) : r * (q + 1) + (xcd - r) * q) + off; }
        const int nig = WGM * nN, gid = wgid / nig, fm = gid * WGM, gsz = (nM - fm) < WGM ? (nM - fm) : WGM;
        u.pm = fm + ((wgid % nig) % gsz); u.pn = (wgid % nig) / gsz; return true;
    }
    __device__ __forceinline__ void a_ready(const Unit&) const {}
    __device__ __forceinline__ void done(const Unit&) const {}
};


__device__ __forceinline__ unsigned cvt_pk_bf16(float lo, float hi) { unsigned r; asm volatile("v_cvt_pk_bf16_f32 %0, %1, %2" : "=v"(r) : "v"(lo), "v"(hi)); return r; }
template <int ACT  > struct EpiBf16 {
    static constexpr bool PERM = true, AFTER_DRAIN = false;
    bf16_t* O; int ldc;
    __device__ __forceinline__ void operator()(const f32x4 (&acc)[2][2][4][2], const Unit& u, int wr, int wc, int fr, int fq) const {
        const int row0 = u.pm * BM + wr * 64 + fr; const int col0 = u.pn * BM + wc * 32 + 8 * fq;
#pragma unroll
        for (int ai = 0; ai < 2; ++ai)
#pragma unroll
            for (int m = 0; m < 4; ++m) { bf16_t* rowp = O + (size_t)(row0 + ai * HALF + m * 16) * ldc + col0;
#pragma unroll
                for (int bj = 0; bj < 2; ++bj) { f32x4 v0 = acc[ai][bj][m][0], v1 = acc[ai][bj][m][1];
                    if (ACT == 2) {
#pragma unroll
                        for (int e = 0; e < 4; ++e) { float a = v0[e] > 0.f ? v0[e] : 0.f; v0[e] = a * a; float b = v1[e] > 0.f ? v1[e] : 0.f; v1[e] = b * b; } }
                    u32x4 w; w.x = cvt_pk_bf16(v0[0], v0[1]); w.y = cvt_pk_bf16(v0[2], v0[3]); w.z = cvt_pk_bf16(v1[0], v1[1]); w.w = cvt_pk_bf16(v1[2], v1[3]);
                    *(u32x4*)(rowp + bj * HALF) = w; } }
    }
};
struct EpiResid {
    static constexpr bool PERM = false, AFTER_DRAIN = false;
    const float* xin; float* xout; const float* gate;
    __device__ __forceinline__ void operator()(const f32x4 (&acc)[2][2][4][2], const Unit& u, int wr, int wc, int fr, int fq) const {
        const int col0 = u.pn * BM + wc * 32 + 4 * fq; const int b = (u.pm * BM) >> 12;
        f32x4 gv[2][2];
#pragma unroll
        for (int bj = 0; bj < 2; ++bj)
#pragma unroll
            for (int n = 0; n < 2; ++n) gv[bj][n] = *(const f32x4*)(gate + (size_t)b * 6144 + col0 + bj * HALF + n * 16);
#pragma unroll
        for (int ai = 0; ai < 2; ++ai)
#pragma unroll
            for (int m = 0; m < 4; ++m) { const size_t off = (size_t)(u.pm * BM + ai * HALF + wr * 64 + m * 16 + fr) * 1024 + col0;
#pragma unroll
                for (int bj = 0; bj < 2; ++bj)
#pragma unroll
                    for (int n = 0; n < 2; ++n) { const f32x4 xi = *(const f32x4*)(xin + off + bj * HALF + n * 16); *(f32x4*)(xout + off + bj * HALF + n * 16) = xi + gv[bj][n] * acc[ai][bj][m][n]; }
                if (m & 1) asm volatile("" ::: "memory"); }
    }
};

template <class Epi, class Sched, bool ALIGN_EPI = false, bool SP2 = false>
__device__ __forceinline__ void gemm_phase(PG8_LAS unsigned char* lds, const Gemm g, const Sched& S, const Epi& E) {
    const int tid = tid_(), wid = __builtin_amdgcn_readfirstlane(tid >> 6), lane = tid & 63, wr = wid >> 2, wc = wid & 3, fr = lane & 15, fq = lane >> 4;
    const int K = g.K, nt = K / BK;
    unsigned voffA[2], voffB[2];
#pragma unroll
    for (int i = 0; i < 2; ++i) { int R, C; stage_rc(tid * 16 + i * 8192, R, C); const int Rb = Epi::PERM ? ((R & ~31) + perm32(R & 31)) : R;
        voffA[i] = (unsigned)(R * K + C) * 2u; voffB[i] = (unsigned)(Rb * K + C) * 2u; }
    const size_t kstep = (size_t)(BK * 2);
    const size_t hstep = (size_t)HALF * K * 2;
    const size_t tstep = 2 * hstep;
    const unsigned ldsw = (unsigned)wid * 1024u;
    const int aoff = lds_byte(wr * 64 + fr, fq * 8), boff = lds_byte(wc * 32 + fr, fq * 8);
#define PG8_SA(b, h) (((b) * 2 + (h)) * HTB)
#define PG8_SB(b, h) ((4 + (b) * 2 + (h)) * HTB)
#define PG8_STAGE(bufoff, gbase, voff) do { _Pragma("unroll") for (int _i = 0; _i < 2; ++_i) \
        __builtin_amdgcn_global_load_lds((const unsigned*)((const char*)(gbase) + (voff)[_i]), (PG8_LAS unsigned*)(lds + (bufoff) + ldsw + _i * 8192), 16, 0, 0); } while (0)
#define PG8_LDA(dst, b, h) do { _Pragma("unroll") for (int m = 0; m < 4; ++m) _Pragma("unroll") for (int k = 0; k < 2; ++k) dst[m][k] = *(const PG8_LAS bf16x8*)(lds + PG8_SA(b, h) + aoff + m * 2048 + k * 1024); } while (0)
#define PG8_LDB(dst, b, h) do { _Pragma("unroll") for (int n = 0; n < 2; ++n) _Pragma("unroll") for (int k = 0; k < 2; ++k) dst[n][k] = *(const PG8_LAS bf16x8*)(lds + PG8_SB(b, h) + boff + n * 2048 + k * 1024); } while (0)
#define PG8_MMA(ai, bj, At, Bt) do { __builtin_amdgcn_s_setprio(1); _Pragma("unroll") for (int m = 0; m < 4; ++m) _Pragma("unroll") for (int n = 0; n < 2; ++n) _Pragma("unroll") for (int k = 0; k < 2; ++k) \
        acc[ai][bj][m][n] = __builtin_amdgcn_mfma_f32_16x16x32_bf16(Bt[n][k], At[m][k], acc[ai][bj][m][n], 0, 0, 0); __builtin_amdgcn_s_setprio(0); } while (0)
#define PG8_WAIT_V(n) asm volatile("s_waitcnt vmcnt(" #n ")" ::: "memory")
#define PG8_WAIT_L(n) asm volatile("s_waitcnt lgkmcnt(" #n ")" ::: "memory")
#define PG8_BAR __builtin_amdgcn_s_barrier()
#define PG8_SCHED __builtin_amdgcn_sched_barrier(0)
    Unit cur, nxt; int ui = 0;
    if (!S.next(0, cur)) return;
    f32x4 acc[2][2][4][2];
#pragma unroll
    for (int a = 0; a < 2; ++a)
#pragma unroll
        for (int b = 0; b < 2; ++b)
#pragma unroll
            for (int m = 0; m < 4; ++m)
#pragma unroll
                for (int n = 0; n < 2; ++n) acc[a][b][m][n] = (f32x4){0.f, 0.f, 0.f, 0.f};
    bf16x8 At[4][2], B0[2][2], B1[2][2];
    const char* cA = (const char*)g.A + (size_t)cur.pm * tstep; const char* cB = (const char*)g.Bt + (size_t)cur.pn * tstep;
    S.a_ready(cur);
    if constexpr (SP2) {
        PG8_STAGE(PG8_SB(0, 0), cB, voffB); PG8_STAGE(PG8_SB(0, 1), cB + hstep, voffB); PG8_STAGE(PG8_SA(0, 0), cA, voffA); PG8_STAGE(PG8_SA(0, 1), cA + hstep, voffA);
        if (wr == 1) PG8_BAR;
        PG8_WAIT_V(2); PG8_BAR;
        PG8_STAGE(PG8_SB(1, 0), cB + kstep, voffB); PG8_STAGE(PG8_SA(1, 0), cA + kstep, voffA); PG8_STAGE(PG8_SB(1, 1), cB + hstep + kstep, voffB);
        PG8_WAIT_V(6); PG8_BAR;
    } else {
        PG8_STAGE(PG8_SB(0, 0), cB, voffB); PG8_STAGE(PG8_SA(0, 0), cA, voffA); PG8_STAGE(PG8_SB(0, 1), cB + hstep, voffB); PG8_STAGE(PG8_SA(0, 1), cA + hstep, voffA);
        if (wr == 1) PG8_BAR;
        PG8_WAIT_V(4); PG8_BAR;
        PG8_STAGE(PG8_SB(1, 0), cB + kstep, voffB); PG8_STAGE(PG8_SA(1, 0), cA + kstep, voffA); PG8_STAGE(PG8_SB(1, 1), cB + hstep + kstep, voffB);
        PG8_WAIT_V(6); PG8_BAR;
    }
    for (;;) {
        const bool has_next = S.next(ui + 1, nxt);
        const char* nA = has_next ? (const char*)g.A + (size_t)nxt.pm * tstep : cA; const char* nB = has_next ? (const char*)g.Bt + (size_t)nxt.pn * tstep : cB;
        for (int t = 0; t < nt; t += 2) {
            const bool last = (t == nt - 2);
            const char* a1 = cA + (size_t)(t + 1) * kstep;
            const char* a2 = last ? nA : cA + (size_t)(t + 2) * kstep; const char* b2 = last ? nB : cB + (size_t)(t + 2) * kstep;
            const char* a3 = a2 + kstep; const char* b3 = b2 + kstep;
            if (last && has_next) S.a_ready(nxt);
            if constexpr (SP2) {
            PG8_LDB(B0, 0, 0); PG8_LDB(B1, 0, 1); PG8_SCHED; PG8_LDA(At, 0, 0); PG8_STAGE(PG8_SA(1, 1), a1 + hstep, voffA);
            PG8_WAIT_V(8); PG8_WAIT_L(0); PG8_BAR; PG8_MMA(0, 0, At, B0); PG8_MMA(0, 1, At, B1); PG8_BAR; PG8_SCHED;
            PG8_LDA(At, 0, 1); PG8_STAGE(PG8_SB(0, 0), b2, voffB); PG8_STAGE(PG8_SB(0, 1), b2 + hstep, voffB); PG8_STAGE(PG8_SA(0, 0), a2, voffA);
            PG8_WAIT_V(8); PG8_WAIT_L(0); PG8_BAR; PG8_MMA(1, 0, At, B0); PG8_MMA(1, 1, At, B1); PG8_BAR; PG8_SCHED;
            PG8_LDB(B0, 1, 0); PG8_LDB(B1, 1, 1); PG8_SCHED; PG8_LDA(At, 1, 0); PG8_STAGE(PG8_SA(0, 1), a2 + hstep, voffA);
            PG8_WAIT_V(8); PG8_WAIT_L(0); PG8_BAR; PG8_MMA(0, 0, At, B0); PG8_MMA(0, 1, At, B1); PG8_BAR; PG8_SCHED;
            PG8_LDA(At, 1, 1); PG8_STAGE(PG8_SB(1, 0), b3, voffB); PG8_STAGE(PG8_SB(1, 1), b3 + hstep, voffB); PG8_STAGE(PG8_SA(1, 0), a3, voffA);
            PG8_WAIT_V(8); PG8_WAIT_L(0); PG8_BAR; PG8_MMA(1, 0, At, B0); PG8_MMA(1, 1, At, B1); PG8_BAR; PG8_SCHED;
            } else {
            PG8_LDB(B0, 0, 0); PG8_SCHED; PG8_LDA(At, 0, 0); PG8_STAGE(PG8_SA(1, 1), a1 + hstep, voffA);
            PG8_WAIT_L(8); PG8_BAR; PG8_WAIT_L(0); PG8_MMA(0, 0, At, B0); PG8_BAR; PG8_SCHED;
            PG8_LDB(B1, 0, 1); PG8_STAGE(PG8_SB(0, 0), b2, voffB);
            PG8_BAR; PG8_WAIT_L(0); PG8_MMA(0, 1, At, B1); PG8_BAR;
            PG8_LDA(At, 0, 1); PG8_STAGE(PG8_SA(0, 0), a2, voffA);
            PG8_BAR; PG8_WAIT_L(0); PG8_MMA(1, 0, At, B0); PG8_BAR; PG8_SCHED;
            PG8_STAGE(PG8_SB(0, 1), b2 + hstep, voffB);
            PG8_WAIT_V(6); PG8_BAR; PG8_MMA(1, 1, At, B1); PG8_BAR;
            PG8_LDB(B0, 1, 0); PG8_SCHED; PG8_LDA(At, 1, 0); PG8_STAGE(PG8_SA(0, 1), a2 + hstep, voffA);
            PG8_WAIT_L(8); PG8_BAR; PG8_WAIT_L(0); PG8_MMA(0, 0, At, B0); PG8_BAR; PG8_SCHED;
            PG8_LDB(B1, 1, 1); PG8_STAGE(PG8_SB(1, 0), b3, voffB);
            PG8_BAR; PG8_WAIT_L(0); PG8_MMA(0, 1, At, B1); PG8_BAR;
            PG8_LDA(At, 1, 1); PG8_STAGE(PG8_SA(1, 0), a3, voffA);
            PG8_BAR; PG8_WAIT_L(0); PG8_MMA(1, 0, At, B0); PG8_BAR; PG8_SCHED;
            PG8_STAGE(PG8_SB(1, 1), b3 + hstep, voffB);
            PG8_WAIT_V(6); PG8_BAR; PG8_MMA(1, 1, At, B1); PG8_BAR;
            }
        }
        if constexpr (ALIGN_EPI) { if (wr == 0) PG8_BAR; }
        if constexpr (!Epi::AFTER_DRAIN) { E(acc, cur, wr, wc, fr, fq); S.done(cur); }
        if (!has_next) break;
#pragma unroll
        for (int a = 0; a < 2; ++a)
#pragma unroll
            for (int b = 0; b < 2; ++b)
#pragma unroll
                for (int m = 0; m < 4; ++m)
#pragma unroll
                    for (int n = 0; n < 2; ++n) acc[a][b][m][n] = (f32x4){0.f, 0.f, 0.f, 0.f};
        cur = nxt; cA = nA; cB = nB; ++ui;
        if constexpr (ALIGN_EPI) { if (wr == 1) PG8_BAR; }
    }
    PG8_WAIT_V(0);
    if constexpr (!ALIGN_EPI) { if (wr == 0) PG8_BAR; }
    PG8_BAR;
    if constexpr (Epi::AFTER_DRAIN) { E.fused(acc, cur, wr, wc, fr, fq, lds, wid, lane); S.done(cur); }
#undef PG8_SA
#undef PG8_SB
#undef PG8_STAGE
#undef PG8_LDA
#undef PG8_LDB
#undef PG8_MMA
#undef PG8_WAIT_V
#undef PG8_WAIT_L
#undef PG8_BAR
#undef PG8_SCHED
}
}

namespace attn_body {
using bf16=__hip_bfloat16;
using bf16x8=__attribute__((ext_vector_type(8)))short;
using s16x4=__attribute__((ext_vector_type(4)))short;
using f32x16=__attribute__((ext_vector_type(16)))float;
using u32x4=__attribute__((ext_vector_type(4)))unsigned;
constexpr int D=64;
constexpr int NW=8,QBLK=32,QB=QBLK*NW,KVBLK=64;
__device__ __forceinline__ int crow(int r,int hi){return (r&3)+8*(r>>2)+4*hi;}
#define SBAR() __builtin_amdgcn_sched_barrier(0)
__device__ __forceinline__ void cmask(f32x16&p0,f32x16&p1,int jb,int qrel,int hi){
  const float NEG=-INFINITY; int kb=64*jb+4*hi;
  #pragma unroll
  for(int r=0;r<16;++r){int kv=kb+(r&3)+8*(r>>2); if(kv>qrel)p0[r]=NEG; if(kv+32>qrel)p1[r]=NEG;}
}

__device__ __forceinline__ void lmask(f32x16&p0,f32x16&p1,int t,int qrel,int hi){
  const float NEG=-30000.f; int kb=64*t+4*hi;
  #pragma unroll
  for(int r=0;r<16;++r){int kv=kb+(r&3)+8*(r>>2); if(kv<=qrel)p0[r]=NEG; if(kv+32<=qrel)p1[r]=NEG;}
}
__device__ __forceinline__ void smask(f32x16&p0,f32x16&p1,bool on){
  const float NEG=-INFINITY;
  #pragma unroll
  for(int r=0;r<16;++r){ p0[r]=on?p0[r]:NEG; p1[r]=on?p1[r]:NEG; }
}
constexpr int NSLOT=3, SLOTB=8192;
constexpr int LDS_K=0, LDS_V=NSLOT*SLOTB, LDS_WS=2*NSLOT*SLOTB, LDS_OST=LDS_WS+NW*64*4, LDS_BYTES=LDS_OST+NW*4096;
constexpr float C2=0.125f*1.4426950408889634f;
__device__ __forceinline__ void glds16(const void*gsrc,unsigned lds_dst){unsigned keep;
  asm volatile("s_mov_b32 %0, m0\n\ts_mov_b32 m0, %2\n\ts_nop 0\n\tglobal_load_lds_dwordx4 %1, off\n\ts_mov_b32 m0, %0":"=&s"(keep):"v"(gsrc),"s"(lds_dst):"memory");}
__device__ __forceinline__ float max3f(float a,float b,float c){float r;asm("v_max3_f32 %0, %1, %2, %3":"=v"(r):"v"(a),"v"(b),"v"(c));return r;}
__device__ __forceinline__ float max2f(float a,float b){float r;asm("v_max_f32_e32 %0, %1, %2":"=v"(r):"v"(a),"v"(b));return r;}
__device__ __forceinline__ float fadd_s(float a,float b){float r;asm("v_add_f32_e32 %0, %1, %2":"=v"(r):"v"(a),"v"(b));return r;}
__device__ __forceinline__ float fsub_s(float a,float b){float r;asm("v_sub_f32_e32 %0, %1, %2":"=v"(r):"v"(a),"v"(b));return r;}
typedef float f32x2_t __attribute__((ext_vector_type(2))); typedef __bf16 bf16x2_t __attribute__((ext_vector_type(2)));
__device__ __forceinline__ unsigned cvtpk_s(float lo,float hi){f32x2_t v={lo,hi};bf16x2_t b=__builtin_convertvector(v,bf16x2_t);return __builtin_bit_cast(unsigned,b);}
#define WAIT_BAR(N) asm volatile("s_waitcnt vmcnt(" #N ") lgkmcnt(0)\n\ts_barrier":::"memory")

__device__ __forceinline__ void qkt(f32x16&p0,f32x16&p1,const char*Kslot,const bf16x8*qr,const f32x16&negm,int r32,int hi){
  const char*kb=Kslot+hi*1024+r32*16;
  #pragma unroll
  for(int d0=0;d0<4;++d0){
    const bf16x8 b0=*reinterpret_cast<const bf16x8*>(kb+d0*2048);
    const bf16x8 b1=*reinterpret_cast<const bf16x8*>(kb+d0*2048+512);
    if(d0==0){p0=__builtin_amdgcn_mfma_f32_32x32x16_bf16(b0,qr[0],negm,0,0,0);p1=__builtin_amdgcn_mfma_f32_32x32x16_bf16(b1,qr[0],negm,0,0,0);}
    else{p0=__builtin_amdgcn_mfma_f32_32x32x16_bf16(b0,qr[d0],p0,0,0,0);p1=__builtin_amdgcn_mfma_f32_32x32x16_bf16(b1,qr[d0],p1,0,0,0);}}
}
typedef __attribute__((address_space(3))) const char* lds_cptr;
typedef short v4i16_t __attribute__((ext_vector_type(4)));
__device__ __forceinline__ void kload8(bf16x8*kf,lds_cptr kp){
  kf[0]=*(const __attribute__((address_space(3))) bf16x8*)(kp);      kf[1]=*(const __attribute__((address_space(3))) bf16x8*)(kp+512);
  kf[2]=*(const __attribute__((address_space(3))) bf16x8*)(kp+2048); kf[3]=*(const __attribute__((address_space(3))) bf16x8*)(kp+2560);
  kf[4]=*(const __attribute__((address_space(3))) bf16x8*)(kp+4096); kf[5]=*(const __attribute__((address_space(3))) bf16x8*)(kp+4608);
  kf[6]=*(const __attribute__((address_space(3))) bf16x8*)(kp+6144); kf[7]=*(const __attribute__((address_space(3))) bf16x8*)(kp+6656);
}
__device__ __forceinline__ void kload2(bf16x8*kf,lds_cptr kp,int j){ kf[2*j]=*(const __attribute__((address_space(3))) bf16x8*)(kp+j*2048); kf[2*j+1]=*(const __attribute__((address_space(3))) bf16x8*)(kp+j*2048+512); }
__device__ __forceinline__ s16x4 vtr(lds_cptr p){ return __builtin_bit_cast(s16x4,__builtin_amdgcn_ds_read_tr16_b64_v4i16((__attribute__((address_space(3))) v4i16_t*)p)); }
__device__ __forceinline__ float rowmax(const f32x16&p0,const f32x16&p1){
  float a=max3f(p0[0],p0[1],p1[0]),b=max3f(p0[2],p0[3],p1[1]);a=max3f(a,p1[2],p1[3]);
  #pragma unroll
  for(int r=4;r<16;r+=4){a=max3f(a,p0[r],p0[r+1]);b=max3f(b,p0[r+2],p0[r+3]);a=max3f(a,p1[r],p1[r+1]);b=max3f(b,p1[r+2],p1[r+3]);}
  const float m=max2f(a,b);
  auto rr=__builtin_amdgcn_permlane32_swap(__float_as_uint(m),__float_as_uint(m),false,false);
  return max2f(__uint_as_float(rr[0]),__uint_as_float(rr[1]));
}
__device__ __forceinline__ void pv(f32x16*o,int vb,bf16x8 pa0,bf16x8 pa1,bf16x8 pa2,bf16x8 pa3){
  #pragma unroll
  for(int d0=0;d0<2;++d0){s16x4 lo[4],hi[4];
    #pragma unroll
    for(int ks=0;ks<4;++ks){
      asm volatile("ds_read_b64_tr_b16 %0,%1 offset:%c2":"=&v"(lo[ks]):"v"(vb),"i"(d0*4096+ks*1024):"memory");
      asm volatile("ds_read_b64_tr_b16 %0,%1 offset:%c2":"=&v"(hi[ks]):"v"(vb),"i"(d0*4096+ks*1024+512):"memory");}
    asm volatile("s_waitcnt lgkmcnt(0)":::"memory");SBAR();
    #define PK(k) (bf16x8){lo[k][0],lo[k][1],lo[k][2],lo[k][3],hi[k][0],hi[k][1],hi[k][2],hi[k][3]}
    o[d0]=__builtin_amdgcn_mfma_f32_32x32x16_bf16(pa0,PK(0),o[d0],0,0,0);
    o[d0]=__builtin_amdgcn_mfma_f32_32x32x16_bf16(pa1,PK(1),o[d0],0,0,0);
    o[d0]=__builtin_amdgcn_mfma_f32_32x32x16_bf16(pa2,PK(2),o[d0],0,0,0);
    o[d0]=__builtin_amdgcn_mfma_f32_32x32x16_bf16(pa3,PK(3),o[d0],0,0,0);
    #undef PK
  }
}

#ifndef ATTN_STORE16
#define ATTN_STORE16(p,v) (*(u32x4*)(p)=(v))
#endif
template<int THRL,int MODE> __device__ __forceinline__ void attn_unit(long rowbase,int qb,const bf16*Qh,int ldq,const bf16*__restrict__ Kh0,const bf16*__restrict__ Vh0,int ldkv,bf16*Oh,int ldo,const unsigned long long*selrow,char*shm){
  const int tid=tid_(),lane=tid&63,r32=lane&31,hi=lane>>5; const int wid=__builtin_amdgcn_readfirstlane(tid>>6);
  const int q0=qb*QB;
  int t_lo=0; bool lower=false; if(MODE==2){ if(qb>=2){ t_lo=4*qb-8; lower=true; } }
  const bf16*Qw=Qh+(rowbase+q0+wid*QBLK)*ldq;
  const bf16*Kh=Kh0+(rowbase+(long)t_lo*KVBLK)*ldkv,*Vh=Vh0+(rowbase+(long)t_lo*KVBLK)*ldkv;
  const unsigned lds0=(unsigned)(uintptr_t)shm;
  float*wsf=(float*)(shm+LDS_WS)+wid*64;
  const bf16*ksrc=Kh+(long)lane*ldkv+wid*8;
  const bf16*vsrc=Vh+(long)(16*(wid&3)+(lane>>2))*ldkv+(wid>>2)*32+(lane&3)*8;
  const unsigned kdst=lds0+LDS_K+wid*1024, vdst=lds0+LDS_V+wid*1024;
  #define DMA_K(t,slot) glds16(ksrc+(long)(t)*KVBLK*ldkv,(unsigned)__builtin_amdgcn_readfirstlane(kdst+(slot)))
  #define DMA_V(t,slot) glds16(vsrc+(long)(t)*KVBLK*ldkv,(unsigned)__builtin_amdgcn_readfirstlane(vdst+(slot)))
  const int vb0=(int)(lds0+LDS_V)+((lane>>4)&1)*32+(lane&3)*8+(4*hi+((lane&15)>>2))*64;
  const char*Kbase=shm+LDS_K; bf16x8 kf[8];
  const lds_cptr shm3=(lds_cptr)shm; const lds_cptr kp0=shm3+LDS_K+hi*1024+r32*16; const lds_cptr vp0=shm3+LDS_V+((lane>>4)&1)*32+(lane&3)*8+(4*hi+((lane&15)>>2))*64;
  const int NT=(q0+QB)/KVBLK-t_lo;
  DMA_K(0,0);DMA_V(0,0);DMA_K(1,SLOTB);
  bf16x8 qr[4];
  #pragma unroll
  for(int d0=0;d0<4;++d0)qr[d0]=*reinterpret_cast<const bf16x8*>(&Qw[(long)r32*ldq+d0*16+hi*8]);
  float mhat=0.f,l_reg=0.f;f32x16 o[2];o[0]=f32x16{};o[1]=f32x16{};f32x16 negm=f32x16{};asm volatile("":"+v"(negm));
  const int qrel=wid*QBLK+r32;
  unsigned long long msk=0ull; if(MODE==1) msk=selrow[q0+qrel];
  #define XMASK(P0,P1,t) do{ if(MODE==1) smask(P0,P1,((msk>>(t))&1ull)!=0ull); if(MODE==2){ if(lower&&(t)<4) lmask(P0,P1,(t),qrel,hi); } }while(0)
  #define CMASK(P0,P1,t) do{ XMASK(P0,P1,t); int jb_=(t)-(NT-4); if(jb_>=0)cmask(P0,P1,jb_,qrel,hi);}while(0)
  bool resc=false;
  #define START(P0,P1) do{ const float rm=rowmax(P0,P1); resc=false; \
    { const float dl=rm; mhat=fadd_s(mhat,dl); \
      _Pragma("unroll") for(int r=0;r<16;++r){P0[r]=fsub_s(P0[r],dl);P1[r]=fsub_s(P1[r],dl);} \
      _Pragma("unroll") for(int r=0;r<16;++r)negm[r]=-mhat; asm volatile("":"+v"(negm)); } \
    _Pragma("unroll") for(int r=0;r<16;++r)P0[r]=__builtin_amdgcn_exp2f(P0[r]); }while(0)
  #define RESC() do{ if(resc){ asm volatile("s_waitcnt lgkmcnt(0)":::"memory"); \
      _Pragma("unroll") for(int d_=0;d_<2;++d_) _Pragma("unroll") for(int r=0;r<16;++r)o[d_][r]*=wsf[crow(r,hi)]; } }while(0)
  f32x16 pA0,pA1,pB0,pB1;
  int sl_prev=0,sl_cur=0,sl_next=SLOTB;
  #define ROT() do{sl_prev=sl_cur;sl_cur=sl_next;sl_next=(sl_next==(NSLOT-1)*SLOTB)?0:sl_next+SLOTB;}while(0)
  DMA_K(2,2*SLOTB);
  WAIT_BAR(3);
  qkt(pA0,pA1,Kbase,qr,negm,r32,hi);asm volatile("s_nop 15\n\ts_nop 7":"+v"(pA0),"+v"(pA1));CMASK(pA0,pA1,0);
  START(pA0,pA1);
  _Pragma("unroll") for(int r=0;r<16;++r)pA1[r]=__builtin_amdgcn_exp2f(pA1[r]);
  WAIT_BAR(0);
  DMA_K(3,0);DMA_V(1,SLOTB);
  ROT();
  kload8(kf,kp0+sl_cur);
  WAIT_BAR(2);
  s16x4 vlo[8],vhi[8]; u32x4 pw0,pw1,pw2,pw3;
  #define PKW(P,B) cvtpk_s(P[B],P[B+1])
  #define PAF(k) __builtin_bit_cast(bf16x8,pw##k)
  #define VFR(i) (bf16x8){vlo[i][0],vlo[i][1],vlo[i][2],vlo[i][3],vhi[i][0],vhi[i][1],vhi[i][2],vhi[i][3]}
  #define PIN(x) asm volatile("":"+v"(x))
  #define MX3(a,b,c) __builtin_fmaxf(__builtin_fmaxf((a),(b)),(c))
  #define GAPA(MF,A0,A1,A2,A3,W0,W1,PW) do{ MF; sacc+=A0; sacc+=A1; sacc+=A2; sacc+=A3; PIN(sacc); W0; W1; PIN(PW); SBAR(); }while(0)
  #define EX(v) __builtin_amdgcn_exp2f(v)
  #define GAPB(MF,X,B) do{ MF; X[B]=EX(X[B]); X[B+1]=EX(X[B+1]); X[B+2]=EX(X[B+2]); X[B+3]=EX(X[B+3]); PIN(X); SBAR(); }while(0)
  #define VRD(i) do{ vlo[i]=vtr(vp_+(((i)>>2)*4096+((i)&3)*1024)); vhi[i]=vtr(vp_+(((i)>>2)*4096+((i)&3)*1024+512)); }while(0)
  #define KRD(G,j) do{ if(G){ kload2(kf,kp0+sl_next,j); SBAR(); } }while(0)
  #define STEP(C0,C1,P0,P1,t,GK,GV,GL) do{ SBAR(); \
    const lds_cptr vp_=vp0+sl_prev; \
    VRD(0); SBAR(); float sacc=(P0[0]+P0[1]); \
    GAPA(C0=__builtin_amdgcn_mfma_f32_32x32x16_bf16(kf[0],qr[0],negm,0,0,0), P0[2],P0[3],P0[4],P0[5],     pw0[0]=PKW(P0,0), pw0[1]=PKW(P0,2), pw0); \
    VRD(4); SBAR(); GAPA(C1=__builtin_amdgcn_mfma_f32_32x32x16_bf16(kf[1],qr[0],negm,0,0,0), P0[6],P0[7],P0[8],P0[9],     pw0[2]=PKW(P0,4), pw0[3]=PKW(P0,6), pw0); \
    VRD(1); SBAR(); GAPA(C0=__builtin_amdgcn_mfma_f32_32x32x16_bf16(kf[2],qr[1],C0,0,0,0),   P0[10],P0[11],P0[12],P0[13], pw1[0]=PKW(P0,8), pw1[1]=PKW(P0,10), pw1); \
    VRD(5); SBAR(); GAPA(C1=__builtin_amdgcn_mfma_f32_32x32x16_bf16(kf[3],qr[1],C1,0,0,0),   P0[14],P0[15],P1[0],P1[1],   pw1[2]=PKW(P0,12),pw1[3]=PKW(P0,14), pw1); \
    VRD(2); SBAR(); GAPA(C0=__builtin_amdgcn_mfma_f32_32x32x16_bf16(kf[4],qr[2],C0,0,0,0),   P1[2],P1[3],P1[4],P1[5],     pw2[0]=PKW(P1,0), pw2[1]=PKW(P1,2), pw2); \
    VRD(6); SBAR(); GAPA(C1=__builtin_amdgcn_mfma_f32_32x32x16_bf16(kf[5],qr[2],C1,0,0,0),   P1[6],P1[7],P1[8],P1[9],     pw2[2]=PKW(P1,4), pw2[3]=PKW(P1,6), pw2); \
    VRD(3); SBAR(); GAPA(C0=__builtin_amdgcn_mfma_f32_32x32x16_bf16(kf[6],qr[3],C0,0,0,0),   P1[10],P1[11],P1[12],P1[13], pw3[0]=PKW(P1,8), pw3[1]=PKW(P1,10), pw3); \
    VRD(7); SBAR(); GAPA(C1=__builtin_amdgcn_mfma_f32_32x32x16_bf16(kf[7],qr[3],C1,0,0,0),   P1[14],P1[15],0.f,0.f,       pw3[2]=PKW(P1,12),pw3[3]=PKW(P1,14), pw3); \
    l_reg+=sacc; \
    if(GK){DMA_K((t)+3,sl_cur);} if(GV){DMA_V((t)+1,sl_next);} \
    CMASK(C0,C1,t); \
    { float a=MX3(C0[0],C0[1],C1[0]),b=MX3(C0[2],C0[3],C1[1]); a=MX3(a,C1[2],C1[3]); \
      _Pragma("unroll") for(int r=4;r<16;r+=4){a=MX3(a,C0[r],C0[r+1]);b=MX3(b,C0[r+2],C0[r+3]);a=MX3(a,C1[r],C1[r+1]);b=MX3(b,C1[r+2],C1[r+3]);} \
      float rm=__builtin_fmaxf(a,b); { auto rr=__builtin_amdgcn_permlane32_swap(__float_as_uint(rm),__float_as_uint(rm),false,false); rm=__builtin_fmaxf(__uint_as_float(rr[0]),__uint_as_float(rr[1])); } \
      resc=false; \
      if(__builtin_expect(__any(rm>(float)THRL),0)){ const float dl=__builtin_fmaxf(rm,0.f); mhat+=dl; \
        _Pragma("unroll") for(int r=0;r<16;++r){C0[r]-=dl;C1[r]-=dl;} \
        _Pragma("unroll") for(int r=0;r<16;++r)negm[r]=-mhat; asm volatile("":"+v"(negm)); \
        const float f=__builtin_amdgcn_exp2f(-dl); l_reg*=f; if(hi==0)wsf[r32]=f; resc=true; } } \
    SBAR(); \
    GAPB(o[0]=__builtin_amdgcn_mfma_f32_32x32x16_bf16(PAF(0),VFR(0),o[0],0,0,0), C0,0); \
    GAPB(o[1]=__builtin_amdgcn_mfma_f32_32x32x16_bf16(PAF(0),VFR(4),o[1],0,0,0), C0,4); \
    KRD(GL,0); GAPB(o[0]=__builtin_amdgcn_mfma_f32_32x32x16_bf16(PAF(1),VFR(1),o[0],0,0,0), C0,8); \
    KRD(GL,1); GAPB(o[1]=__builtin_amdgcn_mfma_f32_32x32x16_bf16(PAF(1),VFR(5),o[1],0,0,0), C0,12); \
    KRD(GL,2); GAPB(o[0]=__builtin_amdgcn_mfma_f32_32x32x16_bf16(PAF(2),VFR(2),o[0],0,0,0), C1,0); \
    KRD(GL,3); GAPB(o[1]=__builtin_amdgcn_mfma_f32_32x32x16_bf16(PAF(2),VFR(6),o[1],0,0,0), C1,4); \
    GAPB(o[0]=__builtin_amdgcn_mfma_f32_32x32x16_bf16(PAF(3),VFR(3),o[0],0,0,0), C1,8); \
    GAPB(o[1]=__builtin_amdgcn_mfma_f32_32x32x16_bf16(PAF(3),VFR(7),o[1],0,0,0), C1,12); \
    }while(0)
  int t=1;
  #undef CMASK
  #define CMASK(P0,P1,t) XMASK(P0,P1,t)
  for(;t+5<NT;t+=2){
    STEP(pB0,pB1,pA0,pA1,t,true,true,true);     WAIT_BAR(2); RESC(); ROT();
    STEP(pA0,pA1,pB0,pB1,t+1,true,true,true);   WAIT_BAR(2); RESC(); ROT();
  }
  #undef CMASK
  #define CMASK(P0,P1,t) do{ XMASK(P0,P1,t); int jb_=(t)-(NT-4); if(jb_>=0)cmask(P0,P1,jb_,qrel,hi);}while(0)
  #define ENDW(tt) do{ if((tt)+3<NT){WAIT_BAR(2);} else if((tt)+2<NT){WAIT_BAR(1);} else {WAIT_BAR(0);} }while(0)
  for(;t+1<NT;t+=2){
    STEP(pB0,pB1,pA0,pA1,t,(t+3<NT),(t+1<NT),(t+1<NT));       ENDW(t);   RESC(); ROT();
    STEP(pA0,pA1,pB0,pB1,t+1,(t+4<NT),(t+2<NT),(t+2<NT));     ENDW(t+1); RESC(); ROT();
  }
  STEP(pB0,pB1,pA0,pA1,NT-1,false,false,false); RESC();
  { float sacc=pB0[0]+pB0[1]; _Pragma("unroll") for(int r=2;r<16;++r)sacc+=pB0[r]; _Pragma("unroll") for(int r=0;r<16;++r)sacc+=pB1[r]; l_reg+=sacc;
    pw0=(u32x4){PKW(pB0,0),PKW(pB0,2),PKW(pB0,4),PKW(pB0,6)};pw1=(u32x4){PKW(pB0,8),PKW(pB0,10),PKW(pB0,12),PKW(pB0,14)};pw2=(u32x4){PKW(pB1,0),PKW(pB1,2),PKW(pB1,4),PKW(pB1,6)};pw3=(u32x4){PKW(pB1,8),PKW(pB1,10),PKW(pB1,12),PKW(pB1,14)};
    SBAR(); pv(o,vb0+sl_cur,PAF(0),PAF(1),PAF(2),PAF(3)); }
  #undef PKW
  #undef PAF
  #undef VFR
  #undef PIN
  #undef MX3
  #undef GAPA
  #undef GAPB
  #undef EX
  #undef VRD
  #undef KRD
  #undef STEP
  #undef ENDW
  {auto rr=__builtin_amdgcn_permlane32_swap(__float_as_uint(l_reg),__float_as_uint(l_reg),false,false);l_reg=__uint_as_float(rr[0])+__uint_as_float(rr[1]);}
  if(hi==0)wsf[32+r32]=l_reg;asm volatile("s_waitcnt lgkmcnt(0)":::"memory");
  float rli[16];
  #pragma unroll
  for(int r=0;r<16;++r)rli[r]=__builtin_amdgcn_rcpf(wsf[32+crow(r,hi)]);
  bf16*Ow=Oh+(rowbase+q0+wid*QBLK)*ldo;
  { bf16*stg=(bf16*)(shm+LDS_OST)+wid*2048;
    #pragma unroll
    for(int r=0;r<16;++r){const int orow=crow(r,hi);
      #pragma unroll
      for(int d0=0;d0<2;++d0)stg[orow*64+d0*32+r32]=__float2bfloat16(o[d0][r]*rli[r]);}
    asm volatile("s_waitcnt lgkmcnt(0)":::"memory");
    #pragma unroll
    for(int i=0;i<4;++i){const int row=i*8+(lane>>3),ch=lane&7; const u32x4 v=*(const u32x4*)(stg+row*64+ch*8); ATTN_STORE16(Ow+(long)row*ldo+ch*8,v);} }
  asm volatile("s_waitcnt lgkmcnt(0)\n\ts_barrier":::"memory");
  #undef DMA_K
  #undef DMA_V
  #undef CMASK
  #undef XMASK
  #undef START
  #undef RESC
  #undef ROT
}
constexpr int ATTN_LDS_BYTES=LDS_BYTES;
#undef SBAR
#undef WAIT_BAR
}

__device__ __forceinline__ void ph_attn_diff_fast(unsigned char* lds) {
  using namespace attn_body;
  const bf16* PROJ = (const bf16*)(P(ws) + WS_PROJ); bf16* ATT = (bf16*)(P(ws) + WS_ATT);
  const int G = gdim_(), bx = bid_(); const int v0 = (G % 8 == 0) ? (bx % 8) * (G / 8) + bx / 8 : bx;
  for (int vcu = v0; vcu < 256; vcu += G) {
    const int bhp = vcu >> 1, half = bhp & 1, c = (bhp >> 1) & 1, h8 = (bhp >> 2) & 7, b = bhp >> 5;
#pragma unroll 1
    for (int i = 0; i < 8; ++i) { const int sp = 4 * (vcu & 1) + (i >> 1); const int qb = (i & 1) ? 15 - sp : sp;
      attn_unit<8, 0>((long)b * S, qb, PROJ + (h8 * 2 + c) * 64, DIFF_IN, PROJ + 1024 + (h8 * 2 + c) * 64, PROJ + 2048 + h8 * 128 + half * 64, DIFF_IN,
                      ATT + c * 1024 + h8 * 128 + half * 64, 2048, nullptr, (char*)lds); }
  }
}
__device__ __forceinline__ void ph_attn_sel_fast(unsigned char* lds) {
  using namespace attn_body;
  const bf16* PROJ = (const bf16*)(P(ws) + WS_PROJ); bf16* OSEL = (bf16*)(P(ws) + WS_ATT + 32 * MiB);
  const u64* SEL = (const u64*)(P(ws) + WS_SEL);
  const int G = gdim_(), bx = bid_(); const int v0 = (G % 8 == 0) ? (bx % 8) * (G / 8) + bx / 8 : bx;
  for (int vcu = v0; vcu < 256; vcu += G) {
    const int bh = vcu >> 2, hd = bh & 15, b = bh >> 4, g = hd >> 2;
#pragma unroll 1
    for (int i = 0; i < 4; ++i) { const int sp = 2 * (vcu & 3) + (i >> 1); const int qb = (i & 1) ? 15 - sp : sp;
      attn_unit<8, 1>((long)b * S, qb, PROJ + hd * 64, NSA_P, PROJ + 1536 + g * 64, PROJ + 1792 + g * 64, NSA_P, OSEL + hd * 64, 1024, SEL + (size_t)(b * 4 + g) * S, (char*)lds); }
  }
}
__device__ __forceinline__ void ph_attn_win_fast(unsigned char* lds) {
  using namespace attn_body;
  const bf16* PROJ = (const bf16*)(P(ws) + WS_PROJ); bf16* OWIN = (bf16*)(P(ws) + WS_ATT + 64 * MiB);
  const int G = gdim_(), bx = bid_(); const int v0 = (G % 8 == 0) ? (bx % 8) * (G / 8) + bx / 8 : bx;
  for (int vcu = v0; vcu < 256; vcu += G) {
    const int bh = vcu >> 2, hd = bh & 15, b = bh >> 4, g = hd >> 2;
#pragma unroll 1
    for (int i = 0; i < 4; ++i) { const int qb = (vcu & 3) + 4 * i;
      attn_unit<8, 2>((long)b * S, qb, PROJ + hd * 64, NSA_P, PROJ + 2048 + g * 64, PROJ + 2304 + g * 64, NSA_P, OWIN + hd * 64, 1024, nullptr, (char*)lds); }
  }
}

#define XB_TMO      128
#define XB_XCNT(j)  (256  + 64 * (j))
#define XB_XSUB(j)  (1280 + 64 * (j))
#define XB_XGEN(j)  (2304 + 64 * (j))
#define XB_TOP      3328
#define XB_TOPGEN   3392
#define XCD_BAR_WORDS 3456
#define XB_SPIN_CAP (1u << 18)

__device__ __forceinline__ unsigned xb_ld(unsigned* p)              { return __hip_atomic_load(p, __ATOMIC_RELAXED, __HIP_MEMORY_SCOPE_AGENT); }
__device__ __forceinline__ unsigned xb_add(unsigned* p, unsigned v) { return __hip_atomic_fetch_add(p, v, __ATOMIC_RELAXED, __HIP_MEMORY_SCOPE_AGENT); }
__device__ __forceinline__ unsigned xb_xcc_id() { return (unsigned)__builtin_amdgcn_s_getreg((3 << 11) | 20) & 0xFu; }
#define XB_SPIN(cond, bar) do { unsigned _sp = 0; while (cond) { __builtin_amdgcn_s_sleep(1); \
    if ((++_sp & 255u) == 0u) { if (xb_ld(&(bar)[XB_TMO])) break; if (_sp > XB_SPIN_CAP) { atomicAdd(&(bar)[XB_TMO], 1u); break; } } } } while (0)

struct XcdBarrier {
    unsigned* bar; unsigned x;
    volatile __attribute__((address_space(3))) unsigned* st;
};

__device__ __forceinline__ XcdBarrier xcd_barrier_post(unsigned* bar, volatile __attribute__((address_space(3))) unsigned* st) {
    XcdBarrier b; b.bar = bar; b.x = xb_xcc_id(); b.st = st;
    if (tid_() == 0) (void)xb_add(&bar[XB_XCNT(b.x)], 1u);
    return b;
}
__device__ __forceinline__ void xcd_barrier_complete(unsigned* bar, unsigned x, unsigned& nloc, unsigned& nx) {
    const unsigned G = gridDim.x * gridDim.y * gridDim.z;
    unsigned sum, cnt, mine, sp = 0u;
    for (;;) {
        sum = 0u; cnt = 0u; mine = 0u;
#pragma unroll
        for (unsigned j = 0; j < 16; ++j) { const unsigned c = xb_ld(&bar[XB_XCNT(j)]); sum += c; cnt += (c > 0u) ? 1u : 0u; mine = (j == x) ? c : mine; }
        if (sum == G) break;
        __builtin_amdgcn_s_sleep(1);
        if ((++sp & 255u) == 0u) { if (xb_ld(&bar[XB_TMO])) break; if (sp > XB_SPIN_CAP) { atomicAdd(&bar[XB_TMO], 1u); break; } }
    }
    nloc = mine > 0u ? mine : 1u; nx = cnt > 0u ? cnt : 1u;
}

__device__ __forceinline__ void xcd_barrier(const XcdBarrier& b) {
    asm volatile("s_waitcnt vmcnt(0)" ::: "memory");
    __syncthreads();
    if (tid_() == 0) {
        unsigned* bar = b.bar;
        __builtin_amdgcn_s_waitcnt(0);
        unsigned nloc = b.st[0], nx = b.st[1];
        if (nloc == 0u) { xcd_barrier_complete(bar, b.x, nloc, nx); b.st[0] = nloc; b.st[1] = nx; }
        const unsigned old = xb_add(&bar[XB_XSUB(b.x)], 1u);
        const unsigned gen = old / nloc;
        if (old + 1u == (gen + 1u) * nloc) {
            __builtin_amdgcn_fence(__ATOMIC_RELEASE, "agent");
            asm volatile("s_waitcnt vmcnt(0)" ::: "memory");
            const unsigned og = xb_add(&bar[XB_TOP], 1u);
            const unsigned tg = og / nx;
            if (og + 1u == (tg + 1u) * nx) xb_add(&bar[XB_TOPGEN], 1u);
            else XB_SPIN(xb_ld(&bar[XB_TOPGEN]) == tg, bar);
            __builtin_amdgcn_fence(__ATOMIC_ACQUIRE, "agent");
            xb_add(&bar[XB_XGEN(b.x)], 1u);
            asm volatile("s_waitcnt vmcnt(0)" ::: "memory");
        } else {
            XB_SPIN(xb_ld(&bar[XB_XGEN(b.x)]) == gen, bar);
            __builtin_amdgcn_fence(__ATOMIC_ACQUIRE, "agent");
            asm volatile("s_waitcnt vmcnt(0)" ::: "memory");
        }
    }
    __syncthreads();
}

__device__ __forceinline__ void ph_prologue(unsigned char* lds) {
  const int tid = tid_();
  float* silu = (float*)lds;
  float* red = silu + 4096;
  float* MOD = (float*)(P(ws) + WS_MOD);
  for (int i = tid; i < 4096; i += NTHR) { const float v = P(c)[i]; silu[i] = v / (1.f + expf(-v)); }
  __syncthreads();
  for (int item = bid_(); item < 4 * 48; item += gdim_()) {
    const int l = item / 48, nc = item % 48, cc = tid & 127, ks = tid >> 7;
    const float* w = P(w_ada) + ((size_t)l * 1024 + ks * 256) * 6144 + nc * 128 + cc;
    float a0 = 0.f, a1 = 0.f, a2 = 0.f, a3 = 0.f;
#pragma unroll 8
    for (int k = 0; k < 256; ++k) { const float wv = w[(size_t)k * 6144]; const int kk = ks * 256 + k;
      a0 += silu[kk] * wv; a1 += silu[1024 + kk] * wv; a2 += silu[2048 + kk] * wv; a3 += silu[3072 + kk] * wv; }
    red[(ks * 4 + 0) * 128 + cc] = a0; red[(ks * 4 + 1) * 128 + cc] = a1; red[(ks * 4 + 2) * 128 + cc] = a2; red[(ks * 4 + 3) * 128 + cc] = a3;
    __syncthreads();
    { const int b = tid >> 7;
      const float s = red[(0 * 4 + b) * 128 + cc] + red[(1 * 4 + b) * 128 + cc] + red[(2 * 4 + b) * 128 + cc] + red[(3 * 4 + b) * 128 + cc];
      MOD[(size_t)(l * 4 + b) * 6144 + nc * 128 + cc] = s + P(b_ada)[l * 6144 + nc * 128 + cc]; }
    __syncthreads();
  }
  float* rope = (float*)(P(ws) + WS_ROPE);
  for (int m = bid_() * NTHR + tid; m < T; m += gdim_() * NTHR) {
    const float fp = (float)P(pos)[m];
    const float INV[8] = {1.0f, 0.1939227432012558f, 0.03760603070259094f, 0.007292664609849453f, 0.0014142135623842478f, 0.00027424818836152554f, 5.3182957344688475e-05f, 1.0313385246263351e-05f};
#pragma unroll
    for (int i = 0; i < 8; ++i) {
      const float ang = fp * INV[i];
      const double a = (double)ang; const double kq = rint(a * 0.63661977236758134308); const double r = a - kq * 1.57079632679489661923;
      const int q = (int)((long long)kq & 3ll);
      const double r2 = r * r;
      const double sr = r * (1.0 + r2 * (-1.0 / 6 + r2 * (1.0 / 120 + r2 * (-1.0 / 5040 + r2 * (1.0 / 362880 + r2 * (-1.0 / 39916800 + r2 * (1.0 / 6227020800.0)))))));
      const double cr = 1.0 + r2 * (-0.5 + r2 * (1.0 / 24 + r2 * (-1.0 / 720 + r2 * (1.0 / 40320 + r2 * (-1.0 / 3628800 + r2 * (1.0 / 479001600.0))))));
      const double sn = (q == 0) ? sr : (q == 1) ? cr : (q == 2) ? -sr : -cr;
      const double cs = (q == 0) ? cr : (q == 1) ? -sr : (q == 2) ? -cr : sr;
      rope[(size_t)m * 16 + i] = (float)cs; rope[(size_t)m * 16 + 8 + i] = (float)sn;
    }
  }
  if (bid_() == 0 && tid < 2) {
    const int j = tid; float s1 = 0.f, s2 = 0.f;
    for (int i = 0; i < 64; ++i) { s1 += P(diff_lq1)[j * 64 + i] * P(diff_lk1)[j * 64 + i]; s2 += P(diff_lq2)[j * 64 + i] * P(diff_lk2)[j * 64 + i]; }
    ((float*)(P(ws) + WS_SMALL))[j] = expf(s1) - expf(s2) + lam_init_of(j);
  }
}


__device__ __forceinline__ void transpose_item(const float* W, int K, int N, int Npad, bf16_t* WT, float* scr, int item, int lane) {
  const int nblk = Npad / 32, kb = item / nblk, nb = item % nblk, k0 = 64 * kb, n0 = 32 * nb;
  const int ncol = n0 + (lane & 31); const bool ok = ncol < N;
#pragma unroll 8
  for (int i = 0; i < 32; ++i) { const int kk = 2 * i + (lane >> 5); scr[kk * 33 + (lane & 31)] = ok ? W[(size_t)(k0 + kk) * N + ncol] : 0.f; }
  asm volatile("s_waitcnt lgkmcnt(0)" ::: "memory");
  const int c = lane & 7;
#pragma unroll
  for (int j = 0; j < 4; ++j) { const int n = (lane >> 3) + 8 * j; const float* sp = scr + (8 * c) * 33 + n;
    uint4 o; o.x = pk2(sp[0 * 33], sp[1 * 33]); o.y = pk2(sp[2 * 33], sp[3 * 33]); o.z = pk2(sp[4 * 33], sp[5 * 33]); o.w = pk2(sp[6 * 33], sp[7 * 33]);
    *(uint4*)(WT + (size_t)(n0 + n) * K + k0 + 8 * c) = o; }
  asm volatile("s_waitcnt lgkmcnt(0)" ::: "memory");
}
__device__ __forceinline__ void ph_weights(unsigned char* lds) {
  const int tid = tid_(), lane = tid & 63, wave = tid >> 6;
  float* scr = (float*)(lds + wave * 16384);
  const int gw = bid_() * 8 + wave, NGW = gdim_() * 8;
  for (int it = gw; it < 4 * 6144; it += NGW) {
    const int i = it / 6144; int r = it % 6144; const int j = i >> 1; const bool nsa = (i & 1) == 0;
    bf16_t* base = (bf16_t*)(P(ws) + WS_WT + (size_t)i * WT_LAYER);
    const int n_in = nsa ? 16 * (NSA_P / 32) : 16 * (DIFF_IN / 32);
    if (r < n_in) { if (nsa) transpose_item(P(nsa_w_in) + (size_t)j * D * NSA_IN, D, NSA_IN, NSA_P, base, scr, r, lane); else transpose_item(P(diff_w_in) + (size_t)j * D * DIFF_IN, D, DIFF_IN, DIFF_IN, base, scr, r, lane); continue; }
    r -= n_in;
    if (r < 512) { transpose_item((nsa ? P(nsa_w_out) : P(diff_w_out)) + (size_t)j * D * D, D, D, D, base + WT_OUT / 2, scr, r, lane); continue; }
    r -= 512;
    if (r < 2048) { transpose_item(P(w_mlp_in) + (size_t)i * D * DFF, D, DFF, DFF, base + WT_MI / 2, scr, r, lane); continue; }
    r -= 2048;
    if (r < 2048) transpose_item(P(w_mlp_out) + (size_t)i * DFF * D, DFF, D, D, base + WT_MO / 2, scr, r, lane);
  }
  for (int it = gw; it < 4 * 128; it += NGW) {
    const int jk = it >> 7, jj = jk >> 1, kv = jk & 1;
    transpose_item((kv ? P(nsa_w_cv1) : P(nsa_w_ck1)) + (size_t)jj * 2048 * 128, 2048, 128, 128, (bf16_t*)(P(ws) + WS_W1T) + (size_t)jk * 128 * 2048, scr, it & 127, lane);
  }
}
__device__ __forceinline__ void ph_cmp_bias(unsigned char* lds) {
  float* red = (float*)lds;
  const int tid = tid_(), n = tid & 127, ks = tid >> 7;
  for (int jk = bid_(); jk < 4; jk += gdim_()) {
    const int jj = jk >> 1, kv = jk & 1;
    const float* pe = (kv ? P(nsa_pe_v) : P(nsa_pe_k)) + jj * 2048; const float* w1 = (kv ? P(nsa_w_cv1) : P(nsa_w_ck1)) + (size_t)jj * 2048 * 128;
    float a = 0.f;
#pragma unroll 16
    for (int k = ks * 512; k < ks * 512 + 512; ++k) a += pe[k] * w1[(size_t)k * 128 + n];
    __syncthreads();
    red[ks * 128 + n] = a;
    __syncthreads();
    if (tid < 128) ((float*)(P(ws) + WS_SMALL))[64 + jk * 128 + tid] = red[tid] + red[128 + tid] + red[256 + tid] + red[384 + tid];
  }
}

__device__ __forceinline__ void ph_norm(const float* xin, const float* gvec, const float* mod  , int sh_off, int sc_off, bf16_t* H) {
  const int tid = tid_(), lane = tid & 63, wave = tid >> 6;
  for (int m = bid_() * 8 + wave; m < T; m += gdim_() * 8) {
    const int b = m >> 12;
    const float4* xr = (const float4*)(xin + (size_t)m * D) + lane;
    float4 v[4]; float ss = 0.f;
#pragma unroll
    for (int j = 0; j < 4; ++j) { v[j] = xr[64 * j]; ss += (v[j].x * v[j].x + v[j].y * v[j].y) + (v[j].z * v[j].z + v[j].w * v[j].w); }
    ss = wave_sum(ss);
    const float rstd = 1.0f / sqrtf(ss * (1.0f / D) + EPS);
#pragma unroll
    for (int j = 0; j < 4; ++j) {
      const int col = 4 * lane + 256 * j;
      const float4 g = *(const float4*)(gvec + col), sc = *(const float4*)(mod + (size_t)b * 6144 + sc_off + col), sh = *(const float4*)(mod + (size_t)b * 6144 + sh_off + col);
      const float h0 = v[j].x * rstd * g.x * (1.f + sc.x) + sh.x, h1 = v[j].y * rstd * g.y * (1.f + sc.y) + sh.y;
      const float h2 = v[j].z * rstd * g.z * (1.f + sc.z) + sh.z, h3 = v[j].w * rstd * g.w * (1.f + sc.w) + sh.w;
      uint2 o; o.x = pk2(h0, h1); o.y = pk2(h2, h3);
      *(uint2*)(H + (size_t)m * D + col) = o;
    }
  }
}

struct EpiStore { bf16_t* O; int ld; int relu2;
  __device__ __forceinline__ void operator()(int row, int col, const float* v) const {
    float a = v[0], b = v[1], c = v[2], d = v[3];
    if (relu2) { a = fmaxf(a, 0.f); a *= a; b = fmaxf(b, 0.f); b *= b; c = fmaxf(c, 0.f); c *= c; d = fmaxf(d, 0.f); d *= d; }
    uint2 o; o.x = pk2(a, b); o.y = pk2(c, d); *(uint2*)(O + (size_t)row * ld + col) = o; } };
struct EpiResid { const float* xin; float* xout; const float* gate;
  __device__ __forceinline__ void operator()(int row, int col, const float* v) const {
    const int b = row >> 12; const float4 g = *(const float4*)(gate + (size_t)b * 6144 + col); const float4 xi = *(const float4*)(xin + (size_t)row * D + col);
    float4 o; o.x = xi.x + g.x * v[0]; o.y = xi.y + g.y * v[1]; o.z = xi.z + g.z * v[2]; o.w = xi.w + g.w * v[3];
    *(float4*)(xout + (size_t)row * D + col) = o; } };

template <class Epi>
__device__ __forceinline__ void gemm_naive(const bf16_t* A, int lda, const float* W, int N, int K, unsigned char* lds, const Epi& E) {
  asm volatile("" : "+s"(N), "+s"(K), "+s"(lda));
  float* As = (float*)lds;
  float* Bs = As + 16 * 132;
  const int tid = tid_(), tx = tid & 31, ty = tid >> 5;
  const int nN = (N + 127) / 128, nM = T / 128;
  const int ar = tid >> 2, ak = (tid & 3) * 4, bk = tid >> 5, bc = (tid & 31) * 4;
  for (int u = bid_(); u < nM * nN; u += gdim_()) {
    const int pm = u / nN, pn = u % nN;
    float acc[8][4];
#pragma unroll
    for (int i = 0; i < 8; ++i) { acc[i][0] = 0.f; acc[i][1] = 0.f; acc[i][2] = 0.f; acc[i][3] = 0.f; }
    const bf16_t* Ap = A + (size_t)(pm * 128 + ar) * lda + ak;
    const int wcol = pn * 128 + bc; const bool bok = wcol < N;
    const float* Wp = W + (size_t)bk * N + (bok ? wcol : 0);
    for (int k0 = 0; k0 < K; k0 += 16) {
      const uint2 av = *(const uint2*)(Ap + k0);
      float4 bv = *(const float4*)(Wp + (size_t)k0 * N);
      if (!bok) bv = make_float4(0.f, 0.f, 0.f, 0.f);
      __syncthreads();
      As[(ak + 0) * 132 + ar] = bf2f(av.x & 0xffffu); As[(ak + 1) * 132 + ar] = bf2f(av.x >> 16);
      As[(ak + 2) * 132 + ar] = bf2f(av.y & 0xffffu); As[(ak + 3) * 132 + ar] = bf2f(av.y >> 16);
      *(float4*)(Bs + bk * 128 + bc) = bv;
      __syncthreads();
#pragma unroll
      for (int k = 0; k < 16; ++k) {
        const float4 a0 = *(const float4*)(As + k * 132 + ty * 8), a1 = *(const float4*)(As + k * 132 + ty * 8 + 4);
        const float4 b = *(const float4*)(Bs + k * 128 + tx * 4);
        const float a[8] = {a0.x, a0.y, a0.z, a0.w, a1.x, a1.y, a1.z, a1.w};
#pragma unroll
        for (int i = 0; i < 8; ++i) { acc[i][0] += a[i] * b.x; acc[i][1] += a[i] * b.y; acc[i][2] += a[i] * b.z; acc[i][3] += a[i] * b.w; }
      }
    }
    const int col = pn * 128 + tx * 4;
    if (col < N) {
#pragma unroll
      for (int i = 0; i < 8; ++i) E(pm * 128 + ty * 8 + i, col, acc[i]);
    }
  }
}

__device__ __forceinline__ void head_norm_rope(const float* v, const float* gain, const float* cs  , int sub, float* vn, float* vr) {
  float ss = 0.f;
#pragma unroll
  for (int i = 0; i < 8; ++i) ss += v[i] * v[i];
  ss += __shfl_xor(ss, 1); ss += __shfl_xor(ss, 2); ss += __shfl_xor(ss, 4);
  const float rstd = 1.0f / sqrtf(ss * (1.0f / 64.0f) + EPS);
#pragma unroll
  for (int i = 0; i < 8; ++i) vn[i] = v[i] * rstd * gain[sub * 8 + i];
#pragma unroll
  for (int i = 0; i < 8; ++i) {
    const float other = __shfl_xor(vn[i], 1);
    const float c = cs[i], s = cs[8 + i];
    float r = vn[i];
    if (sub == 0) r = vn[i] * c - other * s;
    else if (sub == 1) r = vn[i] * c + other * s;
    vr[i] = r;
  }
}

__device__ __forceinline__ void ph_post_diff(int j, bf16_t* PROJ) {
  const int tid = tid_(), lane = tid & 63, wave = tid >> 6, sub = lane & 7;
  const float* rope = (const float*)(P(ws) + WS_ROPE);
  for (int m = bid_() * 8 + wave; m < T; m += gdim_() * 8) {
    const float* cs = rope + (size_t)m * 16;
#pragma unroll
    for (int it = 0; it < 4; ++it) {
      bf16_t* ptr = PROJ + (size_t)m * DIFF_IN + it * 512 + lane * 8;
      float v[8], vn[8], vr[8]; unpack8(*(const uint4*)ptr, v);
      const float* gain = (it < 2) ? (P(diff_q_gain) + j * 64) : (P(diff_k_gain) + j * 64);
      head_norm_rope(v, gain, cs, sub, vn, vr);
      const float sc = (it < 2) ? C2 : 1.0f;
#pragma unroll
      for (int i = 0; i < 8; ++i) vr[i] *= sc;
      *(uint4*)ptr = pack8(vr);
    }
  }
}
__device__ __forceinline__ void ph_post_nsa(int j, bf16_t* PROJ, bf16_t* QC) {
  const int tid = tid_(), lane = tid & 63, wave = tid >> 6, sub = lane & 7;
  const float* rope = (const float*)(P(ws) + WS_ROPE);
  for (int m = bid_() * 8 + wave; m < T; m += gdim_() * 8) {
    const float* cs = rope + (size_t)m * 16;
#pragma unroll
    for (int it = 0; it < 2; ++it) {
      bf16_t* ptr = PROJ + (size_t)m * NSA_P + it * 512 + lane * 8;
      float v[8], vn[8], vr[8]; unpack8(*(const uint4*)ptr, v);
      head_norm_rope(v, P(nsa_q_gain) + j * 64, cs, sub, vn, vr);
#pragma unroll
      for (int i = 0; i < 8; ++i) { vr[i] *= C2; vn[i] *= C2; }
      *(uint4*)ptr = pack8(vr);
      *(uint4*)(QC + (size_t)m * D + it * 512 + lane * 8) = pack8(vn);
    }
    {
      const int hi = lane >> 5;
      bf16_t* ptr = PROJ + (size_t)m * NSA_P + (hi ? 2048 : 1536) + (lane & 31) * 8;
      float v[8], vn[8], vr[8]; unpack8(*(const uint4*)ptr, v);
      head_norm_rope(v, P(nsa_k_gain) + j * 192 + (hi ? 128 : 64), cs, sub, vn, vr);
      *(uint4*)ptr = pack8(vr);
    }
  }
}

template <int DV, int MODE>
__device__ __forceinline__ void attn_naive_unit(int b, int qc, const bf16_t* Qp, int ldq, const bf16_t* Kp, const bf16_t* Vp, int ldkv, bf16_t* Op, int ldo, const u64* selmask, unsigned char* lds) {
  constexpr int DVS = DV / 8;
  float* Ks = (float*)lds;
  float* Vs = Ks + 64 * 64;
  const int tid = tid_(), qi = tid & 63, sl = tid >> 6;
  const int qabs = qc * 64 + qi;
  const size_t rowq = (size_t)b * S + qabs;
  float q[64];
#pragma unroll
  for (int i = 0; i < 8; ++i) unpack8(*(const uint4*)(Qp + rowq * ldq + i * 8), q + i * 8);
  float m = -INFINITY, l = 0.f, o[DVS];
#pragma unroll
  for (int i = 0; i < DVS; ++i) o[i] = 0.f;
  u64 msk = 0ull; if (MODE == 1) msk = selmask[qabs];
  const int t_lo = (MODE == 2) ? (qc > 8 ? qc - 8 : 0) : 0;
  for (int tt = t_lo; tt <= qc; ++tt) {
    __syncthreads();
    { const int key = tid >> 3, ch = tid & 7; float f[8];
      unpack8(*(const uint4*)(Kp + ((size_t)b * S + tt * 64 + key) * ldkv + ch * 8), f);
#pragma unroll
      for (int i = 0; i < 8; ++i) Ks[key * 64 + ch * 8 + i] = f[i];
#pragma unroll
      for (int r = 0; r < DV / 64; ++r) {
        unpack8(*(const uint4*)(Vp + ((size_t)b * S + tt * 64 + key) * ldkv + r * 64 + ch * 8), f);
#pragma unroll
        for (int i = 0; i < 8; ++i) Vs[key * DV + r * 64 + ch * 8 + i] = f[i];
      } }
    __syncthreads();
    const bool tile_on = (MODE == 1) ? (((msk >> tt) & 1ull) != 0ull) : true;
    if (tile_on) {
      for (int jk = 0; jk < 64; ++jk) {
        const int key = tt * 64 + jk;
        bool valid = key <= qabs; if (MODE == 2) valid = valid && (key > qabs - 512);
        if (valid) {
          float s = 0.f;
#pragma unroll
          for (int d = 0; d < 64; d += 4) { const float4 kk = *(const float4*)(Ks + jk * 64 + d); s += q[d] * kk.x + q[d + 1] * kk.y + q[d + 2] * kk.z + q[d + 3] * kk.w; }
          const float mn = fmaxf(m, s); const float sc = exp2f(m - mn), pp = exp2f(s - mn);
          l = l * sc + pp;
#pragma unroll
          for (int i = 0; i < DVS; ++i) o[i] = o[i] * sc + pp * Vs[jk * DV + sl * DVS + i];
          m = mn;
        }
      }
    }
  }
  const float inv = l > 0.f ? 1.0f / l : 0.f;
  bf16_t* op = Op + rowq * ldo + sl * DVS;
  if (DVS == 8) { float r[8];
#pragma unroll
    for (int i = 0; i < 8; ++i) r[i] = o[i] * inv;
    *(uint4*)op = pack8(r);
  } else {
#pragma unroll
    for (int h2 = 0; h2 < DVS / 8; ++h2) { float r[8];
#pragma unroll
      for (int i = 0; i < 8; ++i) r[i] = o[h2 * 8 + i] * inv;
      *(uint4*)(op + h2 * 8) = pack8(r); }
  }
}

__device__ __forceinline__ void ph_attn_diff(unsigned char* lds) {
  const bf16_t* PROJ = (const bf16_t*)(P(ws) + WS_PROJ); bf16_t* ATT = (bf16_t*)(P(ws) + WS_ATT);
  const int NU = NB * 64 * 16;
  for (int u = bid_(); u < NU; u += gdim_()) {
    const int vh = u & 15, qc = 63 - ((u >> 4) & 63), b = u >> 10;
    const int h8 = vh >> 1, c = vh & 1;
    attn_naive_unit<128, 0>(b, qc, PROJ + vh * 64, DIFF_IN, PROJ + 1024 + vh * 64, PROJ + 2048 + h8 * 128, DIFF_IN, ATT + c * 1024 + h8 * 128, 2048, nullptr, lds);
  }
}
__device__ __forceinline__ void ph_attn_sel(unsigned char* lds) {
  const bf16_t* PROJ = (const bf16_t*)(P(ws) + WS_PROJ); bf16_t* OSEL = (bf16_t*)(P(ws) + WS_ATT + 32 * MiB);
  const u64* SEL = (const u64*)(P(ws) + WS_SEL);
  const int NU = NB * 64 * 16;
  for (int u = bid_(); u < NU; u += gdim_()) {
    const int hd = u & 15, qc = 63 - ((u >> 4) & 63), b = u >> 10, g = hd >> 2;
    attn_naive_unit<64, 1>(b, qc, PROJ + hd * 64, NSA_P, PROJ + 1536 + g * 64, PROJ + 1792 + g * 64, NSA_P, OSEL + hd * 64, D, SEL + (size_t)(b * 4 + g) * S, lds);
  }
}
__device__ __forceinline__ void ph_attn_win(unsigned char* lds) {
  const bf16_t* PROJ = (const bf16_t*)(P(ws) + WS_PROJ); bf16_t* OWIN = (bf16_t*)(P(ws) + WS_ATT + 64 * MiB);
  const int NU = NB * 64 * 16;
  for (int u = bid_(); u < NU; u += gdim_()) {
    const int hd = u & 15, qc = (u >> 4) & 63, b = u >> 10, g = hd >> 2;
    attn_naive_unit<64, 2>(b, qc, PROJ + hd * 64, NSA_P, PROJ + 2048 + g * 64, PROJ + 2304 + g * 64, NSA_P, OWIN + hd * 64, D, nullptr, lds);
  }
}

__device__ __forceinline__ void ph_compress(int j, unsigned char* lds) {
  typedef short bf16x8_t __attribute__((ext_vector_type(8))); typedef float f32x16_t __attribute__((ext_vector_type(16)));
  const bf16_t* PROJ = (const bf16_t*)(P(ws) + WS_PROJ);
  unsigned char* Xb = lds;
  float* part = (float*)(lds + 67584);
  float* hid = part + 2 * 32 * 128;
  const int tid = tid_(), lane = tid & 63, wave = tid >> 6, r = lane & 31, h = lane >> 5, nb = wave & 3, kh = wave >> 2;
  for (int it = bid_(); it < 256; it += gdim_()) {
    const int rt = it & 7, kv = (it >> 3) & 1, bg = it >> 4, b = bg >> 2, g = bg & 3;
    const bf16_t* W1T = (const bf16_t*)(P(ws) + WS_W1T) + (size_t)(j * 2 + kv) * 128 * 2048;
    const float* w2 = (kv ? P(nsa_w_cv2) : P(nsa_w_ck2)) + (size_t)j * 128 * 64;
    const int colbase = (kv ? 1280 : 1024) + g * 64;
    __syncthreads();
    for (int i = tid; i < 528 * 8; i += NTHR) { const int tk = i >> 3, ch = i & 7, tok = 512 * rt + tk;
      uint4 v = make_uint4(0u, 0u, 0u, 0u); if (tok < S) v = *(const uint4*)(PROJ + ((size_t)b * S + tok) * NSA_P + colbase + ch * 8);
      *(uint4*)(Xb + tk * 128 + ((ch ^ ((tk >> 4) & 7)) * 16)) = v; }
    __syncthreads();
    f32x16_t acc;
#pragma unroll
    for (int q = 0; q < 16; ++q) acc[q] = 0.f;
    const bf16_t* wrow = W1T + (size_t)(nb * 32 + r) * 2048 + 8 * h;
#pragma unroll 2
    for (int l = 16 * kh; l < 16 * kh + 16; ++l) {
      const int tk = 16 * r + l; const unsigned char* xr = Xb + tk * 128; const int sw = (tk >> 4) & 7;
#pragma unroll
      for (int dq = 0; dq < 4; ++dq) {
        const bf16x8_t av = *(const bf16x8_t*)(xr + (((2 * dq + h) ^ sw) * 16));
        const bf16x8_t bv = *(const bf16x8_t*)(wrow + l * 64 + 16 * dq);
        acc = __builtin_amdgcn_mfma_f32_32x32x16_bf16(av, bv, acc, 0, 0, 0);
      }
    }
#pragma unroll
    for (int q = 0; q < 16; ++q) part[(kh * 32 + ((q & 3) + 8 * (q >> 2) + 4 * h)) * 128 + nb * 32 + r] = acc[q];
    __syncthreads();
    const float* CB = (const float*)(P(ws) + WS_SMALL) + 64 + (j * 2 + kv) * 128;
    for (int i = tid; i < 32 * 128; i += NTHR) { const float hs = part[i] + part[4096 + i] + CB[i & 127]; hid[i] = hs / (1.f + expf(-hs)); }
    __syncthreads();
    { const int e = tid & 63, rq = tid >> 6; float o0 = 0.f, o1 = 0.f, o2 = 0.f, o3 = 0.f;
      for (int hh = 0; hh < 128; ++hh) { const float wv = w2[hh * 64 + e];
        o0 += hid[(rq * 4 + 0) * 128 + hh] * wv; o1 += hid[(rq * 4 + 1) * 128 + hh] * wv; o2 += hid[(rq * 4 + 2) * 128 + hh] * wv; o3 += hid[(rq * 4 + 3) * 128 + hh] * wv; }
      float ov[4] = {o0, o1, o2, o3};
      bf16_t* KC = (bf16_t*)(P(ws) + WS_KCMP);
      bf16_t* VT = (bf16_t*)(P(ws) + WS_VCMP);
#pragma unroll
      for (int rr = 0; rr < 4; ++rr) { const int c = 32 * rt + rq * 4 + rr; float v = ov[rr];
        if (kv == 0) { const float ss = wave_sum(v * v); v = v * (1.0f / sqrtf(ss * (1.0f / 64.0f) + EPS)) * P(nsa_k_gain)[j * 192 + e]; }
        if (c >= 255) v = 0.f;
        if (kv == 0) KC[((size_t)bg * 256 + c) * 64 + e] = (bf16_t)f2bf(v); else VT[((size_t)bg * 64 + e) * 256 + c] = (bf16_t)f2bf(v); }
    }
  }
}

__device__ __forceinline__ void ph_cmp_attn(unsigned char* lds) {
  typedef short bf16x8_t __attribute__((ext_vector_type(8))); typedef float f32x16_t __attribute__((ext_vector_type(16)));
  unsigned char* Kimg = lds;
  unsigned char* VTl = lds + 32768;
  float* IMP = (float*)(lds + 32768 + 33280);
  const bf16_t* QC = (const bf16_t*)(P(ws) + WS_OC);
  const bf16_t* KC = (const bf16_t*)(P(ws) + WS_KCMP); const bf16_t* VT = (const bf16_t*)(P(ws) + WS_VCMP);
  bf16_t* OCMP = (bf16_t*)(P(ws) + WS_ATT);
  u64* SEL = (u64*)(P(ws) + WS_SEL);
  const int tid = tid_(), lane = tid & 63, wave = tid >> 6, r32 = lane & 31, hi = lane >> 5, hh = r32 >> 3, q8 = r32 & 7;
  const int G = gdim_(), bx = bid_(); const int v0 = (G % 8 == 0) ? (bx % 8) * (G / 8) + bx / 8 : bx;
  for (int vcu = v0; vcu < 256; vcu += G) {
    const int bg = vcu >> 4, b = bg >> 2, g = bg & 3;
    __syncthreads();
    for (int i = tid; i < 2048; i += NTHR) { const int c = i >> 3, ch = i & 7; *(uint4*)(Kimg + ch * 4096 + c * 16) = *(const uint4*)(KC + ((size_t)bg * 256 + c) * 64 + ch * 8); }
    for (int i = tid; i < 4096; i += NTHR) { const int d = i >> 6, c8 = i & 63; *(uint2*)(VTl + d * 520 + c8 * 8) = *(const uint2*)(VT + ((size_t)bg * 64 + d) * 256 + c8 * 4); }
    __syncthreads();
    float* imw = IMP + wave * 8 * 65;
    bf16_t* stg = (bf16_t*)(lds + 83968) + wave * 2048;
#pragma unroll 1
    for (int ui = 0; ui < 4; ++ui) {
      const int qc = (vcu & 15) + 16 * ui, t0 = qc * 64, tq0 = t0 + 8 * wave;
      const int t = tq0 + q8;
      for (int i = lane; i < 8 * 65; i += 64) imw[i] = 0.f;
      bf16x8_t qr[4];
      { const bf16_t* qp = QC + ((size_t)b * S + t) * D + (g * 4 + hh) * 64 + hi * 8;
#pragma unroll
        for (int d0 = 0; d0 < 4; ++d0) qr[d0] = *(const bf16x8_t*)(qp + d0 * 16); }
      const int nc = (tq0 + 7 >= 31) ? (((tq0 + 7 - 31) >> 4) + 1) : 0; const int nct = (nc + 31) >> 5;
      int climit = (t - 31) >> 4; if (climit > 254) climit = 254;
      const int cfull = (tq0 - 31) >> 4;
#define CMP_TILE(PACC, ct) do { \
        _Pragma("unroll") for (int q = 0; q < 16; ++q) PACC[q] = 0.f; \
        _Pragma("unroll") for (int d0 = 0; d0 < 4; ++d0) { const bf16x8_t kf = *(const bf16x8_t*)(Kimg + (2 * d0 + hi) * 4096 + (32 * (ct) + r32) * 16); PACC = __builtin_amdgcn_mfma_f32_32x32x16_bf16(kf, qr[d0], PACC, 0, 0, 0); } \
        if (32 * (ct) + 31 > cfull) { const int rel = climit - 32 * (ct) - 4 * hi; \
          _Pragma("unroll") for (int q = 0; q < 16; ++q) PACC[q] = (((q & 3) + 8 * (q >> 2)) <= rel) ? PACC[q] : -INFINITY; } } while (0)
      float mx = -INFINITY, sum = 0.f;
#pragma unroll 1
      for (int ct = 0; ct < nct; ++ct) { f32x16_t pacc; CMP_TILE(pacc, ct);
        float tm = pacc[0];
#pragma unroll
        for (int q = 1; q < 16; ++q) tm = fmaxf(tm, pacc[q]);
        const float mn = fmaxf(mx, tm), mns = (mn == -INFINITY) ? 0.f : mn;
        float ts = 0.f;
#pragma unroll
        for (int q = 0; q < 16; ++q) ts += __builtin_amdgcn_exp2f(pacc[q] - mns);
        sum = sum * __builtin_amdgcn_exp2f(mx - mns) + ts; mx = mn; }
      { const float mo = __shfl_xor(mx, 32), so = __shfl_xor(sum, 32); const float M = fmaxf(mx, mo), Ms = (M == -INFINITY) ? 0.f : M;
        sum = sum * __builtin_amdgcn_exp2f(mx - Ms) + so * __builtin_amdgcn_exp2f(mo - Ms); mx = Ms; }
      const float ms = mx;
      const float inv = sum > 0.f ? 1.0f / sum : 0.f;
      f32x16_t o0, o1;
#pragma unroll
      for (int q = 0; q < 16; ++q) { o0[q] = 0.f; o1[q] = 0.f; }
      float carry = 0.f;
#pragma unroll 1
      for (int ct = 0; ct < nct; ++ct) {
        f32x16_t pr; CMP_TILE(pr, ct);
#pragma unroll
        for (int q = 0; q < 16; ++q) pr[q] = __builtin_amdgcn_exp2f(pr[q] - ms) * inv;
        float qs[4], recv[4];
#pragma unroll
        for (int g4 = 0; g4 < 4; ++g4) { float a = (pr[4 * g4] + pr[4 * g4 + 1]) + (pr[4 * g4 + 2] + pr[4 * g4 + 3]), l3 = pr[4 * g4 + 3];
          a += __shfl_xor(a, 8); l3 += __shfl_xor(l3, 8); a += __shfl_xor(a, 16); l3 += __shfl_xor(l3, 16);
          qs[g4] = a; recv[g4] = __shfl_xor(l3, 32); }
        if (hh == 0) {
#pragma unroll
          for (int g4 = 0; g4 < 4; ++g4) { const float nb = hi ? recv[g4] : (g4 ? recv[g4 - 1] : carry); imw[q8 * 65 + 8 * ct + 2 * g4 + hi] = qs[g4] + nb; } }
        carry = recv[3];
#pragma unroll
        for (int s2 = 0; s2 < 2; ++s2) {
          uint4 pw; pw.x = pg8::cvt_pk_bf16(pr[8 * s2 + 0], pr[8 * s2 + 1]); pw.y = pg8::cvt_pk_bf16(pr[8 * s2 + 2], pr[8 * s2 + 3]);
          pw.z = pg8::cvt_pk_bf16(pr[8 * s2 + 4], pr[8 * s2 + 5]); pw.w = pg8::cvt_pk_bf16(pr[8 * s2 + 6], pr[8 * s2 + 7]);
          const bf16x8_t pa = __builtin_bit_cast(bf16x8_t, pw);
          const int cb = (32 * ct + 16 * s2 + 4 * hi) * 2;
          { const uint2 lo = *(const uint2*)(VTl + r32 * 520 + cb), hi2 = *(const uint2*)(VTl + r32 * 520 + cb + 16);
            uint4 vv; vv.x = lo.x; vv.y = lo.y; vv.z = hi2.x; vv.w = hi2.y; o0 = __builtin_amdgcn_mfma_f32_32x32x16_bf16(pa, __builtin_bit_cast(bf16x8_t, vv), o0, 0, 0, 0); }
          { const uint2 lo = *(const uint2*)(VTl + (32 + r32) * 520 + cb), hi2 = *(const uint2*)(VTl + (32 + r32) * 520 + cb + 16);
            uint4 vv; vv.x = lo.x; vv.y = lo.y; vv.z = hi2.x; vv.w = hi2.y; o1 = __builtin_amdgcn_mfma_f32_32x32x16_bf16(pa, __builtin_bit_cast(bf16x8_t, vv), o1, 0, 0, 0); }
        }
      }
#undef CMP_TILE
      if (hh == 0 && hi == 0 && nct > 0 && nct < 8) imw[q8 * 65 + 8 * nct] = carry;
      {
#pragma unroll
        for (int q = 0; q < 16; ++q) { const int row = (q & 3) + 8 * (q >> 2) + 4 * hi; stg[row * 64 + r32] = (bf16_t)f2bf(o0[q]); stg[row * 64 + 32 + r32] = (bf16_t)f2bf(o1[q]); }
        asm volatile("s_waitcnt lgkmcnt(0)" ::: "memory");
#pragma unroll
        for (int i = 0; i < 4; ++i) { const int row = i * 8 + (lane >> 3), ch = lane & 7;
          *(uint4*)(OCMP + ((size_t)b * S + tq0 + (row & 7)) * D + (g * 4 + (row >> 3)) * 64 + ch * 8) = *(const uint4*)(stg + row * 64 + ch * 8); }
      }
      asm volatile("s_waitcnt lgkmcnt(0)" ::: "memory");
#pragma unroll 1
      for (int k8 = 0; k8 < 8; ++k8) {
        const int tq = tq0 + k8, bt = tq >> 6, sb = lane;
        const float v = imw[k8 * 65 + sb];
        const bool forced = (sb == 0) || (sb == bt) || (sb == bt - 1), valid = sb <= bt;
        const float vv = forced ? (1e6f + (float)(64 - sb)) : (valid ? v : (-1.0f - (float)sb));
        const unsigned bits = __float_as_uint(vv); const unsigned key = (bits & 0x80000000u) ? ~bits : (bits | 0x80000000u);
        unsigned prefix = 0u;
#pragma unroll 1
        for (int bit = 31; bit >= 0; --bit) { const unsigned cand = prefix | (1u << bit); const int cnt = __popcll(__ballot(key >= cand)); if (cnt >= 16) prefix = cand; }
        const u64 gt = __ballot(key > prefix); u64 eq = __ballot(key == prefix);
        int need = 16 - __popcll(gt); u64 m = gt;
        while (need > 0 && eq != 0ull) { const u64 low = eq & (0ull - eq); m |= low; eq ^= low; --need; }
        if (lane == 0) SEL[(size_t)bg * S + tq] = m;
      }
      asm volatile("s_waitcnt lgkmcnt(0)" ::: "memory");
    }
  }
}

__device__ __forceinline__ void ph_combine_nsa(int j) {
  const bf16_t* PROJ = (const bf16_t*)(P(ws) + WS_PROJ);
  const bf16_t* OCMP = (const bf16_t*)(P(ws) + WS_ATT); const bf16_t* OSEL = OCMP + (size_t)T * D; const bf16_t* OWIN = OSEL + (size_t)T * D;
  bf16_t* OC = (bf16_t*)(P(ws) + WS_OC);
  for (size_t i = (size_t)bid_() * NTHR + tid_(); i < (size_t)T * 128; i += (size_t)gdim_() * NTHR) {
    const size_t m = i >> 7; const int cg8 = (int)(i & 127), hd = cg8 >> 3;
    float gt[3];
#pragma unroll
    for (int r = 0; r < 3; ++r) { const float gl = bf2f(PROJ[m * NSA_P + 2560 + hd * 3 + r]) + P(nsa_b_gate)[j * 48 + hd * 3 + r]; gt[r] = 1.0f / (1.0f + expf(-gl)); }
    float a[8], bb[8], cc[8], o[8];
    unpack8(*(const uint4*)(OCMP + m * D + cg8 * 8), a); unpack8(*(const uint4*)(OSEL + m * D + cg8 * 8), bb); unpack8(*(const uint4*)(OWIN + m * D + cg8 * 8), cc);
#pragma unroll
    for (int k = 0; k < 8; ++k) o[k] = gt[0] * a[k] + gt[1] * bb[k] + gt[2] * cc[k];
    *(uint4*)(OC + m * D + cg8 * 8) = pack8(o);
  }
}
__device__ __forceinline__ void ph_combine_diff(int j) {
  const bf16_t* ATT = (const bf16_t*)(P(ws) + WS_ATT); bf16_t* OC = (bf16_t*)(P(ws) + WS_OC);
  const float lam = ((const float*)(P(ws) + WS_SMALL))[j]; const float osc = 1.0f - lam_init_of(j);
  const int tid = tid_(), lane = tid & 63, wave = tid >> 6;
  for (int m = bid_() * 8 + wave; m < T; m += gdim_() * 8) {
#pragma unroll
    for (int it = 0; it < 2; ++it) {
      const int col = it * 512 + lane * 8;
      float a[8], b2[8], o[8]; unpack8(*(const uint4*)(ATT + (size_t)m * 2048 + col), a); unpack8(*(const uint4*)(ATT + (size_t)m * 2048 + 1024 + col), b2);
      float ss = 0.f;
#pragma unroll
      for (int k = 0; k < 8; ++k) { o[k] = a[k] - lam * b2[k]; ss += o[k] * o[k]; }
      ss += __shfl_xor(ss, 1); ss += __shfl_xor(ss, 2); ss += __shfl_xor(ss, 4); ss += __shfl_xor(ss, 8);
      const float rstd = 1.0f / sqrtf(ss * (1.0f / 128.0f) + EPS);
#pragma unroll
      for (int k = 0; k < 8; ++k) o[k] = o[k] * rstd * P(diff_subln_g)[j * 128 + (col & 127) + k] * osc;
      *(uint4*)(OC + (size_t)m * D + col) = pack8(o);
    }
  }
}

constexpr int N_PHASES = 1 + 4 * 10;
template <int PH> __device__ __forceinline__ bool phase_body(unsigned char* lds) {
  bool did = true;
  if constexpr (PH == 0) { ph_prologue(lds); __syncthreads(); ph_cmp_bias(lds); __syncthreads(); ph_weights(lds); }
  else {
    constexpr int i = (PH - 1) / 10, lp = (PH - 1) % 10, j = i >> 1; constexpr bool nsa = (i & 1) == 0;
    float* MOD = (float*)(P(ws) + WS_MOD);
    bf16_t* H = (bf16_t*)(P(ws) + WS_H); bf16_t* PROJ = (bf16_t*)(P(ws) + WS_PROJ); bf16_t* OC = (bf16_t*)(P(ws) + WS_OC); bf16_t* HID = (bf16_t*)(P(ws) + WS_HID);
    const float* mod = MOD + (size_t)i * 4 * 6144;
    const float* xcur = (i == 0 && lp < 7) ? P(x) : P(out);
    if constexpr (lp == 0) ph_norm(xcur, P(ln_mix_g) + i * D, mod, 0, 1024, H);
    const bf16_t* WTL = (const bf16_t*)(P(ws) + WS_WT + (size_t)i * WT_LAYER);
    PG8_LAS unsigned char* l3 = (PG8_LAS unsigned char*)lds;
    if constexpr (lp == 1) {
      constexpr int N = nsa ? NSA_P : DIFF_IN;
      pg8::Gemm g{H, WTL, T, N, D}; pg8::StaticOrder S; S.init(T, N, gdim_(), bid_());
      pg8::EpiBf16<0> E{PROJ, N};
      pg8::gemm_phase<pg8::EpiBf16<0>, pg8::StaticOrder, true, true>(l3, g, S, E);
    }
    if constexpr (lp == 2) { if constexpr (nsa) { ph_post_nsa(j, PROJ, OC); ph_compress(j, lds); } else ph_post_diff(j, PROJ); }
    if constexpr (lp == 3) { if constexpr (nsa) { ph_cmp_attn(lds); if (REPEAT_SUB == 1) { __syncthreads(); ph_cmp_attn(lds); } __syncthreads(); ph_attn_win_fast(lds); if (REPEAT_SUB == 2) ph_attn_win_fast(lds); } else ph_attn_diff_fast(lds); }
    if constexpr (lp == 4) { if constexpr (nsa) ph_attn_sel_fast(lds); else did = false; }
    if constexpr (lp == 5) { if constexpr (nsa) ph_combine_nsa(j); else ph_combine_diff(j); }
    if constexpr (lp == 6) {
      pg8::Gemm g{OC, WTL + WT_OUT / 2, T, D, D}; pg8::StaticOrder S; S.init(T, D, gdim_(), bid_());
      pg8::EpiResid E{xcur, P(out), mod + 2048};
      pg8::gemm_phase<pg8::EpiResid, pg8::StaticOrder, true, true>(l3, g, S, E);
    }
    if constexpr (lp == 7) ph_norm(P(out), P(ln_mlp_g) + i * D, mod, 3072, 4096, H);
    if constexpr (lp == 8) {
      pg8::Gemm g{H, WTL + WT_MI / 2, T, DFF, D}; pg8::StaticOrder S; S.init(T, DFF, gdim_(), bid_());
      pg8::EpiBf16<2> E{HID, DFF};
      pg8::gemm_phase<pg8::EpiBf16<2>, pg8::StaticOrder, true, true>(l3, g, S, E);
    }
    if constexpr (lp == 9) {
      pg8::Gemm g{HID, WTL + WT_MO / 2, T, D, DFF}; pg8::StaticOrder S; S.init(T, D, gdim_(), bid_());
      pg8::EpiResid E{P(out), P(out), mod + 5120};
      pg8::gemm_phase<pg8::EpiResid, pg8::StaticOrder, true, true>(l3, g, S, E);
    }
  }
  return did;
}
template <int PH> __device__ __forceinline__ void run_phase(unsigned char* lds, int lo, int hi, const XcdBarrier& bar) {
  if (PH < lo || PH >= hi) return;
  const bool did = phase_body<PH>(lds);
  if constexpr (((REPEAT_MASK >> PH) & 1ull) != 0ull) { if (did) { if (PH == 0) cg::this_grid().sync(); else xcd_barrier(bar); phase_body<PH>(lds); } }
  if (did && PH + 1 < hi) { if (PH == 0) cg::this_grid().sync(); else xcd_barrier(bar); }
}
template <int... I> __device__ __forceinline__ void run_all(std::integer_sequence<int, I...>, unsigned char* lds, int lo, int hi, const XcdBarrier& bar) { (run_phase<I>(lds, lo, hi, bar), ...); }
__global__ void __launch_bounds__(NTHR) fwd_kernel(Params p) {
  extern __shared__ __attribute__((aligned(16))) unsigned char lds[];
  volatile __attribute__((address_space(3))) unsigned* misc = (volatile __attribute__((address_space(3))) unsigned*)((__attribute__((address_space(3))) unsigned char*)lds + MISC_OFF);
  if (tid_() < 16) misc[tid_()] = 0u;
  __syncthreads();
  const XcdBarrier bar = xcd_barrier_post((unsigned*)(P(ws) + WS_CTL) + CW_BAR, misc);
  run_all(std::make_integer_sequence<int, N_PHASES>{}, lds, p.ph_lo, p.ph_hi, bar);
}

extern "C" void kernel_launch(void* const* d_in, const int* in_sizes, int n_in, void* d_out, int out_size, void* d_ws, size_t ws_size, hipStream_t stream) {
  static int grid = 0;
  if (grid == 0) {
    if (n_in != 29 || out_size != T * D || ws_size < WS_END) { fprintf(stderr, "kernel_launch: unexpected problem (n_in %d, out %d, ws %zu)\n", n_in, out_size, ws_size); grid = -1; return; }
    int dev = 0, cus = 0, per_cu = 0;
    hipGetDevice(&dev); hipDeviceGetAttribute(&cus, hipDeviceAttributeMultiprocessorCount, dev);
    hipFuncSetAttribute((const void*)fwd_kernel, hipFuncAttributeMaxDynamicSharedMemorySize, LDS_BYTES);
    hipOccupancyMaxActiveBlocksPerMultiprocessor(&per_cu, (const void*)fwd_kernel, NTHR, LDS_BYTES);
    if (per_cu < 1) { fprintf(stderr, "kernel_launch: occupancy query says %d blocks/CU\n", per_cu); per_cu = 1; }
    grid = cus * 1;
    (void)hipGetLastError();
  }
  if (grid < 0) return;
  if (hipMemsetAsync((char*)d_ws + WS_CTL, 0, CTL_ZERO_BYTES, stream) != hipSuccess) { fprintf(stderr, "kernel_launch: memset failed\n"); return; }
  Params p{};
  memcpy((void*)&p, (const void*)d_in, 29 * sizeof(void*));
  p.out = (float*)d_out; p.ws = (unsigned char*)d_ws; p.ph_lo = 0; p.ph_hi = N_PHASES;
  void* args[] = {&p};
  hipError_t e = hipLaunchCooperativeKernel((const void*)fwd_kernel, dim3(grid), dim3(NTHR), args, LDS_BYTES, stream);
  if (e != hipSuccess) fprintf(stderr, "cooperative launch failed: %s (grid %d)\n", hipGetErrorString(e), grid);
}
```

```cpp
#include <hip/hip_runtime.h>
#include <hip/hip_cooperative_groups.h>
#include <hip/hip_bf16.h>
#include <cstdio>
#include <cstdint>
#include <cstring>
#include <utility>
namespace cg = cooperative_groups;

typedef unsigned short bf16_t;
typedef unsigned long long u64;

constexpr int D = 1024, NB = 4, S = 4096, T = NB * S, DFF = 4096;
constexpr int NSA_IN = 2608, NSA_P = 2816, DIFF_IN = 3072;
constexpr float EPS = 1e-6f;
constexpr float C2 = 0.125f * 1.4426950408889634f;
constexpr int NTHR = 512;
constexpr int LDS_BYTES = 147456;
constexpr unsigned long long REPEAT_MASK = 0ull;
constexpr int REPEAT_SUB = 0;

constexpr size_t MiB = 1u << 20;
constexpr size_t WS_CTL = 0, CTL_ZERO_BYTES = 1 * MiB;
constexpr int CW_BAR = 4096;
constexpr int MISC_OFF = LDS_BYTES - 64;
constexpr size_t WS_MOD = 1 * MiB;
constexpr size_t WS_ROPE = 2 * MiB;
constexpr size_t WS_SMALL = 3 * MiB;
constexpr size_t WS_WT = 4 * MiB;
constexpr size_t WT_LAYER = 24 * MiB, WT_OUT = 6 * MiB, WT_MI = 8 * MiB, WT_MO = 16 * MiB;
constexpr size_t WS_W1T = 100 * MiB;
constexpr size_t WS_H = 104 * MiB;
constexpr size_t WS_PROJ = 136 * MiB;
constexpr size_t WS_ATT = 232 * MiB;
constexpr size_t WS_OC = 328 * MiB;
constexpr size_t WS_KCMP = 360 * MiB;
constexpr size_t WS_VCMP = 361 * MiB;
constexpr size_t WS_SEL = 362 * MiB;
constexpr size_t WS_HID = 136 * MiB;
constexpr size_t WS_END = 364 * MiB;

struct Params {
  const float* x; const float* c; const int* pos; const float* ln_mix_g; const float* ln_mlp_g;
  const float* w_ada; const float* b_ada; const float* w_mlp_in; const float* w_mlp_out;
  const float* nsa_w_in; const float* nsa_b_gate; const float* nsa_q_gain; const float* nsa_k_gain;
  const float* nsa_pe_k; const float* nsa_w_ck1; const float* nsa_w_ck2; const float* nsa_pe_v; const float* nsa_w_cv1; const float* nsa_w_cv2; const float* nsa_w_out;
  const float* diff_w_in; const float* diff_q_gain; const float* diff_k_gain; const float* diff_lq1; const float* diff_lk1; const float* diff_lq2; const float* diff_lk2; const float* diff_subln_g; const float* diff_w_out;
  float* out; unsigned char* ws; int ph_lo, ph_hi;
};

typedef __attribute__((address_space(4))) const unsigned char* kptr_t;
template <class Tp> __device__ __forceinline__ Tp karg_load(unsigned off) {
  asm volatile("" : "+s"(off));
  kptr_t kp = (kptr_t)__builtin_amdgcn_kernarg_segment_ptr();
  return *(const __attribute__((address_space(4))) Tp*)(kp + off);
}
__device__ __forceinline__ int tid_() { int t = (int)threadIdx.x; asm volatile("" : "+v"(t)); return t; }
__device__ __forceinline__ int bid_() { int t = (int)blockIdx.x; asm volatile("" : "+s"(t)); return t; }
__device__ __forceinline__ int gdim_() { int t = (int)gridDim.x; asm volatile("" : "+s"(t)); return t; }
#define P(m) karg_load<decltype(Params::m)>((unsigned)offsetof(Params, m))
__device__ __forceinline__ float bf2f(unsigned v) { return __uint_as_float(v << 16); }
__device__ __forceinline__ unsigned f2bf(float f) { unsigned u = __float_as_uint(f); return (u + 0x7fffu + ((u >> 16) & 1u)) >> 16; }
__device__ __forceinline__ unsigned pk2(float lo, float hi) { return f2bf(lo) | (f2bf(hi) << 16); }
__device__ __forceinline__ void unpack8(const uint4 v, float* f) {
  f[0] = bf2f(v.x & 0xffffu); f[1] = bf2f(v.x >> 16); f[2] = bf2f(v.y & 0xffffu); f[3] = bf2f(v.y >> 16);
  f[4] = bf2f(v.z & 0xffffu); f[5] = bf2f(v.z >> 16); f[6] = bf2f(v.w & 0xffffu); f[7] = bf2f(v.w >> 16);
}
__device__ __forceinline__ uint4 pack8(const float* f) { uint4 v; v.x = pk2(f[0], f[1]); v.y = pk2(f[2], f[3]); v.z = pk2(f[4], f[5]); v.w = pk2(f[6], f[7]); return v; }
__device__ __forceinline__ float wave_sum(float v) {
#pragma unroll
  for (int o = 1; o < 64; o <<= 1) v += __shfl_xor(v, o);
  return v;
}
__device__ __forceinline__ float lam_init_of(int j) { return j == 0 ? 0.35550906759096934f : 0.5560582041556406f; }

namespace pg8 {
#define PG8_LAS __attribute__((address_space(3)))
typedef unsigned short bf16_t;
typedef short bf16x8 __attribute__((ext_vector_type(8)));
typedef float f32x4 __attribute__((ext_vector_type(4)));
typedef unsigned u32x4 __attribute__((ext_vector_type(4)));
constexpr int BM = 256, BK = 64, HALF = 128, HTB = HALF * BK * 2  , STAGE_BYTES = 8 * HTB, NXCD = 8, WGM = 8;

__host__ __device__ __forceinline__ int lds_byte(int r, int c) { const int st = (r >> 4) * 2 + (c >> 5), rr = r & 15, cc = c & 31, ob = rr * 64 + cc * 2; return st * 1024 + (ob ^ (((ob >> 9) & 1) << 5)); }
__host__ __device__ __forceinline__ void stage_rc(int b, int& R, int& C) { const int st = b / 1024, sb = b % 1024, swz = sb ^ (((sb >> 9) & 1) << 5); R = (st >> 1) * 16 + swz / 64; C = (st & 1) * 32 + (swz % 64) / 2; }
__host__ __device__ __forceinline__ int perm32(int rho) { const int n = rho >> 4, i = rho & 15; return 8 * (i >> 2) + 4 * n + (i & 3); }

struct Unit { int pm, pn; };
struct Gemm { const bf16_t* A; const bf16_t* Bt; int M, N, K; };

struct StaticOrder {
    int nM, nN, nwg, G, c;
    __host__ __device__ void init(int M, int N, int G_, int c_) { nM = M / BM; nN = N / BM; nwg = nM * nN; G = G_; c = c_; }
    __host__ __device__ bool next(int i, Unit& u) const {
        const long L = (long)i * G + c; if (L >= nwg) return false;
        int wgid = (int)L; { const int q = nwg / NXCD, r = nwg % NXCD, xcd = wgid % NXCD, off = wgid / NXCD; wgid = (xcd < r ? xcd * (q + 1) : r * (q + 1) + (xcd - r) * q) + off; }
        const int nig = WGM * nN, gid = wgid / nig, fm = gid * WGM, gsz = (nM - fm) < WGM ? (nM - fm) : WGM;
        u.pm = fm + ((wgid % nig) % gsz); u.pn = (wgid % nig) / gsz; return true;
    }
    __device__ __forceinline__ void a_ready(const Unit&) const {}
    __device__ __forceinline__ void done(const Unit&) const {}
};


__device__ __forceinline__ unsigned cvt_pk_bf16(float lo, float hi) { unsigned r; asm volatile("v_cvt_pk_bf16_f32 %0, %1, %2" : "=v"(r) : "v"(lo), "v"(hi)); return r; }
template <int ACT  > struct EpiBf16 {
    static constexpr bool PERM = true, AFTER_DRAIN = false;
    bf16_t* O; int ldc;
    __device__ __forceinline__ void operator()(const f32x4 (&acc)[2][2][4][2], const Unit& u, int wr, int wc, int fr, int fq) const {
        const int row0 = u.pm * BM + wr * 64 + fr; const int col0 = u.pn * BM + wc * 32 + 8 * fq;
#pragma unroll
        for (int ai = 0; ai < 2; ++ai)
#pragma unroll
            for (int m = 0; m < 4; ++m) { bf16_t* rowp = O + (size_t)(row0 + ai * HALF + m * 16) * ldc + col0;
#pragma unroll
                for (int bj = 0; bj < 2; ++bj) { f32x4 v0 = acc[ai][bj][m][0], v1 = acc[ai][bj][m][1];
                    if (ACT == 2) {
#pragma unroll
                        for (int e = 0; e < 4; ++e) { float a = v0[e] > 0.f ? v0[e] : 0.f; v0[e] = a * a; float b = v1[e] > 0.f ? v1[e] : 0.f; v1[e] = b * b; } }
                    u32x4 w; w.x = cvt_pk_bf16(v0[0], v0[1]); w.y = cvt_pk_bf16(v0[2], v0[3]); w.z = cvt_pk_bf16(v1[0], v1[1]); w.w = cvt_pk_bf16(v1[2], v1[3]);
                    *(u32x4*)(rowp + bj * HALF) = w; } }
    }
};
struct EpiResid {
    static constexpr bool PERM = false, AFTER_DRAIN = false;
    const float* xin; float* xout; const float* gate;
    __device__ __forceinline__ void operator()(const f32x4 (&acc)[2][2][4][2], const Unit& u, int wr, int wc, int fr, int fq) const {
        const int col0 = u.pn * BM + wc * 32 + 4 * fq; const int b = (u.pm * BM) >> 12;
        f32x4 gv[2][2];
#pragma unroll
        for (int bj = 0; bj < 2; ++bj)
#pragma unroll
            for (int n = 0; n < 2; ++n) gv[bj][n] = *(const f32x4*)(gate + (size_t)b * 6144 + col0 + bj * HALF + n * 16);
#pragma unroll
        for (int ai = 0; ai < 2; ++ai)
#pragma unroll
            for (int m = 0; m < 4; ++m) { const size_t off = (size_t)(u.pm * BM + ai * HALF + wr * 64 + m * 16 + fr) * 1024 + col0;
#pragma unroll
                for (int bj = 0; bj < 2; ++bj)
#pragma unroll
                    for (int n = 0; n < 2; ++n) { const f32x4 xi = *(const f32x4*)(xin + off + bj * HALF + n * 16); *(f32x4*)(xout + off + bj * HALF + n * 16) = xi + gv[bj][n] * acc[ai][bj][m][n]; }
                if (m & 1) asm volatile("" ::: "memory"); }
    }
};

template <class Epi, class Sched, bool ALIGN_EPI = false, bool SP2 = false>
__device__ __forceinline__ void gemm_phase(PG8_LAS unsigned char* lds, const Gemm g, const Sched& S, const Epi& E) {
    const int tid = tid_(), wid = __builtin_amdgcn_readfirstlane(tid >> 6), lane = tid & 63, wr = wid >> 2, wc = wid & 3, fr = lane & 15, fq = lane >> 4;
    const int K = g.K, nt = K / BK;
    unsigned voffA[2], voffB[2];
#pragma unroll
    for (int i = 0; i < 2; ++i) { int R, C; stage_rc(tid * 16 + i * 8192, R, C); const int Rb = Epi::PERM ? ((R & ~31) + perm32(R & 31)) : R;
        voffA[i] = (unsigned)(R * K + C) * 2u; voffB[i] = (unsigned)(Rb * K + C) * 2u; }
    const size_t kstep = (size_t)(BK * 2);
    const size_t hstep = (size_t)HALF * K * 2;
    const size_t tstep = 2 * hstep;
    const unsigned ldsw = (unsigned)wid * 1024u;
    const int aoff = lds_byte(wr * 64 + fr, fq * 8), boff = lds_byte(wc * 32 + fr, fq * 8);
#define PG8_SA(b, h) (((b) * 2 + (h)) * HTB)
#define PG8_SB(b, h) ((4 + (b) * 2 + (h)) * HTB)
#define PG8_STAGE(bufoff, gbase, voff) do { _Pragma("unroll") for (int _i = 0; _i < 2; ++_i) \
        __builtin_amdgcn_global_load_lds((const unsigned*)((const char*)(gbase) + (voff)[_i]), (PG8_LAS unsigned*)(lds + (bufoff) + ldsw + _i * 8192), 16, 0, 0); } while (0)
#define PG8_LDA(dst, b, h) do { _Pragma("unroll") for (int m = 0; m < 4; ++m) _Pragma("unroll") for (int k = 0; k < 2; ++k) dst[m][k] = *(const PG8_LAS bf16x8*)(lds + PG8_SA(b, h) + aoff + m * 2048 + k * 1024); } while (0)
#define PG8_LDB(dst, b, h) do { _Pragma("unroll") for (int n = 0; n < 2; ++n) _Pragma("unroll") for (int k = 0; k < 2; ++k) dst[n][k] = *(const PG8_LAS bf16x8*)(lds + PG8_SB(b, h) + boff + n * 2048 + k * 1024); } while (0)
#define PG8_MMA(ai, bj, At, Bt) do { __builtin_amdgcn_s_setprio(1); _Pragma("unroll") for (int m = 0; m < 4; ++m) _Pragma("unroll") for (int n = 0; n < 2; ++n) _Pragma("unroll") for (int k = 0; k < 2; ++k) \
        acc[ai][bj][m][n] = __builtin_amdgcn_mfma_f32_16x16x32_bf16(Bt[n][k], At[m][k], acc[ai][bj][m][n], 0, 0, 0); __builtin_amdgcn_s_setprio(0); } while (0)
#define PG8_WAIT_V(n) asm volatile("s_waitcnt vmcnt(" #n ")" ::: "memory")
#define PG8_WAIT_L(n) asm volatile("s_waitcnt lgkmcnt(" #n ")" ::: "memory")
#define PG8_BAR __builtin_amdgcn_s_barrier()
#define PG8_SCHED __builtin_amdgcn_sched_barrier(0)
    Unit cur, nxt; int ui = 0;
    if (!S.next(0, cur)) return;
    f32x4 acc[2][2][4][2];
#pragma unroll
    for (int a = 0; a < 2; ++a)
#pragma unroll
        for (int b = 0; b < 2; ++b)
#pragma unroll
            for (int m = 0; m < 4; ++m)
#pragma unroll
                for (int n = 0; n < 2; ++n) acc[a][b][m][n] = (f32x4){0.f, 0.f, 0.f, 0.f};
    bf16x8 At[4][2], B0[2][2], B1[2][2];
    const char* cA = (const char*)g.A + (size_t)cur.pm * tstep; const char* cB = (const char*)g.Bt + (size_t)cur.pn * tstep;
    S.a_ready(cur);
    if constexpr (SP2) {
        PG8_STAGE(PG8_SB(0, 0), cB, voffB); PG8_STAGE(PG8_SB(0, 1), cB + hstep, voffB); PG8_STAGE(PG8_SA(0, 0), cA, voffA); PG8_STAGE(PG8_SA(0, 1), cA + hstep, voffA);
        if (wr == 1) PG8_BAR;
        PG8_WAIT_V(2); PG8_BAR;
        PG8_STAGE(PG8_SB(1, 0), cB + kstep, voffB); PG8_STAGE(PG8_SA(1, 0), cA + kstep, voffA); PG8_STAGE(PG8_SB(1, 1), cB + hstep + kstep, voffB);
        PG8_WAIT_V(6); PG8_BAR;
    } else {
        PG8_STAGE(PG8_SB(0, 0), cB, voffB); PG8_STAGE(PG8_SA(0, 0), cA, voffA); PG8_STAGE(PG8_SB(0, 1), cB + hstep, voffB); PG8_STAGE(PG8_SA(0, 1), cA + hstep, voffA);
        if (wr == 1) PG8_BAR;
        PG8_WAIT_V(4); PG8_BAR;
        PG8_STAGE(PG8_SB(1, 0), cB + kstep, voffB); PG8_STAGE(PG8_SA(1, 0), cA + kstep, voffA); PG8_STAGE(PG8_SB(1, 1), cB + hstep + kstep, voffB);
        PG8_WAIT_V(6); PG8_BAR;
    }
    for (;;) {
        const bool has_next = S.next(ui + 1, nxt);
        const char* nA = has_next ? (const char*)g.A + (size_t)nxt.pm * tstep : cA; const char* nB = has_next ? (const char*)g.Bt + (size_t)nxt.pn * tstep : cB;
        for (int t = 0; t < nt; t += 2) {
            const bool last = (t == nt - 2);
            const char* a1 = cA + (size_t)(t + 1) * kstep;
            const char* a2 = last ? nA : cA + (size_t)(t + 2) * kstep; const char* b2 = last ? nB : cB + (size_t)(t + 2) * kstep;
            const char* a3 = a2 + kstep; const char* b3 = b2 + kstep;
            if (last && has_next) S.a_ready(nxt);
            if constexpr (SP2) {
            PG8_LDB(B0, 0, 0); PG8_LDB(B1, 0, 1); PG8_SCHED; PG8_LDA(At, 0, 0); PG8_STAGE(PG8_SA(1, 1), a1 + hstep, voffA);
            PG8_WAIT_V(8); PG8_WAIT_L(0); PG8_BAR; PG8_MMA(0, 0, At, B0); PG8_MMA(0, 1, At, B1); PG8_BAR; PG8_SCHED;
            PG8_LDA(At, 0, 1); PG8_STAGE(PG8_SB(0, 0), b2, voffB); PG8_STAGE(PG8_SB(0, 1), b2 + hstep, voffB); PG8_STAGE(PG8_SA(0, 0), a2, voffA);
            PG8_WAIT_V(8); PG8_WAIT_L(0); PG8_BAR; PG8_MMA(1, 0, At, B0); PG8_MMA(1, 1, At, B1); PG8_BAR; PG8_SCHED;
            PG8_LDB(B0, 1, 0); PG8_LDB(B1, 1, 1); PG8_SCHED; PG8_LDA(At, 1, 0); PG8_STAGE(PG8_SA(0, 1), a2 + hstep, voffA);
            PG8_WAIT_V(8); PG8_WAIT_L(0); PG8_BAR; PG8_MMA(0, 0, At, B0); PG8_MMA(0, 1, At, B1); PG8_BAR; PG8_SCHED;
            PG8_LDA(At, 1, 1); PG8_STAGE(PG8_SB(1, 0), b3, voffB); PG8_STAGE(PG8_SB(1, 1), b3 + hstep, voffB); PG8_STAGE(PG8_SA(1, 0), a3, voffA);
            PG8_WAIT_V(8); PG8_WAIT_L(0); PG8_BAR; PG8_MMA(1, 0, At, B0); PG8_MMA(1, 1, At, B1); PG8_BAR; PG8_SCHED;
            } else {
            PG8_LDB(B0, 0, 0); PG8_SCHED; PG8_LDA(At, 0, 0); PG8_STAGE(PG8_SA(1, 1), a1 + hstep, voffA);
            PG8_WAIT_L(8); PG8_BAR; PG8_WAIT_L(0); PG8_MMA(0, 0, At, B0); PG8_BAR; PG8_SCHED;
            PG8_LDB(B1, 0, 1); PG8_STAGE(PG8_SB(0, 0), b2, voffB);
            PG8_BAR; PG8_WAIT_L(0); PG8_MMA(0, 1, At, B1); PG8_BAR;
            PG8_LDA(At, 0, 1); PG8_STAGE(PG8_SA(0, 0), a2, voffA);
            PG8_BAR; PG8_WAIT_L(0); PG8_MMA(1, 0, At, B0); PG8_BAR; PG8_SCHED;
            PG8_STAGE(PG8_SB(0, 1), b2 + hstep, voffB);
            PG8_WAIT_V(6); PG8_BAR; PG8_MMA(1, 1, At, B1); PG8_BAR;
            PG8_LDB(B0, 1, 0); PG8_SCHED; PG8_LDA(At, 1, 0); PG8_STAGE(PG8_SA(0, 1), a2 + hstep, voffA);
            PG8_WAIT_L(8); PG8_BAR; PG8_WAIT_L(0); PG8_MMA(0, 0, At, B0); PG8_BAR; PG8_SCHED;
            PG8_LDB(B1, 1, 1); PG8_STAGE(PG8_SB(1, 0), b3, voffB);
            PG8_BAR; PG8_WAIT_L(0); PG8_MMA(0, 1, At, B1); PG8_BAR;
            PG8_LDA(At, 1, 1); PG8_STAGE(PG8_SA(1, 0), a3, voffA);
            PG8_BAR; PG8_WAIT_L(0); PG8_MMA(1, 0, At, B0); PG8_BAR; PG8_SCHED;
            PG8_STAGE(PG8_SB(1, 1), b3 + hstep, voffB);
            PG8_WAIT_V(6); PG8_BAR; PG8_MMA(1, 1, At, B1); PG8_BAR;
            }
        }
        if constexpr (ALIGN_EPI) { if (wr == 0) PG8_BAR; }
        if constexpr (!Epi::AFTER_DRAIN) { E(acc, cur, wr, wc, fr, fq); S.done(cur); }
        if (!has_next) break;
#pragma unroll
        for (int a = 0; a < 2; ++a)
#pragma unroll
            for (int b = 0; b < 2; ++b)
#pragma unroll
                for (int m = 0; m < 4; ++m)
#pragma unroll
                    for (int n = 0; n < 2; ++n) acc[a][b][m][n] = (f32x4){0.f, 0.f, 0.f, 0.f};
        cur = nxt; cA = nA; cB = nB; ++ui;
        if constexpr (ALIGN_EPI) { if (wr == 1) PG8_BAR; }
    }
    PG8_WAIT_V(0);
    if constexpr (!ALIGN_EPI) { if (wr == 0) PG8_BAR; }
    PG8_BAR;
    if constexpr (Epi::AFTER_DRAIN) { E.fused(acc, cur, wr, wc, fr, fq, lds, wid, lane); S.done(cur); }
#undef PG8_SA
#undef PG8_SB
#undef PG8_STAGE
#undef PG8_LDA
#undef PG8_LDB
#undef PG8_MMA
#undef PG8_WAIT_V
#undef PG8_WAIT_L
#undef PG8_BAR
#undef PG8_SCHED
}
}

namespace attn_body {
using bf16=__hip_bfloat16;
using bf16x8=__attribute__((ext_vector_type(8)))short;
using s16x4=__attribute__((ext_vector_type(4)))short;
using f32x16=__attribute__((ext_vector_type(16)))float;
using u32x4=__attribute__((ext_vector_type(4)))unsigned;
constexpr int D=64;
constexpr int NW=8,QBLK=32,QB=QBLK*NW,KVBLK=64;
__device__ __forceinline__ int crow(int r,int hi){return (r&3)+8*(r>>2)+4*hi;}
#define SBAR() __builtin_amdgcn_sched_barrier(0)
__device__ __forceinline__ void cmask(f32x16&p0,f32x16&p1,int jb,int qrel,int hi){
  const float NEG=-INFINITY; int kb=64*jb+4*hi;
  #pragma unroll
  for(int r=0;r<16;++r){int kv=kb+(r&3)+8*(r>>2); if(kv>qrel)p0[r]=NEG; if(kv+32>qrel)p1[r]=NEG;}
}

__device__ __forceinline__ void lmask(f32x16&p0,f32x16&p1,int t,int qrel,int hi){
  const float NEG=-30000.f; int kb=64*t+4*hi;
  #pragma unroll
  for(int r=0;r<16;++r){int kv=kb+(r&3)+8*(r>>2); if(kv<=qrel)p0[r]=NEG; if(kv+32<=qrel)p1[r]=NEG;}
}
__device__ __forceinline__ void smask(f32x16&p0,f32x16&p1,bool on){
  const float NEG=-INFINITY;
  #pragma unroll
  for(int r=0;r<16;++r){ p0[r]=on?p0[r]:NEG; p1[r]=on?p1[r]:NEG; }
}
constexpr int NSLOT=3, SLOTB=8192;
constexpr int LDS_K=0, LDS_V=NSLOT*SLOTB, LDS_WS=2*NSLOT*SLOTB, LDS_OST=LDS_WS+NW*64*4, LDS_BYTES=LDS_OST+NW*4096;
constexpr float C2=0.125f*1.4426950408889634f;
__device__ __forceinline__ void glds16(const void*gsrc,unsigned lds_dst){unsigned keep;
  asm volatile("s_mov_b32 %0, m0\n\ts_mov_b32 m0, %2\n\ts_nop 0\n\tglobal_load_lds_dwordx4 %1, off\n\ts_mov_b32 m0, %0":"=&s"(keep):"v"(gsrc),"s"(lds_dst):"memory");}
__device__ __forceinline__ float max3f(float a,float b,float c){float r;asm("v_max3_f32 %0, %1, %2, %3":"=v"(r):"v"(a),"v"(b),"v"(c));return r;}
__device__ __forceinline__ float max2f(float a,float b){float r;asm("v_max_f32_e32 %0, %1, %2":"=v"(r):"v"(a),"v"(b));return r;}
__device__ __forceinline__ float fadd_s(float a,float b){float r;asm("v_add_f32_e32 %0, %1, %2":"=v"(r):"v"(a),"v"(b));return r;}
__device__ __forceinline__ float fsub_s(float a,float b){float r;asm("v_sub_f32_e32 %0, %1, %2":"=v"(r):"v"(a),"v"(b));return r;}
typedef float f32x2_t __attribute__((ext_vector_type(2))); typedef __bf16 bf16x2_t __attribute__((ext_vector_type(2)));
__device__ __forceinline__ unsigned cvtpk_s(float lo,float hi){f32x2_t v={lo,hi};bf16x2_t b=__builtin_convertvector(v,bf16x2_t);return __builtin_bit_cast(unsigned,b);}
#define WAIT_BAR(N) asm volatile("s_waitcnt vmcnt(" #N ") lgkmcnt(0)\n\ts_barrier":::"memory")

__device__ __forceinline__ void qkt(f32x16&p0,f32x16&p1,const char*Kslot,const bf16x8*qr,const f32x16&negm,int r32,int hi){
  const char*kb=Kslot+hi*1024+r32*16;
  #pragma unroll
  for(int d0=0;d0<4;++d0){
    const bf16x8 b0=*reinterpret_cast<const bf16x8*>(kb+d0*2048);
    const bf16x8 b1=*reinterpret_cast<const bf16x8*>(kb+d0*2048+512);
    if(d0==0){p0=__builtin_amdgcn_mfma_f32_32x32x16_bf16(b0,qr[0],negm,0,0,0);p1=__builtin_amdgcn_mfma_f32_32x32x16_bf16(b1,qr[0],negm,0,0,0);}
    else{p0=__builtin_amdgcn_mfma_f32_32x32x16_bf16(b0,qr[d0],p0,0,0,0);p1=__builtin_amdgcn_mfma_f32_32x32x16_bf16(b1,qr[d0],p1,0,0,0);}}
}
typedef __attribute__((address_space(3))) const char* lds_cptr;
typedef short v4i16_t __attribute__((ext_vector_type(4)));
__device__ __forceinline__ void kload8(bf16x8*kf,lds_cptr kp){
  kf[0]=*(const __attribute__((address_space(3))) bf16x8*)(kp);      kf[1]=*(const __attribute__((address_space(3))) bf16x8*)(kp+512);
  kf[2]=*(const __attribute__((address_space(3))) bf16x8*)(kp+2048); kf[3]=*(const __attribute__((address_space(3))) bf16x8*)(kp+2560);
  kf[4]=*(const __attribute__((address_space(3))) bf16x8*)(kp+4096); kf[5]=*(const __attribute__((address_space(3))) bf16x8*)(kp+4608);
  kf[6]=*(const __attribute__((address_space(3))) bf16x8*)(kp+6144); kf[7]=*(const __attribute__((address_space(3))) bf16x8*)(kp+6656);
}
__device__ __forceinline__ void kload2(bf16x8*kf,lds_cptr kp,int j){ kf[2*j]=*(const __attribute__((address_space(3))) bf16x8*)(kp+j*2048); kf[2*j+1]=*(const __attribute__((address_space(3))) bf16x8*)(kp+j*2048+512); }
__device__ __forceinline__ s16x4 vtr(lds_cptr p){ return __builtin_bit_cast(s16x4,__builtin_amdgcn_ds_read_tr16_b64_v4i16((__attribute__((address_space(3))) v4i16_t*)p)); }
__device__ __forceinline__ float rowmax(const f32x16&p0,const f32x16&p1){
  float a=max3f(p0[0],p0[1],p1[0]),b=max3f(p0[2],p0[3],p1[1]);a=max3f(a,p1[2],p1[3]);
  #pragma unroll
  for(int r=4;r<16;r+=4){a=max3f(a,p0[r],p0[r+1]);b=max3f(b,p0[r+2],p0[r+3]);a=max3f(a,p1[r],p1[r+1]);b=max3f(b,p1[r+2],p1[r+3]);}
  const float m=max2f(a,b);
  auto rr=__builtin_amdgcn_permlane32_swap(__float_as_uint(m),__float_as_uint(m),false,false);
  return max2f(__uint_as_float(rr[0]),__uint_as_float(rr[1]));
}
__device__ __forceinline__ void pv(f32x16*o,int vb,bf16x8 pa0,bf16x8 pa1,bf16x8 pa2,bf16x8 pa3){
  #pragma unroll
  for(int d0=0;d0<2;++d0){s16x4 lo[4],hi[4];
    #pragma unroll
    for(int ks=0;ks<4;++ks){
      asm volatile("ds_read_b64_tr_b16 %0,%1 offset:%c2":"=&v"(lo[ks]):"v"(vb),"i"(d0*4096+ks*1024):"memory");
      asm volatile("ds_read_b64_tr_b16 %0,%1 offset:%c2":"=&v"(hi[ks]):"v"(vb),"i"(d0*4096+ks*1024+512):"memory");}
    asm volatile("s_waitcnt lgkmcnt(0)":::"memory");SBAR();
    #define PK(k) (bf16x8){lo[k][0],lo[k][1],lo[k][2],lo[k][3],hi[k][0],hi[k][1],hi[k][2],hi[k][3]}
    o[d0]=__builtin_amdgcn_mfma_f32_32x32x16_bf16(pa0,PK(0),o[d0],0,0,0);
    o[d0]=__builtin_amdgcn_mfma_f32_32x32x16_bf16(pa1,PK(1),o[d0],0,0,0);
    o[d0]=__builtin_amdgcn_mfma_f32_32x32x16_bf16(pa2,PK(2),o[d0],0,0,0);
    o[d0]=__builtin_amdgcn_mfma_f32_32x32x16_bf16(pa3,PK(3),o[d0],0,0,0);
    #undef PK
  }
}

#ifndef ATTN_STORE16
#define ATTN_STORE16(p,v) (*(u32x4*)(p)=(v))
#endif
template<int THRL,int MODE> __device__ __forceinline__ void attn_unit(long rowbase,int qb,const bf16*Qh,int ldq,const bf16*__restrict__ Kh0,const bf16*__restrict__ Vh0,int ldkv,bf16*Oh,int ldo,const unsigned long long*selrow,char*shm){
  const int tid=tid_(),lane=tid&63,r32=lane&31,hi=lane>>5; const int wid=__builtin_amdgcn_readfirstlane(tid>>6);
  const int q0=qb*QB;
  int t_lo=0; bool lower=false; if(MODE==2){ if(qb>=2){ t_lo=4*qb-8; lower=true; } }
  const bf16*Qw=Qh+(rowbase+q0+wid*QBLK)*ldq;
  const bf16*Kh=Kh0+(rowbase+(long)t_lo*KVBLK)*ldkv,*Vh=Vh0+(rowbase+(long)t_lo*KVBLK)*ldkv;
  const unsigned lds0=(unsigned)(uintptr_t)shm;
  float*wsf=(float*)(shm+LDS_WS)+wid*64;
  const bf16*ksrc=Kh+(long)lane*ldkv+wid*8;
  const bf16*vsrc=Vh+(long)(16*(wid&3)+(lane>>2))*ldkv+(wid>>2)*32+(lane&3)*8;
  const unsigned kdst=lds0+LDS_K+wid*1024, vdst=lds0+LDS_V+wid*1024;
  #define DMA_K(t,slot) glds16(ksrc+(long)(t)*KVBLK*ldkv,(unsigned)__builtin_amdgcn_readfirstlane(kdst+(slot)))
  #define DMA_V(t,slot) glds16(vsrc+(long)(t)*KVBLK*ldkv,(unsigned)__builtin_amdgcn_readfirstlane(vdst+(slot)))
  const int vb0=(int)(lds0+LDS_V)+((lane>>4)&1)*32+(lane&3)*8+(4*hi+((lane&15)>>2))*64;
  const char*Kbase=shm+LDS_K; bf16x8 kf[8];
  const lds_cptr shm3=(lds_cptr)shm; const lds_cptr kp0=shm3+LDS_K+hi*1024+r32*16; const lds_cptr vp0=shm3+LDS_V+((lane>>4)&1)*32+(lane&3)*8+(4*hi+((lane&15)>>2))*64;
  const int NT=(q0+QB)/KVBLK-t_lo;
  DMA_K(0,0);DMA_V(0,0);DMA_K(1,SLOTB);
  bf16x8 qr[4];
  #pragma unroll
  for(int d0=0;d0<4;++d0)qr[d0]=*reinterpret_cast<const bf16x8*>(&Qw[(long)r32*ldq+d0*16+hi*8]);
  float mhat=0.f,l_reg=0.f;f32x16 o[2];o[0]=f32x16{};o[1]=f32x16{};f32x16 negm=f32x16{};asm volatile("":"+v"(negm));
  const int qrel=wid*QBLK+r32;
  unsigned long long msk=0ull; if(MODE==1) msk=selrow[q0+qrel];
  #define XMASK(P0,P1,t) do{ if(MODE==1) smask(P0,P1,((msk>>(t))&1ull)!=0ull); if(MODE==2){ if(lower&&(t)<4) lmask(P0,P1,(t),qrel,hi); } }while(0)
  #define CMASK(P0,P1,t) do{ XMASK(P0,P1,t); int jb_=(t)-(NT-4); if(jb_>=0)cmask(P0,P1,jb_,qrel,hi);}while(0)
  bool resc=false;
  #define START(P0,P1) do{ const float rm=rowmax(P0,P1); resc=false; \
    { const float dl=rm; mhat=fadd_s(mhat,dl); \
      _Pragma("unroll") for(int r=0;r<16;++r){P0[r]=fsub_s(P0[r],dl);P1[r]=fsub_s(P1[r],dl);} \
      _Pragma("unroll") for(int r=0;r<16;++r)negm[r]=-mhat; asm volatile("":"+v"(negm)); } \
    _Pragma("unroll") for(int r=0;r<16;++r)P0[r]=__builtin_amdgcn_exp2f(P0[r]); }while(0)
  #define RESC() do{ if(resc){ asm volatile("s_waitcnt lgkmcnt(0)":::"memory"); \
      _Pragma("unroll") for(int d_=0;d_<2;++d_) _Pragma("unroll") for(int r=0;r<16;++r)o[d_][r]*=wsf[crow(r,hi)]; } }while(0)
  f32x16 pA0,pA1,pB0,pB1;
  int sl_prev=0,sl_cur=0,sl_next=SLOTB;
  #define ROT() do{sl_prev=sl_cur;sl_cur=sl_next;sl_next=(sl_next==(NSLOT-1)*SLOTB)?0:sl_next+SLOTB;}while(0)
  DMA_K(2,2*SLOTB);
  WAIT_BAR(3);
  qkt(pA0,pA1,Kbase,qr,negm,r32,hi);asm volatile("s_nop 15\n\ts_nop 7":"+v"(pA0),"+v"(pA1));CMASK(pA0,pA1,0);
  START(pA0,pA1);
  _Pragma("unroll") for(int r=0;r<16;++r)pA1[r]=__builtin_amdgcn_exp2f(pA1[r]);
  WAIT_BAR(0);
  DMA_K(3,0);DMA_V(1,SLOTB);
  ROT();
  kload8(kf,kp0+sl_cur);
  WAIT_BAR(2);
  s16x4 vlo[8],vhi[8]; u32x4 pw0,pw1,pw2,pw3;
  #define PKW(P,B) cvtpk_s(P[B],P[B+1])
  #define PAF(k) __builtin_bit_cast(bf16x8,pw##k)
  #define VFR(i) (bf16x8){vlo[i][0],vlo[i][1],vlo[i][2],vlo[i][3],vhi[i][0],vhi[i][1],vhi[i][2],vhi[i][3]}
  #define PIN(x) asm volatile("":"+v"(x))
  #define MX3(a,b,c) __builtin_fmaxf(__builtin_fmaxf((a),(b)),(c))
  #define GAPA(MF,A0,A1,A2,A3,W0,W1,PW) do{ MF; sacc+=A0; sacc+=A1; sacc+=A2; sacc+=A3; PIN(sacc); W0; W1; PIN(PW); SBAR(); }while(0)
  #define EX(v) __builtin_amdgcn_exp2f(v)
  #define GAPB(MF,X,B) do{ MF; X[B]=EX(X[B]); X[B+1]=EX(X[B+1]); X[B+2]=EX(X[B+2]); X[B+3]=EX(X[B+3]); PIN(X); SBAR(); }while(0)
  #define VRD(i) do{ vlo[i]=vtr(vp_+(((i)>>2)*4096+((i)&3)*1024)); vhi[i]=vtr(vp_+(((i)>>2)*4096+((i)&3)*1024+512)); }while(0)
  #define KRD(G,j) do{ if(G){ kload2(kf,kp0+sl_next,j); SBAR(); } }while(0)
  #define STEP(C0,C1,P0,P1,t,GK,GV,GL) do{ SBAR(); \
    const lds_cptr vp_=vp0+sl_prev; \
    VRD(0); SBAR(); float sacc=(P0[0]+P0[1]); \
    GAPA(C0=__builtin_amdgcn_mfma_f32_32x32x16_bf16(kf[0],qr[0],negm,0,0,0), P0[2],P0[3],P0[4],P0[5],     pw0[0]=PKW(P0,0), pw0[1]=PKW(P0,2), pw0); \
    VRD(4); SBAR(); GAPA(C1=__builtin_amdgcn_mfma_f32_32x32x16_bf16(kf[1],qr[0],negm,0,0,0), P0[6],P0[7],P0[8],P0[9],     pw0[2]=PKW(P0,4), pw0[3]=PKW(P0,6), pw0); \
    VRD(1); SBAR(); GAPA(C0=__builtin_amdgcn_mfma_f32_32x32x16_bf16(kf[2],qr[1],C0,0,0,0),   P0[10],P0[11],P0[12],P0[13], pw1[0]=PKW(P0,8), pw1[1]=PKW(P0,10), pw1); \
    VRD(5); SBAR(); GAPA(C1=__builtin_amdgcn_mfma_f32_32x32x16_bf16(kf[3],qr[1],C1,0,0,0),   P0[14],P0[15],P1[0],P1[1],   pw1[2]=PKW(P0,12),pw1[3]=PKW(P0,14), pw1); \
    VRD(2); SBAR(); GAPA(C0=__builtin_amdgcn_mfma_f32_32x32x16_bf16(kf[4],qr[2],C0,0,0,0),   P1[2],P1[3],P1[4],P1[5],     pw2[0]=PKW(P1,0), pw2[1]=PKW(P1,2), pw2); \
    VRD(6); SBAR(); GAPA(C1=__builtin_amdgcn_mfma_f32_32x32x16_bf16(kf[5],qr[2],C1,0,0,0),   P1[6],P1[7],P1[8],P1[9],     pw2[2]=PKW(P1,4), pw2[3]=PKW(P1,6), pw2); \
    VRD(3); SBAR(); GAPA(C0=__builtin_amdgcn_mfma_f32_32x32x16_bf16(kf[6],qr[3],C0,0,0,0),   P1[10],P1[11],P1[12],P1[13], pw3[0]=PKW(P1,8), pw3[1]=PKW(P1,10), pw3); \
    VRD(7); SBAR(); GAPA(C1=__builtin_amdgcn_mfma_f32_32x32x16_bf16(kf[7],qr[3],C1,0,0,0),   P1[14],P1[15],0.f,0.f,       pw3[2]=PKW(P1,12),pw3[3]=PKW(P1,14), pw3); \
    l_reg+=sacc; \
    if(GK){DMA_K((t)+3,sl_cur);} if(GV){DMA_V((t)+1,sl_next);} \
    CMASK(C0,C1,t); \
    { float a=MX3(C0[0],C0[1],C1[0]),b=MX3(C0[2],C0[3],C1[1]); a=MX3(a,C1[2],C1[3]); \
      _Pragma("unroll") for(int r=4;r<16;r+=4){a=MX3(a,C0[r],C0[r+1]);b=MX3(b,C0[r+2],C0[r+3]);a=MX3(a,C1[r],C1[r+1]);b=MX3(b,C1[r+2],C1[r+3]);} \
      float rm=__builtin_fmaxf(a,b); { auto rr=__builtin_amdgcn_permlane32_swap(__float_as_uint(rm),__float_as_uint(rm),false,false); rm=__builtin_fmaxf(__uint_as_float(rr[0]),__uint_as_float(rr[1])); } \
      resc=false; \
      if(__builtin_expect(__any(rm>(float)THRL),0)){ const float dl=__builtin_fmaxf(rm,0.f); mhat+=dl; \
        _Pragma("unroll") for(int r=0;r<16;++r){C0[r]-=dl;C1[r]-=dl;} \
        _Pragma("unroll") for(int r=0;r<16;++r)negm[r]=-mhat; asm volatile("":"+v"(negm)); \
        const float f=__builtin_amdgcn_exp2f(-dl); l_reg*=f; if(hi==0)wsf[r32]=f; resc=true; } } \
    SBAR(); \
    GAPB(o[0]=__builtin_amdgcn_mfma_f32_32x32x16_bf16(PAF(0),VFR(0),o[0],0,0,0), C0,0); \
    GAPB(o[1]=__builtin_amdgcn_mfma_f32_32x32x16_bf16(PAF(0),VFR(4),o[1],0,0,0), C0,4); \
    KRD(GL,0); GAPB(o[0]=__builtin_amdgcn_mfma_f32_32x32x16_bf16(PAF(1),VFR(1),o[0],0,0,0), C0,8); \
    KRD(GL,1); GAPB(o[1]=__builtin_amdgcn_mfma_f32_32x32x16_bf16(PAF(1),VFR(5),o[1],0,0,0), C0,12); \
    KRD(GL,2); GAPB(o[0]=__builtin_amdgcn_mfma_f32_32x32x16_bf16(PAF(2),VFR(2),o[0],0,0,0), C1,0); \
    KRD(GL,3); GAPB(o[1]=__builtin_amdgcn_mfma_f32_32x32x16_bf16(PAF(2),VFR(6),o[1],0,0,0), C1,4); \
    GAPB(o[0]=__builtin_amdgcn_mfma_f32_32x32x16_bf16(PAF(3),VFR(3),o[0],0,0,0), C1,8); \
    GAPB(o[1]=__builtin_amdgcn_mfma_f32_32x32x16_bf16(PAF(3),VFR(7),o[1],0,0,0), C1,12); \
    }while(0)
  int t=1;
  #undef CMASK
  #define CMASK(P0,P1,t) XMASK(P0,P1,t)
  for(;t+5<NT;t+=2){
    STEP(pB0,pB1,pA0,pA1,t,true,true,true);     WAIT_BAR(2); RESC(); ROT();
    STEP(pA0,pA1,pB0,pB1,t+1,true,true,true);   WAIT_BAR(2); RESC(); ROT();
  }
  #undef CMASK
  #define CMASK(P0,P1,t) do{ XMASK(P0,P1,t); int jb_=(t)-(NT-4); if(jb_>=0)cmask(P0,P1,jb_,qrel,hi);}while(0)
  #define ENDW(tt) do{ if((tt)+3<NT){WAIT_BAR(2);} else if((tt)+2<NT){WAIT_BAR(1);} else {WAIT_BAR(0);} }while(0)
  for(;t+1<NT;t+=2){
    STEP(pB0,pB1,pA0,pA1,t,(t+3<NT),(t+1<NT),(t+1<NT));       ENDW(t);   RESC(); ROT();
    STEP(pA0,pA1,pB0,pB1,t+1,(t+4<NT),(t+2<NT),(t+2<NT));     ENDW(t+1); RESC(); ROT();
  }
  STEP(pB0,pB1,pA0,pA1,NT-1,false,false,false); RESC();
  { float sacc=pB0[0]+pB0[1]; _Pragma("unroll") for(int r=2;r<16;++r)sacc+=pB0[r]; _Pragma("unroll") for(int r=0;r<16;++r)sacc+=pB1[r]; l_reg+=sacc;
    pw0=(u32x4){PKW(pB0,0),PKW(pB0,2),PKW(pB0,4),PKW(pB0,6)};pw1=(u32x4){PKW(pB0,8),PKW(pB0,10),PKW(pB0,12),PKW(pB0,14)};pw2=(u32x4){PKW(pB1,0),PKW(pB1,2),PKW(pB1,4),PKW(pB1,6)};pw3=(u32x4){PKW(pB1,8),PKW(pB1,10),PKW(pB1,12),PKW(pB1,14)};
    SBAR(); pv(o,vb0+sl_cur,PAF(0),PAF(1),PAF(2),PAF(3)); }
  #undef PKW
  #undef PAF
  #undef VFR
  #undef PIN
  #undef MX3
  #undef GAPA
  #undef GAPB
  #undef EX
  #undef VRD
  #undef KRD
  #undef STEP
  #undef ENDW
  {auto rr=__builtin_amdgcn_permlane32_swap(__float_as_uint(l_reg),__float_as_uint(l_reg),false,false);l_reg=__uint_as_float(rr[0])+__uint_as_float(rr[1]);}
  if(hi==0)wsf[32+r32]=l_reg;asm volatile("s_waitcnt lgkmcnt(0)":::"memory");
  float rli[16];
  #pragma unroll
  for(int r=0;r<16;++r)rli[r]=__builtin_amdgcn_rcpf(wsf[32+crow(r,hi)]);
  bf16*Ow=Oh+(rowbase+q0+wid*QBLK)*ldo;
  { bf16*stg=(bf16*)(shm+LDS_OST)+wid*2048;
    #pragma unroll
    for(int r=0;r<16;++r){const int orow=crow(r,hi);
      #pragma unroll
      for(int d0=0;d0<2;++d0)stg[orow*64+d0*32+r32]=__float2bfloat16(o[d0][r]*rli[r]);}
    asm volatile("s_waitcnt lgkmcnt(0)":::"memory");
    #pragma unroll
    for(int i=0;i<4;++i){const int row=i*8+(lane>>3),ch=lane&7; const u32x4 v=*(const u32x4*)(stg+row*64+ch*8); ATTN_STORE16(Ow+(long)row*ldo+ch*8,v);} }
  asm volatile("s_waitcnt lgkmcnt(0)\n\ts_barrier":::"memory");
  #undef DMA_K
  #undef DMA_V
  #undef CMASK
  #undef XMASK
  #undef START
  #undef RESC
  #undef ROT
}
constexpr int ATTN_LDS_BYTES=LDS_BYTES;
#undef SBAR
#undef WAIT_BAR
}

__device__ __forceinline__ void ph_attn_diff_fast(unsigned char* lds) {
  using namespace attn_body;
  const bf16* PROJ = (const bf16*)(P(ws) + WS_PROJ); bf16* ATT = (bf16*)(P(ws) + WS_ATT);
  const int G = gdim_(), bx = bid_(); const int v0 = (G % 8 == 0) ? (bx % 8) * (G / 8) + bx / 8 : bx;
  for (int vcu = v0; vcu < 256; vcu += G) {
    const int bhp = vcu >> 1, half = bhp & 1, c = (bhp >> 1) & 1, h8 = (bhp >> 2) & 7, b = bhp >> 5;
#pragma unroll 1
    for (int i = 0; i < 8; ++i) { const int sp = 4 * (vcu & 1) + (i >> 1); const int qb = (i & 1) ? 15 - sp : sp;
      attn_unit<8, 0>((long)b * S, qb, PROJ + (h8 * 2 + c) * 64, DIFF_IN, PROJ + 1024 + (h8 * 2 + c) * 64, PROJ + 2048 + h8 * 128 + half * 64, DIFF_IN,
                      ATT + c * 1024 + h8 * 128 + half * 64, 2048, nullptr, (char*)lds); }
  }
}
__device__ __forceinline__ void ph_attn_sel_fast(unsigned char* lds) {
  using namespace attn_body;
  const bf16* PROJ = (const bf16*)(P(ws) + WS_PROJ); bf16* OSEL = (bf16*)(P(ws) + WS_ATT + 32 * MiB);
  const u64* SEL = (const u64*)(P(ws) + WS_SEL);
  const int G = gdim_(), bx = bid_(); const int v0 = (G % 8 == 0) ? (bx % 8) * (G / 8) + bx / 8 : bx;
  for (int vcu = v0; vcu < 256; vcu += G) {
    const int bh = vcu >> 2, hd = bh & 15, b = bh >> 4, g = hd >> 2;
#pragma unroll 1
    for (int i = 0; i < 4; ++i) { const int sp = 2 * (vcu & 3) + (i >> 1); const int qb = (i & 1) ? 15 - sp : sp;
      attn_unit<8, 1>((long)b * S, qb, PROJ + hd * 64, NSA_P, PROJ + 1536 + g * 64, PROJ + 1792 + g * 64, NSA_P, OSEL + hd * 64, 1024, SEL + (size_t)(b * 4 + g) * S, (char*)lds); }
  }
}
__device__ __forceinline__ void ph_attn_win_fast(unsigned char* lds) {
  using namespace attn_body;
  const bf16* PROJ = (const bf16*)(P(ws) + WS_PROJ); bf16* OWIN = (bf16*)(P(ws) + WS_ATT + 64 * MiB);
  const int G = gdim_(), bx = bid_(); const int v0 = (G % 8 == 0) ? (bx % 8) * (G / 8) + bx / 8 : bx;
  for (int vcu = v0; vcu < 256; vcu += G) {
    const int bh = vcu >> 2, hd = bh & 15, b = bh >> 4, g = hd >> 2;
#pragma unroll 1
    for (int i = 0; i < 4; ++i) { const int qb = (vcu & 3) + 4 * i;
      attn_unit<8, 2>((long)b * S, qb, PROJ + hd * 64, NSA_P, PROJ + 2048 + g * 64, PROJ + 2304 + g * 64, NSA_P, OWIN + hd * 64, 1024, nullptr, (char*)lds); }
  }
}

#define XB_TMO      128
#define XB_XCNT(j)  (256  + 64 * (j))
#define XB_XSUB(j)  (1280 + 64 * (j))
#define XB_XGEN(j)  (2304 + 64 * (j))
#define XB_TOP      3328
#define XB_TOPGEN   3392
#define XCD_BAR_WORDS 3456
#define XB_SPIN_CAP (1u << 18)

__device__ __forceinline__ unsigned xb_ld(unsigned* p)              { return __hip_atomic_load(p, __ATOMIC_RELAXED, __HIP_MEMORY_SCOPE_AGENT); }
__device__ __forceinline__ unsigned xb_add(unsigned* p, unsigned v) { return __hip_atomic_fetch_add(p, v, __ATOMIC_RELAXED, __HIP_MEMORY_SCOPE_AGENT); }
__device__ __forceinline__ unsigned xb_xcc_id() { return (unsigned)__builtin_amdgcn_s_getreg((3 << 11) | 20) & 0xFu; }
#define XB_SPIN(cond, bar) do { unsigned _sp = 0; while (cond) { __builtin_amdgcn_s_sleep(1); \
    if ((++_sp & 255u) == 0u) { if (xb_ld(&(bar)[XB_TMO])) break; if (_sp > XB_SPIN_CAP) { atomicAdd(&(bar)[XB_TMO], 1u); break; } } } } while (0)

struct XcdBarrier {
    unsigned* bar; unsigned x;
    volatile __attribute__((address_space(3))) unsigned* st;
};

__device__ __forceinline__ XcdBarrier xcd_barrier_post(unsigned* bar, volatile __attribute__((address_space(3))) unsigned* st) {
    XcdBarrier b; b.bar = bar; b.x = xb_xcc_id(); b.st = st;
    if (tid_() == 0) (void)xb_add(&bar[XB_XCNT(b.x)], 1u);
    return b;
}
__device__ __forceinline__ void xcd_barrier_complete(unsigned* bar, unsigned x, unsigned& nloc, unsigned& nx) {
    const unsigned G = gridDim.x * gridDim.y * gridDim.z;
    unsigned sum, cnt, mine, sp = 0u;
    for (;;) {
        sum = 0u; cnt = 0u; mine = 0u;
#pragma unroll
        for (unsigned j = 0; j < 16; ++j) { const unsigned c = xb_ld(&bar[XB_XCNT(j)]); sum += c; cnt += (c > 0u) ? 1u : 0u; mine = (j == x) ? c : mine; }
        if (sum == G) break;
        __builtin_amdgcn_s_sleep(1);
        if ((++sp & 255u) == 0u) { if (xb_ld(&bar[XB_TMO])) break; if (sp > XB_SPIN_CAP) { atomicAdd(&bar[XB_TMO], 1u); break; } }
    }
    nloc = mine > 0u ? mine : 1u; nx = cnt > 0u ? cnt : 1u;
}

__device__ __forceinline__ void xcd_barrier(const XcdBarrier& b) {
    asm volatile("s_waitcnt vmcnt(0)" ::: "memory");
    __syncthreads();
    if (tid_() == 0) {
        unsigned* bar = b.bar;
        __builtin_amdgcn_s_waitcnt(0);
        unsigned nloc = b.st[0], nx = b.st[1];
        if (nloc == 0u) { xcd_barrier_complete(bar, b.x, nloc, nx); b.st[0] = nloc; b.st[1] = nx; }
        const unsigned old = xb_add(&bar[XB_XSUB(b.x)], 1u);
        const unsigned gen = old / nloc;
        if (old + 1u == (gen + 1u) * nloc) {
            __builtin_amdgcn_fence(__ATOMIC_RELEASE, "agent");
            asm volatile("s_waitcnt vmcnt(0)" ::: "memory");
            const unsigned og = xb_add(&bar[XB_TOP], 1u);
            const unsigned tg = og / nx;
            if (og + 1u == (tg + 1u) * nx) xb_add(&bar[XB_TOPGEN], 1u);
            else XB_SPIN(xb_ld(&bar[XB_TOPGEN]) == tg, bar);
            __builtin_amdgcn_fence(__ATOMIC_ACQUIRE, "agent");
            xb_add(&bar[XB_XGEN(b.x)], 1u);
            asm volatile("s_waitcnt vmcnt(0)" ::: "memory");
        } else {
            XB_SPIN(xb_ld(&bar[XB_XGEN(b.x)]) == gen, bar);
            __builtin_amdgcn_fence(__ATOMIC_ACQUIRE, "agent");
            asm volatile("s_waitcnt vmcnt(0)" ::: "memory");
        }
    }
    __syncthreads();
}

__device__ __forceinline__ void ph_prologue(unsigned char* lds) {
  const int tid = tid_();
  float* silu = (float*)lds;
  float* red = silu + 4096;
  float* MOD = (float*)(P(ws) + WS_MOD);
  for (int i = tid; i < 4096; i += NTHR) { const float v = P(c)[i]; silu[i] = v / (1.f + expf(-v)); }
  __syncthreads();
  const int cc = tid & 31, ks = tid >> 5;
  for (int item = bid_(); item < 768 + 16; item += gdim_()) {
    if (item < 768) {
      const int l = item / 192, nc = item % 192;
      const float* w = P(w_ada) + ((size_t)l * 1024 + ks * 64) * 6144 + nc * 32 + cc;
      float wv[64];
#pragma unroll
      for (int k = 0; k < 64; ++k) wv[k] = w[(size_t)k * 6144];
      float a0 = 0.f, a1 = 0.f, a2 = 0.f, a3 = 0.f;
#pragma unroll
      for (int k = 0; k < 64; ++k) { const int kk = ks * 64 + k; a0 += silu[kk] * wv[k]; a1 += silu[1024 + kk] * wv[k]; a2 += silu[2048 + kk] * wv[k]; a3 += silu[3072 + kk] * wv[k]; }
      red[(ks * 4 + 0) * 32 + cc] = a0; red[(ks * 4 + 1) * 32 + cc] = a1; red[(ks * 4 + 2) * 32 + cc] = a2; red[(ks * 4 + 3) * 32 + cc] = a3;
      __syncthreads();
      if (tid < 128) { const int bb = tid >> 5; float sacc = 0.f;
#pragma unroll
        for (int q = 0; q < 16; ++q) sacc += red[(q * 4 + bb) * 32 + cc];
        MOD[(size_t)(l * 4 + bb) * 6144 + nc * 32 + cc] = sacc + P(b_ada)[l * 6144 + nc * 32 + cc]; }
      __syncthreads();
    } else {
      const int it = item - 768, jk = it >> 2, nc = it & 3, jj = jk >> 1, kv = jk & 1;
      const float* pe = (kv ? P(nsa_pe_v) : P(nsa_pe_k)) + jj * 2048 + ks * 128; const float* w1 = (kv ? P(nsa_w_cv1) : P(nsa_w_ck1)) + ((size_t)jj * 2048 + ks * 128) * 128 + nc * 32 + cc;
      float a = 0.f;
#pragma unroll 2
      for (int k0 = 0; k0 < 128; k0 += 64) { float wv[64];
#pragma unroll
        for (int k = 0; k < 64; ++k) wv[k] = w1[(size_t)(k0 + k) * 128];
#pragma unroll
        for (int k = 0; k < 64; ++k) a += pe[k0 + k] * wv[k]; }
      red[ks * 32 + cc] = a;
      __syncthreads();
      if (tid < 32) { float sacc = 0.f;
#pragma unroll
        for (int q = 0; q < 16; ++q) sacc += red[q * 32 + cc];
        ((float*)(P(ws) + WS_SMALL))[64 + jk * 128 + nc * 32 + cc] = sacc; }
      __syncthreads();
    }
  }
  float* rope = (float*)(P(ws) + WS_ROPE);
  for (int m = bid_() * NTHR + tid; m < T; m += gdim_() * NTHR) {
    const float fp = (float)P(pos)[m];
    const float INV[8] = {1.0f, 0.1939227432012558f, 0.03760603070259094f, 0.007292664609849453f, 0.0014142135623842478f, 0.00027424818836152554f, 5.3182957344688475e-05f, 1.0313385246263351e-05f};
#pragma unroll
    for (int i = 0; i < 8; ++i) {
      const float ang = fp * INV[i];
      const double a = (double)ang; const double kq = rint(a * 0.63661977236758134308); const double r = a - kq * 1.57079632679489661923;
      const int q = (int)((long long)kq & 3ll);
      const double r2 = r * r;
      const double sr = r * (1.0 + r2 * (-1.0 / 6 + r2 * (1.0 / 120 + r2 * (-1.0 / 5040 + r2 * (1.0 / 362880 + r2 * (-1.0 / 39916800 + r2 * (1.0 / 6227020800.0)))))));
      const double cr = 1.0 + r2 * (-0.5 + r2 * (1.0 / 24 + r2 * (-1.0 / 720 + r2 * (1.0 / 40320 + r2 * (-1.0 / 3628800 + r2 * (1.0 / 479001600.0))))));
      const double sn = (q == 0) ? sr : (q == 1) ? cr : (q == 2) ? -sr : -cr;
      const double cs = (q == 0) ? cr : (q == 1) ? -sr : (q == 2) ? -cr : sr;
      rope[(size_t)m * 16 + i] = (float)cs; rope[(size_t)m * 16 + 8 + i] = (float)sn;
    }
  }
  if (bid_() == 0 && tid < 2) {
    const int j = tid; float s1 = 0.f, s2 = 0.f;
    for (int i = 0; i < 64; ++i) { s1 += P(diff_lq1)[j * 64 + i] * P(diff_lk1)[j * 64 + i]; s2 += P(diff_lq2)[j * 64 + i] * P(diff_lk2)[j * 64 + i]; }
    ((float*)(P(ws) + WS_SMALL))[j] = expf(s1) - expf(s2) + lam_init_of(j);
  }
}


__device__ __forceinline__ void transpose_item(const float* W, int K, int N, int Npad, bf16_t* WT, float* scr, int item, int lane) {
  const int nblk = Npad / 32, kb = item / nblk, nb = item % nblk, k0 = 64 * kb, n0 = 32 * nb;
  const int ncol = n0 + (lane & 31); const bool ok = ncol < N;
#pragma unroll 8
  for (int i = 0; i < 32; ++i) { const int kk = 2 * i + (lane >> 5); scr[kk * 33 + (lane & 31)] = ok ? W[(size_t)(k0 + kk) * N + ncol] : 0.f; }
  asm volatile("s_waitcnt lgkmcnt(0)" ::: "memory");
  const int c = lane & 7;
#pragma unroll
  for (int j = 0; j < 4; ++j) { const int n = (lane >> 3) + 8 * j; const float* sp = scr + (8 * c) * 33 + n;
    uint4 o; o.x = pk2(sp[0 * 33], sp[1 * 33]); o.y = pk2(sp[2 * 33], sp[3 * 33]); o.z = pk2(sp[4 * 33], sp[5 * 33]); o.w = pk2(sp[6 * 33], sp[7 * 33]);
    *(uint4*)(WT + (size_t)(n0 + n) * K + k0 + 8 * c) = o; }
  asm volatile("s_waitcnt lgkmcnt(0)" ::: "memory");
}
__device__ __forceinline__ void ph_weights(unsigned char* lds) {
  const int tid = tid_(), lane = tid & 63, wave = tid >> 6;
  float* scr = (float*)(lds + wave * 16384);
  const int gw = bid_() * 8 + wave, NGW = gdim_() * 8;
  for (int it = gw; it < 4 * 6144; it += NGW) {
    const int i = it / 6144; int r = it % 6144; const int j = i >> 1; const bool nsa = (i & 1) == 0;
    bf16_t* base = (bf16_t*)(P(ws) + WS_WT + (size_t)i * WT_LAYER);
    const int n_in = nsa ? 16 * (NSA_P / 32) : 16 * (DIFF_IN / 32);
    if (r < n_in) { if (nsa) transpose_item(P(nsa_w_in) + (size_t)j * D * NSA_IN, D, NSA_IN, NSA_P, base, scr, r, lane); else transpose_item(P(diff_w_in) + (size_t)j * D * DIFF_IN, D, DIFF_IN, DIFF_IN, base, scr, r, lane); continue; }
    r -= n_in;
    if (r < 512) { transpose_item((nsa ? P(nsa_w_out) : P(diff_w_out)) + (size_t)j * D * D, D, D, D, base + WT_OUT / 2, scr, r, lane); continue; }
    r -= 512;
    if (r < 2048) { transpose_item(P(w_mlp_in) + (size_t)i * D * DFF, D, DFF, DFF, base + WT_MI / 2, scr, r, lane); continue; }
    r -= 2048;
    if (r < 2048) transpose_item(P(w_mlp_out) + (size_t)i * DFF * D, DFF, D, D, base + WT_MO / 2, scr, r, lane);
  }
  for (int it = gw; it < 4 * 128; it += NGW) {
    const int jk = it >> 7, jj = jk >> 1, kv = jk & 1;
    transpose_item((kv ? P(nsa_w_cv1) : P(nsa_w_ck1)) + (size_t)jj * 2048 * 128, 2048, 128, 128, (bf16_t*)(P(ws) + WS_W1T) + (size_t)jk * 128 * 2048, scr, it & 127, lane);
  }
}
__device__ __forceinline__ void ph_cmp_bias(unsigned char* lds) {
  float* red = (float*)lds;
  const int tid = tid_(), n = tid & 127, ks = tid >> 7;
  for (int jk = bid_(); jk < 4; jk += gdim_()) {
    const int jj = jk >> 1, kv = jk & 1;
    const float* pe = (kv ? P(nsa_pe_v) : P(nsa_pe_k)) + jj * 2048; const float* w1 = (kv ? P(nsa_w_cv1) : P(nsa_w_ck1)) + (size_t)jj * 2048 * 128;
    float a = 0.f;
#pragma unroll 16
    for (int k = ks * 512; k < ks * 512 + 512; ++k) a += pe[k] * w1[(size_t)k * 128 + n];
    __syncthreads();
    red[ks * 128 + n] = a;
    __syncthreads();
    if (tid < 128) ((float*)(P(ws) + WS_SMALL))[64 + jk * 128 + tid] = red[tid] + red[128 + tid] + red[256 + tid] + red[384 + tid];
  }
}

__device__ __forceinline__ void ph_norm(const float* xin, const float* gvec, const float* mod  , int sh_off, int sc_off, bf16_t* H) {
  const int tid = tid_(), lane = tid & 63, wave = tid >> 6;
  for (int m = bid_() * 8 + wave; m < T; m += gdim_() * 8) {
    const int b = m >> 12;
    const float4* xr = (const float4*)(xin + (size_t)m * D) + lane;
    float4 v[4]; float ss = 0.f;
#pragma unroll
    for (int j = 0; j < 4; ++j) { v[j] = xr[64 * j]; ss += (v[j].x * v[j].x + v[j].y * v[j].y) + (v[j].z * v[j].z + v[j].w * v[j].w); }
    ss = wave_sum(ss);
    const float rstd = 1.0f / sqrtf(ss * (1.0f / D) + EPS);
#pragma unroll
    for (int j = 0; j < 4; ++j) {
      const int col = 4 * lane + 256 * j;
      const float4 g = *(const float4*)(gvec + col), sc = *(const float4*)(mod + (size_t)b * 6144 + sc_off + col), sh = *(const float4*)(mod + (size_t)b * 6144 + sh_off + col);
      const float h0 = v[j].x * rstd * g.x * (1.f + sc.x) + sh.x, h1 = v[j].y * rstd * g.y * (1.f + sc.y) + sh.y;
      const float h2 = v[j].z * rstd * g.z * (1.f + sc.z) + sh.z, h3 = v[j].w * rstd * g.w * (1.f + sc.w) + sh.w;
      uint2 o; o.x = pk2(h0, h1); o.y = pk2(h2, h3);
      *(uint2*)(H + (size_t)m * D + col) = o;
    }
  }
}

struct EpiStore { bf16_t* O; int ld; int relu2;
  __device__ __forceinline__ void operator()(int row, int col, const float* v) const {
    float a = v[0], b = v[1], c = v[2], d = v[3];
    if (relu2) { a = fmaxf(a, 0.f); a *= a; b = fmaxf(b, 0.f); b *= b; c = fmaxf(c, 0.f); c *= c; d = fmaxf(d, 0.f); d *= d; }
    uint2 o; o.x = pk2(a, b); o.y = pk2(c, d); *(uint2*)(O + (size_t)row * ld + col) = o; } };
struct EpiResid { const float* xin; float* xout; const float* gate;
  __device__ __forceinline__ void operator()(int row, int col, const float* v) const {
    const int b = row >> 12; const float4 g = *(const float4*)(gate + (size_t)b * 6144 + col); const float4 xi = *(const float4*)(xin + (size_t)row * D + col);
    float4 o; o.x = xi.x + g.x * v[0]; o.y = xi.y + g.y * v[1]; o.z = xi.z + g.z * v[2]; o.w = xi.w + g.w * v[3];
    *(float4*)(xout + (size_t)row * D + col) = o; } };

template <class Epi>
__device__ __forceinline__ void gemm_naive(const bf16_t* A, int lda, const float* W, int N, int K, unsigned char* lds, const Epi& E) {
  asm volatile("" : "+s"(N), "+s"(K), "+s"(lda));
  float* As = (float*)lds;
  float* Bs = As + 16 * 132;
  const int tid = tid_(), tx = tid & 31, ty = tid >> 5;
  const int nN = (N + 127) / 128, nM = T / 128;
  const int ar = tid >> 2, ak = (tid & 3) * 4, bk = tid >> 5, bc = (tid & 31) * 4;
  for (int u = bid_(); u < nM * nN; u += gdim_()) {
    const int pm = u / nN, pn = u % nN;
    float acc[8][4];
#pragma unroll
    for (int i = 0; i < 8; ++i) { acc[i][0] = 0.f; acc[i][1] = 0.f; acc[i][2] = 0.f; acc[i][3] = 0.f; }
    const bf16_t* Ap = A + (size_t)(pm * 128 + ar) * lda + ak;
    const int wcol = pn * 128 + bc; const bool bok = wcol < N;
    const float* Wp = W + (size_t)bk * N + (bok ? wcol : 0);
    for (int k0 = 0; k0 < K; k0 += 16) {
      const uint2 av = *(const uint2*)(Ap + k0);
      float4 bv = *(const float4*)(Wp + (size_t)k0 * N);
      if (!bok) bv = make_float4(0.f, 0.f, 0.f, 0.f);
      __syncthreads();
      As[(ak + 0) * 132 + ar] = bf2f(av.x & 0xffffu); As[(ak + 1) * 132 + ar] = bf2f(av.x >> 16);
      As[(ak + 2) * 132 + ar] = bf2f(av.y & 0xffffu); As[(ak + 3) * 132 + ar] = bf2f(av.y >> 16);
      *(float4*)(Bs + bk * 128 + bc) = bv;
      __syncthreads();
#pragma unroll
      for (int k = 0; k < 16; ++k) {
        const float4 a0 = *(const float4*)(As + k * 132 + ty * 8), a1 = *(const float4*)(As + k * 132 + ty * 8 + 4);
        const float4 b = *(const float4*)(Bs + k * 128 + tx * 4);
        const float a[8] = {a0.x, a0.y, a0.z, a0.w, a1.x, a1.y, a1.z, a1.w};
#pragma unroll
        for (int i = 0; i < 8; ++i) { acc[i][0] += a[i] * b.x; acc[i][1] += a[i] * b.y; acc[i][2] += a[i] * b.z; acc[i][3] += a[i] * b.w; }
      }
    }
    const int col = pn * 128 + tx * 4;
    if (col < N) {
#pragma unroll
      for (int i = 0; i < 8; ++i) E(pm * 128 + ty * 8 + i, col, acc[i]);
    }
  }
}

__device__ __forceinline__ void head_norm_rope(const float* v, const float* gain, const float* cs  , int sub, float* vn, float* vr) {
  float ss = 0.f;
#pragma unroll
  for (int i = 0; i < 8; ++i) ss += v[i] * v[i];
  ss += __shfl_xor(ss, 1); ss += __shfl_xor(ss, 2); ss += __shfl_xor(ss, 4);
  const float rstd = 1.0f / sqrtf(ss * (1.0f / 64.0f) + EPS);
#pragma unroll
  for (int i = 0; i < 8; ++i) vn[i] = v[i] * rstd * gain[sub * 8 + i];
#pragma unroll
  for (int i = 0; i < 8; ++i) {
    const float other = __shfl_xor(vn[i], 1);
    const float c = cs[i], s = cs[8 + i];
    float r = vn[i];
    if (sub == 0) r = vn[i] * c - other * s;
    else if (sub == 1) r = vn[i] * c + other * s;
    vr[i] = r;
  }
}

__device__ __forceinline__ void ph_post_diff(int j, bf16_t* PROJ) {
  const int tid = tid_(), lane = tid & 63, wave = tid >> 6, sub = lane & 7;
  const float* rope = (const float*)(P(ws) + WS_ROPE);
  for (int m = bid_() * 8 + wave; m < T; m += gdim_() * 8) {
    const float* cs = rope + (size_t)m * 16;
#pragma unroll
    for (int it = 0; it < 4; ++it) {
      bf16_t* ptr = PROJ + (size_t)m * DIFF_IN + it * 512 + lane * 8;
      float v[8], vn[8], vr[8]; unpack8(*(const uint4*)ptr, v);
      const float* gain = (it < 2) ? (P(diff_q_gain) + j * 64) : (P(diff_k_gain) + j * 64);
      head_norm_rope(v, gain, cs, sub, vn, vr);
      const float sc = (it < 2) ? C2 : 1.0f;
#pragma unroll
      for (int i = 0; i < 8; ++i) vr[i] *= sc;
      *(uint4*)ptr = pack8(vr);
    }
  }
}
__device__ __forceinline__ void ph_post_nsa(int j, bf16_t* PROJ, bf16_t* QC) {
  const int tid = tid_(), lane = tid & 63, wave = tid >> 6, sub = lane & 7;
  const float* rope = (const float*)(P(ws) + WS_ROPE);
  for (int m = bid_() * 8 + wave; m < T; m += gdim_() * 8) {
    const float* cs = rope + (size_t)m * 16;
#pragma unroll
    for (int it = 0; it < 2; ++it) {
      bf16_t* ptr = PROJ + (size_t)m * NSA_P + it * 512 + lane * 8;
      float v[8], vn[8], vr[8]; unpack8(*(const uint4*)ptr, v);
      head_norm_rope(v, P(nsa_q_gain) + j * 64, cs, sub, vn, vr);
#pragma unroll
      for (int i = 0; i < 8; ++i) { vr[i] *= C2; vn[i] *= C2; }
      *(uint4*)ptr = pack8(vr);
      *(uint4*)(QC + (size_t)m * D + it * 512 + lane * 8) = pack8(vn);
    }
    {
      const int hi = lane >> 5;
      bf16_t* ptr = PROJ + (size_t)m * NSA_P + (hi ? 2048 : 1536) + (lane & 31) * 8;
      float v[8], vn[8], vr[8]; unpack8(*(const uint4*)ptr, v);
      head_norm_rope(v, P(nsa_k_gain) + j * 192 + (hi ? 128 : 64), cs, sub, vn, vr);
      *(uint4*)ptr = pack8(vr);
    }
  }
}

template <int DV, int MODE>
__device__ __forceinline__ void attn_naive_unit(int b, int qc, const bf16_t* Qp, int ldq, const bf16_t* Kp, const bf16_t* Vp, int ldkv, bf16_t* Op, int ldo, const u64* selmask, unsigned char* lds) {
  constexpr int DVS = DV / 8;
  float* Ks = (float*)lds;
  float* Vs = Ks + 64 * 64;
  const int tid = tid_(), qi = tid & 63, sl = tid >> 6;
  const int qabs = qc * 64 + qi;
  const size_t rowq = (size_t)b * S + qabs;
  float q[64];
#pragma unroll
  for (int i = 0; i < 8; ++i) unpack8(*(const uint4*)(Qp + rowq * ldq + i * 8), q + i * 8);
  float m = -INFINITY, l = 0.f, o[DVS];
#pragma unroll
  for (int i = 0; i < DVS; ++i) o[i] = 0.f;
  u64 msk = 0ull; if (MODE == 1) msk = selmask[qabs];
  const int t_lo = (MODE == 2) ? (qc > 8 ? qc - 8 : 0) : 0;
  for (int tt = t_lo; tt <= qc; ++tt) {
    __syncthreads();
    { const int key = tid >> 3, ch = tid & 7; float f[8];
      unpack8(*(const uint4*)(Kp + ((size_t)b * S + tt * 64 + key) * ldkv + ch * 8), f);
#pragma unroll
      for (int i = 0; i < 8; ++i) Ks[key * 64 + ch * 8 + i] = f[i];
#pragma unroll
      for (int r = 0; r < DV / 64; ++r) {
        unpack8(*(const uint4*)(Vp + ((size_t)b * S + tt * 64 + key) * ldkv + r * 64 + ch * 8), f);
#pragma unroll
        for (int i = 0; i < 8; ++i) Vs[key * DV + r * 64 + ch * 8 + i] = f[i];
      } }
    __syncthreads();
    const bool tile_on = (MODE == 1) ? (((msk >> tt) & 1ull) != 0ull) : true;
    if (tile_on) {
      for (int jk = 0; jk < 64; ++jk) {
        const int key = tt * 64 + jk;
        bool valid = key <= qabs; if (MODE == 2) valid = valid && (key > qabs - 512);
        if (valid) {
          float s = 0.f;
#pragma unroll
          for (int d = 0; d < 64; d += 4) { const float4 kk = *(const float4*)(Ks + jk * 64 + d); s += q[d] * kk.x + q[d + 1] * kk.y + q[d + 2] * kk.z + q[d + 3] * kk.w; }
          const float mn = fmaxf(m, s); const float sc = exp2f(m - mn), pp = exp2f(s - mn);
          l = l * sc + pp;
#pragma unroll
          for (int i = 0; i < DVS; ++i) o[i] = o[i] * sc + pp * Vs[jk * DV + sl * DVS + i];
          m = mn;
        }
      }
    }
  }
  const float inv = l > 0.f ? 1.0f / l : 0.f;
  bf16_t* op = Op + rowq * ldo + sl * DVS;
  if (DVS == 8) { float r[8];
#pragma unroll
    for (int i = 0; i < 8; ++i) r[i] = o[i] * inv;
    *(uint4*)op = pack8(r);
  } else {
#pragma unroll
    for (int h2 = 0; h2 < DVS / 8; ++h2) { float r[8];
#pragma unroll
      for (int i = 0; i < 8; ++i) r[i] = o[h2 * 8 + i] * inv;
      *(uint4*)(op + h2 * 8) = pack8(r); }
  }
}

__device__ __forceinline__ void ph_attn_diff(unsigned char* lds) {
  const bf16_t* PROJ = (const bf16_t*)(P(ws) + WS_PROJ); bf16_t* ATT = (bf16_t*)(P(ws) + WS_ATT);
  const int NU = NB * 64 * 16;
  for (int u = bid_(); u < NU; u += gdim_()) {
    const int vh = u & 15, qc = 63 - ((u >> 4) & 63), b = u >> 10;
    const int h8 = vh >> 1, c = vh & 1;
    attn_naive_unit<128, 0>(b, qc, PROJ + vh * 64, DIFF_IN, PROJ + 1024 + vh * 64, PROJ + 2048 + h8 * 128, DIFF_IN, ATT + c * 1024 + h8 * 128, 2048, nullptr, lds);
  }
}
__device__ __forceinline__ void ph_attn_sel(unsigned char* lds) {
  const bf16_t* PROJ = (const bf16_t*)(P(ws) + WS_PROJ); bf16_t* OSEL = (bf16_t*)(P(ws) + WS_ATT + 32 * MiB);
  const u64* SEL = (const u64*)(P(ws) + WS_SEL);
  const int NU = NB * 64 * 16;
  for (int u = bid_(); u < NU; u += gdim_()) {
    const int hd = u & 15, qc = 63 - ((u >> 4) & 63), b = u >> 10, g = hd >> 2;
    attn_naive_unit<64, 1>(b, qc, PROJ + hd * 64, NSA_P, PROJ + 1536 + g * 64, PROJ + 1792 + g * 64, NSA_P, OSEL + hd * 64, D, SEL + (size_t)(b * 4 + g) * S, lds);
  }
}
__device__ __forceinline__ void ph_attn_win(unsigned char* lds) {
  const bf16_t* PROJ = (const bf16_t*)(P(ws) + WS_PROJ); bf16_t* OWIN = (bf16_t*)(P(ws) + WS_ATT + 64 * MiB);
  const int NU = NB * 64 * 16;
  for (int u = bid_(); u < NU; u += gdim_()) {
    const int hd = u & 15, qc = (u >> 4) & 63, b = u >> 10, g = hd >> 2;
    attn_naive_unit<64, 2>(b, qc, PROJ + hd * 64, NSA_P, PROJ + 2048 + g * 64, PROJ + 2304 + g * 64, NSA_P, OWIN + hd * 64, D, nullptr, lds);
  }
}

__device__ __forceinline__ void ph_compress(int j, unsigned char* lds) {
  typedef short bf16x8_t __attribute__((ext_vector_type(8))); typedef float f32x16_t __attribute__((ext_vector_type(16)));
  const bf16_t* PROJ = (const bf16_t*)(P(ws) + WS_PROJ);
  unsigned char* Xb = lds;
  float* part = (float*)(lds + 67584);
  float* hid = part + 2 * 32 * 128;
  const int tid = tid_(), lane = tid & 63, wave = tid >> 6, r = lane & 31, h = lane >> 5, nb = wave & 3, kh = wave >> 2;
  for (int it = bid_(); it < 256; it += gdim_()) {
    const int rt = it & 7, kv = (it >> 3) & 1, bg = it >> 4, b = bg >> 2, g = bg & 3;
    const bf16_t* W1T = (const bf16_t*)(P(ws) + WS_W1T) + (size_t)(j * 2 + kv) * 128 * 2048;
    const float* w2 = (kv ? P(nsa_w_cv2) : P(nsa_w_ck2)) + (size_t)j * 128 * 64;
    const int colbase = (kv ? 1280 : 1024) + g * 64;
    __syncthreads();
    for (int i = tid; i < 528 * 8; i += NTHR) { const int tk = i >> 3, ch = i & 7, tok = 512 * rt + tk;
      uint4 v = make_uint4(0u, 0u, 0u, 0u); if (tok < S) v = *(const uint4*)(PROJ + ((size_t)b * S + tok) * NSA_P + colbase + ch * 8);
      *(uint4*)(Xb + tk * 128 + ((ch ^ ((tk >> 4) & 7)) * 16)) = v; }
    __syncthreads();
    f32x16_t acc;
#pragma unroll
    for (int q = 0; q < 16; ++q) acc[q] = 0.f;
    const bf16_t* wrow = W1T + (size_t)(nb * 32 + r) * 2048 + 8 * h;
#pragma unroll 2
    for (int l = 16 * kh; l < 16 * kh + 16; ++l) {
      const int tk = 16 * r + l; const unsigned char* xr = Xb + tk * 128; const int sw = (tk >> 4) & 7;
#pragma unroll
      for (int dq = 0; dq < 4; ++dq) {
        const bf16x8_t av = *(const bf16x8_t*)(xr + (((2 * dq + h) ^ sw) * 16));
        const bf16x8_t bv = *(const bf16x8_t*)(wrow + l * 64 + 16 * dq);
        acc = __builtin_amdgcn_mfma_f32_32x32x16_bf16(av, bv, acc, 0, 0, 0);
      }
    }
#pragma unroll
    for (int q = 0; q < 16; ++q) part[(kh * 32 + ((q & 3) + 8 * (q >> 2) + 4 * h)) * 128 + nb * 32 + r] = acc[q];
    __syncthreads();
    const float* CB = (const float*)(P(ws) + WS_SMALL) + 64 + (j * 2 + kv) * 128;
    for (int i = tid; i < 32 * 128; i += NTHR) { const float hs = part[i] + part[4096 + i] + CB[i & 127]; hid[i] = hs / (1.f + expf(-hs)); }
    __syncthreads();
    { const int e = tid & 63, rq = tid >> 6; float o0 = 0.f, o1 = 0.f, o2 = 0.f, o3 = 0.f;
      for (int hh = 0; hh < 128; ++hh) { const float wv = w2[hh * 64 + e];
        o0 += hid[(rq * 4 + 0) * 128 + hh] * wv; o1 += hid[(rq * 4 + 1) * 128 + hh] * wv; o2 += hid[(rq * 4 + 2) * 128 + hh] * wv; o3 += hid[(rq * 4 + 3) * 128 + hh] * wv; }
      float ov[4] = {o0, o1, o2, o3};
      bf16_t* KC = (bf16_t*)(P(ws) + WS_KCMP);
      bf16_t* VT = (bf16_t*)(P(ws) + WS_VCMP);
#pragma unroll
      for (int rr = 0; rr < 4; ++rr) { const int c = 32 * rt + rq * 4 + rr; float v = ov[rr];
        if (kv == 0) { const float ss = wave_sum(v * v); v = v * (1.0f / sqrtf(ss * (1.0f / 64.0f) + EPS)) * P(nsa_k_gain)[j * 192 + e]; }
        if (c >= 255) v = 0.f;
        if (kv == 0) KC[((size_t)bg * 256 + c) * 64 + e] = (bf16_t)f2bf(v); else VT[((size_t)bg * 64 + e) * 256 + c] = (bf16_t)f2bf(v); }
    }
  }
}

__device__ __forceinline__ void ph_cmp_attn(unsigned char* lds) {
  typedef short bf16x8_t __attribute__((ext_vector_type(8))); typedef float f32x16_t __attribute__((ext_vector_type(16)));
  unsigned char* Kimg = lds;
  unsigned char* VTl = lds + 32768;
  float* IMP = (float*)(lds + 32768 + 33280);
  const bf16_t* QC = (const bf16_t*)(P(ws) + WS_OC);
  const bf16_t* KC = (const bf16_t*)(P(ws) + WS_KCMP); const bf16_t* VT = (const bf16_t*)(P(ws) + WS_VCMP);
  bf16_t* OCMP = (bf16_t*)(P(ws) + WS_ATT);
  u64* SEL = (u64*)(P(ws) + WS_SEL);
  const int tid = tid_(), lane = tid & 63, wave = tid >> 6, r32 = lane & 31, hi = lane >> 5, hh = r32 >> 3, q8 = r32 & 7;
  const int G = gdim_(), bx = bid_(); const int v0 = (G % 8 == 0) ? (bx % 8) * (G / 8) + bx / 8 : bx;
  for (int vcu = v0; vcu < 256; vcu += G) {
    const int bg = vcu >> 4, b = bg >> 2, g = bg & 3;
    __syncthreads();
    for (int i = tid; i < 2048; i += NTHR) { const int c = i >> 3, ch = i & 7; *(uint4*)(Kimg + ch * 4096 + c * 16) = *(const uint4*)(KC + ((size_t)bg * 256 + c) * 64 + ch * 8); }
    for (int i = tid; i < 4096; i += NTHR) { const int d = i >> 6, c8 = i & 63; *(uint2*)(VTl + d * 520 + c8 * 8) = *(const uint2*)(VT + ((size_t)bg * 64 + d) * 256 + c8 * 4); }
    __syncthreads();
    float* imw = IMP + wave * 8 * 65;
    bf16_t* stg = (bf16_t*)(lds + 83968) + wave * 2048;
#pragma unroll 1
    for (int ui = 0; ui < 4; ++ui) {
      const int qc = (vcu & 15) + 16 * ui, t0 = qc * 64, tq0 = t0 + 8 * wave;
      const int t = tq0 + q8;
      for (int i = lane; i < 8 * 65; i += 64) imw[i] = 0.f;
      bf16x8_t qr[4];
      { const bf16_t* qp = QC + ((size_t)b * S + t) * D + (g * 4 + hh) * 64 + hi * 8;
#pragma unroll
        for (int d0 = 0; d0 < 4; ++d0) qr[d0] = *(const bf16x8_t*)(qp + d0 * 16); }
      const int nc = (tq0 + 7 >= 31) ? (((tq0 + 7 - 31) >> 4) + 1) : 0; const int nct = (nc + 31) >> 5;
      int climit = (t - 31) >> 4; if (climit > 254) climit = 254;
      const int cfull = (tq0 - 31) >> 4;
#define CMP_TILE(PACC, ct) do { \
        _Pragma("unroll") for (int q = 0; q < 16; ++q) PACC[q] = 0.f; \
        _Pragma("unroll") for (int d0 = 0; d0 < 4; ++d0) { const bf16x8_t kf = *(const bf16x8_t*)(Kimg + (2 * d0 + hi) * 4096 + (32 * (ct) + r32) * 16); PACC = __builtin_amdgcn_mfma_f32_32x32x16_bf16(kf, qr[d0], PACC, 0, 0, 0); } \
        if (32 * (ct) + 31 > cfull) { const int rel = climit - 32 * (ct) - 4 * hi; \
          _Pragma("unroll") for (int q = 0; q < 16; ++q) PACC[q] = (((q & 3) + 8 * (q >> 2)) <= rel) ? PACC[q] : -INFINITY; } } while (0)
      float mx = -INFINITY, sum = 0.f;
#pragma unroll 1
      for (int ct = 0; ct < nct; ++ct) { f32x16_t pacc; CMP_TILE(pacc, ct);
        float tm = pacc[0];
#pragma unroll
        for (int q = 1; q < 16; ++q) tm = fmaxf(tm, pacc[q]);
        const float mn = fmaxf(mx, tm), mns = (mn == -INFINITY) ? 0.f : mn;
        float ts = 0.f;
#pragma unroll
        for (int q = 0; q < 16; ++q) ts += __builtin_amdgcn_exp2f(pacc[q] - mns);
        sum = sum * __builtin_amdgcn_exp2f(mx - mns) + ts; mx = mn; }
      { const float mo = __shfl_xor(mx, 32), so = __shfl_xor(sum, 32); const float M = fmaxf(mx, mo), Ms = (M == -INFINITY) ? 0.f : M;
        sum = sum * __builtin_amdgcn_exp2f(mx - Ms) + so * __builtin_amdgcn_exp2f(mo - Ms); mx = Ms; }
      const float ms = mx;
      const float inv = sum > 0.f ? 1.0f / sum : 0.f;
      f32x16_t o0, o1;
#pragma unroll
      for (int q = 0; q < 16; ++q) { o0[q] = 0.f; o1[q] = 0.f; }
      float carry = 0.f;
#pragma unroll 1
      for (int ct = 0; ct < nct; ++ct) {
        f32x16_t pr; CMP_TILE(pr, ct);
#pragma unroll
        for (int q = 0; q < 16; ++q) pr[q] = __builtin_amdgcn_exp2f(pr[q] - ms) * inv;
        float qs[4], recv[4];
#pragma unroll
        for (int g4 = 0; g4 < 4; ++g4) { float a = (pr[4 * g4] + pr[4 * g4 + 1]) + (pr[4 * g4 + 2] + pr[4 * g4 + 3]), l3 = pr[4 * g4 + 3];
          a += __shfl_xor(a, 8); l3 += __shfl_xor(l3, 8); a += __shfl_xor(a, 16); l3 += __shfl_xor(l3, 16);
          qs[g4] = a; recv[g4] = __shfl_xor(l3, 32); }
        if (hh == 0) {
#pragma unroll
          for (int g4 = 0; g4 < 4; ++g4) { const float nb = hi ? recv[g4] : (g4 ? recv[g4 - 1] : carry); imw[q8 * 65 + 8 * ct + 2 * g4 + hi] = qs[g4] + nb; } }
        carry = recv[3];
#pragma unroll
        for (int s2 = 0; s2 < 2; ++s2) {
          uint4 pw; pw.x = pg8::cvt_pk_bf16(pr[8 * s2 + 0], pr[8 * s2 + 1]); pw.y = pg8::cvt_pk_bf16(pr[8 * s2 + 2], pr[8 * s2 + 3]);
          pw.z = pg8::cvt_pk_bf16(pr[8 * s2 + 4], pr[8 * s2 + 5]); pw.w = pg8::cvt_pk_bf16(pr[8 * s2 + 6], pr[8 * s2 + 7]);
          const bf16x8_t pa = __builtin_bit_cast(bf16x8_t, pw);
          const int cb = (32 * ct + 16 * s2 + 4 * hi) * 2;
          { const uint2 lo = *(const uint2*)(VTl + r32 * 520 + cb), hi2 = *(const uint2*)(VTl + r32 * 520 + cb + 16);
            uint4 vv; vv.x = lo.x; vv.y = lo.y; vv.z = hi2.x; vv.w = hi2.y; o0 = __builtin_amdgcn_mfma_f32_32x32x16_bf16(pa, __builtin_bit_cast(bf16x8_t, vv), o0, 0, 0, 0); }
          { const uint2 lo = *(const uint2*)(VTl + (32 + r32) * 520 + cb), hi2 = *(const uint2*)(VTl + (32 + r32) * 520 + cb + 16);
            uint4 vv; vv.x = lo.x; vv.y = lo.y; vv.z = hi2.x; vv.w = hi2.y; o1 = __builtin_amdgcn_mfma_f32_32x32x16_bf16(pa, __builtin_bit_cast(bf16x8_t, vv), o1, 0, 0, 0); }
        }
      }
#undef CMP_TILE
      if (hh == 0 && hi == 0 && nct > 0 && nct < 8) imw[q8 * 65 + 8 * nct] = carry;
      {
#pragma unroll
        for (int q = 0; q < 16; ++q) { const int row = (q & 3) + 8 * (q >> 2) + 4 * hi; stg[row * 64 + r32] = (bf16_t)f2bf(o0[q]); stg[row * 64 + 32 + r32] = (bf16_t)f2bf(o1[q]); }
        asm volatile("s_waitcnt lgkmcnt(0)" ::: "memory");
#pragma unroll
        for (int i = 0; i < 4; ++i) { const int row = i * 8 + (lane >> 3), ch = lane & 7;
          *(uint4*)(OCMP + ((size_t)b * S + tq0 + (row & 7)) * D + (g * 4 + (row >> 3)) * 64 + ch * 8) = *(const uint4*)(stg + row * 64 + ch * 8); }
      }
      asm volatile("s_waitcnt lgkmcnt(0)" ::: "memory");
#pragma unroll 1
      for (int k8 = 0; k8 < 8; ++k8) {
        const int tq = tq0 + k8, bt = tq >> 6, sb = lane;
        const float v = imw[k8 * 65 + sb];
        const bool forced = (sb == 0) || (sb == bt) || (sb == bt - 1), valid = sb <= bt;
        const float vv = forced ? (1e6f + (float)(64 - sb)) : (valid ? v : (-1.0f - (float)sb));
        const unsigned bits = __float_as_uint(vv); const unsigned key = (bits & 0x80000000u) ? ~bits : (bits | 0x80000000u);
        unsigned prefix = 0u;
#pragma unroll 1
        for (int bit = 31; bit >= 0; --bit) { const unsigned cand = prefix | (1u << bit); const int cnt = __popcll(__ballot(key >= cand)); if (cnt >= 16) prefix = cand; }
        const u64 gt = __ballot(key > prefix); u64 eq = __ballot(key == prefix);
        int need = 16 - __popcll(gt); u64 m = gt;
        while (need > 0 && eq != 0ull) { const u64 low = eq & (0ull - eq); m |= low; eq ^= low; --need; }
        if (lane == 0) SEL[(size_t)bg * S + tq] = m;
      }
      asm volatile("s_waitcnt lgkmcnt(0)" ::: "memory");
    }
  }
}

__device__ __forceinline__ void ph_combine_nsa(int j) {
  const bf16_t* PROJ = (const bf16_t*)(P(ws) + WS_PROJ);
  const bf16_t* OCMP = (const bf16_t*)(P(ws) + WS_ATT); const bf16_t* OSEL = OCMP + (size_t)T * D; const bf16_t* OWIN = OSEL + (size_t)T * D;
  bf16_t* OC = (bf16_t*)(P(ws) + WS_OC);
  for (size_t i = (size_t)bid_() * NTHR + tid_(); i < (size_t)T * 128; i += (size_t)gdim_() * NTHR) {
    const size_t m = i >> 7; const int cg8 = (int)(i & 127), hd = cg8 >> 3;
    float gt[3];
#pragma unroll
    for (int r = 0; r < 3; ++r) { const float gl = bf2f(PROJ[m * NSA_P + 2560 + hd * 3 + r]) + P(nsa_b_gate)[j * 48 + hd * 3 + r]; gt[r] = 1.0f / (1.0f + expf(-gl)); }
    float a[8], bb[8], cc[8], o[8];
    unpack8(*(const uint4*)(OCMP + m * D + cg8 * 8), a); unpack8(*(const uint4*)(OSEL + m * D + cg8 * 8), bb); unpack8(*(const uint4*)(OWIN + m * D + cg8 * 8), cc);
#pragma unroll
    for (int k = 0; k < 8; ++k) o[k] = gt[0] * a[k] + gt[1] * bb[k] + gt[2] * cc[k];
    *(uint4*)(OC + m * D + cg8 * 8) = pack8(o);
  }
}
__device__ __forceinline__ void ph_combine_diff(int j) {
  const bf16_t* ATT = (const bf16_t*)(P(ws) + WS_ATT); bf16_t* OC = (bf16_t*)(P(ws) + WS_OC);
  const float lam = ((const float*)(P(ws) + WS_SMALL))[j]; const float osc = 1.0f - lam_init_of(j);
  const int tid = tid_(), lane = tid & 63, wave = tid >> 6;
  for (int m = bid_() * 8 + wave; m < T; m += gdim_() * 8) {
#pragma unroll
    for (int it = 0; it < 2; ++it) {
      const int col = it * 512 + lane * 8;
      float a[8], b2[8], o[8]; unpack8(*(const uint4*)(ATT + (size_t)m * 2048 + col), a); unpack8(*(const uint4*)(ATT + (size_t)m * 2048 + 1024 + col), b2);
      float ss = 0.f;
#pragma unroll
      for (int k = 0; k < 8; ++k) { o[k] = a[k] - lam * b2[k]; ss += o[k] * o[k]; }
      ss += __shfl_xor(ss, 1); ss += __shfl_xor(ss, 2); ss += __shfl_xor(ss, 4); ss += __shfl_xor(ss, 8);
      const float rstd = 1.0f / sqrtf(ss * (1.0f / 128.0f) + EPS);
#pragma unroll
      for (int k = 0; k < 8; ++k) o[k] = o[k] * rstd * P(diff_subln_g)[j * 128 + (col & 127) + k] * osc;
      *(uint4*)(OC + (size_t)m * D + col) = pack8(o);
    }
  }
}

constexpr int N_PHASES = 1 + 4 * 10;
template <int PH> __device__ __forceinline__ bool phase_body(unsigned char* lds) {
  bool did = true;
  if constexpr (PH == 0) { ph_prologue(lds); __syncthreads(); ph_weights(lds); }
  else {
    constexpr int i = (PH - 1) / 10, lp = (PH - 1) % 10, j = i >> 1; constexpr bool nsa = (i & 1) == 0;
    float* MOD = (float*)(P(ws) + WS_MOD);
    bf16_t* H = (bf16_t*)(P(ws) + WS_H); bf16_t* PROJ = (bf16_t*)(P(ws) + WS_PROJ); bf16_t* OC = (bf16_t*)(P(ws) + WS_OC); bf16_t* HID = (bf16_t*)(P(ws) + WS_HID);
    const float* mod = MOD + (size_t)i * 4 * 6144;
    const float* xcur = (i == 0 && lp < 7) ? P(x) : P(out);
    if constexpr (lp == 0) ph_norm(xcur, P(ln_mix_g) + i * D, mod, 0, 1024, H);
    const bf16_t* WTL = (const bf16_t*)(P(ws) + WS_WT + (size_t)i * WT_LAYER);
    PG8_LAS unsigned char* l3 = (PG8_LAS unsigned char*)lds;
    if constexpr (lp == 1) {
      constexpr int N = nsa ? NSA_P : DIFF_IN;
      pg8::Gemm g{H, WTL, T, N, D}; pg8::StaticOrder S; S.init(T, N, gdim_(), bid_());
      pg8::EpiBf16<0> E{PROJ, N};
      pg8::gemm_phase<pg8::EpiBf16<0>, pg8::StaticOrder, true, true>(l3, g, S, E);
    }
    if constexpr (lp == 2) { if constexpr (nsa) { ph_post_nsa(j, PROJ, OC); ph_compress(j, lds); } else ph_post_diff(j, PROJ); }
    if constexpr (lp == 3) { if constexpr (nsa) { ph_cmp_attn(lds); if (REPEAT_SUB == 1) { __syncthreads(); ph_cmp_attn(lds); } __syncthreads(); ph_attn_win_fast(lds); if (REPEAT_SUB == 2) ph_attn_win_fast(lds); } else ph_attn_diff_fast(lds); }
    if constexpr (lp == 4) { if constexpr (nsa) ph_attn_sel_fast(lds); else did = false; }
    if constexpr (lp == 5) { if constexpr (nsa) ph_combine_nsa(j); else ph_combine_diff(j); }
    if constexpr (lp == 6) {
      pg8::Gemm g{OC, WTL + WT_OUT / 2, T, D, D}; pg8::StaticOrder S; S.init(T, D, gdim_(), bid_());
      pg8::EpiResid E{xcur, P(out), mod + 2048};
      pg8::gemm_phase<pg8::EpiResid, pg8::StaticOrder, true, true>(l3, g, S, E);
    }
    if constexpr (lp == 7) ph_norm(P(out), P(ln_mlp_g) + i * D, mod, 3072, 4096, H);
    if constexpr (lp == 8) {
      pg8::Gemm g{H, WTL + WT_MI / 2, T, DFF, D}; pg8::StaticOrder S; S.init(T, DFF, gdim_(), bid_());
      pg8::EpiBf16<2> E{HID, DFF};
      pg8::gemm_phase<pg8::EpiBf16<2>, pg8::StaticOrder, true, true>(l3, g, S, E);
    }
    if constexpr (lp == 9) {
      pg8::Gemm g{HID, WTL + WT_MO / 2, T, D, DFF}; pg8::StaticOrder S; S.init(T, D, gdim_(), bid_());
      pg8::EpiResid E{P(out), P(out), mod + 5120};
      pg8::gemm_phase<pg8::EpiResid, pg8::StaticOrder, true, true>(l3, g, S, E);
    }
  }
  return did;
}
template <int PH> __device__ __forceinline__ void run_phase(unsigned char* lds, int lo, int hi, const XcdBarrier& bar) {
  if (PH < lo || PH >= hi) return;
  const bool did = phase_body<PH>(lds);
  if constexpr (((REPEAT_MASK >> PH) & 1ull) != 0ull) { if (did) { if (PH == 0) cg::this_grid().sync(); else xcd_barrier(bar); phase_body<PH>(lds); } }
  if (did && PH + 1 < hi) { if (PH == 0) cg::this_grid().sync(); else xcd_barrier(bar); }
}
template <int... I> __device__ __forceinline__ void run_all(std::integer_sequence<int, I...>, unsigned char* lds, int lo, int hi, const XcdBarrier& bar) { (run_phase<I>(lds, lo, hi, bar), ...); }
__global__ void __launch_bounds__(NTHR) fwd_kernel(Params p) {
  extern __shared__ __attribute__((aligned(16))) unsigned char lds[];
  volatile __attribute__((address_space(3))) unsigned* misc = (volatile __attribute__((address_space(3))) unsigned*)((__attribute__((address_space(3))) unsigned char*)lds + MISC_OFF);
  if (tid_() < 16) misc[tid_()] = 0u;
  __syncthreads();
  const XcdBarrier bar = xcd_barrier_post((unsigned*)(P(ws) + WS_CTL) + CW_BAR, misc);
  run_all(std::make_integer_sequence<int, N_PHASES>{}, lds, p.ph_lo, p.ph_hi, bar);
}

extern "C" void kernel_launch(void* const* d_in, const int* in_sizes, int n_in, void* d_out, int out_size, void* d_ws, size_t ws_size, hipStream_t stream) {
  static int grid = 0;
  if (grid == 0) {
    if (n_in != 29 || out_size != T * D || ws_size < WS_END) { fprintf(stderr, "kernel_launch: unexpected problem (n_in %d, out %d, ws %zu)\n", n_in, out_size, ws_size); grid = -1; return; }
    int dev = 0, cus = 0, per_cu = 0;
    hipGetDevice(&dev); hipDeviceGetAttribute(&cus, hipDeviceAttributeMultiprocessorCount, dev);
    hipFuncSetAttribute((const void*)fwd_kernel, hipFuncAttributeMaxDynamicSharedMemorySize, LDS_BYTES);
    hipOccupancyMaxActiveBlocksPerMultiprocessor(&per_cu, (const void*)fwd_kernel, NTHR, LDS_BYTES);
    if (per_cu < 1) { fprintf(stderr, "kernel_launch: occupancy query says %d blocks/CU\n", per_cu); per_cu = 1; }
    grid = cus * 1;
    (void)hipGetLastError();
  }
  if (grid < 0) return;
  if (hipMemsetAsync((char*)d_ws + WS_CTL, 0, CTL_ZERO_BYTES, stream) != hipSuccess) { fprintf(stderr, "kernel_launch: memset failed\n"); return; }
  Params p{};
  memcpy((void*)&p, (const void*)d_in, 29 * sizeof(void*));
  p.out = (float*)d_out; p.ws = (unsigned char*)d_ws; p.ph_lo = 0; p.ph_hi = N_PHASES;
  void* args[] = {&p};
  hipError_t e = hipLaunchCooperativeKernel((const void*)fwd_kernel, dim3(grid), dim3(NTHR), args, LDS_BYTES, stream);
  if (e != hipSuccess) fprintf(stderr, "cooperative launch failed: %s (grid %d)\n", hipGetErrorString(e), grid);
}
```

```cpp
#include <hip/hip_runtime.h>
#include <hip/hip_cooperative_groups.h>
#include <hip/hip_bf16.h>
#include <cstdio>
#include <cstdint>
#include <cstring>
#include <utility>
namespace cg = cooperative_groups;

typedef unsigned short bf16_t;
typedef unsigned long long u64;

constexpr int D = 1024, NB = 4, S = 4096, T = NB * S, DFF = 4096;
constexpr int NSA_IN = 2608, NSA_P = 2816, DIFF_IN = 3072;
constexpr float EPS = 1e-6f;
constexpr float C2 = 0.125f * 1.4426950408889634f;
constexpr int NTHR = 512;
constexpr int LDS_BYTES = 147456;
constexpr unsigned long long REPEAT_MASK = 0ull;
constexpr int REPEAT_SUB = 0;

constexpr size_t MiB = 1u << 20;
constexpr size_t WS_CTL = 0, CTL_ZERO_BYTES = 1 * MiB;
constexpr int CW_BAR = 4096;
constexpr int MISC_OFF = LDS_BYTES - 64;
constexpr size_t WS_MOD = 1 * MiB;
constexpr size_t WS_ROPE = 2 * MiB;
constexpr size_t WS_SMALL = 3 * MiB;
constexpr size_t WS_WT = 4 * MiB;
constexpr size_t WT_LAYER = 24 * MiB, WT_OUT = 6 * MiB, WT_MI = 8 * MiB, WT_MO = 16 * MiB;
constexpr size_t WS_W1T = 100 * MiB;
constexpr size_t WS_H = 104 * MiB;
constexpr size_t WS_PROJ = 136 * MiB;
constexpr size_t WS_ATT = 232 * MiB;
constexpr size_t WS_OC = 328 * MiB;
constexpr size_t WS_KCMP = 360 * MiB;
constexpr size_t WS_VCMP = 361 * MiB;
constexpr size_t WS_SEL = 362 * MiB;
constexpr size_t WS_HID = 136 * MiB;
constexpr size_t WS_END = 364 * MiB;

struct Params {
  const float* x; const float* c; const int* pos; const float* ln_mix_g; const float* ln_mlp_g;
  const float* w_ada; const float* b_ada; const float* w_mlp_in; const float* w_mlp_out;
  const float* nsa_w_in; const float* nsa_b_gate; const float* nsa_q_gain; const float* nsa_k_gain;
  const float* nsa_pe_k; const float* nsa_w_ck1; const float* nsa_w_ck2; const float* nsa_pe_v; const float* nsa_w_cv1; const float* nsa_w_cv2; const float* nsa_w_out;
  const float* diff_w_in; const float* diff_q_gain; const float* diff_k_gain; const float* diff_lq1; const float* diff_lk1; const float* diff_lq2; const float* diff_lk2; const float* diff_subln_g; const float* diff_w_out;
  float* out; unsigned char* ws; int ph_lo, ph_hi;
};

typedef __attribute__((address_space(4))) const unsigned char* kptr_t;
template <class Tp> __device__ __forceinline__ Tp karg_load(unsigned off) {
  asm volatile("" : "+s"(off));
  kptr_t kp = (kptr_t)__builtin_amdgcn_kernarg_segment_ptr();
  return *(const __attribute__((address_space(4))) Tp*)(kp + off);
}
__device__ __forceinline__ int tid_() { int t = (int)threadIdx.x; asm volatile("" : "+v"(t)); return t; }
__device__ __forceinline__ int bid_() { int t = (int)blockIdx.x; asm volatile("" : "+s"(t)); return t; }
__device__ __forceinline__ int gdim_() { int t = (int)gridDim.x; asm volatile("" : "+s"(t)); return t; }
#define P(m) karg_load<decltype(Params::m)>((unsigned)offsetof(Params, m))
__device__ __forceinline__ float bf2f(unsigned v) { return __uint_as_float(v << 16); }
__device__ __forceinline__ unsigned f2bf(float f) { unsigned u = __float_as_uint(f); return (u + 0x7fffu + ((u >> 16) & 1u)) >> 16; }
__device__ __forceinline__ unsigned pk2(float lo, float hi) { return f2bf(lo) | (f2bf(hi) << 16); }
__device__ __forceinline__ void unpack8(const uint4 v, float* f) {
  f[0] = bf2f(v.x & 0xffffu); f[1] = bf2f(v.x >> 16); f[2] = bf2f(v.y & 0xffffu); f[3] = bf2f(v.y >> 16);
  f[4] = bf2f(v.z & 0xffffu); f[5] = bf2f(v.z >> 16); f[6] = bf2f(v.w & 0xffffu); f[7] = bf2f(v.w >> 16);
}
__device__ __forceinline__ uint4 pack8(const float* f) { uint4 v; v.x = pk2(f[0], f[1]); v.y = pk2(f[2], f[3]); v.z = pk2(f[4], f[5]); v.w = pk2(f[6], f[7]); return v; }
__device__ __forceinline__ float wave_sum(float v) {
#pragma unroll
  for (int o = 1; o < 64; o <<= 1) v += __shfl_xor(v, o);
  return v;
}
__device__ __forceinline__ float lam_init_of(int j) { return j == 0 ? 0.35550906759096934f : 0.5560582041556406f; }

namespace pg8 {
#define PG8_LAS __attribute__((address_space(3)))
typedef unsigned short bf16_t;
typedef short bf16x8 __attribute__((ext_vector_type(8)));
typedef float f32x4 __attribute__((ext_vector_type(4)));
typedef unsigned u32x4 __attribute__((ext_vector_type(4)));
constexpr int BM = 256, BK = 64, HALF = 128, HTB = HALF * BK * 2  , STAGE_BYTES = 8 * HTB, NXCD = 8, WGM = 8;

__host__ __device__ __forceinline__ int lds_byte(int r, int c) { const int st = (r >> 4) * 2 + (c >> 5), rr = r & 15, cc = c & 31, ob = rr * 64 + cc * 2; return st * 1024 + (ob ^ (((ob >> 9) & 1) << 5)); }
__host__ __device__ __forceinline__ void stage_rc(int b, int& R, int& C) { const int st = b / 1024, sb = b % 1024, swz = sb ^ (((sb >> 9) & 1) << 5); R = (st >> 1) * 16 + swz / 64; C = (st & 1) * 32 + (swz % 64) / 2; }
__host__ __device__ __forceinline__ int perm32(int rho) { const int n = rho >> 4, i = rho & 15; return 8 * (i >> 2) + 4 * n + (i & 3); }

struct Unit { int pm, pn; };
struct Gemm { const bf16_t* A; const bf16_t* Bt; int M, N, K; };

struct StaticOrder {
    int nM, nN, nwg, G, c;
    __host__ __device__ void init(int M, int N, int G_, int c_) { nM = M / BM; nN = N / BM; nwg = nM * nN; G = G_; c = c_; }
    __host__ __device__ bool next(int i, Unit& u) const {
        const long L = (long)i * G + c; if (L >= nwg) return false;
        int wgid = (int)L; { const int q = nwg / NXCD, r = nwg % NXCD, xcd = wgid % NXCD, off = wgid / NXCD; wgid = (xcd < r ? xcd * (q + 1) : r * (q + 1) + (xcd - r) * q) + off; }
        const int nig = WGM * nN, gid = wgid / nig, fm = gid * WGM, gsz = (nM - fm) < WGM ? (nM - fm) : WGM;
        u.pm = fm + ((wgid % nig) % gsz); u.pn = (wgid % nig) / gsz; return true;
    }
    __device__ __forceinline__ void a_ready(const Unit&) const {}
    __device__ __forceinline__ void done(const Unit&) const {}
};


__device__ __forceinline__ unsigned cvt_pk_bf16(float lo, float hi) { unsigned r; asm volatile("v_cvt_pk_bf16_f32 %0, %1, %2" : "=v"(r) : "v"(lo), "v"(hi)); return r; }
template <int ACT  > struct EpiBf16 {
    static constexpr bool PERM = true, AFTER_DRAIN = false;
    bf16_t* O; int ldc;
    __device__ __forceinline__ void operator()(const f32x4 (&acc)[2][2][4][2], const Unit& u, int wr, int wc, int fr, int fq) const {
        const int row0 = u.pm * BM + wr * 64 + fr; const int col0 = u.pn * BM + wc * 32 + 8 * fq;
#pragma unroll
        for (int ai = 0; ai < 2; ++ai)
#pragma unroll
            for (int m = 0; m < 4; ++m) { bf16_t* rowp = O + (size_t)(row0 + ai * HALF + m * 16) * ldc + col0;
#pragma unroll
                for (int bj = 0; bj < 2; ++bj) { f32x4 v0 = acc[ai][bj][m][0], v1 = acc[ai][bj][m][1];
                    if (ACT == 2) {
#pragma unroll
                        for (int e = 0; e < 4; ++e) { float a = v0[e] > 0.f ? v0[e] : 0.f; v0[e] = a * a; float b = v1[e] > 0.f ? v1[e] : 0.f; v1[e] = b * b; } }
                    u32x4 w; w.x = cvt_pk_bf16(v0[0], v0[1]); w.y = cvt_pk_bf16(v0[2], v0[3]); w.z = cvt_pk_bf16(v1[0], v1[1]); w.w = cvt_pk_bf16(v1[2], v1[3]);
                    *(u32x4*)(rowp + bj * HALF) = w; } }
    }
};
struct EpiResid {
    static constexpr bool PERM = false, AFTER_DRAIN = false;
    const float* xin; float* xout; const float* gate;
    __device__ __forceinline__ void operator()(const f32x4 (&acc)[2][2][4][2], const Unit& u, int wr, int wc, int fr, int fq) const {
        const int col0 = u.pn * BM + wc * 32 + 4 * fq; const int b = (u.pm * BM) >> 12;
        f32x4 gv[2][2];
#pragma unroll
        for (int bj = 0; bj < 2; ++bj)
#pragma unroll
            for (int n = 0; n < 2; ++n) gv[bj][n] = *(const f32x4*)(gate + (size_t)b * 6144 + col0 + bj * HALF + n * 16);
#pragma unroll
        for (int ai = 0; ai < 2; ++ai)
#pragma unroll
            for (int m = 0; m < 4; ++m) { const size_t off = (size_t)(u.pm * BM + ai * HALF + wr * 64 + m * 16 + fr) * 1024 + col0;
#pragma unroll
                for (int bj = 0; bj < 2; ++bj)
#pragma unroll
                    for (int n = 0; n < 2; ++n) { const f32x4 xi = *(const f32x4*)(xin + off + bj * HALF + n * 16); *(f32x4*)(xout + off + bj * HALF + n * 16) = xi + gv[bj][n] * acc[ai][bj][m][n]; }
                if (m & 1) asm volatile("" ::: "memory"); }
    }
};

template <class Epi, class Sched, bool ALIGN_EPI = false, bool SP2 = false>
__device__ __forceinline__ void gemm_phase(PG8_LAS unsigned char* lds, const Gemm g, const Sched& S, const Epi& E) {
    const int tid = tid_(), wid = __builtin_amdgcn_readfirstlane(tid >> 6), lane = tid & 63, wr = wid >> 2, wc = wid & 3, fr = lane & 15, fq = lane >> 4;
    const int K = g.K, nt = K / BK;
    unsigned voffA[2], voffB[2];
#pragma unroll
    for (int i = 0; i < 2; ++i) { int R, C; stage_rc(tid * 16 + i * 8192, R, C); const int Rb = Epi::PERM ? ((R & ~31) + perm32(R & 31)) : R;
        voffA[i] = (unsigned)(R * K + C) * 2u; voffB[i] = (unsigned)(Rb * K + C) * 2u; }
    const size_t kstep = (size_t)(BK * 2);
    const size_t hstep = (size_t)HALF * K * 2;
    const size_t tstep = 2 * hstep;
    const unsigned ldsw = (unsigned)wid * 1024u;
    const int aoff = lds_byte(wr * 64 + fr, fq * 8), boff = lds_byte(wc * 32 + fr, fq * 8);
#define PG8_SA(b, h) (((b) * 2 + (h)) * HTB)
#define PG8_SB(b, h) ((4 + (b) * 2 + (h)) * HTB)
#define PG8_STAGE(bufoff, gbase, voff) do { _Pragma("unroll") for (int _i = 0; _i < 2; ++_i) \
        __builtin_amdgcn_global_load_lds((const unsigned*)((const char*)(gbase) + (voff)[_i]), (PG8_LAS unsigned*)(lds + (bufoff) + ldsw + _i * 8192), 16, 0, 0); } while (0)
#define PG8_LDA(dst, b, h) do { _Pragma("unroll") for (int m = 0; m < 4; ++m) _Pragma("unroll") for (int k = 0; k < 2; ++k) dst[m][k] = *(const PG8_LAS bf16x8*)(lds + PG8_SA(b, h) + aoff + m * 2048 + k * 1024); } while (0)
#define PG8_LDB(dst, b, h) do { _Pragma("unroll") for (int n = 0; n < 2; ++n) _Pragma("unroll") for (int k = 0; k < 2; ++k) dst[n][k] = *(const PG8_LAS bf16x8*)(lds + PG8_SB(b, h) + boff + n * 2048 + k * 1024); } while (0)
#define PG8_MMA(ai, bj, At, Bt) do { __builtin_amdgcn_s_setprio(1); _Pragma("unroll") for (int m = 0; m < 4; ++m) _Pragma("unroll") for (int n = 0; n < 2; ++n) _Pragma("unroll") for (int k = 0; k < 2; ++k) \
        acc[ai][bj][m][n] = __builtin_amdgcn_mfma_f32_16x16x32_bf16(Bt[n][k], At[m][k], acc[ai][bj][m][n], 0, 0, 0); __builtin_amdgcn_s_setprio(0); } while (0)
#define PG8_WAIT_V(n) asm volatile("s_waitcnt vmcnt(" #n ")" ::: "memory")
#define PG8_WAIT_L(n) asm volatile("s_waitcnt lgkmcnt(" #n ")" ::: "memory")
#define PG8_BAR __builtin_amdgcn_s_barrier()
#define PG8_SCHED __builtin_amdgcn_sched_barrier(0)
    Unit cur, nxt; int ui = 0;
    if (!S.next(0, cur)) return;
    f32x4 acc[2][2][4][2];
#pragma unroll
    for (int a = 0; a < 2; ++a)
#pragma unroll
        for (int b = 0; b < 2; ++b)
#pragma unroll
            for (int m = 0; m < 4; ++m)
#pragma unroll
                for (int n = 0; n < 2; ++n) acc[a][b][m][n] = (f32x4){0.f, 0.f, 0.f, 0.f};
    bf16x8 At[4][2], B0[2][2], B1[2][2];
    const char* cA = (const char*)g.A + (size_t)cur.pm * tstep; const char* cB = (const char*)g.Bt + (size_t)cur.pn * tstep;
    S.a_ready(cur);
    if constexpr (SP2) {
        PG8_STAGE(PG8_SB(0, 0), cB, voffB); PG8_STAGE(PG8_SB(0, 1), cB + hstep, voffB); PG8_STAGE(PG8_SA(0, 0), cA, voffA); PG8_STAGE(PG8_SA(0, 1), cA + hstep, voffA);
        if (wr == 1) PG8_BAR;
        PG8_WAIT_V(2); PG8_BAR;
        PG8_STAGE(PG8_SB(1, 0), cB + kstep, voffB); PG8_STAGE(PG8_SA(1, 0), cA + kstep, voffA); PG8_STAGE(PG8_SB(1, 1), cB + hstep + kstep, voffB);
        PG8_WAIT_V(6); PG8_BAR;
    } else {
        PG8_STAGE(PG8_SB(0, 0), cB, voffB); PG8_STAGE(PG8_SA(0, 0), cA, voffA); PG8_STAGE(PG8_SB(0, 1), cB + hstep, voffB); PG8_STAGE(PG8_SA(0, 1), cA + hstep, voffA);
        if (wr == 1) PG8_BAR;
        PG8_WAIT_V(4); PG8_BAR;
        PG8_STAGE(PG8_SB(1, 0), cB + kstep, voffB); PG8_STAGE(PG8_SA(1, 0), cA + kstep, voffA); PG8_STAGE(PG8_SB(1, 1), cB + hstep + kstep, voffB);
        PG8_WAIT_V(6); PG8_BAR;
    }
    for (;;) {
        const bool has_next = S.next(ui + 1, nxt);
        const char* nA = has_next ? (const char*)g.A + (size_t)nxt.pm * tstep : cA; const char* nB = has_next ? (const char*)g.Bt + (size_t)nxt.pn * tstep : cB;
        for (int t = 0; t < nt; t += 2) {
            const bool last = (t == nt - 2);
            const char* a1 = cA + (size_t)(t + 1) * kstep;
            const char* a2 = last ? nA : cA + (size_t)(t + 2) * kstep; const char* b2 = last ? nB : cB + (size_t)(t + 2) * kstep;
            const char* a3 = a2 + kstep; const char* b3 = b2 + kstep;
            if (last && has_next) S.a_ready(nxt);
            if constexpr (SP2) {
            PG8_LDB(B0, 0, 0); PG8_LDB(B1, 0, 1); PG8_SCHED; PG8_LDA(At, 0, 0); PG8_STAGE(PG8_SA(1, 1), a1 + hstep, voffA);
            PG8_WAIT_V(8); PG8_WAIT_L(0); PG8_BAR; PG8_MMA(0, 0, At, B0); PG8_MMA(0, 1, At, B1); PG8_BAR; PG8_SCHED;
            PG8_LDA(At, 0, 1); PG8_STAGE(PG8_SB(0, 0), b2, voffB); PG8_STAGE(PG8_SB(0, 1), b2 + hstep, voffB); PG8_STAGE(PG8_SA(0, 0), a2, voffA);
            PG8_WAIT_V(8); PG8_WAIT_L(0); PG8_BAR; PG8_MMA(1, 0, At, B0); PG8_MMA(1, 1, At, B1); PG8_BAR; PG8_SCHED;
            PG8_LDB(B0, 1, 0); PG8_LDB(B1, 1, 1); PG8_SCHED; PG8_LDA(At, 1, 0); PG8_STAGE(PG8_SA(0, 1), a2 + hstep, voffA);
            PG8_WAIT_V(8); PG8_WAIT_L(0); PG8_BAR; PG8_MMA(0, 0, At, B0); PG8_MMA(0, 1, At, B1); PG8_BAR; PG8_SCHED;
            PG8_LDA(At, 1, 1); PG8_STAGE(PG8_SB(1, 0), b3, voffB); PG8_STAGE(PG8_SB(1, 1), b3 + hstep, voffB); PG8_STAGE(PG8_SA(1, 0), a3, voffA);
            PG8_WAIT_V(8); PG8_WAIT_L(0); PG8_BAR; PG8_MMA(1, 0, At, B0); PG8_MMA(1, 1, At, B1); PG8_BAR; PG8_SCHED;
            } else {
            PG8_LDB(B0, 0, 0); PG8_SCHED; PG8_LDA(At, 0, 0); PG8_STAGE(PG8_SA(1, 1), a1 + hstep, voffA);
            PG8_WAIT_L(8); PG8_BAR; PG8_WAIT_L(0); PG8_MMA(0, 0, At, B0); PG8_BAR; PG8_SCHED;
            PG8_LDB(B1, 0, 1); PG8_STAGE(PG8_SB(0, 0), b2, voffB);
            PG8_BAR; PG8_WAIT_L(0); PG8_MMA(0, 1, At, B1); PG8_BAR;
            PG8_LDA(At, 0, 1); PG8_STAGE(PG8_SA(0, 0), a2, voffA);
            PG8_BAR; PG8_WAIT_L(0); PG8_MMA(1, 0, At, B0); PG8_BAR; PG8_SCHED;
            PG8_STAGE(PG8_SB(0, 1), b2 + hstep, voffB);
            PG8_WAIT_V(6); PG8_BAR; PG8_MMA(1, 1, At, B1); PG8_BAR;
            PG8_LDB(B0, 1, 0); PG8_SCHED; PG8_LDA(At, 1, 0); PG8_STAGE(PG8_SA(0, 1), a2 + hstep, voffA);
            PG8_WAIT_L(8); PG8_BAR; PG8_WAIT_L(0); PG8_MMA(0, 0, At, B0); PG8_BAR; PG8_SCHED;
            PG8_LDB(B1, 1, 1); PG8_STAGE(PG8_SB(1, 0), b3, voffB);
            PG8_BAR; PG8_WAIT_L(0); PG8_MMA(0, 1, At, B1); PG8_BAR;
            PG8_LDA(At, 1, 1); PG8_STAGE(PG8_SA(1, 0), a3, voffA);
            PG8_BAR; PG8_WAIT_L(0); PG8_MMA(1, 0, At, B0); PG8_BAR; PG8_SCHED;
            PG8_STAGE(PG8_SB(1, 1), b3 + hstep, voffB);
            PG8_WAIT_V(6); PG8_BAR; PG8_MMA(1, 1, At, B1); PG8_BAR;
            }
        }
        if constexpr (ALIGN_EPI) { if (wr == 0) PG8_BAR; }
        if constexpr (!Epi::AFTER_DRAIN) { E(acc, cur, wr, wc, fr, fq); S.done(cur); }
        if (!has_next) break;
#pragma unroll
        for (int a = 0; a < 2; ++a)
#pragma unroll
            for (int b = 0; b < 2; ++b)
#pragma unroll
                for (int m = 0; m < 4; ++m)
#pragma unroll
                    for (int n = 0; n < 2; ++n) acc[a][b][m][n] = (f32x4){0.f, 0.f, 0.f, 0.f};
        cur = nxt; cA = nA; cB = nB; ++ui;
        if constexpr (ALIGN_EPI) { if (wr == 1) PG8_BAR; }
    }
    PG8_WAIT_V(0);
    if constexpr (!ALIGN_EPI) { if (wr == 0) PG8_BAR; }
    PG8_BAR;
    if constexpr (Epi::AFTER_DRAIN) { E.fused(acc, cur, wr, wc, fr, fq, lds, wid, lane); S.done(cur); }
#undef PG8_SA
#undef PG8_SB
#undef PG8_STAGE
#undef PG8_LDA
#undef PG8_LDB
#undef PG8_MMA
#undef PG8_WAIT_V
#undef PG8_WAIT_L
#undef PG8_BAR
#undef PG8_SCHED
}
}

namespace attn_body {
using bf16=__hip_bfloat16;
using bf16x8=__attribute__((ext_vector_type(8)))short;
using s16x4=__attribute__((ext_vector_type(4)))short;
using f32x16=__attribute__((ext_vector_type(16)))float;
using u32x4=__attribute__((ext_vector_type(4)))unsigned;
constexpr int D=64;
constexpr int NW=8,QBLK=32,QB=QBLK*NW,KVBLK=64;
__device__ __forceinline__ int crow(int r,int hi){return (r&3)+8*(r>>2)+4*hi;}
#define SBAR() __builtin_amdgcn_sched_barrier(0)
__device__ __forceinline__ void cmask(f32x16&p0,f32x16&p1,int jb,int qrel,int hi){
  const float NEG=-INFINITY; int kb=64*jb+4*hi;
  #pragma unroll
  for(int r=0;r<16;++r){int kv=kb+(r&3)+8*(r>>2); if(kv>qrel)p0[r]=NEG; if(kv+32>qrel)p1[r]=NEG;}
}

__device__ __forceinline__ void lmask(f32x16&p0,f32x16&p1,int t,int qrel,int hi){
  const float NEG=-30000.f; int kb=64*t+4*hi;
  #pragma unroll
  for(int r=0;r<16;++r){int kv=kb+(r&3)+8*(r>>2); if(kv<=qrel)p0[r]=NEG; if(kv+32<=qrel)p1[r]=NEG;}
}
__device__ __forceinline__ void smask(f32x16&p0,f32x16&p1,bool on){
  const float NEG=-INFINITY;
  #pragma unroll
  for(int r=0;r<16;++r){ p0[r]=on?p0[r]:NEG; p1[r]=on?p1[r]:NEG; }
}
constexpr int NSLOT=3, SLOTB=8192;
constexpr int LDS_K=0, LDS_V=NSLOT*SLOTB, LDS_WS=2*NSLOT*SLOTB, LDS_OST=LDS_WS+NW*64*4, LDS_BYTES=LDS_OST+NW*4096;
constexpr float C2=0.125f*1.4426950408889634f;
__device__ __forceinline__ void glds16(const void*gsrc,unsigned lds_dst){unsigned keep;
  asm volatile("s_mov_b32 %0, m0\n\ts_mov_b32 m0, %2\n\ts_nop 0\n\tglobal_load_lds_dwordx4 %1, off\n\ts_mov_b32 m0, %0":"=&s"(keep):"v"(gsrc),"s"(lds_dst):"memory");}
__device__ __forceinline__ float max3f(float a,float b,float c){float r;asm("v_max3_f32 %0, %1, %2, %3":"=v"(r):"v"(a),"v"(b),"v"(c));return r;}
__device__ __forceinline__ float max2f(float a,float b){float r;asm("v_max_f32_e32 %0, %1, %2":"=v"(r):"v"(a),"v"(b));return r;}
__device__ __forceinline__ float fadd_s(float a,float b){float r;asm("v_add_f32_e32 %0, %1, %2":"=v"(r):"v"(a),"v"(b));return r;}
__device__ __forceinline__ float fsub_s(float a,float b){float r;asm("v_sub_f32_e32 %0, %1, %2":"=v"(r):"v"(a),"v"(b));return r;}
typedef float f32x2_t __attribute__((ext_vector_type(2))); typedef __bf16 bf16x2_t __attribute__((ext_vector_type(2)));
__device__ __forceinline__ unsigned cvtpk_s(float lo,float hi){f32x2_t v={lo,hi};bf16x2_t b=__builtin_convertvector(v,bf16x2_t);return __builtin_bit_cast(unsigned,b);}
#define WAIT_BAR(N) asm volatile("s_waitcnt vmcnt(" #N ") lgkmcnt(0)\n\ts_barrier":::"memory")

__device__ __forceinline__ void qkt(f32x16&p0,f32x16&p1,const char*Kslot,const bf16x8*qr,const f32x16&negm,int r32,int hi){
  const char*kb=Kslot+hi*1024+r32*16;
  #pragma unroll
  for(int d0=0;d0<4;++d0){
    const bf16x8 b0=*reinterpret_cast<const bf16x8*>(kb+d0*2048);
    const bf16x8 b1=*reinterpret_cast<const bf16x8*>(kb+d0*2048+512);
    if(d0==0){p0=__builtin_amdgcn_mfma_f32_32x32x16_bf16(b0,qr[0],negm,0,0,0);p1=__builtin_amdgcn_mfma_f32_32x32x16_bf16(b1,qr[0],negm,0,0,0);}
    else{p0=__builtin_amdgcn_mfma_f32_32x32x16_bf16(b0,qr[d0],p0,0,0,0);p1=__builtin_amdgcn_mfma_f32_32x32x16_bf16(b1,qr[d0],p1,0,0,0);}}
}
typedef __attribute__((address_space(3))) const char* lds_cptr;
typedef short v4i16_t __attribute__((ext_vector_type(4)));
__device__ __forceinline__ void kload8(bf16x8*kf,lds_cptr kp){
  kf[0]=*(const __attribute__((address_space(3))) bf16x8*)(kp);      kf[1]=*(const __attribute__((address_space(3))) bf16x8*)(kp+512);
  kf[2]=*(const __attribute__((address_space(3))) bf16x8*)(kp+2048); kf[3]=*(const __attribute__((address_space(3))) bf16x8*)(kp+2560);
  kf[4]=*(const __attribute__((address_space(3))) bf16x8*)(kp+4096); kf[5]=*(const __attribute__((address_space(3))) bf16x8*)(kp+4608);
  kf[6]=*(const __attribute__((address_space(3))) bf16x8*)(kp+6144); kf[7]=*(const __attribute__((address_space(3))) bf16x8*)(kp+6656);
}
__device__ __forceinline__ void kload2(bf16x8*kf,lds_cptr kp,int j){ kf[2*j]=*(const __attribute__((address_space(3))) bf16x8*)(kp+j*2048); kf[2*j+1]=*(const __attribute__((address_space(3))) bf16x8*)(kp+j*2048+512); }
__device__ __forceinline__ s16x4 vtr(lds_cptr p){ return __builtin_bit_cast(s16x4,__builtin_amdgcn_ds_read_tr16_b64_v4i16((__attribute__((address_space(3))) v4i16_t*)p)); }
__device__ __forceinline__ float rowmax(const f32x16&p0,const f32x16&p1){
  float a=max3f(p0[0],p0[1],p1[0]),b=max3f(p0[2],p0[3],p1[1]);a=max3f(a,p1[2],p1[3]);
  #pragma unroll
  for(int r=4;r<16;r+=4){a=max3f(a,p0[r],p0[r+1]);b=max3f(b,p0[r+2],p0[r+3]);a=max3f(a,p1[r],p1[r+1]);b=max3f(b,p1[r+2],p1[r+3]);}
  const float m=max2f(a,b);
  auto rr=__builtin_amdgcn_permlane32_swap(__float_as_uint(m),__float_as_uint(m),false,false);
  return max2f(__uint_as_float(rr[0]),__uint_as_float(rr[1]));
}
__device__ __forceinline__ void pv(f32x16*o,int vb,bf16x8 pa0,bf16x8 pa1,bf16x8 pa2,bf16x8 pa3){
  #pragma unroll
  for(int d0=0;d0<2;++d0){s16x4 lo[4],hi[4];
    #pragma unroll
    for(int ks=0;ks<4;++ks){
      asm volatile("ds_read_b64_tr_b16 %0,%1 offset:%c2":"=&v"(lo[ks]):"v"(vb),"i"(d0*4096+ks*1024):"memory");
      asm volatile("ds_read_b64_tr_b16 %0,%1 offset:%c2":"=&v"(hi[ks]):"v"(vb),"i"(d0*4096+ks*1024+512):"memory");}
    asm volatile("s_waitcnt lgkmcnt(0)":::"memory");SBAR();
    #define PK(k) (bf16x8){lo[k][0],lo[k][1],lo[k][2],lo[k][3],hi[k][0],hi[k][1],hi[k][2],hi[k][3]}
    o[d0]=__builtin_amdgcn_mfma_f32_32x32x16_bf16(pa0,PK(0),o[d0],0,0,0);
    o[d0]=__builtin_amdgcn_mfma_f32_32x32x16_bf16(pa1,PK(1),o[d0],0,0,0);
    o[d0]=__builtin_amdgcn_mfma_f32_32x32x16_bf16(pa2,PK(2),o[d0],0,0,0);
    o[d0]=__builtin_amdgcn_mfma_f32_32x32x16_bf16(pa3,PK(3),o[d0],0,0,0);
    #undef PK
  }
}

#ifndef ATTN_STORE16
#define ATTN_STORE16(p,v) (*(u32x4*)(p)=(v))
#endif
struct NsaMix { int hd, j; };
template<int THRL,int MODE> __device__ __forceinline__ void attn_unit(long rowbase,int qb,const bf16*Qh,int ldq,const bf16*__restrict__ Kh0,const bf16*__restrict__ Vh0,int ldkv,bf16*Oh,int ldo,const unsigned long long*selrow,char*shm,const NsaMix mix){
  const int tid=tid_(),lane=tid&63,r32=lane&31,hi=lane>>5; const int wid=__builtin_amdgcn_readfirstlane(tid>>6);
  const int q0=qb*QB;
  int t_lo=0; bool lower=false; if(MODE==2){ if(qb>=2){ t_lo=4*qb-8; lower=true; } }
  const bf16*Qw=Qh+(rowbase+q0+wid*QBLK)*ldq;
  const bf16*Kh=Kh0+(rowbase+(long)t_lo*KVBLK)*ldkv,*Vh=Vh0+(rowbase+(long)t_lo*KVBLK)*ldkv;
  const unsigned lds0=(unsigned)(uintptr_t)shm;
  float*wsf=(float*)(shm+LDS_WS)+wid*64;
  const bf16*ksrc=Kh+(long)lane*ldkv+wid*8;
  const bf16*vsrc=Vh+(long)(16*(wid&3)+(lane>>2))*ldkv+(wid>>2)*32+(lane&3)*8;
  const unsigned kdst=lds0+LDS_K+wid*1024, vdst=lds0+LDS_V+wid*1024;
  #define DMA_K(t,slot) glds16(ksrc+(long)(t)*KVBLK*ldkv,(unsigned)__builtin_amdgcn_readfirstlane(kdst+(slot)))
  #define DMA_V(t,slot) glds16(vsrc+(long)(t)*KVBLK*ldkv,(unsigned)__builtin_amdgcn_readfirstlane(vdst+(slot)))
  const int vb0=(int)(lds0+LDS_V)+((lane>>4)&1)*32+(lane&3)*8+(4*hi+((lane&15)>>2))*64;
  const char*Kbase=shm+LDS_K; bf16x8 kf[8];
  const lds_cptr shm3=(lds_cptr)shm; const lds_cptr kp0=shm3+LDS_K+hi*1024+r32*16; const lds_cptr vp0=shm3+LDS_V+((lane>>4)&1)*32+(lane&3)*8+(4*hi+((lane&15)>>2))*64;
  const int NT=(q0+QB)/KVBLK-t_lo;
  DMA_K(0,0);DMA_V(0,0);DMA_K(1,SLOTB);
  bf16x8 qr[4];
  #pragma unroll
  for(int d0=0;d0<4;++d0)qr[d0]=*reinterpret_cast<const bf16x8*>(&Qw[(long)r32*ldq+d0*16+hi*8]);
  float mhat=0.f,l_reg=0.f;f32x16 o[2];o[0]=f32x16{};o[1]=f32x16{};f32x16 negm=f32x16{};asm volatile("":"+v"(negm));
  const int qrel=wid*QBLK+r32;
  unsigned long long msk=0ull; if(MODE==1) msk=selrow[q0+qrel];
  #define XMASK(P0,P1,t) do{ if(MODE==1) smask(P0,P1,((msk>>(t))&1ull)!=0ull); if(MODE==2){ if(lower&&(t)<4) lmask(P0,P1,(t),qrel,hi); } }while(0)
  #define CMASK(P0,P1,t) do{ XMASK(P0,P1,t); int jb_=(t)-(NT-4); if(jb_>=0)cmask(P0,P1,jb_,qrel,hi);}while(0)
  bool resc=false;
  #define START(P0,P1) do{ const float rm=rowmax(P0,P1); resc=false; \
    { const float dl=rm; mhat=fadd_s(mhat,dl); \
      _Pragma("unroll") for(int r=0;r<16;++r){P0[r]=fsub_s(P0[r],dl);P1[r]=fsub_s(P1[r],dl);} \
      _Pragma("unroll") for(int r=0;r<16;++r)negm[r]=-mhat; asm volatile("":"+v"(negm)); } \
    _Pragma("unroll") for(int r=0;r<16;++r)P0[r]=__builtin_amdgcn_exp2f(P0[r]); }while(0)
  #define RESC() do{ if(resc){ asm volatile("s_waitcnt lgkmcnt(0)":::"memory"); \
      _Pragma("unroll") for(int d_=0;d_<2;++d_) _Pragma("unroll") for(int r=0;r<16;++r)o[d_][r]*=wsf[crow(r,hi)]; } }while(0)
  f32x16 pA0,pA1,pB0,pB1;
  int sl_prev=0,sl_cur=0,sl_next=SLOTB;
  #define ROT() do{sl_prev=sl_cur;sl_cur=sl_next;sl_next=(sl_next==(NSLOT-1)*SLOTB)?0:sl_next+SLOTB;}while(0)
  DMA_K(2,2*SLOTB);
  WAIT_BAR(3);
  qkt(pA0,pA1,Kbase,qr,negm,r32,hi);asm volatile("s_nop 15\n\ts_nop 7":"+v"(pA0),"+v"(pA1));CMASK(pA0,pA1,0);
  START(pA0,pA1);
  _Pragma("unroll") for(int r=0;r<16;++r)pA1[r]=__builtin_amdgcn_exp2f(pA1[r]);
  WAIT_BAR(0);
  DMA_K(3,0);DMA_V(1,SLOTB);
  ROT();
  kload8(kf,kp0+sl_cur);
  WAIT_BAR(2);
  s16x4 vlo[8],vhi[8]; u32x4 pw0,pw1,pw2,pw3;
  #define PKW(P,B) cvtpk_s(P[B],P[B+1])
  #define PAF(k) __builtin_bit_cast(bf16x8,pw##k)
  #define VFR(i) (bf16x8){vlo[i][0],vlo[i][1],vlo[i][2],vlo[i][3],vhi[i][0],vhi[i][1],vhi[i][2],vhi[i][3]}
  #define PIN(x) asm volatile("":"+v"(x))
  #define MX3(a,b,c) __builtin_fmaxf(__builtin_fmaxf((a),(b)),(c))
  #define GAPA(MF,A0,A1,A2,A3,W0,W1,PW) do{ MF; sacc+=A0; sacc+=A1; sacc+=A2; sacc+=A3; PIN(sacc); W0; W1; PIN(PW); SBAR(); }while(0)
  #define EX(v) __builtin_amdgcn_exp2f(v)
  #define GAPB(MF,X,B) do{ MF; X[B]=EX(X[B]); X[B+1]=EX(X[B+1]); X[B+2]=EX(X[B+2]); X[B+3]=EX(X[B+3]); PIN(X); SBAR(); }while(0)
  #define VRD(i) do{ vlo[i]=vtr(vp_+(((i)>>2)*4096+((i)&3)*1024)); vhi[i]=vtr(vp_+(((i)>>2)*4096+((i)&3)*1024+512)); }while(0)
  #define KRD(G,j) do{ if(G){ kload2(kf,kp0+sl_next,j); SBAR(); } }while(0)
  #define STEP(C0,C1,P0,P1,t,GK,GV,GL) do{ SBAR(); \
    const lds_cptr vp_=vp0+sl_prev; \
    VRD(0); SBAR(); float sacc=(P0[0]+P0[1]); \
    GAPA(C0=__builtin_amdgcn_mfma_f32_32x32x16_bf16(kf[0],qr[0],negm,0,0,0), P0[2],P0[3],P0[4],P0[5],     pw0[0]=PKW(P0,0), pw0[1]=PKW(P0,2), pw0); \
    VRD(4); SBAR(); GAPA(C1=__builtin_amdgcn_mfma_f32_32x32x16_bf16(kf[1],qr[0],negm,0,0,0), P0[6],P0[7],P0[8],P0[9],     pw0[2]=PKW(P0,4), pw0[3]=PKW(P0,6), pw0); \
    VRD(1); SBAR(); GAPA(C0=__builtin_amdgcn_mfma_f32_32x32x16_bf16(kf[2],qr[1],C0,0,0,0),   P0[10],P0[11],P0[12],P0[13], pw1[0]=PKW(P0,8), pw1[1]=PKW(P0,10), pw1); \
    VRD(5); SBAR(); GAPA(C1=__builtin_amdgcn_mfma_f32_32x32x16_bf16(kf[3],qr[1],C1,0,0,0),   P0[14],P0[15],P1[0],P1[1],   pw1[2]=PKW(P0,12),pw1[3]=PKW(P0,14), pw1); \
    VRD(2); SBAR(); GAPA(C0=__builtin_amdgcn_mfma_f32_32x32x16_bf16(kf[4],qr[2],C0,0,0,0),   P1[2],P1[3],P1[4],P1[5],     pw2[0]=PKW(P1,0), pw2[1]=PKW(P1,2), pw2); \
    VRD(6); SBAR(); GAPA(C1=__builtin_amdgcn_mfma_f32_32x32x16_bf16(kf[5],qr[2],C1,0,0,0),   P1[6],P1[7],P1[8],P1[9],     pw2[2]=PKW(P1,4), pw2[3]=PKW(P1,6), pw2); \
    VRD(3); SBAR(); GAPA(C0=__builtin_amdgcn_mfma_f32_32x32x16_bf16(kf[6],qr[3],C0,0,0,0),   P1[10],P1[11],P1[12],P1[13], pw3[0]=PKW(P1,8), pw3[1]=PKW(P1,10), pw3); \
    VRD(7); SBAR(); GAPA(C1=__builtin_amdgcn_mfma_f32_32x32x16_bf16(kf[7],qr[3],C1,0,0,0),   P1[14],P1[15],0.f,0.f,       pw3[2]=PKW(P1,12),pw3[3]=PKW(P1,14), pw3); \
    l_reg+=sacc; \
    if(GK){DMA_K((t)+3,sl_cur);} if(GV){DMA_V((t)+1,sl_next);} \
    CMASK(C0,C1,t); \
    { float a=MX3(C0[0],C0[1],C1[0]),b=MX3(C0[2],C0[3],C1[1]); a=MX3(a,C1[2],C1[3]); \
      _Pragma("unroll") for(int r=4;r<16;r+=4){a=MX3(a,C0[r],C0[r+1]);b=MX3(b,C0[r+2],C0[r+3]);a=MX3(a,C1[r],C1[r+1]);b=MX3(b,C1[r+2],C1[r+3]);} \
      float rm=__builtin_fmaxf(a,b); { auto rr=__builtin_amdgcn_permlane32_swap(__float_as_uint(rm),__float_as_uint(rm),false,false); rm=__builtin_fmaxf(__uint_as_float(rr[0]),__uint_as_float(rr[1])); } \
      resc=false; \
      if(__builtin_expect(__any(rm>(float)THRL),0)){ const float dl=__builtin_fmaxf(rm,0.f); mhat+=dl; \
        _Pragma("unroll") for(int r=0;r<16;++r){C0[r]-=dl;C1[r]-=dl;} \
        _Pragma("unroll") for(int r=0;r<16;++r)negm[r]=-mhat; asm volatile("":"+v"(negm)); \
        const float f=__builtin_amdgcn_exp2f(-dl); l_reg*=f; if(hi==0)wsf[r32]=f; resc=true; } } \
    SBAR(); \
    GAPB(o[0]=__builtin_amdgcn_mfma_f32_32x32x16_bf16(PAF(0),VFR(0),o[0],0,0,0), C0,0); \
    GAPB(o[1]=__builtin_amdgcn_mfma_f32_32x32x16_bf16(PAF(0),VFR(4),o[1],0,0,0), C0,4); \
    KRD(GL,0); GAPB(o[0]=__builtin_amdgcn_mfma_f32_32x32x16_bf16(PAF(1),VFR(1),o[0],0,0,0), C0,8); \
    KRD(GL,1); GAPB(o[1]=__builtin_amdgcn_mfma_f32_32x32x16_bf16(PAF(1),VFR(5),o[1],0,0,0), C0,12); \
    KRD(GL,2); GAPB(o[0]=__builtin_amdgcn_mfma_f32_32x32x16_bf16(PAF(2),VFR(2),o[0],0,0,0), C1,0); \
    KRD(GL,3); GAPB(o[1]=__builtin_amdgcn_mfma_f32_32x32x16_bf16(PAF(2),VFR(6),o[1],0,0,0), C1,4); \
    GAPB(o[0]=__builtin_amdgcn_mfma_f32_32x32x16_bf16(PAF(3),VFR(3),o[0],0,0,0), C1,8); \
    GAPB(o[1]=__builtin_amdgcn_mfma_f32_32x32x16_bf16(PAF(3),VFR(7),o[1],0,0,0), C1,12); \
    }while(0)
  int t=1;
  #undef CMASK
  #define CMASK(P0,P1,t) XMASK(P0,P1,t)
  for(;t+5<NT;t+=2){
    STEP(pB0,pB1,pA0,pA1,t,true,true,true);     WAIT_BAR(2); RESC(); ROT();
    STEP(pA0,pA1,pB0,pB1,t+1,true,true,true);   WAIT_BAR(2); RESC(); ROT();
  }
  #undef CMASK
  #define CMASK(P0,P1,t) do{ XMASK(P0,P1,t); int jb_=(t)-(NT-4); if(jb_>=0)cmask(P0,P1,jb_,qrel,hi);}while(0)
  #define ENDW(tt) do{ if((tt)+3<NT){WAIT_BAR(2);} else if((tt)+2<NT){WAIT_BAR(1);} else {WAIT_BAR(0);} }while(0)
  for(;t+1<NT;t+=2){
    STEP(pB0,pB1,pA0,pA1,t,(t+3<NT),(t+1<NT),(t+1<NT));       ENDW(t);   RESC(); ROT();
    STEP(pA0,pA1,pB0,pB1,t+1,(t+4<NT),(t+2<NT),(t+2<NT));     ENDW(t+1); RESC(); ROT();
  }
  STEP(pB0,pB1,pA0,pA1,NT-1,false,false,false); RESC();
  { float sacc=pB0[0]+pB0[1]; _Pragma("unroll") for(int r=2;r<16;++r)sacc+=pB0[r]; _Pragma("unroll") for(int r=0;r<16;++r)sacc+=pB1[r]; l_reg+=sacc;
    pw0=(u32x4){PKW(pB0,0),PKW(pB0,2),PKW(pB0,4),PKW(pB0,6)};pw1=(u32x4){PKW(pB0,8),PKW(pB0,10),PKW(pB0,12),PKW(pB0,14)};pw2=(u32x4){PKW(pB1,0),PKW(pB1,2),PKW(pB1,4),PKW(pB1,6)};pw3=(u32x4){PKW(pB1,8),PKW(pB1,10),PKW(pB1,12),PKW(pB1,14)};
    SBAR(); pv(o,vb0+sl_cur,PAF(0),PAF(1),PAF(2),PAF(3)); }
  #undef PKW
  #undef PAF
  #undef VFR
  #undef PIN
  #undef MX3
  #undef GAPA
  #undef GAPB
  #undef EX
  #undef VRD
  #undef KRD
  #undef STEP
  #undef ENDW
  {auto rr=__builtin_amdgcn_permlane32_swap(__float_as_uint(l_reg),__float_as_uint(l_reg),false,false);l_reg=__uint_as_float(rr[0])+__uint_as_float(rr[1]);}
  if(hi==0)wsf[32+r32]=l_reg;asm volatile("s_waitcnt lgkmcnt(0)":::"memory");
  float rli[16];
  #pragma unroll
  for(int r=0;r<16;++r)rli[r]=__builtin_amdgcn_rcpf(wsf[32+crow(r,hi)]);
  bf16*Ow=Oh+(rowbase+q0+wid*QBLK)*ldo;
  { bf16*stg=(bf16*)(shm+LDS_OST)+wid*2048;
    #pragma unroll
    for(int r=0;r<16;++r){const int orow=crow(r,hi);
      #pragma unroll
      for(int d0=0;d0<2;++d0)stg[orow*64+d0*32+r32]=__float2bfloat16(o[d0][r]*rli[r]);}
    asm volatile("s_waitcnt lgkmcnt(0)":::"memory");
    #pragma unroll
    for(int i=0;i<4;++i){const int row=i*8+(lane>>3),ch=lane&7; u32x4 v=*(const u32x4*)(stg+row*64+ch*8);
      if(MODE==1){ const long grow=rowbase+q0+wid*QBLK+row;
        const unsigned short*ocmp=(const unsigned short*)(P(ws)+WS_ATT)+mix.hd*64, *owin=(const unsigned short*)(P(ws)+WS_ATT+64*MiB)+mix.hd*64;
        const u32x4 a=*(const u32x4*)(ocmp+grow*ldo+ch*8), c=*(const u32x4*)(owin+grow*ldo+ch*8);
        const unsigned short*gp=(const unsigned short*)(P(ws)+WS_PROJ)+grow*NSA_P+2560+mix.hd*3; const float*bgp=P(nsa_b_gate)+mix.j*48+mix.hd*3;
        const float g0=1.0f/(1.0f+__expf(-(__uint_as_float((unsigned)gp[0]<<16)+bgp[0]))), g1=1.0f/(1.0f+__expf(-(__uint_as_float((unsigned)gp[1]<<16)+bgp[1]))), g2=1.0f/(1.0f+__expf(-(__uint_as_float((unsigned)gp[2]<<16)+bgp[2])));
        #pragma unroll
        for(int e=0;e<4;++e){ const float alo=__uint_as_float(a[e]<<16),ahi=__uint_as_float(a[e]&0xffff0000u), vlo=__uint_as_float(v[e]<<16),vhi=__uint_as_float(v[e]&0xffff0000u), clo=__uint_as_float(c[e]<<16),chi=__uint_as_float(c[e]&0xffff0000u);
          v[e]=cvtpk_s(g0*alo+g1*vlo+g2*clo, g0*ahi+g1*vhi+g2*chi); } }
      ATTN_STORE16(Ow+(long)row*ldo+ch*8,v);} }
  asm volatile("s_waitcnt lgkmcnt(0)\n\ts_barrier":::"memory");
  #undef DMA_K
  #undef DMA_V
  #undef CMASK
  #undef XMASK
  #undef START
  #undef RESC
  #undef ROT
}
constexpr int ATTN_LDS_BYTES=LDS_BYTES;
#undef SBAR
#undef WAIT_BAR
}

__device__ __forceinline__ void ph_attn_diff_fast(unsigned char* lds) {
  using namespace attn_body;
  const bf16* PROJ = (const bf16*)(P(ws) + WS_PROJ); bf16* ATT = (bf16*)(P(ws) + WS_ATT);
  const int G = gdim_(), bx = bid_(); const int v0 = (G % 8 == 0) ? (bx % 8) * (G / 8) + bx / 8 : bx;
  for (int vcu = v0; vcu < 256; vcu += G) {
    const int bhp = vcu >> 1, half = bhp & 1, c = (bhp >> 1) & 1, h8 = (bhp >> 2) & 7, b = bhp >> 5;
#pragma unroll 1
    for (int i = 0; i < 8; ++i) { const int sp = 4 * (vcu & 1) + (i >> 1); const int qb = (i & 1) ? 15 - sp : sp;
      attn_unit<8, 0>((long)b * S, qb, PROJ + (h8 * 2 + c) * 64, DIFF_IN, PROJ + 1024 + (h8 * 2 + c) * 64, PROJ + 2048 + h8 * 128 + half * 64, DIFF_IN,
                      ATT + c * 1024 + h8 * 128 + half * 64, 2048, nullptr, (char*)lds, NsaMix{}); }
  }
}
__device__ __forceinline__ void ph_attn_sel_fast(int j, unsigned char* lds) {
  using namespace attn_body;
  const bf16* PROJ = (const bf16*)(P(ws) + WS_PROJ); bf16* OC = (bf16*)(P(ws) + WS_OC);
  const u64* SEL = (const u64*)(P(ws) + WS_SEL);
  const int G = gdim_(), bx = bid_(); const int v0 = (G % 8 == 0) ? (bx % 8) * (G / 8) + bx / 8 : bx;
  for (int vcu = v0; vcu < 256; vcu += G) {
    const int bh = vcu >> 2, hd = bh & 15, b = bh >> 4, g = hd >> 2;
    const NsaMix mix{hd, j};
#pragma unroll 1
    for (int i = 0; i < 4; ++i) { const int sp = 2 * (vcu & 3) + (i >> 1); const int qb = (i & 1) ? 15 - sp : sp;
      attn_unit<8, 1>((long)b * S, qb, PROJ + hd * 64, NSA_P, PROJ + 1536 + g * 64, PROJ + 1792 + g * 64, NSA_P, OC + hd * 64, 1024, SEL + (size_t)(b * 4 + g) * S, (char*)lds, mix); }
  }
}
__device__ __forceinline__ void ph_attn_win_fast(unsigned char* lds) {
  using namespace attn_body;
  const bf16* PROJ = (const bf16*)(P(ws) + WS_PROJ); bf16* OWIN = (bf16*)(P(ws) + WS_ATT + 64 * MiB);
  const int G = gdim_(), bx = bid_(); const int v0 = (G % 8 == 0) ? (bx % 8) * (G / 8) + bx / 8 : bx;
  for (int vcu = v0; vcu < 256; vcu += G) {
    const int bh = vcu >> 2, hd = bh & 15, b = bh >> 4, g = hd >> 2;
#pragma unroll 1
    for (int i = 0; i < 4; ++i) { const int qb = (vcu & 3) + 4 * i;
      attn_unit<8, 2>((long)b * S, qb, PROJ + hd * 64, NSA_P, PROJ + 2048 + g * 64, PROJ + 2304 + g * 64, NSA_P, OWIN + hd * 64, 1024, nullptr, (char*)lds, NsaMix{}); }
  }
}

#define XB_TMO      128
#define XB_XCNT(j)  (256  + 64 * (j))
#define XB_XSUB(j)  (1280 + 64 * (j))
#define XB_XGEN(j)  (2304 + 64 * (j))
#define XB_TOP      3328
#define XB_TOPGEN   3392
#define XCD_BAR_WORDS 3456
#define XB_SPIN_CAP (1u << 18)

__device__ __forceinline__ unsigned xb_ld(unsigned* p)              { return __hip_atomic_load(p, __ATOMIC_RELAXED, __HIP_MEMORY_SCOPE_AGENT); }
__device__ __forceinline__ unsigned xb_add(unsigned* p, unsigned v) { return __hip_atomic_fetch_add(p, v, __ATOMIC_RELAXED, __HIP_MEMORY_SCOPE_AGENT); }
__device__ __forceinline__ unsigned xb_xcc_id() { return (unsigned)__builtin_amdgcn_s_getreg((3 << 11) | 20) & 0xFu; }
#define XB_SPIN(cond, bar) do { unsigned _sp = 0; while (cond) { __builtin_amdgcn_s_sleep(1); \
    if ((++_sp & 255u) == 0u) { if (xb_ld(&(bar)[XB_TMO])) break; if (_sp > XB_SPIN_CAP) { atomicAdd(&(bar)[XB_TMO], 1u); break; } } } } while (0)

struct XcdBarrier {
    unsigned* bar; unsigned x;
    volatile __attribute__((address_space(3))) unsigned* st;
};

__device__ __forceinline__ XcdBarrier xcd_barrier_post(unsigned* bar, volatile __attribute__((address_space(3))) unsigned* st) {
    XcdBarrier b; b.bar = bar; b.x = xb_xcc_id(); b.st = st;
    if (tid_() == 0) (void)xb_add(&bar[XB_XCNT(b.x)], 1u);
    return b;
}
__device__ __forceinline__ void xcd_barrier_complete(unsigned* bar, unsigned x, unsigned& nloc, unsigned& nx) {
    const unsigned G = gridDim.x * gridDim.y * gridDim.z;
    unsigned sum, cnt, mine, sp = 0u;
    for (;;) {
        sum = 0u; cnt = 0u; mine = 0u;
#pragma unroll
        for (unsigned j = 0; j < 16; ++j) { const unsigned c = xb_ld(&bar[XB_XCNT(j)]); sum += c; cnt += (c > 0u) ? 1u : 0u; mine = (j == x) ? c : mine; }
        if (sum == G) break;
        __builtin_amdgcn_s_sleep(1);
        if ((++sp & 255u) == 0u) { if (xb_ld(&bar[XB_TMO])) break; if (sp > XB_SPIN_CAP) { atomicAdd(&bar[XB_TMO], 1u); break; } }
    }
    nloc = mine > 0u ? mine : 1u; nx = cnt > 0u ? cnt : 1u;
}

__device__ __forceinline__ void xcd_barrier(const XcdBarrier& b) {
    asm volatile("s_waitcnt vmcnt(0)" ::: "memory");
    __syncthreads();
    if (tid_() == 0) {
        unsigned* bar = b.bar;
        __builtin_amdgcn_s_waitcnt(0);
        unsigned nloc = b.st[0], nx = b.st[1];
        if (nloc == 0u) { xcd_barrier_complete(bar, b.x, nloc, nx); b.st[0] = nloc; b.st[1] = nx; }
        const unsigned old = xb_add(&bar[XB_XSUB(b.x)], 1u);
        const unsigned gen = old / nloc;
        if (old + 1u == (gen + 1u) * nloc) {
            __builtin_amdgcn_fence(__ATOMIC_RELEASE, "agent");
            asm volatile("s_waitcnt vmcnt(0)" ::: "memory");
            const unsigned og = xb_add(&bar[XB_TOP], 1u);
            const unsigned tg = og / nx;
            if (og + 1u == (tg + 1u) * nx) xb_add(&bar[XB_TOPGEN], 1u);
            else XB_SPIN(xb_ld(&bar[XB_TOPGEN]) == tg, bar);
            __builtin_amdgcn_fence(__ATOMIC_ACQUIRE, "agent");
            xb_add(&bar[XB_XGEN(b.x)], 1u);
            asm volatile("s_waitcnt vmcnt(0)" ::: "memory");
        } else {
            XB_SPIN(xb_ld(&bar[XB_XGEN(b.x)]) == gen, bar);
            __builtin_amdgcn_fence(__ATOMIC_ACQUIRE, "agent");
            asm volatile("s_waitcnt vmcnt(0)" ::: "memory");
        }
    }
    __syncthreads();
}

__device__ __forceinline__ void ph_prologue(unsigned char* lds) {
  const int tid = tid_();
  float* silu = (float*)lds;
  float* red = silu + 4096;
  float* MOD = (float*)(P(ws) + WS_MOD);
  for (int i = tid; i < 4096; i += NTHR) { const float v = P(c)[i]; silu[i] = v / (1.f + expf(-v)); }
  __syncthreads();
  const int cc = tid & 31, ks = tid >> 5;
  for (int item = bid_(); item < 768 + 16; item += gdim_()) {
    if (item < 768) {
      const int l = item / 192, nc = item % 192;
      const float* w = P(w_ada) + ((size_t)l * 1024 + ks * 64) * 6144 + nc * 32 + cc;
      float wv[64];
#pragma unroll
      for (int k = 0; k < 64; ++k) wv[k] = w[(size_t)k * 6144];
      float a0 = 0.f, a1 = 0.f, a2 = 0.f, a3 = 0.f;
#pragma unroll
      for (int k = 0; k < 64; ++k) { const int kk = ks * 64 + k; a0 += silu[kk] * wv[k]; a1 += silu[1024 + kk] * wv[k]; a2 += silu[2048 + kk] * wv[k]; a3 += silu[3072 + kk] * wv[k]; }
      red[(ks * 4 + 0) * 32 + cc] = a0; red[(ks * 4 + 1) * 32 + cc] = a1; red[(ks * 4 + 2) * 32 + cc] = a2; red[(ks * 4 + 3) * 32 + cc] = a3;
      __syncthreads();
      if (tid < 128) { const int bb = tid >> 5; float sacc = 0.f;
#pragma unroll
        for (int q = 0; q < 16; ++q) sacc += red[(q * 4 + bb) * 32 + cc];
        MOD[(size_t)(l * 4 + bb) * 6144 + nc * 32 + cc] = sacc + P(b_ada)[l * 6144 + nc * 32 + cc]; }
      __syncthreads();
    } else {
      const int it = item - 768, jk = it >> 2, nc = it & 3, jj = jk >> 1, kv = jk & 1;
      const float* pe = (kv ? P(nsa_pe_v) : P(nsa_pe_k)) + jj * 2048 + ks * 128; const float* w1 = (kv ? P(nsa_w_cv1) : P(nsa_w_ck1)) + ((size_t)jj * 2048 + ks * 128) * 128 + nc * 32 + cc;
      float a = 0.f;
#pragma unroll 2
      for (int k0 = 0; k0 < 128; k0 += 64) { float wv[64];
#pragma unroll
        for (int k = 0; k < 64; ++k) wv[k] = w1[(size_t)(k0 + k) * 128];
#pragma unroll
        for (int k = 0; k < 64; ++k) a += pe[k0 + k] * wv[k]; }
      red[ks * 32 + cc] = a;
      __syncthreads();
      if (tid < 32) { float sacc = 0.f;
#pragma unroll
        for (int q = 0; q < 16; ++q) sacc += red[q * 32 + cc];
        ((float*)(P(ws) + WS_SMALL))[64 + jk * 128 + nc * 32 + cc] = sacc; }
      __syncthreads();
    }
  }
  float* rope = (float*)(P(ws) + WS_ROPE);
  for (int m = bid_() * NTHR + tid; m < T; m += gdim_() * NTHR) {
    const float fp = (float)P(pos)[m];
    const float INV[8] = {1.0f, 0.1939227432012558f, 0.03760603070259094f, 0.007292664609849453f, 0.0014142135623842478f, 0.00027424818836152554f, 5.3182957344688475e-05f, 1.0313385246263351e-05f};
#pragma unroll
    for (int i = 0; i < 8; ++i) {
      const float ang = fp * INV[i];
      const double a = (double)ang; const double kq = rint(a * 0.63661977236758134308); const double r = a - kq * 1.57079632679489661923;
      const int q = (int)((long long)kq & 3ll);
      const double r2 = r * r;
      const double sr = r * (1.0 + r2 * (-1.0 / 6 + r2 * (1.0 / 120 + r2 * (-1.0 / 5040 + r2 * (1.0 / 362880 + r2 * (-1.0 / 39916800 + r2 * (1.0 / 6227020800.0)))))));
      const double cr = 1.0 + r2 * (-0.5 + r2 * (1.0 / 24 + r2 * (-1.0 / 720 + r2 * (1.0 / 40320 + r2 * (-1.0 / 3628800 + r2 * (1.0 / 479001600.0))))));
      const double sn = (q == 0) ? sr : (q == 1) ? cr : (q == 2) ? -sr : -cr;
      const double cs = (q == 0) ? cr : (q == 1) ? -sr : (q == 2) ? -cr : sr;
      rope[(size_t)m * 16 + i] = (float)cs; rope[(size_t)m * 16 + 8 + i] = (float)sn;
    }
  }
  if (bid_() == 0 && tid < 2) {
    const int j = tid; float s1 = 0.f, s2 = 0.f;
    for (int i = 0; i < 64; ++i) { s1 += P(diff_lq1)[j * 64 + i] * P(diff_lk1)[j * 64 + i]; s2 += P(diff_lq2)[j * 64 + i] * P(diff_lk2)[j * 64 + i]; }
    ((float*)(P(ws) + WS_SMALL))[j] = expf(s1) - expf(s2) + lam_init_of(j);
  }
}


__device__ __forceinline__ void transpose_item(const float* W, int K, int N, int Npad, bf16_t* WT, float* scr, int item, int lane) {
  const int nblk = Npad / 32, kb = item / nblk, nb = item % nblk, k0 = 64 * kb, n0 = 32 * nb;
  const int ncol = n0 + (lane & 31); const bool ok = ncol < N;
#pragma unroll 8
  for (int i = 0; i < 32; ++i) { const int kk = 2 * i + (lane >> 5); scr[kk * 33 + (lane & 31)] = ok ? W[(size_t)(k0 + kk) * N + ncol] : 0.f; }
  asm volatile("s_waitcnt lgkmcnt(0)" ::: "memory");
  const int c = lane & 7;
#pragma unroll
  for (int j = 0; j < 4; ++j) { const int n = (lane >> 3) + 8 * j; const float* sp = scr + (8 * c) * 33 + n;
    uint4 o; o.x = pk2(sp[0 * 33], sp[1 * 33]); o.y = pk2(sp[2 * 33], sp[3 * 33]); o.z = pk2(sp[4 * 33], sp[5 * 33]); o.w = pk2(sp[6 * 33], sp[7 * 33]);
    *(uint4*)(WT + (size_t)(n0 + n) * K + k0 + 8 * c) = o; }
  asm volatile("s_waitcnt lgkmcnt(0)" ::: "memory");
}
__device__ __forceinline__ void ph_weights(unsigned char* lds) {
  const int tid = tid_(), lane = tid & 63, wave = tid >> 6;
  float* scr = (float*)(lds + wave * 16384);
  const int gw = bid_() * 8 + wave, NGW = gdim_() * 8;
  for (int it = gw; it < 4 * 6144; it += NGW) {
    const int i = it / 6144; int r = it % 6144; const int j = i >> 1; const bool nsa = (i & 1) == 0;
    bf16_t* base = (bf16_t*)(P(ws) + WS_WT + (size_t)i * WT_LAYER);
    const int n_in = nsa ? 16 * (NSA_P / 32) : 16 * (DIFF_IN / 32);
    if (r < n_in) { if (nsa) transpose_item(P(nsa_w_in) + (size_t)j * D * NSA_IN, D, NSA_IN, NSA_P, base, scr, r, lane); else transpose_item(P(diff_w_in) + (size_t)j * D * DIFF_IN, D, DIFF_IN, DIFF_IN, base, scr, r, lane); continue; }
    r -= n_in;
    if (r < 512) { transpose_item((nsa ? P(nsa_w_out) : P(diff_w_out)) + (size_t)j * D * D, D, D, D, base + WT_OUT / 2, scr, r, lane); continue; }
    r -= 512;
    if (r < 2048) { transpose_item(P(w_mlp_in) + (size_t)i * D * DFF, D, DFF, DFF, base + WT_MI / 2, scr, r, lane); continue; }
    r -= 2048;
    if (r < 2048) transpose_item(P(w_mlp_out) + (size_t)i * DFF * D, DFF, D, D, base + WT_MO / 2, scr, r, lane);
  }
  for (int it = gw; it < 4 * 128; it += NGW) {
    const int jk = it >> 7, jj = jk >> 1, kv = jk & 1;
    transpose_item((kv ? P(nsa_w_cv1) : P(nsa_w_ck1)) + (size_t)jj * 2048 * 128, 2048, 128, 128, (bf16_t*)(P(ws) + WS_W1T) + (size_t)jk * 128 * 2048, scr, it & 127, lane);
  }
}
__device__ __forceinline__ void ph_cmp_bias(unsigned char* lds) {
  float* red = (float*)lds;
  const int tid = tid_(), n = tid & 127, ks = tid >> 7;
  for (int jk = bid_(); jk < 4; jk += gdim_()) {
    const int jj = jk >> 1, kv = jk & 1;
    const float* pe = (kv ? P(nsa_pe_v) : P(nsa_pe_k)) + jj * 2048; const float* w1 = (kv ? P(nsa_w_cv1) : P(nsa_w_ck1)) + (size_t)jj * 2048 * 128;
    float a = 0.f;
#pragma unroll 16
    for (int k = ks * 512; k < ks * 512 + 512; ++k) a += pe[k] * w1[(size_t)k * 128 + n];
    __syncthreads();
    red[ks * 128 + n] = a;
    __syncthreads();
    if (tid < 128) ((float*)(P(ws) + WS_SMALL))[64 + jk * 128 + tid] = red[tid] + red[128 + tid] + red[256 + tid] + red[384 + tid];
  }
}

__device__ __forceinline__ void ph_norm(const float* xin, const float* gvec, const float* mod  , int sh_off, int sc_off, bf16_t* H) {
  const int tid = tid_(), lane = tid & 63, wave = tid >> 6;
  for (int m = bid_() * 8 + wave; m < T; m += gdim_() * 8) {
    const int b = m >> 12;
    const float4* xr = (const float4*)(xin + (size_t)m * D) + lane;
    float4 v[4]; float ss = 0.f;
#pragma unroll
    for (int j = 0; j < 4; ++j) { v[j] = xr[64 * j]; ss += (v[j].x * v[j].x + v[j].y * v[j].y) + (v[j].z * v[j].z + v[j].w * v[j].w); }
    ss = wave_sum(ss);
    const float rstd = 1.0f / sqrtf(ss * (1.0f / D) + EPS);
#pragma unroll
    for (int j = 0; j < 4; ++j) {
      const int col = 4 * lane + 256 * j;
      const float4 g = *(const float4*)(gvec + col), sc = *(const float4*)(mod + (size_t)b * 6144 + sc_off + col), sh = *(const float4*)(mod + (size_t)b * 6144 + sh_off + col);
      const float h0 = v[j].x * rstd * g.x * (1.f + sc.x) + sh.x, h1 = v[j].y * rstd * g.y * (1.f + sc.y) + sh.y;
      const float h2 = v[j].z * rstd * g.z * (1.f + sc.z) + sh.z, h3 = v[j].w * rstd * g.w * (1.f + sc.w) + sh.w;
      uint2 o; o.x = pk2(h0, h1); o.y = pk2(h2, h3);
      *(uint2*)(H + (size_t)m * D + col) = o;
    }
  }
}

struct EpiStore { bf16_t* O; int ld; int relu2;
  __device__ __forceinline__ void operator()(int row, int col, const float* v) const {
    float a = v[0], b = v[1], c = v[2], d = v[3];
    if (relu2) { a = fmaxf(a, 0.f); a *= a; b = fmaxf(b, 0.f); b *= b; c = fmaxf(c, 0.f); c *= c; d = fmaxf(d, 0.f); d *= d; }
    uint2 o; o.x = pk2(a, b); o.y = pk2(c, d); *(uint2*)(O + (size_t)row * ld + col) = o; } };
struct EpiResid { const float* xin; float* xout; const float* gate;
  __device__ __forceinline__ void operator()(int row, int col, const float* v) const {
    const int b = row >> 12; const float4 g = *(const float4*)(gate + (size_t)b * 6144 + col); const float4 xi = *(const float4*)(xin + (size_t)row * D + col);
    float4 o; o.x = xi.x + g.x * v[0]; o.y = xi.y + g.y * v[1]; o.z = xi.z + g.z * v[2]; o.w = xi.w + g.w * v[3];
    *(float4*)(xout + (size_t)row * D + col) = o; } };

template <class Epi>
__device__ __forceinline__ void gemm_naive(const bf16_t* A, int lda, const float* W, int N, int K, unsigned char* lds, const Epi& E) {
  asm volatile("" : "+s"(N), "+s"(K), "+s"(lda));
  float* As = (float*)lds;
  float* Bs = As + 16 * 132;
  const int tid = tid_(), tx = tid & 31, ty = tid >> 5;
  const int nN = (N + 127) / 128, nM = T / 128;
  const int ar = tid >> 2, ak = (tid & 3) * 4, bk = tid >> 5, bc = (tid & 31) * 4;
  for (int u = bid_(); u < nM * nN; u += gdim_()) {
    const int pm = u / nN, pn = u % nN;
    float acc[8][4];
#pragma unroll
    for (int i = 0; i < 8; ++i) { acc[i][0] = 0.f; acc[i][1] = 0.f; acc[i][2] = 0.f; acc[i][3] = 0.f; }
    const bf16_t* Ap = A + (size_t)(pm * 128 + ar) * lda + ak;
    const int wcol = pn * 128 + bc; const bool bok = wcol < N;
    const float* Wp = W + (size_t)bk * N + (bok ? wcol : 0);
    for (int k0 = 0; k0 < K; k0 += 16) {
      const uint2 av = *(const uint2*)(Ap + k0);
      float4 bv = *(const float4*)(Wp + (size_t)k0 * N);
      if (!bok) bv = make_float4(0.f, 0.f, 0.f, 0.f);
      __syncthreads();
      As[(ak + 0) * 132 + ar] = bf2f(av.x & 0xffffu); As[(ak + 1) * 132 + ar] = bf2f(av.x >> 16);
      As[(ak + 2) * 132 + ar] = bf2f(av.y & 0xffffu); As[(ak + 3) * 132 + ar] = bf2f(av.y >> 16);
      *(float4*)(Bs + bk * 128 + bc) = bv;
      __syncthreads();
#pragma unroll
      for (int k = 0; k < 16; ++k) {
        const float4 a0 = *(const float4*)(As + k * 132 + ty * 8), a1 = *(const float4*)(As + k * 132 + ty * 8 + 4);
        const float4 b = *(const float4*)(Bs + k * 128 + tx * 4);
        const float a[8] = {a0.x, a0.y, a0.z, a0.w, a1.x, a1.y, a1.z, a1.w};
#pragma unroll
        for (int i = 0; i < 8; ++i) { acc[i][0] += a[i] * b.x; acc[i][1] += a[i] * b.y; acc[i][2] += a[i] * b.z; acc[i][3] += a[i] * b.w; }
      }
    }
    const int col = pn * 128 + tx * 4;
    if (col < N) {
#pragma unroll
      for (int i = 0; i < 8; ++i) E(pm * 128 + ty * 8 + i, col, acc[i]);
    }
  }
}

__device__ __forceinline__ void head_norm_rope(const float* v, const float* gain, const float* cs  , int sub, float* vn, float* vr) {
  float ss = 0.f;
#pragma unroll
  for (int i = 0; i < 8; ++i) ss += v[i] * v[i];
  ss += __shfl_xor(ss, 1); ss += __shfl_xor(ss, 2); ss += __shfl_xor(ss, 4);
  const float rstd = 1.0f / sqrtf(ss * (1.0f / 64.0f) + EPS);
#pragma unroll
  for (int i = 0; i < 8; ++i) vn[i] = v[i] * rstd * gain[sub * 8 + i];
#pragma unroll
  for (int i = 0; i < 8; ++i) {
    const float other = __shfl_xor(vn[i], 1);
    const float c = cs[i], s = cs[8 + i];
    float r = vn[i];
    if (sub == 0) r = vn[i] * c - other * s;
    else if (sub == 1) r = vn[i] * c + other * s;
    vr[i] = r;
  }
}

__device__ __forceinline__ void ph_post_diff(int j, bf16_t* PROJ) {
  const int tid = tid_(), lane = tid & 63, wave = tid >> 6, sub = lane & 7;
  const float* rope = (const float*)(P(ws) + WS_ROPE);
  for (int m = bid_() * 8 + wave; m < T; m += gdim_() * 8) {
    const float* cs = rope + (size_t)m * 16;
#pragma unroll
    for (int it = 0; it < 4; ++it) {
      bf16_t* ptr = PROJ + (size_t)m * DIFF_IN + it * 512 + lane * 8;
      float v[8], vn[8], vr[8]; unpack8(*(const uint4*)ptr, v);
      const float* gain = (it < 2) ? (P(diff_q_gain) + j * 64) : (P(diff_k_gain) + j * 64);
      head_norm_rope(v, gain, cs, sub, vn, vr);
      const float sc = (it < 2) ? C2 : 1.0f;
#pragma unroll
      for (int i = 0; i < 8; ++i) vr[i] *= sc;
      *(uint4*)ptr = pack8(vr);
    }
  }
}
__device__ __forceinline__ void ph_post_nsa(int j, bf16_t* PROJ, bf16_t* QC) {
  const int tid = tid_(), lane = tid & 63, wave = tid >> 6, sub = lane & 7;
  const float* rope = (const float*)(P(ws) + WS_ROPE);
  for (int m = bid_() * 8 + wave; m < T; m += gdim_() * 8) {
    const float* cs = rope + (size_t)m * 16;
#pragma unroll
    for (int it = 0; it < 2; ++it) {
      bf16_t* ptr = PROJ + (size_t)m * NSA_P + it * 512 + lane * 8;
      float v[8], vn[8], vr[8]; unpack8(*(const uint4*)ptr, v);
      head_norm_rope(v, P(nsa_q_gain) + j * 64, cs, sub, vn, vr);
#pragma unroll
      for (int i = 0; i < 8; ++i) { vr[i] *= C2; vn[i] *= C2; }
      *(uint4*)ptr = pack8(vr);
      *(uint4*)(QC + (size_t)m * D + it * 512 + lane * 8) = pack8(vn);
    }
    {
      const int hi = lane >> 5;
      bf16_t* ptr = PROJ + (size_t)m * NSA_P + (hi ? 2048 : 1536) + (lane & 31) * 8;
      float v[8], vn[8], vr[8]; unpack8(*(const uint4*)ptr, v);
      head_norm_rope(v, P(nsa_k_gain) + j * 192 + (hi ? 128 : 64), cs, sub, vn, vr);
      *(uint4*)ptr = pack8(vr);
    }
  }
}

template <int DV, int MODE>
__device__ __forceinline__ void attn_naive_unit(int b, int qc, const bf16_t* Qp, int ldq, const bf16_t* Kp, const bf16_t* Vp, int ldkv, bf16_t* Op, int ldo, const u64* selmask, unsigned char* lds) {
  constexpr int DVS = DV / 8;
  float* Ks = (float*)lds;
  float* Vs = Ks + 64 * 64;
  const int tid = tid_(), qi = tid & 63, sl = tid >> 6;
  const int qabs = qc * 64 + qi;
  const size_t rowq = (size_t)b * S + qabs;
  float q[64];
#pragma unroll
  for (int i = 0; i < 8; ++i) unpack8(*(const uint4*)(Qp + rowq * ldq + i * 8), q + i * 8);
  float m = -INFINITY, l = 0.f, o[DVS];
#pragma unroll
  for (int i = 0; i < DVS; ++i) o[i] = 0.f;
  u64 msk = 0ull; if (MODE == 1) msk = selmask[qabs];
  const int t_lo = (MODE == 2) ? (qc > 8 ? qc - 8 : 0) : 0;
  for (int tt = t_lo; tt <= qc; ++tt) {
    __syncthreads();
    { const int key = tid >> 3, ch = tid & 7; float f[8];
      unpack8(*(const uint4*)(Kp + ((size_t)b * S + tt * 64 + key) * ldkv + ch * 8), f);
#pragma unroll
      for (int i = 0; i < 8; ++i) Ks[key * 64 + ch * 8 + i] = f[i];
#pragma unroll
      for (int r = 0; r < DV / 64; ++r) {
        unpack8(*(const uint4*)(Vp + ((size_t)b * S + tt * 64 + key) * ldkv + r * 64 + ch * 8), f);
#pragma unroll
        for (int i = 0; i < 8; ++i) Vs[key * DV + r * 64 + ch * 8 + i] = f[i];
      } }
    __syncthreads();
    const bool tile_on = (MODE == 1) ? (((msk >> tt) & 1ull) != 0ull) : true;
    if (tile_on) {
      for (int jk = 0; jk < 64; ++jk) {
        const int key = tt * 64 + jk;
        bool valid = key <= qabs; if (MODE == 2) valid = valid && (key > qabs - 512);
        if (valid) {
          float s = 0.f;
#pragma unroll
          for (int d = 0; d < 64; d += 4) { const float4 kk = *(const float4*)(Ks + jk * 64 + d); s += q[d] * kk.x + q[d + 1] * kk.y + q[d + 2] * kk.z + q[d + 3] * kk.w; }
          const float mn = fmaxf(m, s); const float sc = exp2f(m - mn), pp = exp2f(s - mn);
          l = l * sc + pp;
#pragma unroll
          for (int i = 0; i < DVS; ++i) o[i] = o[i] * sc + pp * Vs[jk * DV + sl * DVS + i];
          m = mn;
        }
      }
    }
  }
  const float inv = l > 0.f ? 1.0f / l : 0.f;
  bf16_t* op = Op + rowq * ldo + sl * DVS;
  if (DVS == 8) { float r[8];
#pragma unroll
    for (int i = 0; i < 8; ++i) r[i] = o[i] * inv;
    *(uint4*)op = pack8(r);
  } else {
#pragma unroll
    for (int h2 = 0; h2 < DVS / 8; ++h2) { float r[8];
#pragma unroll
      for (int i = 0; i < 8; ++i) r[i] = o[h2 * 8 + i] * inv;
      *(uint4*)(op + h2 * 8) = pack8(r); }
  }
}

__device__ __forceinline__ void ph_attn_diff(unsigned char* lds) {
  const bf16_t* PROJ = (const bf16_t*)(P(ws) + WS_PROJ); bf16_t* ATT = (bf16_t*)(P(ws) + WS_ATT);
  const int NU = NB * 64 * 16;
  for (int u = bid_(); u < NU; u += gdim_()) {
    const int vh = u & 15, qc = 63 - ((u >> 4) & 63), b = u >> 10;
    const int h8 = vh >> 1, c = vh & 1;
    attn_naive_unit<128, 0>(b, qc, PROJ + vh * 64, DIFF_IN, PROJ + 1024 + vh * 64, PROJ + 2048 + h8 * 128, DIFF_IN, ATT + c * 1024 + h8 * 128, 2048, nullptr, lds);
  }
}
__device__ __forceinline__ void ph_attn_sel(unsigned char* lds) {
  const bf16_t* PROJ = (const bf16_t*)(P(ws) + WS_PROJ); bf16_t* OSEL = (bf16_t*)(P(ws) + WS_ATT + 32 * MiB);
  const u64* SEL = (const u64*)(P(ws) + WS_SEL);
  const int NU = NB * 64 * 16;
  for (int u = bid_(); u < NU; u += gdim_()) {
    const int hd = u & 15, qc = 63 - ((u >> 4) & 63), b = u >> 10, g = hd >> 2;
    attn_naive_unit<64, 1>(b, qc, PROJ + hd * 64, NSA_P, PROJ + 1536 + g * 64, PROJ + 1792 + g * 64, NSA_P, OSEL + hd * 64, D, SEL + (size_t)(b * 4 + g) * S, lds);
  }
}
__device__ __forceinline__ void ph_attn_win(unsigned char* lds) {
  const bf16_t* PROJ = (const bf16_t*)(P(ws) + WS_PROJ); bf16_t* OWIN = (bf16_t*)(P(ws) + WS_ATT + 64 * MiB);
  const int NU = NB * 64 * 16;
  for (int u = bid_(); u < NU; u += gdim_()) {
    const int hd = u & 15, qc = (u >> 4) & 63, b = u >> 10, g = hd >> 2;
    attn_naive_unit<64, 2>(b, qc, PROJ + hd * 64, NSA_P, PROJ + 2048 + g * 64, PROJ + 2304 + g * 64, NSA_P, OWIN + hd * 64, D, nullptr, lds);
  }
}

__device__ __forceinline__ void ph_compress(int j, unsigned char* lds) {
  typedef short bf16x8_t __attribute__((ext_vector_type(8))); typedef float f32x16_t __attribute__((ext_vector_type(16)));
  const bf16_t* PROJ = (const bf16_t*)(P(ws) + WS_PROJ);
  unsigned char* Xb = lds;
  float* part = (float*)(lds + 67584);
  float* hid = part + 2 * 32 * 128;
  const int tid = tid_(), lane = tid & 63, wave = tid >> 6, r = lane & 31, h = lane >> 5, nb = wave & 3, kh = wave >> 2;
  for (int it = bid_(); it < 256; it += gdim_()) {
    const int rt = it & 7, kv = (it >> 3) & 1, bg = it >> 4, b = bg >> 2, g = bg & 3;
    const bf16_t* W1T = (const bf16_t*)(P(ws) + WS_W1T) + (size_t)(j * 2 + kv) * 128 * 2048;
    const float* w2 = (kv ? P(nsa_w_cv2) : P(nsa_w_ck2)) + (size_t)j * 128 * 64;
    const int colbase = (kv ? 1280 : 1024) + g * 64;
    __syncthreads();
    for (int i = tid; i < 528 * 8; i += NTHR) { const int tk = i >> 3, ch = i & 7, tok = 512 * rt + tk;
      uint4 v = make_uint4(0u, 0u, 0u, 0u); if (tok < S) v = *(const uint4*)(PROJ + ((size_t)b * S + tok) * NSA_P + colbase + ch * 8);
      *(uint4*)(Xb + tk * 128 + ((ch ^ ((tk >> 4) & 7)) * 16)) = v; }
    __syncthreads();
    f32x16_t acc;
#pragma unroll
    for (int q = 0; q < 16; ++q) acc[q] = 0.f;
    const bf16_t* wrow = W1T + (size_t)(nb * 32 + r) * 2048 + 8 * h;
#pragma unroll 2
    for (int l = 16 * kh; l < 16 * kh + 16; ++l) {
      const int tk = 16 * r + l; const unsigned char* xr = Xb + tk * 128; const int sw = (tk >> 4) & 7;
#pragma unroll
      for (int dq = 0; dq < 4; ++dq) {
        const bf16x8_t av = *(const bf16x8_t*)(xr + (((2 * dq + h) ^ sw) * 16));
        const bf16x8_t bv = *(const bf16x8_t*)(wrow + l * 64 + 16 * dq);
        acc = __builtin_amdgcn_mfma_f32_32x32x16_bf16(av, bv, acc, 0, 0, 0);
      }
    }
#pragma unroll
    for (int q = 0; q < 16; ++q) part[(kh * 32 + ((q & 3) + 8 * (q >> 2) + 4 * h)) * 128 + nb * 32 + r] = acc[q];
    __syncthreads();
    const float* CB = (const float*)(P(ws) + WS_SMALL) + 64 + (j * 2 + kv) * 128;
    for (int i = tid; i < 32 * 128; i += NTHR) { const float hs = part[i] + part[4096 + i] + CB[i & 127]; hid[i] = hs / (1.f + expf(-hs)); }
    __syncthreads();
    { const int e = tid & 63, rq = tid >> 6; float o0 = 0.f, o1 = 0.f, o2 = 0.f, o3 = 0.f;
      for (int hh = 0; hh < 128; ++hh) { const float wv = w2[hh * 64 + e];
        o0 += hid[(rq * 4 + 0) * 128 + hh] * wv; o1 += hid[(rq * 4 + 1) * 128 + hh] * wv; o2 += hid[(rq * 4 + 2) * 128 + hh] * wv; o3 += hid[(rq * 4 + 3) * 128 + hh] * wv; }
      float ov[4] = {o0, o1, o2, o3};
      bf16_t* KC = (bf16_t*)(P(ws) + WS_KCMP);
      bf16_t* VT = (bf16_t*)(P(ws) + WS_VCMP);
#pragma unroll
      for (int rr = 0; rr < 4; ++rr) { const int c = 32 * rt + rq * 4 + rr; float v = ov[rr];
        if (kv == 0) { const float ss = wave_sum(v * v); v = v * (1.0f / sqrtf(ss * (1.0f / 64.0f) + EPS)) * P(nsa_k_gain)[j * 192 + e]; }
        if (c >= 255) v = 0.f;
        if (kv == 0) KC[((size_t)bg * 256 + c) * 64 + e] = (bf16_t)f2bf(v); else VT[((size_t)bg * 64 + e) * 256 + c] = (bf16_t)f2bf(v); }
    }
  }
}

__device__ __forceinline__ void ph_cmp_attn(unsigned char* lds) {
  typedef short bf16x8_t __attribute__((ext_vector_type(8))); typedef float f32x16_t __attribute__((ext_vector_type(16)));
  unsigned char* Kimg = lds;
  unsigned char* VTl = lds + 32768;
  float* IMP = (float*)(lds + 32768 + 33280);
  const bf16_t* QC = (const bf16_t*)(P(ws) + WS_OC);
  const bf16_t* KC = (const bf16_t*)(P(ws) + WS_KCMP); const bf16_t* VT = (const bf16_t*)(P(ws) + WS_VCMP);
  bf16_t* OCMP = (bf16_t*)(P(ws) + WS_ATT);
  u64* SEL = (u64*)(P(ws) + WS_SEL);
  const int tid = tid_(), lane = tid & 63, wave = tid >> 6, r32 = lane & 31, hi = lane >> 5, hh = r32 >> 3, q8 = r32 & 7;
  const int G = gdim_(), bx = bid_(); const int v0 = (G % 8 == 0) ? (bx % 8) * (G / 8) + bx / 8 : bx;
  for (int vcu = v0; vcu < 256; vcu += G) {
    const int bg = vcu >> 4, b = bg >> 2, g = bg & 3;
    __syncthreads();
    for (int i = tid; i < 2048; i += NTHR) { const int c = i >> 3, ch = i & 7; *(uint4*)(Kimg + ch * 4096 + c * 16) = *(const uint4*)(KC + ((size_t)bg * 256 + c) * 64 + ch * 8); }
    for (int i = tid; i < 4096; i += NTHR) { const int d = i >> 6, c8 = i & 63; *(uint2*)(VTl + d * 520 + c8 * 8) = *(const uint2*)(VT + ((size_t)bg * 64 + d) * 256 + c8 * 4); }
    __syncthreads();
    float* imw = IMP + wave * 8 * 65;
    bf16_t* stg = (bf16_t*)(lds + 83968) + wave * 2048;
#pragma unroll 1
    for (int ui = 0; ui < 4; ++ui) {
      const int qc = (vcu & 15) + 16 * ui, t0 = qc * 64, tq0 = t0 + 8 * wave;
      const int t = tq0 + q8;
      for (int i = lane; i < 8 * 65; i += 64) imw[i] = 0.f;
      bf16x8_t qr[4];
      { const bf16_t* qp = QC + ((size_t)b * S + t) * D + (g * 4 + hh) * 64 + hi * 8;
#pragma unroll
        for (int d0 = 0; d0 < 4; ++d0) qr[d0] = *(const bf16x8_t*)(qp + d0 * 16); }
      const int nc = (tq0 + 7 >= 31) ? (((tq0 + 7 - 31) >> 4) + 1) : 0; const int nct = (nc + 31) >> 5;
      int climit = (t - 31) >> 4; if (climit > 254) climit = 254;
      const int cfull = (tq0 - 31) >> 4;
#define CMP_TILE(PACC, ct) do { \
        _Pragma("unroll") for (int q = 0; q < 16; ++q) PACC[q] = 0.f; \
        _Pragma("unroll") for (int d0 = 0; d0 < 4; ++d0) { const bf16x8_t kf = *(const bf16x8_t*)(Kimg + (2 * d0 + hi) * 4096 + (32 * (ct) + r32) * 16); PACC = __builtin_amdgcn_mfma_f32_32x32x16_bf16(kf, qr[d0], PACC, 0, 0, 0); } \
        if (32 * (ct) + 31 > cfull) { const int rel = climit - 32 * (ct) - 4 * hi; \
          _Pragma("unroll") for (int q = 0; q < 16; ++q) PACC[q] = (((q & 3) + 8 * (q >> 2)) <= rel) ? PACC[q] : -INFINITY; } } while (0)
      float mx = -INFINITY, sum = 0.f;
#pragma unroll 1
      for (int ct = 0; ct < nct; ++ct) { f32x16_t pacc; CMP_TILE(pacc, ct);
        float tm = pacc[0];
#pragma unroll
        for (int q = 1; q < 16; ++q) tm = fmaxf(tm, pacc[q]);
        const float mn = fmaxf(mx, tm), mns = (mn == -INFINITY) ? 0.f : mn;
        float ts = 0.f;
#pragma unroll
        for (int q = 0; q < 16; ++q) ts += __builtin_amdgcn_exp2f(pacc[q] - mns);
        sum = sum * __builtin_amdgcn_exp2f(mx - mns) + ts; mx = mn; }
      { const float mo = __shfl_xor(mx, 32), so = __shfl_xor(sum, 32); const float M = fmaxf(mx, mo), Ms = (M == -INFINITY) ? 0.f : M;
        sum = sum * __builtin_amdgcn_exp2f(mx - Ms) + so * __builtin_amdgcn_exp2f(mo - Ms); mx = Ms; }
      const float ms = mx;
      const float inv = sum > 0.f ? 1.0f / sum : 0.f;
      f32x16_t o0, o1;
#pragma unroll
      for (int q = 0; q < 16; ++q) { o0[q] = 0.f; o1[q] = 0.f; }
      float carry = 0.f;
#pragma unroll 1
      for (int ct = 0; ct < nct; ++ct) {
        f32x16_t pr; CMP_TILE(pr, ct);
#pragma unroll
        for (int q = 0; q < 16; ++q) pr[q] = __builtin_amdgcn_exp2f(pr[q] - ms) * inv;
        float qs[4], recv[4];
#pragma unroll
        for (int g4 = 0; g4 < 4; ++g4) { float a = (pr[4 * g4] + pr[4 * g4 + 1]) + (pr[4 * g4 + 2] + pr[4 * g4 + 3]), l3 = pr[4 * g4 + 3];
          a += __shfl_xor(a, 8); l3 += __shfl_xor(l3, 8); a += __shfl_xor(a, 16); l3 += __shfl_xor(l3, 16);
          qs[g4] = a; recv[g4] = __shfl_xor(l3, 32); }
        if (hh == 0) {
#pragma unroll
          for (int g4 = 0; g4 < 4; ++g4) { const float nb = hi ? recv[g4] : (g4 ? recv[g4 - 1] : carry); imw[q8 * 65 + 8 * ct + 2 * g4 + hi] = qs[g4] + nb; } }
        carry = recv[3];
#pragma unroll
        for (int s2 = 0; s2 < 2; ++s2) {
          uint4 pw; pw.x = pg8::cvt_pk_bf16(pr[8 * s2 + 0], pr[8 * s2 + 1]); pw.y = pg8::cvt_pk_bf16(pr[8 * s2 + 2], pr[8 * s2 + 3]);
          pw.z = pg8::cvt_pk_bf16(pr[8 * s2 + 4], pr[8 * s2 + 5]); pw.w = pg8::cvt_pk_bf16(pr[8 * s2 + 6], pr[8 * s2 + 7]);
          const bf16x8_t pa = __builtin_bit_cast(bf16x8_t, pw);
          const int cb = (32 * ct + 16 * s2 + 4 * hi) * 2;
          { const uint2 lo = *(const uint2*)(VTl + r32 * 520 + cb), hi2 = *(const uint2*)(VTl + r32 * 520 + cb + 16);
            uint4 vv; vv.x = lo.x; vv.y = lo.y; vv.z = hi2.x; vv.w = hi2.y; o0 = __builtin_amdgcn_mfma_f32_32x32x16_bf16(pa, __builtin_bit_cast(bf16x8_t, vv), o0, 0, 0, 0); }
          { const uint2 lo = *(const uint2*)(VTl + (32 + r32) * 520 + cb), hi2 = *(const uint2*)(VTl + (32 + r32) * 520 + cb + 16);
            uint4 vv; vv.x = lo.x; vv.y = lo.y; vv.z = hi2.x; vv.w = hi2.y; o1 = __builtin_amdgcn_mfma_f32_32x32x16_bf16(pa, __builtin_bit_cast(bf16x8_t, vv), o1, 0, 0, 0); }
        }
      }
#undef CMP_TILE
      if (hh == 0 && hi == 0 && nct > 0 && nct < 8) imw[q8 * 65 + 8 * nct] = carry;
      {
#pragma unroll
        for (int q = 0; q < 16; ++q) { const int row = (q & 3) + 8 * (q >> 2) + 4 * hi; stg[row * 64 + r32] = (bf16_t)f2bf(o0[q]); stg[row * 64 + 32 + r32] = (bf16_t)f2bf(o1[q]); }
        asm volatile("s_waitcnt lgkmcnt(0)" ::: "memory");
#pragma unroll
        for (int i = 0; i < 4; ++i) { const int row = i * 8 + (lane >> 3), ch = lane & 7;
          *(uint4*)(OCMP + ((size_t)b * S + tq0 + (row & 7)) * D + (g * 4 + (row >> 3)) * 64 + ch * 8) = *(const uint4*)(stg + row * 64 + ch * 8); }
      }
      asm volatile("s_waitcnt lgkmcnt(0)" ::: "memory");
#pragma unroll 1
      for (int k8 = 0; k8 < 8; ++k8) {
        const int tq = tq0 + k8, bt = tq >> 6, sb = lane;
        const float v = imw[k8 * 65 + sb];
        const bool forced = (sb == 0) || (sb == bt) || (sb == bt - 1), valid = sb <= bt;
        const float vv = forced ? (1e6f + (float)(64 - sb)) : (valid ? v : (-1.0f - (float)sb));
        const unsigned bits = __float_as_uint(vv); const unsigned key = (bits & 0x80000000u) ? ~bits : (bits | 0x80000000u);
        unsigned prefix = 0u;
#pragma unroll 1
        for (int bit = 31; bit >= 0; --bit) { const unsigned cand = prefix | (1u << bit); const int cnt = __popcll(__ballot(key >= cand)); if (cnt >= 16) prefix = cand; }
        const u64 gt = __ballot(key > prefix); u64 eq = __ballot(key == prefix);
        int need = 16 - __popcll(gt); u64 m = gt;
        while (need > 0 && eq != 0ull) { const u64 low = eq & (0ull - eq); m |= low; eq ^= low; --need; }
        if (lane == 0) SEL[(size_t)bg * S + tq] = m;
      }
      asm volatile("s_waitcnt lgkmcnt(0)" ::: "memory");
    }
  }
}

__device__ __forceinline__ void ph_combine_nsa(int j) {
  const bf16_t* PROJ = (const bf16_t*)(P(ws) + WS_PROJ);
  const bf16_t* OCMP = (const bf16_t*)(P(ws) + WS_ATT); const bf16_t* OSEL = OCMP + (size_t)T * D; const bf16_t* OWIN = OSEL + (size_t)T * D;
  bf16_t* OC = (bf16_t*)(P(ws) + WS_OC);
  for (size_t i = (size_t)bid_() * NTHR + tid_(); i < (size_t)T * 128; i += (size_t)gdim_() * NTHR) {
    const size_t m = i >> 7; const int cg8 = (int)(i & 127), hd = cg8 >> 3;
    float gt[3];
#pragma unroll
    for (int r = 0; r < 3; ++r) { const float gl = bf2f(PROJ[m * NSA_P + 2560 + hd * 3 + r]) + P(nsa_b_gate)[j * 48 + hd * 3 + r]; gt[r] = 1.0f / (1.0f + expf(-gl)); }
    float a[8], bb[8], cc[8], o[8];
    unpack8(*(const uint4*)(OCMP + m * D + cg8 * 8), a); unpack8(*(const uint4*)(OSEL + m * D + cg8 * 8), bb); unpack8(*(const uint4*)(OWIN + m * D + cg8 * 8), cc);
#pragma unroll
    for (int k = 0; k < 8; ++k) o[k] = gt[0] * a[k] + gt[1] * bb[k] + gt[2] * cc[k];
    *(uint4*)(OC + m * D + cg8 * 8) = pack8(o);
  }
}
__device__ __forceinline__ void ph_combine_diff(int j) {
  const bf16_t* ATT = (const bf16_t*)(P(ws) + WS_ATT); bf16_t* OC = (bf16_t*)(P(ws) + WS_OC);
  const float lam = ((const float*)(P(ws) + WS_SMALL))[j]; const float osc = 1.0f - lam_init_of(j);
  const int tid = tid_(), lane = tid & 63, wave = tid >> 6;
  for (int m = bid_() * 8 + wave; m < T; m += gdim_() * 8) {
#pragma unroll
    for (int it = 0; it < 2; ++it) {
      const int col = it * 512 + lane * 8;
      float a[8], b2[8], o[8]; unpack8(*(const uint4*)(ATT + (size_t)m * 2048 + col), a); unpack8(*(const uint4*)(ATT + (size_t)m * 2048 + 1024 + col), b2);
      float ss = 0.f;
#pragma unroll
      for (int k = 0; k < 8; ++k) { o[k] = a[k] - lam * b2[k]; ss += o[k] * o[k]; }
      ss += __shfl_xor(ss, 1); ss += __shfl_xor(ss, 2); ss += __shfl_xor(ss, 4); ss += __shfl_xor(ss, 8);
      const float rstd = 1.0f / sqrtf(ss * (1.0f / 128.0f) + EPS);
#pragma unroll
      for (int k = 0; k < 8; ++k) o[k] = o[k] * rstd * P(diff_subln_g)[j * 128 + (col & 127) + k] * osc;
      *(uint4*)(OC + (size_t)m * D + col) = pack8(o);
    }
  }
}

constexpr int N_PHASES = 1 + 4 * 10;
template <int PH> __device__ __forceinline__ bool phase_body(unsigned char* lds) {
  bool did = true;
  if constexpr (PH == 0) { ph_prologue(lds); __syncthreads(); ph_weights(lds); }
  else {
    constexpr int i = (PH - 1) / 10, lp = (PH - 1) % 10, j = i >> 1; constexpr bool nsa = (i & 1) == 0;
    float* MOD = (float*)(P(ws) + WS_MOD);
    bf16_t* H = (bf16_t*)(P(ws) + WS_H); bf16_t* PROJ = (bf16_t*)(P(ws) + WS_PROJ); bf16_t* OC = (bf16_t*)(P(ws) + WS_OC); bf16_t* HID = (bf16_t*)(P(ws) + WS_HID);
    const float* mod = MOD + (size_t)i * 4 * 6144;
    const float* xcur = (i == 0 && lp < 7) ? P(x) : P(out);
    if constexpr (lp == 0) ph_norm(xcur, P(ln_mix_g) + i * D, mod, 0, 1024, H);
    const bf16_t* WTL = (const bf16_t*)(P(ws) + WS_WT + (size_t)i * WT_LAYER);
    PG8_LAS unsigned char* l3 = (PG8_LAS unsigned char*)lds;
    if constexpr (lp == 1) {
      constexpr int N = nsa ? NSA_P : DIFF_IN;
      pg8::Gemm g{H, WTL, T, N, D}; pg8::StaticOrder S; S.init(T, N, gdim_(), bid_());
      pg8::EpiBf16<0> E{PROJ, N};
      pg8::gemm_phase<pg8::EpiBf16<0>, pg8::StaticOrder, true, true>(l3, g, S, E);
    }
    if constexpr (lp == 2) { if constexpr (nsa) { ph_post_nsa(j, PROJ, OC); ph_compress(j, lds); } else ph_post_diff(j, PROJ); }
    if constexpr (lp == 3) { if constexpr (nsa) { ph_cmp_attn(lds); if (REPEAT_SUB == 1) { __syncthreads(); ph_cmp_attn(lds); } __syncthreads(); ph_attn_win_fast(lds); if (REPEAT_SUB == 2) ph_attn_win_fast(lds); } else ph_attn_diff_fast(lds); }
    if constexpr (lp == 4) { if constexpr (nsa) ph_attn_sel_fast(j, lds); else did = false; }
    if constexpr (lp == 5) { if constexpr (nsa) did = false; else ph_combine_diff(j); }
    if constexpr (lp == 6) {
      pg8::Gemm g{OC, WTL + WT_OUT / 2, T, D, D}; pg8::StaticOrder S; S.init(T, D, gdim_(), bid_());
      pg8::EpiResid E{xcur, P(out), mod + 2048};
      pg8::gemm_phase<pg8::EpiResid, pg8::StaticOrder, true, true>(l3, g, S, E);
    }
    if constexpr (lp == 7) ph_norm(P(out), P(ln_mlp_g) + i * D, mod, 3072, 4096, H);
    if constexpr (lp == 8) {
      pg8::Gemm g{H, WTL + WT_MI / 2, T, DFF, D}; pg8::StaticOrder S; S.init(T, DFF, gdim_(), bid_());
      pg8::EpiBf16<2> E{HID, DFF};
      pg8::gemm_phase<pg8::EpiBf16<2>, pg8::StaticOrder, true, true>(l3, g, S, E);
    }
    if constexpr (lp == 9) {
      pg8::Gemm g{HID, WTL + WT_MO / 2, T, D, DFF}; pg8::StaticOrder S; S.init(T, D, gdim_(), bid_());
      pg8::EpiResid E{P(out), P(out), mod + 5120};
      pg8::gemm_phase<pg8::EpiResid, pg8::StaticOrder, true, true>(l3, g, S, E);
    }
  }
  return did;
}
template <int PH> __device__ __forceinline__ void run_phase(unsigned char* lds, int lo, int hi, const XcdBarrier& bar) {
  if (PH < lo || PH >= hi) return;
  const bool did = phase_body<PH>(lds);
  if constexpr (((REPEAT_MASK >> PH) & 1ull) != 0ull) { if (did) { if (PH == 0) cg::this_grid().sync(); else xcd_barrier(bar); phase_body<PH>(lds); } }
  if (did && PH + 1 < hi) { if (PH == 0) cg::this_grid().sync(); else xcd_barrier(bar); }
}
template <int... I> __device__ __forceinline__ void run_all(std::integer_sequence<int, I...>, unsigned char* lds, int lo, int hi, const XcdBarrier& bar) { (run_phase<I>(lds, lo, hi, bar), ...); }
__global__ void __launch_bounds__(NTHR) fwd_kernel(Params p) {
  extern __shared__ __attribute__((aligned(16))) unsigned char lds[];
  volatile __attribute__((address_space(3))) unsigned* misc = (volatile __attribute__((address_space(3))) unsigned*)((__attribute__((address_space(3))) unsigned char*)lds + MISC_OFF);
  if (tid_() < 16) misc[tid_()] = 0u;
  __syncthreads();
  const XcdBarrier bar = xcd_barrier_post((unsigned*)(P(ws) + WS_CTL) + CW_BAR, misc);
  run_all(std::make_integer_sequence<int, N_PHASES>{}, lds, p.ph_lo, p.ph_hi, bar);
}

extern "C" void kernel_launch(void* const* d_in, const int* in_sizes, int n_in, void* d_out, int out_size, void* d_ws, size_t ws_size, hipStream_t stream) {
  static int grid = 0;
  if (grid == 0) {
    if (n_in != 29 || out_size != T * D || ws_size < WS_END) { fprintf(stderr, "kernel_launch: unexpected problem (n_in %d, out %d, ws %zu)\n", n_in, out_size, ws_size); grid = -1; return; }
    int dev = 0, cus = 0, per_cu = 0;
    hipGetDevice(&dev); hipDeviceGetAttribute(&cus, hipDeviceAttributeMultiprocessorCount, dev);
    hipFuncSetAttribute((const void*)fwd_kernel, hipFuncAttributeMaxDynamicSharedMemorySize, LDS_BYTES);
    hipOccupancyMaxActiveBlocksPerMultiprocessor(&per_cu, (const void*)fwd_kernel, NTHR, LDS_BYTES);
    if (per_cu < 1) { fprintf(stderr, "kernel_launch: occupancy query says %d blocks/CU\n", per_cu); per_cu = 1; }
    grid = cus * 1;
    (void)hipGetLastError();
  }
  if (grid < 0) return;
  if (hipMemsetAsync((char*)d_ws + WS_CTL, 0, CTL_ZERO_BYTES, stream) != hipSuccess) { fprintf(stderr, "kernel_launch: memset failed\n"); return; }
  Params p{};
  memcpy((void*)&p, (const void*)d_in, 29 * sizeof(void*));
  p.out = (float*)d_out; p.ws = (unsigned char*)d_ws; p.ph_lo = 0; p.ph_hi = N_PHASES;
  void* args[] = {&p};
  hipError_t e = hipLaunchCooperativeKernel((const void*)fwd_kernel, dim3(grid), dim3(NTHR), args, LDS_BYTES, stream);
  if (e != hipSuccess) fprintf(stderr, "cooperative launch failed: %s (grid %d)\n", hipGetErrorString(e), grid);
}
```

```cpp
#include <hip/hip_runtime.h>
#include <hip/hip_cooperative_groups.h>
#include <hip/hip_bf16.h>
#include <cstdio>
#include <cstdint>
#include <cstring>
#include <utility>
namespace cg = cooperative_groups;

typedef unsigned short bf16_t;
typedef unsigned long long u64;

constexpr int D = 1024, NB = 4, S = 4096, T = NB * S, DFF = 4096;
constexpr int NSA_IN = 2608, NSA_P = 2816, DIFF_IN = 3072;
constexpr float EPS = 1e-6f;
constexpr float C2 = 0.125f * 1.4426950408889634f;
constexpr int NTHR = 512;
constexpr int LDS_BYTES = 147456;
constexpr unsigned long long REPEAT_MASK = 0ull;
constexpr int REPEAT_SUB = 0;

constexpr size_t MiB = 1u << 20;
constexpr size_t WS_CTL = 0, CTL_ZERO_BYTES = 1 * MiB;
constexpr int CW_BAR = 4096;
constexpr int MISC_OFF = LDS_BYTES - 64;
constexpr size_t WS_MOD = 1 * MiB;
constexpr size_t WS_ROPE = 2 * MiB;
constexpr size_t WS_SMALL = 3 * MiB;
constexpr size_t WS_WT = 4 * MiB;
constexpr size_t WT_LAYER = 24 * MiB, WT_OUT = 6 * MiB, WT_MI = 8 * MiB, WT_MO = 16 * MiB;
constexpr size_t WS_W1T = 100 * MiB;
constexpr size_t WS_H = 104 * MiB;
constexpr size_t WS_PROJ = 136 * MiB;
constexpr size_t WS_ATT = 232 * MiB;
constexpr size_t WS_OC = 328 * MiB;
constexpr size_t WS_KCMP = 360 * MiB;
constexpr size_t WS_VCMP = 361 * MiB;
constexpr size_t WS_SEL = 362 * MiB;
constexpr size_t WS_HID = 136 * MiB;
constexpr size_t WS_END = 364 * MiB;

struct Params {
  const float* x; const float* c; const int* pos; const float* ln_mix_g; const float* ln_mlp_g;
  const float* w_ada; const float* b_ada; const float* w_mlp_in; const float* w_mlp_out;
  const float* nsa_w_in; const float* nsa_b_gate; const float* nsa_q_gain; const float* nsa_k_gain;
  const float* nsa_pe_k; const float* nsa_w_ck1; const float* nsa_w_ck2; const float* nsa_pe_v; const float* nsa_w_cv1; const float* nsa_w_cv2; const float* nsa_w_out;
  const float* diff_w_in; const float* diff_q_gain; const float* diff_k_gain; const float* diff_lq1; const float* diff_lk1; const float* diff_lq2; const float* diff_lk2; const float* diff_subln_g; const float* diff_w_out;
  float* out; unsigned char* ws; int ph_lo, ph_hi;
};

typedef __attribute__((address_space(4))) const unsigned char* kptr_t;
template <class Tp> __device__ __forceinline__ Tp karg_load(unsigned off) {
  asm volatile("" : "+s"(off));
  kptr_t kp = (kptr_t)__builtin_amdgcn_kernarg_segment_ptr();
  return *(const __attribute__((address_space(4))) Tp*)(kp + off);
}
__device__ __forceinline__ int tid_() { int t = (int)threadIdx.x; asm volatile("" : "+v"(t)); return t; }
__device__ __forceinline__ int bid_() { int t = (int)blockIdx.x; asm volatile("" : "+s"(t)); return t; }
__device__ __forceinline__ int gdim_() { int t = (int)gridDim.x; asm volatile("" : "+s"(t)); return t; }
#define P(m) karg_load<decltype(Params::m)>((unsigned)offsetof(Params, m))
__device__ __forceinline__ float bf2f(unsigned v) { return __uint_as_float(v << 16); }
__device__ __forceinline__ unsigned f2bf(float f) { unsigned u = __float_as_uint(f); return (u + 0x7fffu + ((u >> 16) & 1u)) >> 16; }
__device__ __forceinline__ unsigned pk2(float lo, float hi) { return f2bf(lo) | (f2bf(hi) << 16); }
__device__ __forceinline__ void unpack8(const uint4 v, float* f) {
  f[0] = bf2f(v.x & 0xffffu); f[1] = bf2f(v.x >> 16); f[2] = bf2f(v.y & 0xffffu); f[3] = bf2f(v.y >> 16);
  f[4] = bf2f(v.z & 0xffffu); f[5] = bf2f(v.z >> 16); f[6] = bf2f(v.w & 0xffffu); f[7] = bf2f(v.w >> 16);
}
__device__ __forceinline__ uint4 pack8(const float* f) { uint4 v; v.x = pk2(f[0], f[1]); v.y = pk2(f[2], f[3]); v.z = pk2(f[4], f[5]); v.w = pk2(f[6], f[7]); return v; }
__device__ __forceinline__ float wave_sum(float v) {
#pragma unroll
  for (int o = 1; o < 64; o <<= 1) v += __shfl_xor(v, o);
  return v;
}
__device__ __forceinline__ float lam_init_of(int j) { return j == 0 ? 0.35550906759096934f : 0.5560582041556406f; }

namespace pg8 {
#define PG8_LAS __attribute__((address_space(3)))
typedef unsigned short bf16_t;
typedef short bf16x8 __attribute__((ext_vector_type(8)));
typedef float f32x4 __attribute__((ext_vector_type(4)));
typedef unsigned u32x4 __attribute__((ext_vector_type(4)));
constexpr int BM = 256, BK = 64, HALF = 128, HTB = HALF * BK * 2  , STAGE_BYTES = 8 * HTB, NXCD = 8, WGM = 8;

__host__ __device__ __forceinline__ int lds_byte(int r, int c) { const int st = (r >> 4) * 2 + (c >> 5), rr = r & 15, cc = c & 31, ob = rr * 64 + cc * 2; return st * 1024 + (ob ^ (((ob >> 9) & 1) << 5)); }
__host__ __device__ __forceinline__ void stage_rc(int b, int& R, int& C) { const int st = b / 1024, sb = b % 1024, swz = sb ^ (((sb >> 9) & 1) << 5); R = (st >> 1) * 16 + swz / 64; C = (st & 1) * 32 + (swz % 64) / 2; }
__host__ __device__ __forceinline__ int perm32(int rho) { const int n = rho >> 4, i = rho & 15; return 8 * (i >> 2) + 4 * n + (i & 3); }

struct Unit { int pm, pn; };
struct Gemm { const bf16_t* A; const bf16_t* Bt; int M, N, K; };

struct StaticOrder {
    int nM, nN, nwg, G, c;
    __host__ __device__ void init(int M, int N, int G_, int c_) { nM = M / BM; nN = N / BM; nwg = nM * nN; G = G_; c = c_; }
    __host__ __device__ bool next(int i, Unit& u) const {
        const long L = (long)i * G + c; if (L >= nwg) return false;
        int wgid = (int)L; { const int q = nwg / NXCD, r = nwg % NXCD, xcd = wgid % NXCD, off = wgid / NXCD; wgid = (xcd < r ? xcd * (q + 1) : r * (q + 1) + (xcd - r) * q) + off; }
        const int nig = WGM * nN, gid = wgid / nig, fm = gid * WGM, gsz = (nM - fm) < WGM ? (nM - fm) : WGM;
        u.pm = fm + ((wgid % nig) % gsz); u.pn = (wgid % nig) / gsz; return true;
    }
    __device__ __forceinline__ void a_ready(const Unit&) const {}
    __device__ __forceinline__ void done(const Unit&) const {}
};


__device__ __forceinline__ unsigned cvt_pk_bf16(float lo, float hi) { unsigned r; asm volatile("v_cvt_pk_bf16_f32 %0, %1, %2" : "=v"(r) : "v"(lo), "v"(hi)); return r; }
template <int ACT  > struct EpiBf16 {
    static constexpr bool PERM = true, AFTER_DRAIN = false;
    bf16_t* O; int ldc;
    __device__ __forceinline__ void operator()(const f32x4 (&acc)[2][2][4][2], const Unit& u, int wr, int wc, int fr, int fq) const {
        const int row0 = u.pm * BM + wr * 64 + fr; const int col0 = u.pn * BM + wc * 32 + 8 * fq;
#pragma unroll
        for (int ai = 0; ai < 2; ++ai)
#pragma unroll
            for (int m = 0; m < 4; ++m) { bf16_t* rowp = O + (size_t)(row0 + ai * HALF + m * 16) * ldc + col0;
#pragma unroll
                for (int bj = 0; bj < 2; ++bj) { f32x4 v0 = acc[ai][bj][m][0], v1 = acc[ai][bj][m][1];
                    if (ACT == 2) {
#pragma unroll
                        for (int e = 0; e < 4; ++e) { float a = v0[e] > 0.f ? v0[e] : 0.f; v0[e] = a * a; float b = v1[e] > 0.f ? v1[e] : 0.f; v1[e] = b * b; } }
                    u32x4 w; w.x = cvt_pk_bf16(v0[0], v0[1]); w.y = cvt_pk_bf16(v0[2], v0[3]); w.z = cvt_pk_bf16(v1[0], v1[1]); w.w = cvt_pk_bf16(v1[2], v1[3]);
                    *(u32x4*)(rowp + bj * HALF) = w; } }
    }
};
struct EpiResid {
    static constexpr bool PERM = false, AFTER_DRAIN = false;
    const float* xin; float* xout; const float* gate;
    __device__ __forceinline__ void operator()(const f32x4 (&acc)[2][2][4][2], const Unit& u, int wr, int wc, int fr, int fq) const {
        const int col0 = u.pn * BM + wc * 32 + 4 * fq; const int b = (u.pm * BM) >> 12;
        f32x4 gv[2][2];
#pragma unroll
        for (int bj = 0; bj < 2; ++bj)
#pragma unroll
            for (int n = 0; n < 2; ++n) gv[bj][n] = *(const f32x4*)(gate + (size_t)b * 6144 + col0 + bj * HALF + n * 16);
#pragma unroll
        for (int ai = 0; ai < 2; ++ai)
#pragma unroll
            for (int m = 0; m < 4; ++m) { const size_t off = (size_t)(u.pm * BM + ai * HALF + wr * 64 + m * 16 + fr) * 1024 + col0;
#pragma unroll
                for (int bj = 0; bj < 2; ++bj)
#pragma unroll
                    for (int n = 0; n < 2; ++n) { const f32x4 xi = *(const f32x4*)(xin + off + bj * HALF + n * 16); *(f32x4*)(xout + off + bj * HALF + n * 16) = xi + gv[bj][n] * acc[ai][bj][m][n]; }
                if (m & 1) asm volatile("" ::: "memory"); }
    }
};

template <class Epi, class Sched, bool ALIGN_EPI = false, bool SP2 = false>
__device__ __forceinline__ void gemm_phase(PG8_LAS unsigned char* lds, const Gemm g, const Sched& S, const Epi& E) {
    const int tid = tid_(), wid = __builtin_amdgcn_readfirstlane(tid >> 6), lane = tid & 63, wr = wid >> 2, wc = wid & 3, fr = lane & 15, fq = lane >> 4;
    const int K = g.K, nt = K / BK;
    unsigned voffA[2], voffB[2];
#pragma unroll
    for (int i = 0; i < 2; ++i) { int R, C; stage_rc(tid * 16 + i * 8192, R, C); const int Rb = Epi::PERM ? ((R & ~31) + perm32(R & 31)) : R;
        voffA[i] = (unsigned)(R * K + C) * 2u; voffB[i] = (unsigned)(Rb * K + C) * 2u; }
    const size_t kstep = (size_t)(BK * 2);
    const size_t hstep = (size_t)HALF * K * 2;
    const size_t tstep = 2 * hstep;
    const unsigned ldsw = (unsigned)wid * 1024u;
    const int aoff = lds_byte(wr * 64 + fr, fq * 8), boff = lds_byte(wc * 32 + fr, fq * 8);
#define PG8_SA(b, h) (((b) * 2 + (h)) * HTB)
#define PG8_SB(b, h) ((4 + (b) * 2 + (h)) * HTB)
#define PG8_STAGE(bufoff, gbase, voff) do { _Pragma("unroll") for (int _i = 0; _i < 2; ++_i) \
        __builtin_amdgcn_global_load_lds((const unsigned*)((const char*)(gbase) + (voff)[_i]), (PG8_LAS unsigned*)(lds + (bufoff) + ldsw + _i * 8192), 16, 0, 0); } while (0)
#define PG8_LDA(dst, b, h) do { _Pragma("unroll") for (int m = 0; m < 4; ++m) _Pragma("unroll") for (int k = 0; k < 2; ++k) dst[m][k] = *(const PG8_LAS bf16x8*)(lds + PG8_SA(b, h) + aoff + m * 2048 + k * 1024); } while (0)
#define PG8_LDB(dst, b, h) do { _Pragma("unroll") for (int n = 0; n < 2; ++n) _Pragma("unroll") for (int k = 0; k < 2; ++k) dst[n][k] = *(const PG8_LAS bf16x8*)(lds + PG8_SB(b, h) + boff + n * 2048 + k * 1024); } while (0)
#define PG8_MMA(ai, bj, At, Bt) do { __builtin_amdgcn_s_setprio(1); _Pragma("unroll") for (int m = 0; m < 4; ++m) _Pragma("unroll") for (int n = 0; n < 2; ++n) _Pragma("unroll") for (int k = 0; k < 2; ++k) \
        acc[ai][bj][m][n] = __builtin_amdgcn_mfma_f32_16x16x32_bf16(Bt[n][k], At[m][k], acc[ai][bj][m][n], 0, 0, 0); __builtin_amdgcn_s_setprio(0); } while (0)
#define PG8_WAIT_V(n) asm volatile("s_waitcnt vmcnt(" #n ")" ::: "memory")
#define PG8_WAIT_L(n) asm volatile("s_waitcnt lgkmcnt(" #n ")" ::: "memory")
#define PG8_BAR __builtin_amdgcn_s_barrier()
#define PG8_SCHED __builtin_amdgcn_sched_barrier(0)
    Unit cur, nxt; int ui = 0;
    if (!S.next(0, cur)) return;
    f32x4 acc[2][2][4][2];
#pragma unroll
    for (int a = 0; a < 2; ++a)
#pragma unroll
        for (int b = 0; b < 2; ++b)
#pragma unroll
            for (int m = 0; m < 4; ++m)
#pragma unroll
                for (int n = 0; n < 2; ++n) acc[a][b][m][n] = (f32x4){0.f, 0.f, 0.f, 0.f};
    bf16x8 At[4][2], B0[2][2], B1[2][2];
    const char* cA = (const char*)g.A + (size_t)cur.pm * tstep; const char* cB = (const char*)g.Bt + (size_t)cur.pn * tstep;
    S.a_ready(cur);
    if constexpr (SP2) {
        PG8_STAGE(PG8_SB(0, 0), cB, voffB); PG8_STAGE(PG8_SB(0, 1), cB + hstep, voffB); PG8_STAGE(PG8_SA(0, 0), cA, voffA); PG8_STAGE(PG8_SA(0, 1), cA + hstep, voffA);
        if (wr == 1) PG8_BAR;
        PG8_WAIT_V(2); PG8_BAR;
        PG8_STAGE(PG8_SB(1, 0), cB + kstep, voffB); PG8_STAGE(PG8_SA(1, 0), cA + kstep, voffA); PG8_STAGE(PG8_SB(1, 1), cB + hstep + kstep, voffB);
        PG8_WAIT_V(6); PG8_BAR;
    } else {
        PG8_STAGE(PG8_SB(0, 0), cB, voffB); PG8_STAGE(PG8_SA(0, 0), cA, voffA); PG8_STAGE(PG8_SB(0, 1), cB + hstep, voffB); PG8_STAGE(PG8_SA(0, 1), cA + hstep, voffA);
        if (wr == 1) PG8_BAR;
        PG8_WAIT_V(4); PG8_BAR;
        PG8_STAGE(PG8_SB(1, 0), cB + kstep, voffB); PG8_STAGE(PG8_SA(1, 0), cA + kstep, voffA); PG8_STAGE(PG8_SB(1, 1), cB + hstep + kstep, voffB);
        PG8_WAIT_V(6); PG8_BAR;
    }
    for (;;) {
        const bool has_next = S.next(ui + 1, nxt);
        const char* nA = has_next ? (const char*)g.A + (size_t)nxt.pm * tstep : cA; const char* nB = has_next ? (const char*)g.Bt + (size_t)nxt.pn * tstep : cB;
        for (int t = 0; t < nt; t += 2) {
            const bool last = (t == nt - 2);
            const char* a1 = cA + (size_t)(t + 1) * kstep;
            const char* a2 = last ? nA : cA + (size_t)(t + 2) * kstep; const char* b2 = last ? nB : cB + (size_t)(t + 2) * kstep;
            const char* a3 = a2 + kstep; const char* b3 = b2 + kstep;
            if (last && has_next) S.a_ready(nxt);
            if constexpr (SP2) {
            PG8_LDB(B0, 0, 0); PG8_LDB(B1, 0, 1); PG8_SCHED; PG8_LDA(At, 0, 0); PG8_STAGE(PG8_SA(1, 1), a1 + hstep, voffA);
            PG8_WAIT_V(8); PG8_WAIT_L(0); PG8_BAR; PG8_MMA(0, 0, At, B0); PG8_MMA(0, 1, At, B1); PG8_BAR; PG8_SCHED;
            PG8_LDA(At, 0, 1); PG8_STAGE(PG8_SB(0, 0), b2, voffB); PG8_STAGE(PG8_SB(0, 1), b2 + hstep, voffB); PG8_STAGE(PG8_SA(0, 0), a2, voffA);
            PG8_WAIT_V(8); PG8_WAIT_L(0); PG8_BAR; PG8_MMA(1, 0, At, B0); PG8_MMA(1, 1, At, B1); PG8_BAR; PG8_SCHED;
            PG8_LDB(B0, 1, 0); PG8_LDB(B1, 1, 1); PG8_SCHED; PG8_LDA(At, 1, 0); PG8_STAGE(PG8_SA(0, 1), a2 + hstep, voffA);
            PG8_WAIT_V(8); PG8_WAIT_L(0); PG8_BAR; PG8_MMA(0, 0, At, B0); PG8_MMA(0, 1, At, B1); PG8_BAR; PG8_SCHED;
            PG8_LDA(At, 1, 1); PG8_STAGE(PG8_SB(1, 0), b3, voffB); PG8_STAGE(PG8_SB(1, 1), b3 + hstep, voffB); PG8_STAGE(PG8_SA(1, 0), a3, voffA);
            PG8_WAIT_V(8); PG8_WAIT_L(0); PG8_BAR; PG8_MMA(1, 0, At, B0); PG8_MMA(1, 1, At, B1); PG8_BAR; PG8_SCHED;
            } else {
            PG8_LDB(B0, 0, 0); PG8_SCHED; PG8_LDA(At, 0, 0); PG8_STAGE(PG8_SA(1, 1), a1 + hstep, voffA);
            PG8_WAIT_L(8); PG8_BAR; PG8_WAIT_L(0); PG8_MMA(0, 0, At, B0); PG8_BAR; PG8_SCHED;
            PG8_LDB(B1, 0, 1); PG8_STAGE(PG8_SB(0, 0), b2, voffB);
            PG8_BAR; PG8_WAIT_L(0); PG8_MMA(0, 1, At, B1); PG8_BAR;
            PG8_LDA(At, 0, 1); PG8_STAGE(PG8_SA(0, 0), a2, voffA);
            PG8_BAR; PG8_WAIT_L(0); PG8_MMA(1, 0, At, B0); PG8_BAR; PG8_SCHED;
            PG8_STAGE(PG8_SB(0, 1), b2 + hstep, voffB);
            PG8_WAIT_V(6); PG8_BAR; PG8_MMA(1, 1, At, B1); PG8_BAR;
            PG8_LDB(B0, 1, 0); PG8_SCHED; PG8_LDA(At, 1, 0); PG8_STAGE(PG8_SA(0, 1), a2 + hstep, voffA);
            PG8_WAIT_L(8); PG8_BAR; PG8_WAIT_L(0); PG8_MMA(0, 0, At, B0); PG8_BAR; PG8_SCHED;
            PG8_LDB(B1, 1, 1); PG8_STAGE(PG8_SB(1, 0), b3, voffB);
            PG8_BAR; PG8_WAIT_L(0); PG8_MMA(0, 1, At, B1); PG8_BAR;
            PG8_LDA(At, 1, 1); PG8_STAGE(PG8_SA(1, 0), a3, voffA);
            PG8_BAR; PG8_WAIT_L(0); PG8_MMA(1, 0, At, B0); PG8_BAR; PG8_SCHED;
            PG8_STAGE(PG8_SB(1, 1), b3 + hstep, voffB);
            PG8_WAIT_V(6); PG8_BAR; PG8_MMA(1, 1, At, B1); PG8_BAR;
            }
        }
        if constexpr (ALIGN_EPI) { if (wr == 0) PG8_BAR; }
        if constexpr (!Epi::AFTER_DRAIN) { E(acc, cur, wr, wc, fr, fq); S.done(cur); }
        if (!has_next) break;
#pragma unroll
        for (int a = 0; a < 2; ++a)
#pragma unroll
            for (int b = 0; b < 2; ++b)
#pragma unroll
                for (int m = 0; m < 4; ++m)
#pragma unroll
                    for (int n = 0; n < 2; ++n) acc[a][b][m][n] = (f32x4){0.f, 0.f, 0.f, 0.f};
        cur = nxt; cA = nA; cB = nB; ++ui;
        if constexpr (ALIGN_EPI) { if (wr == 1) PG8_BAR; }
    }
    PG8_WAIT_V(0);
    if constexpr (!ALIGN_EPI) { if (wr == 0) PG8_BAR; }
    PG8_BAR;
    if constexpr (Epi::AFTER_DRAIN) { E.fused(acc, cur, wr, wc, fr, fq, lds, wid, lane); S.done(cur); }
#undef PG8_SA
#undef PG8_SB
#undef PG8_STAGE
#undef PG8_LDA
#undef PG8_LDB
#undef PG8_MMA
#undef PG8_WAIT_V
#undef PG8_WAIT_L
#undef PG8_BAR
#undef PG8_SCHED
}
}

namespace attn_body {
using bf16=__hip_bfloat16;
using bf16x8=__attribute__((ext_vector_type(8)))short;
using s16x4=__attribute__((ext_vector_type(4)))short;
using f32x16=__attribute__((ext_vector_type(16)))float;
using u32x4=__attribute__((ext_vector_type(4)))unsigned;
constexpr int D=64;
constexpr int NW=8,QBLK=32,QB=QBLK*NW,KVBLK=64;
__device__ __forceinline__ int crow(int r,int hi){return (r&3)+8*(r>>2)+4*hi;}
#define SBAR() __builtin_amdgcn_sched_barrier(0)
__device__ __forceinline__ void cmask(f32x16&p0,f32x16&p1,int jb,int qrel,int hi){
  const float NEG=-INFINITY; int kb=64*jb+4*hi;
  #pragma unroll
  for(int r=0;r<16;++r){int kv=kb+(r&3)+8*(r>>2); if(kv>qrel)p0[r]=NEG; if(kv+32>qrel)p1[r]=NEG;}
}

__device__ __forceinline__ void lmask(f32x16&p0,f32x16&p1,int t,int qrel,int hi){
  const float NEG=-30000.f; int kb=64*t+4*hi;
  #pragma unroll
  for(int r=0;r<16;++r){int kv=kb+(r&3)+8*(r>>2); if(kv<=qrel)p0[r]=NEG; if(kv+32<=qrel)p1[r]=NEG;}
}
__device__ __forceinline__ void smask(f32x16&p0,f32x16&p1,bool on){
  const float NEG=-INFINITY;
  #pragma unroll
  for(int r=0;r<16;++r){ p0[r]=on?p0[r]:NEG; p1[r]=on?p1[r]:NEG; }
}
constexpr int NSLOT=3, SLOTB=8192;
constexpr int LDS_K=0, LDS_V=NSLOT*SLOTB, LDS_WS=2*NSLOT*SLOTB, LDS_OST=LDS_WS+NW*64*4, LDS_BYTES=LDS_OST+NW*4096;
constexpr float C2=0.125f*1.4426950408889634f;
__device__ __forceinline__ void glds16(const void*gsrc,unsigned lds_dst){unsigned keep;
  asm volatile("s_mov_b32 %0, m0\n\ts_mov_b32 m0, %2\n\ts_nop 0\n\tglobal_load_lds_dwordx4 %1, off\n\ts_mov_b32 m0, %0":"=&s"(keep):"v"(gsrc),"s"(lds_dst):"memory");}
__device__ __forceinline__ float max3f(float a,float b,float c){float r;asm("v_max3_f32 %0, %1, %2, %3":"=v"(r):"v"(a),"v"(b),"v"(c));return r;}
__device__ __forceinline__ float max2f(float a,float b){float r;asm("v_max_f32_e32 %0, %1, %2":"=v"(r):"v"(a),"v"(b));return r;}
__device__ __forceinline__ float fadd_s(float a,float b){float r;asm("v_add_f32_e32 %0, %1, %2":"=v"(r):"v"(a),"v"(b));return r;}
__device__ __forceinline__ float fsub_s(float a,float b){float r;asm("v_sub_f32_e32 %0, %1, %2":"=v"(r):"v"(a),"v"(b));return r;}
typedef float f32x2_t __attribute__((ext_vector_type(2))); typedef __bf16 bf16x2_t __attribute__((ext_vector_type(2)));
__device__ __forceinline__ unsigned cvtpk_s(float lo,float hi){f32x2_t v={lo,hi};bf16x2_t b=__builtin_convertvector(v,bf16x2_t);return __builtin_bit_cast(unsigned,b);}
#define WAIT_BAR(N) asm volatile("s_waitcnt vmcnt(" #N ") lgkmcnt(0)\n\ts_barrier":::"memory")

__device__ __forceinline__ void qkt(f32x16&p0,f32x16&p1,const char*Kslot,const bf16x8*qr,const f32x16&negm,int r32,int hi){
  const char*kb=Kslot+hi*1024+r32*16;
  #pragma unroll
  for(int d0=0;d0<4;++d0){
    const bf16x8 b0=*reinterpret_cast<const bf16x8*>(kb+d0*2048);
    const bf16x8 b1=*reinterpret_cast<const bf16x8*>(kb+d0*2048+512);
    if(d0==0){p0=__builtin_amdgcn_mfma_f32_32x32x16_bf16(b0,qr[0],negm,0,0,0);p1=__builtin_amdgcn_mfma_f32_32x32x16_bf16(b1,qr[0],negm,0,0,0);}
    else{p0=__builtin_amdgcn_mfma_f32_32x32x16_bf16(b0,qr[d0],p0,0,0,0);p1=__builtin_amdgcn_mfma_f32_32x32x16_bf16(b1,qr[d0],p1,0,0,0);}}
}
typedef __attribute__((address_space(3))) const char* lds_cptr;
typedef short v4i16_t __attribute__((ext_vector_type(4)));
__device__ __forceinline__ void kload8(bf16x8*kf,lds_cptr kp){
  kf[0]=*(const __attribute__((address_space(3))) bf16x8*)(kp);      kf[1]=*(const __attribute__((address_space(3))) bf16x8*)(kp+512);
  kf[2]=*(const __attribute__((address_space(3))) bf16x8*)(kp+2048); kf[3]=*(const __attribute__((address_space(3))) bf16x8*)(kp+2560);
  kf[4]=*(const __attribute__((address_space(3))) bf16x8*)(kp+4096); kf[5]=*(const __attribute__((address_space(3))) bf16x8*)(kp+4608);
  kf[6]=*(const __attribute__((address_space(3))) bf16x8*)(kp+6144); kf[7]=*(const __attribute__((address_space(3))) bf16x8*)(kp+6656);
}
__device__ __forceinline__ void kload2(bf16x8*kf,lds_cptr kp,int j){ kf[2*j]=*(const __attribute__((address_space(3))) bf16x8*)(kp+j*2048); kf[2*j+1]=*(const __attribute__((address_space(3))) bf16x8*)(kp+j*2048+512); }
__device__ __forceinline__ s16x4 vtr(lds_cptr p){ return __builtin_bit_cast(s16x4,__builtin_amdgcn_ds_read_tr16_b64_v4i16((__attribute__((address_space(3))) v4i16_t*)p)); }
__device__ __forceinline__ float rowmax(const f32x16&p0,const f32x16&p1){
  float a=max3f(p0[0],p0[1],p1[0]),b=max3f(p0[2],p0[3],p1[1]);a=max3f(a,p1[2],p1[3]);
  #pragma unroll
  for(int r=4;r<16;r+=4){a=max3f(a,p0[r],p0[r+1]);b=max3f(b,p0[r+2],p0[r+3]);a=max3f(a,p1[r],p1[r+1]);b=max3f(b,p1[r+2],p1[r+3]);}
  const float m=max2f(a,b);
  auto rr=__builtin_amdgcn_permlane32_swap(__float_as_uint(m),__float_as_uint(m),false,false);
  return max2f(__uint_as_float(rr[0]),__uint_as_float(rr[1]));
}
__device__ __forceinline__ void pv(f32x16*o,int vb,bf16x8 pa0,bf16x8 pa1,bf16x8 pa2,bf16x8 pa3){
  #pragma unroll
  for(int d0=0;d0<2;++d0){s16x4 lo[4],hi[4];
    #pragma unroll
    for(int ks=0;ks<4;++ks){
      asm volatile("ds_read_b64_tr_b16 %0,%1 offset:%c2":"=&v"(lo[ks]):"v"(vb),"i"(d0*4096+ks*1024):"memory");
      asm volatile("ds_read_b64_tr_b16 %0,%1 offset:%c2":"=&v"(hi[ks]):"v"(vb),"i"(d0*4096+ks*1024+512):"memory");}
    asm volatile("s_waitcnt lgkmcnt(0)":::"memory");SBAR();
    #define PK(k) (bf16x8){lo[k][0],lo[k][1],lo[k][2],lo[k][3],hi[k][0],hi[k][1],hi[k][2],hi[k][3]}
    o[d0]=__builtin_amdgcn_mfma_f32_32x32x16_bf16(pa0,PK(0),o[d0],0,0,0);
    o[d0]=__builtin_amdgcn_mfma_f32_32x32x16_bf16(pa1,PK(1),o[d0],0,0,0);
    o[d0]=__builtin_amdgcn_mfma_f32_32x32x16_bf16(pa2,PK(2),o[d0],0,0,0);
    o[d0]=__builtin_amdgcn_mfma_f32_32x32x16_bf16(pa3,PK(3),o[d0],0,0,0);
    #undef PK
  }
}

#ifndef ATTN_STORE16
#define ATTN_STORE16(p,v) (*(u32x4*)(p)=(v))
#endif
struct NsaMix { int hd, j; };
template<int THRL,int MODE> __device__ __forceinline__ void attn_unit(long rowbase,int qb,const bf16*Qh,int ldq,const bf16*__restrict__ Kh0,const bf16*__restrict__ Vh0,int ldkv,bf16*Oh,int ldo,const unsigned long long*selrow,char*shm,const NsaMix mix){
  const int tid=tid_(),lane=tid&63,r32=lane&31,hi=lane>>5; const int wid=__builtin_amdgcn_readfirstlane(tid>>6);
  const int q0=qb*QB;
  int t_lo=0; bool lower=false; if(MODE==2){ if(qb>=2){ t_lo=4*qb-8; lower=true; } }
  const bf16*Qw=Qh+(rowbase+q0+wid*QBLK)*ldq;
  const bf16*Kh=Kh0+(rowbase+(long)t_lo*KVBLK)*ldkv,*Vh=Vh0+(rowbase+(long)t_lo*KVBLK)*ldkv;
  const unsigned lds0=(unsigned)(uintptr_t)shm;
  float*wsf=(float*)(shm+LDS_WS)+wid*64;
  const bf16*ksrc=Kh+(long)lane*ldkv+wid*8;
  const bf16*vsrc=Vh+(long)(16*(wid&3)+(lane>>2))*ldkv+(wid>>2)*32+(lane&3)*8;
  const unsigned kdst=lds0+LDS_K+wid*1024, vdst=lds0+LDS_V+wid*1024;
  #define DMA_K(t,slot) glds16(ksrc+(long)(t)*KVBLK*ldkv,(unsigned)__builtin_amdgcn_readfirstlane(kdst+(slot)))
  #define DMA_V(t,slot) glds16(vsrc+(long)(t)*KVBLK*ldkv,(unsigned)__builtin_amdgcn_readfirstlane(vdst+(slot)))
  const int vb0=(int)(lds0+LDS_V)+((lane>>4)&1)*32+(lane&3)*8+(4*hi+((lane&15)>>2))*64;
  const char*Kbase=shm+LDS_K; bf16x8 kf[8];
  const lds_cptr shm3=(lds_cptr)shm; const lds_cptr kp0=shm3+LDS_K+hi*1024+r32*16; const lds_cptr vp0=shm3+LDS_V+((lane>>4)&1)*32+(lane&3)*8+(4*hi+((lane&15)>>2))*64;
  const int NT=(q0+QB)/KVBLK-t_lo;
  DMA_K(0,0);DMA_V(0,0);DMA_K(1,SLOTB);
  bf16x8 qr[4];
  #pragma unroll
  for(int d0=0;d0<4;++d0)qr[d0]=*reinterpret_cast<const bf16x8*>(&Qw[(long)r32*ldq+d0*16+hi*8]);
  float mhat=0.f,l_reg=0.f;f32x16 o[2];o[0]=f32x16{};o[1]=f32x16{};f32x16 negm=f32x16{};asm volatile("":"+v"(negm));
  const int qrel=wid*QBLK+r32;
  unsigned long long msk=0ull; if(MODE==1) msk=selrow[q0+qrel];
  #define XMASK(P0,P1,t) do{ if(MODE==1) smask(P0,P1,((msk>>(t))&1ull)!=0ull); if(MODE==2){ if(lower&&(t)<4) lmask(P0,P1,(t),qrel,hi); } }while(0)
  #define CMASK(P0,P1,t) do{ XMASK(P0,P1,t); int jb_=(t)-(NT-4); if(jb_>=0)cmask(P0,P1,jb_,qrel,hi);}while(0)
  bool resc=false;
  #define START(P0,P1) do{ const float rm=rowmax(P0,P1); resc=false; \
    { const float dl=rm; mhat=fadd_s(mhat,dl); \
      _Pragma("unroll") for(int r=0;r<16;++r){P0[r]=fsub_s(P0[r],dl);P1[r]=fsub_s(P1[r],dl);} \
      _Pragma("unroll") for(int r=0;r<16;++r)negm[r]=-mhat; asm volatile("":"+v"(negm)); } \
    _Pragma("unroll") for(int r=0;r<16;++r)P0[r]=__builtin_amdgcn_exp2f(P0[r]); }while(0)
  #define RESC() do{ if(resc){ asm volatile("s_waitcnt lgkmcnt(0)":::"memory"); \
      _Pragma("unroll") for(int d_=0;d_<2;++d_) _Pragma("unroll") for(int r=0;r<16;++r)o[d_][r]*=wsf[crow(r,hi)]; } }while(0)
  f32x16 pA0,pA1,pB0,pB1;
  int sl_prev=0,sl_cur=0,sl_next=SLOTB;
  #define ROT() do{sl_prev=sl_cur;sl_cur=sl_next;sl_next=(sl_next==(NSLOT-1)*SLOTB)?0:sl_next+SLOTB;}while(0)
  DMA_K(2,2*SLOTB);
  WAIT_BAR(3);
  qkt(pA0,pA1,Kbase,qr,negm,r32,hi);asm volatile("s_nop 15\n\ts_nop 7":"+v"(pA0),"+v"(pA1));CMASK(pA0,pA1,0);
  START(pA0,pA1);
  _Pragma("unroll") for(int r=0;r<16;++r)pA1[r]=__builtin_amdgcn_exp2f(pA1[r]);
  WAIT_BAR(0);
  DMA_K(3,0);DMA_V(1,SLOTB);
  ROT();
  kload8(kf,kp0+sl_cur);
  WAIT_BAR(2);
  s16x4 vlo[8],vhi[8]; u32x4 pw0,pw1,pw2,pw3;
  #define PKW(P,B) cvtpk_s(P[B],P[B+1])
  #define PAF(k) __builtin_bit_cast(bf16x8,pw##k)
  #define VFR(i) (bf16x8){vlo[i][0],vlo[i][1],vlo[i][2],vlo[i][3],vhi[i][0],vhi[i][1],vhi[i][2],vhi[i][3]}
  #define PIN(x) asm volatile("":"+v"(x))
  #define MX3(a,b,c) __builtin_fmaxf(__builtin_fmaxf((a),(b)),(c))
  #define GAPA(MF,A0,A1,A2,A3,W0,W1,PW) do{ MF; sacc+=A0; sacc+=A1; sacc+=A2; sacc+=A3; PIN(sacc); W0; W1; PIN(PW); SBAR(); }while(0)
  #define EX(v) __builtin_amdgcn_exp2f(v)
  #define GAPB(MF,X,B) do{ MF; X[B]=EX(X[B]); X[B+1]=EX(X[B+1]); X[B+2]=EX(X[B+2]); X[B+3]=EX(X[B+3]); PIN(X); SBAR(); }while(0)
  #define VRD(i) do{ vlo[i]=vtr(vp_+(((i)>>2)*4096+((i)&3)*1024)); vhi[i]=vtr(vp_+(((i)>>2)*4096+((i)&3)*1024+512)); }while(0)
  #define KRD(G,j) do{ if(G){ kload2(kf,kp0+sl_next,j); SBAR(); } }while(0)
  #define STEP(C0,C1,P0,P1,t,GK,GV,GL) do{ SBAR(); \
    const lds_cptr vp_=vp0+sl_prev; \
    VRD(0); SBAR(); float sacc=(P0[0]+P0[1]); \
    GAPA(C0=__builtin_amdgcn_mfma_f32_32x32x16_bf16(kf[0],qr[0],negm,0,0,0), P0[2],P0[3],P0[4],P0[5],     pw0[0]=PKW(P0,0), pw0[1]=PKW(P0,2), pw0); \
    VRD(4); SBAR(); GAPA(C1=__builtin_amdgcn_mfma_f32_32x32x16_bf16(kf[1],qr[0],negm,0,0,0), P0[6],P0[7],P0[8],P0[9],     pw0[2]=PKW(P0,4), pw0[3]=PKW(P0,6), pw0); \
    VRD(1); SBAR(); GAPA(C0=__builtin_amdgcn_mfma_f32_32x32x16_bf16(kf[2],qr[1],C0,0,0,0),   P0[10],P0[11],P0[12],P0[13], pw1[0]=PKW(P0,8), pw1[1]=PKW(P0,10), pw1); \
    VRD(5); SBAR(); GAPA(C1=__builtin_amdgcn_mfma_f32_32x32x16_bf16(kf[3],qr[1],C1,0,0,0),   P0[14],P0[15],P1[0],P1[1],   pw1[2]=PKW(P0,12),pw1[3]=PKW(P0,14), pw1); \
    VRD(2); SBAR(); GAPA(C0=__builtin_amdgcn_mfma_f32_32x32x16_bf16(kf[4],qr[2],C0,0,0,0),   P1[2],P1[3],P1[4],P1[5],     pw2[0]=PKW(P1,0), pw2[1]=PKW(P1,2), pw2); \
    VRD(6); SBAR(); GAPA(C1=__builtin_amdgcn_mfma_f32_32x32x16_bf16(kf[5],qr[2],C1,0,0,0),   P1[6],P1[7],P1[8],P1[9],     pw2[2]=PKW(P1,4), pw2[3]=PKW(P1,6), pw2); \
    VRD(3); SBAR(); GAPA(C0=__builtin_amdgcn_mfma_f32_32x32x16_bf16(kf[6],qr[3],C0,0,0,0),   P1[10],P1[11],P1[12],P1[13], pw3[0]=PKW(P1,8), pw3[1]=PKW(P1,10), pw3); \
    VRD(7); SBAR(); GAPA(C1=__builtin_amdgcn_mfma_f32_32x32x16_bf16(kf[7],qr[3],C1,0,0,0),   P1[14],P1[15],0.f,0.f,       pw3[2]=PKW(P1,12),pw3[3]=PKW(P1,14), pw3); \
    l_reg+=sacc; \
    if(GK){DMA_K((t)+3,sl_cur);} if(GV){DMA_V((t)+1,sl_next);} \
    CMASK(C0,C1,t); \
    { float a=MX3(C0[0],C0[1],C1[0]),b=MX3(C0[2],C0[3],C1[1]); a=MX3(a,C1[2],C1[3]); \
      _Pragma("unroll") for(int r=4;r<16;r+=4){a=MX3(a,C0[r],C0[r+1]);b=MX3(b,C0[r+2],C0[r+3]);a=MX3(a,C1[r],C1[r+1]);b=MX3(b,C1[r+2],C1[r+3]);} \
      float rm=__builtin_fmaxf(a,b); { auto rr=__builtin_amdgcn_permlane32_swap(__float_as_uint(rm),__float_as_uint(rm),false,false); rm=__builtin_fmaxf(__uint_as_float(rr[0]),__uint_as_float(rr[1])); } \
      resc=false; \
      if(__builtin_expect(__any(rm>(float)THRL),0)){ const float dl=__builtin_fmaxf(rm,0.f); mhat+=dl; \
        _Pragma("unroll") for(int r=0;r<16;++r){C0[r]-=dl;C1[r]-=dl;} \
        _Pragma("unroll") for(int r=0;r<16;++r)negm[r]=-mhat; asm volatile("":"+v"(negm)); \
        const float f=__builtin_amdgcn_exp2f(-dl); l_reg*=f; if(hi==0)wsf[r32]=f; resc=true; } } \
    SBAR(); \
    GAPB(o[0]=__builtin_amdgcn_mfma_f32_32x32x16_bf16(PAF(0),VFR(0),o[0],0,0,0), C0,0); \
    GAPB(o[1]=__builtin_amdgcn_mfma_f32_32x32x16_bf16(PAF(0),VFR(4),o[1],0,0,0), C0,4); \
    KRD(GL,0); GAPB(o[0]=__builtin_amdgcn_mfma_f32_32x32x16_bf16(PAF(1),VFR(1),o[0],0,0,0), C0,8); \
    KRD(GL,1); GAPB(o[1]=__builtin_amdgcn_mfma_f32_32x32x16_bf16(PAF(1),VFR(5),o[1],0,0,0), C0,12); \
    KRD(GL,2); GAPB(o[0]=__builtin_amdgcn_mfma_f32_32x32x16_bf16(PAF(2),VFR(2),o[0],0,0,0), C1,0); \
    KRD(GL,3); GAPB(o[1]=__builtin_amdgcn_mfma_f32_32x32x16_bf16(PAF(2),VFR(6),o[1],0,0,0), C1,4); \
    GAPB(o[0]=__builtin_amdgcn_mfma_f32_32x32x16_bf16(PAF(3),VFR(3),o[0],0,0,0), C1,8); \
    GAPB(o[1]=__builtin_amdgcn_mfma_f32_32x32x16_bf16(PAF(3),VFR(7),o[1],0,0,0), C1,12); \
    }while(0)
  int t=1;
  #undef CMASK
  #define CMASK(P0,P1,t) XMASK(P0,P1,t)
  for(;t+5<NT;t+=2){
    STEP(pB0,pB1,pA0,pA1,t,true,true,true);     WAIT_BAR(2); RESC(); ROT();
    STEP(pA0,pA1,pB0,pB1,t+1,true,true,true);   WAIT_BAR(2); RESC(); ROT();
  }
  #undef CMASK
  #define CMASK(P0,P1,t) do{ XMASK(P0,P1,t); int jb_=(t)-(NT-4); if(jb_>=0)cmask(P0,P1,jb_,qrel,hi);}while(0)
  #define ENDW(tt) do{ if((tt)+3<NT){WAIT_BAR(2);} else if((tt)+2<NT){WAIT_BAR(1);} else {WAIT_BAR(0);} }while(0)
  for(;t+1<NT;t+=2){
    STEP(pB0,pB1,pA0,pA1,t,(t+3<NT),(t+1<NT),(t+1<NT));       ENDW(t);   RESC(); ROT();
    STEP(pA0,pA1,pB0,pB1,t+1,(t+4<NT),(t+2<NT),(t+2<NT));     ENDW(t+1); RESC(); ROT();
  }
  STEP(pB0,pB1,pA0,pA1,NT-1,false,false,false); RESC();
  { float sacc=pB0[0]+pB0[1]; _Pragma("unroll") for(int r=2;r<16;++r)sacc+=pB0[r]; _Pragma("unroll") for(int r=0;r<16;++r)sacc+=pB1[r]; l_reg+=sacc;
    pw0=(u32x4){PKW(pB0,0),PKW(pB0,2),PKW(pB0,4),PKW(pB0,6)};pw1=(u32x4){PKW(pB0,8),PKW(pB0,10),PKW(pB0,12),PKW(pB0,14)};pw2=(u32x4){PKW(pB1,0),PKW(pB1,2),PKW(pB1,4),PKW(pB1,6)};pw3=(u32x4){PKW(pB1,8),PKW(pB1,10),PKW(pB1,12),PKW(pB1,14)};
    SBAR(); pv(o,vb0+sl_cur,PAF(0),PAF(1),PAF(2),PAF(3)); }
  #undef PKW
  #undef PAF
  #undef VFR
  #undef PIN
  #undef MX3
  #undef GAPA
  #undef GAPB
  #undef EX
  #undef VRD
  #undef KRD
  #undef STEP
  #undef ENDW
  {auto rr=__builtin_amdgcn_permlane32_swap(__float_as_uint(l_reg),__float_as_uint(l_reg),false,false);l_reg=__uint_as_float(rr[0])+__uint_as_float(rr[1]);}
  if(hi==0)wsf[32+r32]=l_reg;asm volatile("s_waitcnt lgkmcnt(0)":::"memory");
  float rli[16];
  #pragma unroll
  for(int r=0;r<16;++r)rli[r]=__builtin_amdgcn_rcpf(wsf[32+crow(r,hi)]);
  bf16*Ow=Oh+(rowbase+q0+wid*QBLK)*ldo;
  { bf16*stg=(bf16*)(shm+LDS_OST)+wid*2048;
    #pragma unroll
    for(int r=0;r<16;++r){const int orow=crow(r,hi);
      #pragma unroll
      for(int d0=0;d0<2;++d0)stg[orow*64+d0*32+r32]=__float2bfloat16(o[d0][r]*rli[r]);}
    asm volatile("s_waitcnt lgkmcnt(0)":::"memory");
    #pragma unroll
    for(int i=0;i<4;++i){const int row=i*8+(lane>>3),ch=lane&7; u32x4 v=*(const u32x4*)(stg+row*64+ch*8);
      if(MODE==1){ const long grow=rowbase+q0+wid*QBLK+row;
        const unsigned short*ocmp=(const unsigned short*)(P(ws)+WS_ATT)+mix.hd*64, *owin=(const unsigned short*)(P(ws)+WS_ATT+64*MiB)+mix.hd*64;
        const u32x4 a=*(const u32x4*)(ocmp+grow*ldo+ch*8), c=*(const u32x4*)(owin+grow*ldo+ch*8);
        const unsigned short*gp=(const unsigned short*)(P(ws)+WS_PROJ)+grow*NSA_P+2560+mix.hd*3; const float*bgp=P(nsa_b_gate)+mix.j*48+mix.hd*3;
        const float g0=1.0f/(1.0f+__expf(-(__uint_as_float((unsigned)gp[0]<<16)+bgp[0]))), g1=1.0f/(1.0f+__expf(-(__uint_as_float((unsigned)gp[1]<<16)+bgp[1]))), g2=1.0f/(1.0f+__expf(-(__uint_as_float((unsigned)gp[2]<<16)+bgp[2])));
        #pragma unroll
        for(int e=0;e<4;++e){ const float alo=__uint_as_float(a[e]<<16),ahi=__uint_as_float(a[e]&0xffff0000u), vlo=__uint_as_float(v[e]<<16),vhi=__uint_as_float(v[e]&0xffff0000u), clo=__uint_as_float(c[e]<<16),chi=__uint_as_float(c[e]&0xffff0000u);
          v[e]=cvtpk_s(g0*alo+g1*vlo+g2*clo, g0*ahi+g1*vhi+g2*chi); } }
      ATTN_STORE16(Ow+(long)row*ldo+ch*8,v);} }
  asm volatile("s_waitcnt lgkmcnt(0)\n\ts_barrier":::"memory");
  #undef DMA_K
  #undef DMA_V
  #undef CMASK
  #undef XMASK
  #undef START
  #undef RESC
  #undef ROT
}
constexpr int ATTN_LDS_BYTES=LDS_BYTES;
#undef SBAR
#undef WAIT_BAR
}

__device__ __forceinline__ void ph_attn_diff_fast(int j, unsigned char* lds) {
  using namespace attn_body;
  typedef unsigned u32x4_t __attribute__((ext_vector_type(4)));
  const bf16* PROJ = (const bf16*)(P(ws) + WS_PROJ); bf16* ATT = (bf16*)(P(ws) + WS_ATT);
  const int G = gdim_(), bx = bid_(); const int v0 = (G % 8 == 0) ? (bx % 8) * (G / 8) + bx / 8 : bx;
  for (int vcu = v0; vcu < 256; vcu += G) {
    const int bh8 = vcu >> 3, h8 = bh8 & 7, b = bh8 >> 3, sp = vcu & 7;
#pragma unroll 1
    for (int pi = 0; pi < 2; ++pi) { const int qb = pi ? sp : 15 - sp;
#pragma unroll 1
      for (int u4 = 0; u4 < 4; ++u4) { const int c = u4 >> 1, half = u4 & 1;
        attn_unit<8, 0>((long)b * S, qb, PROJ + (h8 * 2 + c) * 64, DIFF_IN, PROJ + 1024 + (h8 * 2 + c) * 64, PROJ + 2048 + h8 * 128 + half * 64, DIFF_IN,
                        ATT + c * 1024 + h8 * 128 + half * 64, 2048, nullptr, (char*)lds, NsaMix{}); }
      asm volatile("s_waitcnt vmcnt(0)" ::: "memory"); __syncthreads();
      { const int tid = tid_(), lane = tid & 63, wave = tid >> 6;
        const float lam = ((const float*)(P(ws) + WS_SMALL))[j]; const float osc = 1.0f - lam_init_of(j);
        const unsigned short* A = (const unsigned short*)ATT; bf16_t* OC = (bf16_t*)(P(ws) + WS_OC); const float* sg = P(diff_subln_g) + j * 128 + (lane & 15) * 8;
#pragma unroll 2
        for (int it = 0; it < 8; ++it) { const size_t m = (size_t)b * S + qb * 256 + it * 32 + wave * 4 + (lane >> 4); const int col = h8 * 128 + (lane & 15) * 8;
          const u32x4_t av = __builtin_nontemporal_load((const u32x4_t*)(A + m * 2048 + col)), bv = __builtin_nontemporal_load((const u32x4_t*)(A + m * 2048 + 1024 + col));
          float o[8]; float ss = 0.f;
#pragma unroll
          for (int e = 0; e < 4; ++e) { o[2 * e] = __uint_as_float(av[e] << 16) - lam * __uint_as_float(bv[e] << 16); o[2 * e + 1] = __uint_as_float(av[e] & 0xffff0000u) - lam * __uint_as_float(bv[e] & 0xffff0000u); }
#pragma unroll
          for (int k = 0; k < 8; ++k) ss += o[k] * o[k];
          ss += __shfl_xor(ss, 1); ss += __shfl_xor(ss, 2); ss += __shfl_xor(ss, 4); ss += __shfl_xor(ss, 8);
          const float rstd = 1.0f / sqrtf(ss * (1.0f / 128.0f) + EPS);
#pragma unroll
          for (int k = 0; k < 8; ++k) o[k] = o[k] * rstd * sg[k] * osc;
          *(uint4*)(OC + m * 1024 + col) = pack8(o); }
      }
    }
  }
}
__device__ __forceinline__ void ph_attn_sel_fast(int j, unsigned char* lds) {
  using namespace attn_body;
  const bf16* PROJ = (const bf16*)(P(ws) + WS_PROJ); bf16* OC = (bf16*)(P(ws) + WS_OC);
  const u64* SEL = (const u64*)(P(ws) + WS_SEL);
  const int G = gdim_(), bx = bid_(); const int v0 = (G % 8 == 0) ? (bx % 8) * (G / 8) + bx / 8 : bx;
  for (int vcu = v0; vcu < 256; vcu += G) {
    const int bh = vcu >> 2, hd = bh & 15, b = bh >> 4, g = hd >> 2;
    const NsaMix mix{hd, j};
#pragma unroll 1
    for (int i = 0; i < 4; ++i) { const int sp = 2 * (vcu & 3) + (i >> 1); const int qb = (i & 1) ? 15 - sp : sp;
      attn_unit<8, 1>((long)b * S, qb, PROJ + hd * 64, NSA_P, PROJ + 1536 + g * 64, PROJ + 1792 + g * 64, NSA_P, OC + hd * 64, 1024, SEL + (size_t)(b * 4 + g) * S, (char*)lds, mix); }
  }
}
__device__ __forceinline__ void ph_attn_win_fast(unsigned char* lds) {
  using namespace attn_body;
  const bf16* PROJ = (const bf16*)(P(ws) + WS_PROJ); bf16* OWIN = (bf16*)(P(ws) + WS_ATT + 64 * MiB);
  const int G = gdim_(), bx = bid_(); const int v0 = (G % 8 == 0) ? (bx % 8) * (G / 8) + bx / 8 : bx;
  for (int vcu = v0; vcu < 256; vcu += G) {
    const int bh = vcu >> 2, hd = bh & 15, b = bh >> 4, g = hd >> 2;
#pragma unroll 1
    for (int i = 0; i < 4; ++i) { const int qb = (vcu & 3) + 4 * i;
      attn_unit<8, 2>((long)b * S, qb, PROJ + hd * 64, NSA_P, PROJ + 2048 + g * 64, PROJ + 2304 + g * 64, NSA_P, OWIN + hd * 64, 1024, nullptr, (char*)lds, NsaMix{}); }
  }
}

#define XB_TMO      128
#define XB_XCNT(j)  (256  + 64 * (j))
#define XB_XSUB(j)  (1280 + 64 * (j))
#define XB_XGEN(j)  (2304 + 64 * (j))
#define XB_TOP      3328
#define XB_TOPGEN   3392
#define XCD_BAR_WORDS 3456
#define XB_SPIN_CAP (1u << 18)

__device__ __forceinline__ unsigned xb_ld(unsigned* p)              { return __hip_atomic_load(p, __ATOMIC_RELAXED, __HIP_MEMORY_SCOPE_AGENT); }
__device__ __forceinline__ unsigned xb_add(unsigned* p, unsigned v) { return __hip_atomic_fetch_add(p, v, __ATOMIC_RELAXED, __HIP_MEMORY_SCOPE_AGENT); }
__device__ __forceinline__ unsigned xb_xcc_id() { return (unsigned)__builtin_amdgcn_s_getreg((3 << 11) | 20) & 0xFu; }
#define XB_SPIN(cond, bar) do { unsigned _sp = 0; while (cond) { __builtin_amdgcn_s_sleep(1); \
    if ((++_sp & 255u) == 0u) { if (xb_ld(&(bar)[XB_TMO])) break; if (_sp > XB_SPIN_CAP) { atomicAdd(&(bar)[XB_TMO], 1u); break; } } } } while (0)

struct XcdBarrier {
    unsigned* bar; unsigned x;
    volatile __attribute__((address_space(3))) unsigned* st;
};

__device__ __forceinline__ XcdBarrier xcd_barrier_post(unsigned* bar, volatile __attribute__((address_space(3))) unsigned* st) {
    XcdBarrier b; b.bar = bar; b.x = xb_xcc_id(); b.st = st;
    if (tid_() == 0) (void)xb_add(&bar[XB_XCNT(b.x)], 1u);
    return b;
}
__device__ __forceinline__ void xcd_barrier_complete(unsigned* bar, unsigned x, unsigned& nloc, unsigned& nx) {
    const unsigned G = gridDim.x * gridDim.y * gridDim.z;
    unsigned sum, cnt, mine, sp = 0u;
    for (;;) {
        sum = 0u; cnt = 0u; mine = 0u;
#pragma unroll
        for (unsigned j = 0; j < 16; ++j) { const unsigned c = xb_ld(&bar[XB_XCNT(j)]); sum += c; cnt += (c > 0u) ? 1u : 0u; mine = (j == x) ? c : mine; }
        if (sum == G) break;
        __builtin_amdgcn_s_sleep(1);
        if ((++sp & 255u) == 0u) { if (xb_ld(&bar[XB_TMO])) break; if (sp > XB_SPIN_CAP) { atomicAdd(&bar[XB_TMO], 1u); break; } }
    }
    nloc = mine > 0u ? mine : 1u; nx = cnt > 0u ? cnt : 1u;
}

__device__ __forceinline__ void xcd_barrier(const XcdBarrier& b) {
    asm volatile("s_waitcnt vmcnt(0)" ::: "memory");
    __syncthreads();
    if (tid_() == 0) {
        unsigned* bar = b.bar;
        __builtin_amdgcn_s_waitcnt(0);
        unsigned nloc = b.st[0], nx = b.st[1];
        if (nloc == 0u) { xcd_barrier_complete(bar, b.x, nloc, nx); b.st[0] = nloc; b.st[1] = nx; }
        const unsigned old = xb_add(&bar[XB_XSUB(b.x)], 1u);
        const unsigned gen = old / nloc;
        if (old + 1u == (gen + 1u) * nloc) {
            __builtin_amdgcn_fence(__ATOMIC_RELEASE, "agent");
            asm volatile("s_waitcnt vmcnt(0)" ::: "memory");
            const unsigned og = xb_add(&bar[XB_TOP], 1u);
            const unsigned tg = og / nx;
            if (og + 1u == (tg + 1u) * nx) xb_add(&bar[XB_TOPGEN], 1u);
            else XB_SPIN(xb_ld(&bar[XB_TOPGEN]) == tg, bar);
            __builtin_amdgcn_fence(__ATOMIC_ACQUIRE, "agent");
            xb_add(&bar[XB_XGEN(b.x)], 1u);
            asm volatile("s_waitcnt vmcnt(0)" ::: "memory");
        } else {
            XB_SPIN(xb_ld(&bar[XB_XGEN(b.x)]) == gen, bar);
            __builtin_amdgcn_fence(__ATOMIC_ACQUIRE, "agent");
            asm volatile("s_waitcnt vmcnt(0)" ::: "memory");
        }
    }
    __syncthreads();
}

__device__ __forceinline__ void ph_prologue(unsigned char* lds) {
  const int tid = tid_();
  float* silu = (float*)lds;
  float* red = silu + 4096;
  float* MOD = (float*)(P(ws) + WS_MOD);
  for (int i = tid; i < 4096; i += NTHR) { const float v = P(c)[i]; silu[i] = v / (1.f + expf(-v)); }
  __syncthreads();
  const int cc = tid & 31, ks = tid >> 5;
  for (int item = bid_(); item < 768 + 16; item += gdim_()) {
    if (item < 768) {
      const int l = item / 192, nc = item % 192;
      const float* w = P(w_ada) + ((size_t)l * 1024 + ks * 64) * 6144 + nc * 32 + cc;
      float wv[64];
#pragma unroll
      for (int k = 0; k < 64; ++k) wv[k] = w[(size_t)k * 6144];
      float a0 = 0.f, a1 = 0.f, a2 = 0.f, a3 = 0.f;
#pragma unroll
      for (int k = 0; k < 64; ++k) { const int kk = ks * 64 + k; a0 += silu[kk] * wv[k]; a1 += silu[1024 + kk] * wv[k]; a2 += silu[2048 + kk] * wv[k]; a3 += silu[3072 + kk] * wv[k]; }
      red[(ks * 4 + 0) * 32 + cc] = a0; red[(ks * 4 + 1) * 32 + cc] = a1; red[(ks * 4 + 2) * 32 + cc] = a2; red[(ks * 4 + 3) * 32 + cc] = a3;
      __syncthreads();
      if (tid < 128) { const int bb = tid >> 5; float sacc = 0.f;
#pragma unroll
        for (int q = 0; q < 16; ++q) sacc += red[(q * 4 + bb) * 32 + cc];
        MOD[(size_t)(l * 4 + bb) * 6144 + nc * 32 + cc] = sacc + P(b_ada)[l * 6144 + nc * 32 + cc]; }
      __syncthreads();
    } else {
      const int it = item - 768, jk = it >> 2, nc = it & 3, jj = jk >> 1, kv = jk & 1;
      const float* pe = (kv ? P(nsa_pe_v) : P(nsa_pe_k)) + jj * 2048 + ks * 128; const float* w1 = (kv ? P(nsa_w_cv1) : P(nsa_w_ck1)) + ((size_t)jj * 2048 + ks * 128) * 128 + nc * 32 + cc;
      float a = 0.f;
#pragma unroll 2
      for (int k0 = 0; k0 < 128; k0 += 64) { float wv[64];
#pragma unroll
        for (int k = 0; k < 64; ++k) wv[k] = w1[(size_t)(k0 + k) * 128];
#pragma unroll
        for (int k = 0; k < 64; ++k) a += pe[k0 + k] * wv[k]; }
      red[ks * 32 + cc] = a;
      __syncthreads();
      if (tid < 32) { float sacc = 0.f;
#pragma unroll
        for (int q = 0; q < 16; ++q) sacc += red[q * 32 + cc];
        ((float*)(P(ws) + WS_SMALL))[64 + jk * 128 + nc * 32 + cc] = sacc; }
      __syncthreads();
    }
  }
  float* rope = (float*)(P(ws) + WS_ROPE);
  for (int m = bid_() * NTHR + tid; m < T; m += gdim_() * NTHR) {
    const float fp = (float)P(pos)[m];
    const float INV[8] = {1.0f, 0.1939227432012558f, 0.03760603070259094f, 0.007292664609849453f, 0.0014142135623842478f, 0.00027424818836152554f, 5.3182957344688475e-05f, 1.0313385246263351e-05f};
#pragma unroll
    for (int i = 0; i < 8; ++i) {
      const float ang = fp * INV[i];
      const double a = (double)ang; const double kq = rint(a * 0.63661977236758134308); const double r = a - kq * 1.57079632679489661923;
      const int q = (int)((long long)kq & 3ll);
      const double r2 = r * r;
      const double sr = r * (1.0 + r2 * (-1.0 / 6 + r2 * (1.0 / 120 + r2 * (-1.0 / 5040 + r2 * (1.0 / 362880 + r2 * (-1.0 / 39916800 + r2 * (1.0 / 6227020800.0)))))));
      const double cr = 1.0 + r2 * (-0.5 + r2 * (1.0 / 24 + r2 * (-1.0 / 720 + r2 * (1.0 / 40320 + r2 * (-1.0 / 3628800 + r2 * (1.0 / 479001600.0))))));
      const double sn = (q == 0) ? sr : (q == 1) ? cr : (q == 2) ? -sr : -cr;
      const double cs = (q == 0) ? cr : (q == 1) ? -sr : (q == 2) ? -cr : sr;
      rope[(size_t)m * 16 + i] = (float)cs; rope[(size_t)m * 16 + 8 + i] = (float)sn;
    }
  }
  if (bid_() == 0 && tid < 2) {
    const int j = tid; float s1 = 0.f, s2 = 0.f;
    for (int i = 0; i < 64; ++i) { s1 += P(diff_lq1)[j * 64 + i] * P(diff_lk1)[j * 64 + i]; s2 += P(diff_lq2)[j * 64 + i] * P(diff_lk2)[j * 64 + i]; }
    ((float*)(P(ws) + WS_SMALL))[j] = expf(s1) - expf(s2) + lam_init_of(j);
  }
}


__device__ __forceinline__ void transpose_item(const float* W, int K, int N, int Npad, bf16_t* WT, float* scr, int item, int lane) {
  const int nblk = Npad / 32, kb = item / nblk, nb = item % nblk, k0 = 64 * kb, n0 = 32 * nb;
  const int ncol = n0 + (lane & 31); const bool ok = ncol < N;
#pragma unroll 8
  for (int i = 0; i < 32; ++i) { const int kk = 2 * i + (lane >> 5); scr[kk * 33 + (lane & 31)] = ok ? W[(size_t)(k0 + kk) * N + ncol] : 0.f; }
  asm volatile("s_waitcnt lgkmcnt(0)" ::: "memory");
  const int c = lane & 7;
#pragma unroll
  for (int j = 0; j < 4; ++j) { const int n = (lane >> 3) + 8 * j; const float* sp = scr + (8 * c) * 33 + n;
    uint4 o; o.x = pk2(sp[0 * 33], sp[1 * 33]); o.y = pk2(sp[2 * 33], sp[3 * 33]); o.z = pk2(sp[4 * 33], sp[5 * 33]); o.w = pk2(sp[6 * 33], sp[7 * 33]);
    *(uint4*)(WT + (size_t)(n0 + n) * K + k0 + 8 * c) = o; }
  asm volatile("s_waitcnt lgkmcnt(0)" ::: "memory");
}
__device__ __forceinline__ void ph_weights(unsigned char* lds) {
  const int tid = tid_(), lane = tid & 63, wave = tid >> 6;
  float* scr = (float*)(lds + wave * 16384);
  const int gw = bid_() * 8 + wave, NGW = gdim_() * 8;
  for (int it = gw; it < 4 * 6144; it += NGW) {
    const int i = it / 6144; int r = it % 6144; const int j = i >> 1; const bool nsa = (i & 1) == 0;
    bf16_t* base = (bf16_t*)(P(ws) + WS_WT + (size_t)i * WT_LAYER);
    const int n_in = nsa ? 16 * (NSA_P / 32) : 16 * (DIFF_IN / 32);
    if (r < n_in) { if (nsa) transpose_item(P(nsa_w_in) + (size_t)j * D * NSA_IN, D, NSA_IN, NSA_P, base, scr, r, lane); else transpose_item(P(diff_w_in) + (size_t)j * D * DIFF_IN, D, DIFF_IN, DIFF_IN, base, scr, r, lane); continue; }
    r -= n_in;
    if (r < 512) { transpose_item((nsa ? P(nsa_w_out) : P(diff_w_out)) + (size_t)j * D * D, D, D, D, base + WT_OUT / 2, scr, r, lane); continue; }
    r -= 512;
    if (r < 2048) { transpose_item(P(w_mlp_in) + (size_t)i * D * DFF, D, DFF, DFF, base + WT_MI / 2, scr, r, lane); continue; }
    r -= 2048;
    if (r < 2048) transpose_item(P(w_mlp_out) + (size_t)i * DFF * D, DFF, D, D, base + WT_MO / 2, scr, r, lane);
  }
  for (int it = gw; it < 4 * 128; it += NGW) {
    const int jk = it >> 7, jj = jk >> 1, kv = jk & 1;
    transpose_item((kv ? P(nsa_w_cv1) : P(nsa_w_ck1)) + (size_t)jj * 2048 * 128, 2048, 128, 128, (bf16_t*)(P(ws) + WS_W1T) + (size_t)jk * 128 * 2048, scr, it & 127, lane);
  }
}
__device__ __forceinline__ void ph_cmp_bias(unsigned char* lds) {
  float* red = (float*)lds;
  const int tid = tid_(), n = tid & 127, ks = tid >> 7;
  for (int jk = bid_(); jk < 4; jk += gdim_()) {
    const int jj = jk >> 1, kv = jk & 1;
    const float* pe = (kv ? P(nsa_pe_v) : P(nsa_pe_k)) + jj * 2048; const float* w1 = (kv ? P(nsa_w_cv1) : P(nsa_w_ck1)) + (size_t)jj * 2048 * 128;
    float a = 0.f;
#pragma unroll 16
    for (int k = ks * 512; k < ks * 512 + 512; ++k) a += pe[k] * w1[(size_t)k * 128 + n];
    __syncthreads();
    red[ks * 128 + n] = a;
    __syncthreads();
    if (tid < 128) ((float*)(P(ws) + WS_SMALL))[64 + jk * 128 + tid] = red[tid] + red[128 + tid] + red[256 + tid] + red[384 + tid];
  }
}

__device__ __forceinline__ void ph_norm(const float* xin, const float* gvec, const float* mod  , int sh_off, int sc_off, bf16_t* H) {
  const int tid = tid_(), lane = tid & 63, wave = tid >> 6;
  for (int m = bid_() * 8 + wave; m < T; m += gdim_() * 8) {
    const int b = m >> 12;
    const float4* xr = (const float4*)(xin + (size_t)m * D) + lane;
    float4 v[4]; float ss = 0.f;
#pragma unroll
    for (int j = 0; j < 4; ++j) { v[j] = xr[64 * j]; ss += (v[j].x * v[j].x + v[j].y * v[j].y) + (v[j].z * v[j].z + v[j].w * v[j].w); }
    ss = wave_sum(ss);
    const float rstd = 1.0f / sqrtf(ss * (1.0f / D) + EPS);
#pragma unroll
    for (int j = 0; j < 4; ++j) {
      const int col = 4 * lane + 256 * j;
      const float4 g = *(const float4*)(gvec + col), sc = *(const float4*)(mod + (size_t)b * 6144 + sc_off + col), sh = *(const float4*)(mod + (size_t)b * 6144 + sh_off + col);
      const float h0 = v[j].x * rstd * g.x * (1.f + sc.x) + sh.x, h1 = v[j].y * rstd * g.y * (1.f + sc.y) + sh.y;
      const float h2 = v[j].z * rstd * g.z * (1.f + sc.z) + sh.z, h3 = v[j].w * rstd * g.w * (1.f + sc.w) + sh.w;
      uint2 o; o.x = pk2(h0, h1); o.y = pk2(h2, h3);
      *(uint2*)(H + (size_t)m * D + col) = o;
    }
  }
}

struct EpiStore { bf16_t* O; int ld; int relu2;
  __device__ __forceinline__ void operator()(int row, int col, const float* v) const {
    float a = v[0], b = v[1], c = v[2], d = v[3];
    if (relu2) { a = fmaxf(a, 0.f); a *= a; b = fmaxf(b, 0.f); b *= b; c = fmaxf(c, 0.f); c *= c; d = fmaxf(d, 0.f); d *= d; }
    uint2 o; o.x = pk2(a, b); o.y = pk2(c, d); *(uint2*)(O + (size_t)row * ld + col) = o; } };
struct EpiResid { const float* xin; float* xout; const float* gate;
  __device__ __forceinline__ void operator()(int row, int col, const float* v) const {
    const int b = row >> 12; const float4 g = *(const float4*)(gate + (size_t)b * 6144 + col); const float4 xi = *(const float4*)(xin + (size_t)row * D + col);
    float4 o; o.x = xi.x + g.x * v[0]; o.y = xi.y + g.y * v[1]; o.z = xi.z + g.z * v[2]; o.w = xi.w + g.w * v[3];
    *(float4*)(xout + (size_t)row * D + col) = o; } };

template <class Epi>
__device__ __forceinline__ void gemm_naive(const bf16_t* A, int lda, const float* W, int N, int K, unsigned char* lds, const Epi& E) {
  asm volatile("" : "+s"(N), "+s"(K), "+s"(lda));
  float* As = (float*)lds;
  float* Bs = As + 16 * 132;
  const int tid = tid_(), tx = tid & 31, ty = tid >> 5;
  const int nN = (N + 127) / 128, nM = T / 128;
  const int ar = tid >> 2, ak = (tid & 3) * 4, bk = tid >> 5, bc = (tid & 31) * 4;
  for (int u = bid_(); u < nM * nN; u += gdim_()) {
    const int pm = u / nN, pn = u % nN;
    float acc[8][4];
#pragma unroll
    for (int i = 0; i < 8; ++i) { acc[i][0] = 0.f; acc[i][1] = 0.f; acc[i][2] = 0.f; acc[i][3] = 0.f; }
    const bf16_t* Ap = A + (size_t)(pm * 128 + ar) * lda + ak;
    const int wcol = pn * 128 + bc; const bool bok = wcol < N;
    const float* Wp = W + (size_t)bk * N + (bok ? wcol : 0);
    for (int k0 = 0; k0 < K; k0 += 16) {
      const uint2 av = *(const uint2*)(Ap + k0);
      float4 bv = *(const float4*)(Wp + (size_t)k0 * N);
      if (!bok) bv = make_float4(0.f, 0.f, 0.f, 0.f);
      __syncthreads();
      As[(ak + 0) * 132 + ar] = bf2f(av.x & 0xffffu); As[(ak + 1) * 132 + ar] = bf2f(av.x >> 16);
      As[(ak + 2) * 132 + ar] = bf2f(av.y & 0xffffu); As[(ak + 3) * 132 + ar] = bf2f(av.y >> 16);
      *(float4*)(Bs + bk * 128 + bc) = bv;
      __syncthreads();
#pragma unroll
      for (int k = 0; k < 16; ++k) {
        const float4 a0 = *(const float4*)(As + k * 132 + ty * 8), a1 = *(const float4*)(As + k * 132 + ty * 8 + 4);
        const float4 b = *(const float4*)(Bs + k * 128 + tx * 4);
        const float a[8] = {a0.x, a0.y, a0.z, a0.w, a1.x, a1.y, a1.z, a1.w};
#pragma unroll
        for (int i = 0; i < 8; ++i) { acc[i][0] += a[i] * b.x; acc[i][1] += a[i] * b.y; acc[i][2] += a[i] * b.z; acc[i][3] += a[i] * b.w; }
      }
    }
    const int col = pn * 128 + tx * 4;
    if (col < N) {
#pragma unroll
      for (int i = 0; i < 8; ++i) E(pm * 128 + ty * 8 + i, col, acc[i]);
    }
  }
}

__device__ __forceinline__ void head_norm_rope(const float* v, const float* gain, const float* cs  , int sub, float* vn, float* vr) {
  float ss = 0.f;
#pragma unroll
  for (int i = 0; i < 8; ++i) ss += v[i] * v[i];
  ss += __shfl_xor(ss, 1); ss += __shfl_xor(ss, 2); ss += __shfl_xor(ss, 4);
  const float rstd = 1.0f / sqrtf(ss * (1.0f / 64.0f) + EPS);
#pragma unroll
  for (int i = 0; i < 8; ++i) vn[i] = v[i] * rstd * gain[sub * 8 + i];
#pragma unroll
  for (int i = 0; i < 8; ++i) {
    const float other = __shfl_xor(vn[i], 1);
    const float c = cs[i], s = cs[8 + i];
    float r = vn[i];
    if (sub == 0) r = vn[i] * c - other * s;
    else if (sub == 1) r = vn[i] * c + other * s;
    vr[i] = r;
  }
}

__device__ __forceinline__ void ph_post_diff(int j, bf16_t* PROJ) {
  const int tid = tid_(), lane = tid & 63, wave = tid >> 6, sub = lane & 7;
  const float* rope = (const float*)(P(ws) + WS_ROPE);
  for (int m = bid_() * 8 + wave; m < T; m += gdim_() * 8) {
    const float* cs = rope + (size_t)m * 16;
#pragma unroll
    for (int it = 0; it < 4; ++it) {
      bf16_t* ptr = PROJ + (size_t)m * DIFF_IN + it * 512 + lane * 8;
      float v[8], vn[8], vr[8]; unpack8(*(const uint4*)ptr, v);
      const float* gain = (it < 2) ? (P(diff_q_gain) + j * 64) : (P(diff_k_gain) + j * 64);
      head_norm_rope(v, gain, cs, sub, vn, vr);
      const float sc = (it < 2) ? C2 : 1.0f;
#pragma unroll
      for (int i = 0; i < 8; ++i) vr[i] *= sc;
      *(uint4*)ptr = pack8(vr);
    }
  }
}
__device__ __forceinline__ void ph_post_nsa(int j, bf16_t* PROJ, bf16_t* QC) {
  const int tid = tid_(), lane = tid & 63, wave = tid >> 6, sub = lane & 7;
  const float* rope = (const float*)(P(ws) + WS_ROPE);
  for (int m = bid_() * 8 + wave; m < T; m += gdim_() * 8) {
    const float* cs = rope + (size_t)m * 16;
#pragma unroll
    for (int it = 0; it < 2; ++it) {
      bf16_t* ptr = PROJ + (size_t)m * NSA_P + it * 512 + lane * 8;
      float v[8], vn[8], vr[8]; unpack8(*(const uint4*)ptr, v);
      head_norm_rope(v, P(nsa_q_gain) + j * 64, cs, sub, vn, vr);
#pragma unroll
      for (int i = 0; i < 8; ++i) { vr[i] *= C2; vn[i] *= C2; }
      *(uint4*)ptr = pack8(vr);
      *(uint4*)(QC + (size_t)m * D + it * 512 + lane * 8) = pack8(vn);
    }
    {
      const int hi = lane >> 5;
      bf16_t* ptr = PROJ + (size_t)m * NSA_P + (hi ? 2048 : 1536) + (lane & 31) * 8;
      float v[8], vn[8], vr[8]; unpack8(*(const uint4*)ptr, v);
      head_norm_rope(v, P(nsa_k_gain) + j * 192 + (hi ? 128 : 64), cs, sub, vn, vr);
      *(uint4*)ptr = pack8(vr);
    }
  }
}

template <int DV, int MODE>
__device__ __forceinline__ void attn_naive_unit(int b, int qc, const bf16_t* Qp, int ldq, const bf16_t* Kp, const bf16_t* Vp, int ldkv, bf16_t* Op, int ldo, const u64* selmask, unsigned char* lds) {
  constexpr int DVS = DV / 8;
  float* Ks = (float*)lds;
  float* Vs = Ks + 64 * 64;
  const int tid = tid_(), qi = tid & 63, sl = tid >> 6;
  const int qabs = qc * 64 + qi;
  const size_t rowq = (size_t)b * S + qabs;
  float q[64];
#pragma unroll
  for (int i = 0; i < 8; ++i) unpack8(*(const uint4*)(Qp + rowq * ldq + i * 8), q + i * 8);
  float m = -INFINITY, l = 0.f, o[DVS];
#pragma unroll
  for (int i = 0; i < DVS; ++i) o[i] = 0.f;
  u64 msk = 0ull; if (MODE == 1) msk = selmask[qabs];
  const int t_lo = (MODE == 2) ? (qc > 8 ? qc - 8 : 0) : 0;
  for (int tt = t_lo; tt <= qc; ++tt) {
    __syncthreads();
    { const int key = tid >> 3, ch = tid & 7; float f[8];
      unpack8(*(const uint4*)(Kp + ((size_t)b * S + tt * 64 + key) * ldkv + ch * 8), f);
#pragma unroll
      for (int i = 0; i < 8; ++i) Ks[key * 64 + ch * 8 + i] = f[i];
#pragma unroll
      for (int r = 0; r < DV / 64; ++r) {
        unpack8(*(const uint4*)(Vp + ((size_t)b * S + tt * 64 + key) * ldkv + r * 64 + ch * 8), f);
#pragma unroll
        for (int i = 0; i < 8; ++i) Vs[key * DV + r * 64 + ch * 8 + i] = f[i];
      } }
    __syncthreads();
    const bool tile_on = (MODE == 1) ? (((msk >> tt) & 1ull) != 0ull) : true;
    if (tile_on) {
      for (int jk = 0; jk < 64; ++jk) {
        const int key = tt * 64 + jk;
        bool valid = key <= qabs; if (MODE == 2) valid = valid && (key > qabs - 512);
        if (valid) {
          float s = 0.f;
#pragma unroll
          for (int d = 0; d < 64; d += 4) { const float4 kk = *(const float4*)(Ks + jk * 64 + d); s += q[d] * kk.x + q[d + 1] * kk.y + q[d + 2] * kk.z + q[d + 3] * kk.w; }
          const float mn = fmaxf(m, s); const float sc = exp2f(m - mn), pp = exp2f(s - mn);
          l = l * sc + pp;
#pragma unroll
          for (int i = 0; i < DVS; ++i) o[i] = o[i] * sc + pp * Vs[jk * DV + sl * DVS + i];
          m = mn;
        }
      }
    }
  }
  const float inv = l > 0.f ? 1.0f / l : 0.f;
  bf16_t* op = Op + rowq * ldo + sl * DVS;
  if (DVS == 8) { float r[8];
#pragma unroll
    for (int i = 0; i < 8; ++i) r[i] = o[i] * inv;
    *(uint4*)op = pack8(r);
  } else {
#pragma unroll
    for (int h2 = 0; h2 < DVS / 8; ++h2) { float r[8];
#pragma unroll
      for (int i = 0; i < 8; ++i) r[i] = o[h2 * 8 + i] * inv;
      *(uint4*)(op + h2 * 8) = pack8(r); }
  }
}

__device__ __forceinline__ void ph_attn_diff(unsigned char* lds) {
  const bf16_t* PROJ = (const bf16_t*)(P(ws) + WS_PROJ); bf16_t* ATT = (bf16_t*)(P(ws) + WS_ATT);
  const int NU = NB * 64 * 16;
  for (int u = bid_(); u < NU; u += gdim_()) {
    const int vh = u & 15, qc = 63 - ((u >> 4) & 63), b = u >> 10;
    const int h8 = vh >> 1, c = vh & 1;
    attn_naive_unit<128, 0>(b, qc, PROJ + vh * 64, DIFF_IN, PROJ + 1024 + vh * 64, PROJ + 2048 + h8 * 128, DIFF_IN, ATT + c * 1024 + h8 * 128, 2048, nullptr, lds);
  }
}
__device__ __forceinline__ void ph_attn_sel(unsigned char* lds) {
  const bf16_t* PROJ = (const bf16_t*)(P(ws) + WS_PROJ); bf16_t* OSEL = (bf16_t*)(P(ws) + WS_ATT + 32 * MiB);
  const u64* SEL = (const u64*)(P(ws) + WS_SEL);
  const int NU = NB * 64 * 16;
  for (int u = bid_(); u < NU; u += gdim_()) {
    const int hd = u & 15, qc = 63 - ((u >> 4) & 63), b = u >> 10, g = hd >> 2;
    attn_naive_unit<64, 1>(b, qc, PROJ + hd * 64, NSA_P, PROJ + 1536 + g * 64, PROJ + 1792 + g * 64, NSA_P, OSEL + hd * 64, D, SEL + (size_t)(b * 4 + g) * S, lds);
  }
}
__device__ __forceinline__ void ph_attn_win(unsigned char* lds) {
  const bf16_t* PROJ = (const bf16_t*)(P(ws) + WS_PROJ); bf16_t* OWIN = (bf16_t*)(P(ws) + WS_ATT + 64 * MiB);
  const int NU = NB * 64 * 16;
  for (int u = bid_(); u < NU; u += gdim_()) {
    const int hd = u & 15, qc = (u >> 4) & 63, b = u >> 10, g = hd >> 2;
    attn_naive_unit<64, 2>(b, qc, PROJ + hd * 64, NSA_P, PROJ + 2048 + g * 64, PROJ + 2304 + g * 64, NSA_P, OWIN + hd * 64, D, nullptr, lds);
  }
}

__device__ __forceinline__ void ph_compress(int j, unsigned char* lds) {
  typedef short bf16x8_t __attribute__((ext_vector_type(8))); typedef float f32x16_t __attribute__((ext_vector_type(16)));
  const bf16_t* PROJ = (const bf16_t*)(P(ws) + WS_PROJ);
  unsigned char* Xb = lds;
  float* part = (float*)(lds + 67584);
  float* hid = part + 2 * 32 * 128;
  const int tid = tid_(), lane = tid & 63, wave = tid >> 6, r = lane & 31, h = lane >> 5, nb = wave & 3, kh = wave >> 2;
  for (int it = bid_(); it < 256; it += gdim_()) {
    const int rt = it & 7, kv = (it >> 3) & 1, bg = it >> 4, b = bg >> 2, g = bg & 3;
    const bf16_t* W1T = (const bf16_t*)(P(ws) + WS_W1T) + (size_t)(j * 2 + kv) * 128 * 2048;
    const float* w2 = (kv ? P(nsa_w_cv2) : P(nsa_w_ck2)) + (size_t)j * 128 * 64;
    const int colbase = (kv ? 1280 : 1024) + g * 64;
    __syncthreads();
    for (int i = tid; i < 528 * 8; i += NTHR) { const int tk = i >> 3, ch = i & 7, tok = 512 * rt + tk;
      uint4 v = make_uint4(0u, 0u, 0u, 0u); if (tok < S) v = *(const uint4*)(PROJ + ((size_t)b * S + tok) * NSA_P + colbase + ch * 8);
      *(uint4*)(Xb + tk * 128 + ((ch ^ ((tk >> 4) & 7)) * 16)) = v; }
    __syncthreads();
    f32x16_t acc;
#pragma unroll
    for (int q = 0; q < 16; ++q) acc[q] = 0.f;
    const bf16_t* wrow = W1T + (size_t)(nb * 32 + r) * 2048 + 8 * h;
#pragma unroll 2
    for (int l = 16 * kh; l < 16 * kh + 16; ++l) {
      const int tk = 16 * r + l; const unsigned char* xr = Xb + tk * 128; const int sw = (tk >> 4) & 7;
#pragma unroll
      for (int dq = 0; dq < 4; ++dq) {
        const bf16x8_t av = *(const bf16x8_t*)(xr + (((2 * dq + h) ^ sw) * 16));
        const bf16x8_t bv = *(const bf16x8_t*)(wrow + l * 64 + 16 * dq);
        acc = __builtin_amdgcn_mfma_f32_32x32x16_bf16(av, bv, acc, 0, 0, 0);
      }
    }
#pragma unroll
    for (int q = 0; q < 16; ++q) part[(kh * 32 + ((q & 3) + 8 * (q >> 2) + 4 * h)) * 128 + nb * 32 + r] = acc[q];
    __syncthreads();
    const float* CB = (const float*)(P(ws) + WS_SMALL) + 64 + (j * 2 + kv) * 128;
    for (int i = tid; i < 32 * 128; i += NTHR) { const float hs = part[i] + part[4096 + i] + CB[i & 127]; hid[i] = hs / (1.f + expf(-hs)); }
    __syncthreads();
    { const int e = tid & 63, rq = tid >> 6; float o0 = 0.f, o1 = 0.f, o2 = 0.f, o3 = 0.f;
      for (int hh = 0; hh < 128; ++hh) { const float wv = w2[hh * 64 + e];
        o0 += hid[(rq * 4 + 0) * 128 + hh] * wv; o1 += hid[(rq * 4 + 1) * 128 + hh] * wv; o2 += hid[(rq * 4 + 2) * 128 + hh] * wv; o3 += hid[(rq * 4 + 3) * 128 + hh] * wv; }
      float ov[4] = {o0, o1, o2, o3};
      bf16_t* KC = (bf16_t*)(P(ws) + WS_KCMP);
      bf16_t* VT = (bf16_t*)(P(ws) + WS_VCMP);
#pragma unroll
      for (int rr = 0; rr < 4; ++rr) { const int c = 32 * rt + rq * 4 + rr; float v = ov[rr];
        if (kv == 0) { const float ss = wave_sum(v * v); v = v * (1.0f / sqrtf(ss * (1.0f / 64.0f) + EPS)) * P(nsa_k_gain)[j * 192 + e]; }
        if (c >= 255) v = 0.f;
        if (kv == 0) KC[((size_t)bg * 256 + c) * 64 + e] = (bf16_t)f2bf(v); else VT[((size_t)bg * 64 + e) * 256 + c] = (bf16_t)f2bf(v); }
    }
  }
}

__device__ __forceinline__ void ph_cmp_attn(unsigned char* lds) {
  typedef short bf16x8_t __attribute__((ext_vector_type(8))); typedef float f32x16_t __attribute__((ext_vector_type(16)));
  unsigned char* Kimg = lds;
  unsigned char* VTl = lds + 32768;
  float* IMP = (float*)(lds + 32768 + 33280);
  const bf16_t* QC = (const bf16_t*)(P(ws) + WS_OC);
  const bf16_t* KC = (const bf16_t*)(P(ws) + WS_KCMP); const bf16_t* VT = (const bf16_t*)(P(ws) + WS_VCMP);
  bf16_t* OCMP = (bf16_t*)(P(ws) + WS_ATT);
  u64* SEL = (u64*)(P(ws) + WS_SEL);
  const int tid = tid_(), lane = tid & 63, wave = tid >> 6, r32 = lane & 31, hi = lane >> 5, hh = r32 >> 3, q8 = r32 & 7;
  const int G = gdim_(), bx = bid_(); const int v0 = (G % 8 == 0) ? (bx % 8) * (G / 8) + bx / 8 : bx;
  for (int vcu = v0; vcu < 256; vcu += G) {
    const int bg = vcu >> 4, b = bg >> 2, g = bg & 3;
    __syncthreads();
    for (int i = tid; i < 2048; i += NTHR) { const int c = i >> 3, ch = i & 7; *(uint4*)(Kimg + ch * 4096 + c * 16) = *(const uint4*)(KC + ((size_t)bg * 256 + c) * 64 + ch * 8); }
    for (int i = tid; i < 4096; i += NTHR) { const int d = i >> 6, c8 = i & 63; *(uint2*)(VTl + d * 520 + c8 * 8) = *(const uint2*)(VT + ((size_t)bg * 64 + d) * 256 + c8 * 4); }
    __syncthreads();
    float* imw = IMP + wave * 8 * 65;
    bf16_t* stg = (bf16_t*)(lds + 83968) + wave * 2048;
#pragma unroll 1
    for (int ui = 0; ui < 4; ++ui) {
      const int qc = (vcu & 15) + 16 * ui, t0 = qc * 64, tq0 = t0 + 8 * wave;
      const int t = tq0 + q8;
      for (int i = lane; i < 8 * 65; i += 64) imw[i] = 0.f;
      bf16x8_t qr[4];
      { const bf16_t* qp = QC + ((size_t)b * S + t) * D + (g * 4 + hh) * 64 + hi * 8;
#pragma unroll
        for (int d0 = 0; d0 < 4; ++d0) qr[d0] = *(const bf16x8_t*)(qp + d0 * 16); }
      const int nc = (tq0 + 7 >= 31) ? (((tq0 + 7 - 31) >> 4) + 1) : 0; const int nct = (nc + 31) >> 5;
      int climit = (t - 31) >> 4; if (climit > 254) climit = 254;
      const int cfull = (tq0 - 31) >> 4;
#define CMP_TILE(PACC, ct) do { \
        _Pragma("unroll") for (int q = 0; q < 16; ++q) PACC[q] = 0.f; \
        _Pragma("unroll") for (int d0 = 0; d0 < 4; ++d0) { const bf16x8_t kf = *(const bf16x8_t*)(Kimg + (2 * d0 + hi) * 4096 + (32 * (ct) + r32) * 16); PACC = __builtin_amdgcn_mfma_f32_32x32x16_bf16(kf, qr[d0], PACC, 0, 0, 0); } \
        if (32 * (ct) + 31 > cfull) { const int rel = climit - 32 * (ct) - 4 * hi; \
          _Pragma("unroll") for (int q = 0; q < 16; ++q) PACC[q] = (((q & 3) + 8 * (q >> 2)) <= rel) ? PACC[q] : -INFINITY; } } while (0)
      float mx = -INFINITY, sum = 0.f;
#pragma unroll 1
      for (int ct = 0; ct < nct; ++ct) { f32x16_t pacc; CMP_TILE(pacc, ct);
        float tm = pacc[0];
#pragma unroll
        for (int q = 1; q < 16; ++q) tm = fmaxf(tm, pacc[q]);
        const float mn = fmaxf(mx, tm), mns = (mn == -INFINITY) ? 0.f : mn;
        float ts = 0.f;
#pragma unroll
        for (int q = 0; q < 16; ++q) ts += __builtin_amdgcn_exp2f(pacc[q] - mns);
        sum = sum * __builtin_amdgcn_exp2f(mx - mns) + ts; mx = mn; }
      { const float mo = __shfl_xor(mx, 32), so = __shfl_xor(sum, 32); const float M = fmaxf(mx, mo), Ms = (M == -INFINITY) ? 0.f : M;
        sum = sum * __builtin_amdgcn_exp2f(mx - Ms) + so * __builtin_amdgcn_exp2f(mo - Ms); mx = Ms; }
      const float ms = mx;
      const float inv = sum > 0.f ? 1.0f / sum : 0.f;
      f32x16_t o0, o1;
#pragma unroll
      for (int q = 0; q < 16; ++q) { o0[q] = 0.f; o1[q] = 0.f; }
      float carry = 0.f;
#pragma unroll 1
      for (int ct = 0; ct < nct; ++ct) {
        f32x16_t pr; CMP_TILE(pr, ct);
#pragma unroll
        for (int q = 0; q < 16; ++q) pr[q] = __builtin_amdgcn_exp2f(pr[q] - ms) * inv;
        float qs[4], recv[4];
#pragma unroll
        for (int g4 = 0; g4 < 4; ++g4) { float a = (pr[4 * g4] + pr[4 * g4 + 1]) + (pr[4 * g4 + 2] + pr[4 * g4 + 3]), l3 = pr[4 * g4 + 3];
          a += __shfl_xor(a, 8); l3 += __shfl_xor(l3, 8); a += __shfl_xor(a, 16); l3 += __shfl_xor(l3, 16);
          qs[g4] = a; recv[g4] = __shfl_xor(l3, 32); }
        if (hh == 0) {
#pragma unroll
          for (int g4 = 0; g4 < 4; ++g4) { const float nb = hi ? recv[g4] : (g4 ? recv[g4 - 1] : carry); imw[q8 * 65 + 8 * ct + 2 * g4 + hi] = qs[g4] + nb; } }
        carry = recv[3];
#pragma unroll
        for (int s2 = 0; s2 < 2; ++s2) {
          uint4 pw; pw.x = pg8::cvt_pk_bf16(pr[8 * s2 + 0], pr[8 * s2 + 1]); pw.y = pg8::cvt_pk_bf16(pr[8 * s2 + 2], pr[8 * s2 + 3]);
          pw.z = pg8::cvt_pk_bf16(pr[8 * s2 + 4], pr[8 * s2 + 5]); pw.w = pg8::cvt_pk_bf16(pr[8 * s2 + 6], pr[8 * s2 + 7]);
          const bf16x8_t pa = __builtin_bit_cast(bf16x8_t, pw);
          const int cb = (32 * ct + 16 * s2 + 4 * hi) * 2;
          { const uint2 lo = *(const uint2*)(VTl + r32 * 520 + cb), hi2 = *(const uint2*)(VTl + r32 * 520 + cb + 16);
            uint4 vv; vv.x = lo.x; vv.y = lo.y; vv.z = hi2.x; vv.w = hi2.y; o0 = __builtin_amdgcn_mfma_f32_32x32x16_bf16(pa, __builtin_bit_cast(bf16x8_t, vv), o0, 0, 0, 0); }
          { const uint2 lo = *(const uint2*)(VTl + (32 + r32) * 520 + cb), hi2 = *(const uint2*)(VTl + (32 + r32) * 520 + cb + 16);
            uint4 vv; vv.x = lo.x; vv.y = lo.y; vv.z = hi2.x; vv.w = hi2.y; o1 = __builtin_amdgcn_mfma_f32_32x32x16_bf16(pa, __builtin_bit_cast(bf16x8_t, vv), o1, 0, 0, 0); }
        }
      }
#undef CMP_TILE
      if (hh == 0 && hi == 0 && nct > 0 && nct < 8) imw[q8 * 65 + 8 * nct] = carry;
      {
#pragma unroll
        for (int q = 0; q < 16; ++q) { const int row = (q & 3) + 8 * (q >> 2) + 4 * hi; stg[row * 64 + r32] = (bf16_t)f2bf(o0[q]); stg[row * 64 + 32 + r32] = (bf16_t)f2bf(o1[q]); }
        asm volatile("s_waitcnt lgkmcnt(0)" ::: "memory");
#pragma unroll
        for (int i = 0; i < 4; ++i) { const int row = i * 8 + (lane >> 3), ch = lane & 7;
          *(uint4*)(OCMP + ((size_t)b * S + tq0 + (row & 7)) * D + (g * 4 + (row >> 3)) * 64 + ch * 8) = *(const uint4*)(stg + row * 64 + ch * 8); }
      }
      asm volatile("s_waitcnt lgkmcnt(0)" ::: "memory");
#pragma unroll 1
      for (int k8 = 0; k8 < 8; ++k8) {
        const int tq = tq0 + k8, bt = tq >> 6, sb = lane;
        const float v = imw[k8 * 65 + sb];
        const bool forced = (sb == 0) || (sb == bt) || (sb == bt - 1), valid = sb <= bt;
        const float vv = forced ? (1e6f + (float)(64 - sb)) : (valid ? v : (-1.0f - (float)sb));
        const unsigned bits = __float_as_uint(vv); const unsigned key = (bits & 0x80000000u) ? ~bits : (bits | 0x80000000u);
        unsigned prefix = 0u;
#pragma unroll 1
        for (int bit = 31; bit >= 0; --bit) { const unsigned cand = prefix | (1u << bit); const int cnt = __popcll(__ballot(key >= cand)); if (cnt >= 16) prefix = cand; }
        const u64 gt = __ballot(key > prefix); u64 eq = __ballot(key == prefix);
        int need = 16 - __popcll(gt); u64 m = gt;
        while (need > 0 && eq != 0ull) { const u64 low = eq & (0ull - eq); m |= low; eq ^= low; --need; }
        if (lane == 0) SEL[(size_t)bg * S + tq] = m;
      }
      asm volatile("s_waitcnt lgkmcnt(0)" ::: "memory");
    }
  }
}

__device__ __forceinline__ void ph_combine_nsa(int j) {
  const bf16_t* PROJ = (const bf16_t*)(P(ws) + WS_PROJ);
  const bf16_t* OCMP = (const bf16_t*)(P(ws) + WS_ATT); const bf16_t* OSEL = OCMP + (size_t)T * D; const bf16_t* OWIN = OSEL + (size_t)T * D;
  bf16_t* OC = (bf16_t*)(P(ws) + WS_OC);
  for (size_t i = (size_t)bid_() * NTHR + tid_(); i < (size_t)T * 128; i += (size_t)gdim_() * NTHR) {
    const size_t m = i >> 7; const int cg8 = (int)(i & 127), hd = cg8 >> 3;
    float gt[3];
#pragma unroll
    for (int r = 0; r < 3; ++r) { const float gl = bf2f(PROJ[m * NSA_P + 2560 + hd * 3 + r]) + P(nsa_b_gate)[j * 48 + hd * 3 + r]; gt[r] = 1.0f / (1.0f + expf(-gl)); }
    float a[8], bb[8], cc[8], o[8];
    unpack8(*(const uint4*)(OCMP + m * D + cg8 * 8), a); unpack8(*(const uint4*)(OSEL + m * D + cg8 * 8), bb); unpack8(*(const uint4*)(OWIN + m * D + cg8 * 8), cc);
#pragma unroll
    for (int k = 0; k < 8; ++k) o[k] = gt[0] * a[k] + gt[1] * bb[k] + gt[2] * cc[k];
    *(uint4*)(OC + m * D + cg8 * 8) = pack8(o);
  }
}
__device__ __forceinline__ void ph_combine_diff(int j) {
  const bf16_t* ATT = (const bf16_t*)(P(ws) + WS_ATT); bf16_t* OC = (bf16_t*)(P(ws) + WS_OC);
  const float lam = ((const float*)(P(ws) + WS_SMALL))[j]; const float osc = 1.0f - lam_init_of(j);
  const int tid = tid_(), lane = tid & 63, wave = tid >> 6;
  for (int m = bid_() * 8 + wave; m < T; m += gdim_() * 8) {
#pragma unroll
    for (int it = 0; it < 2; ++it) {
      const int col = it * 512 + lane * 8;
      float a[8], b2[8], o[8]; unpack8(*(const uint4*)(ATT + (size_t)m * 2048 + col), a); unpack8(*(const uint4*)(ATT + (size_t)m * 2048 + 1024 + col), b2);
      float ss = 0.f;
#pragma unroll
      for (int k = 0; k < 8; ++k) { o[k] = a[k] - lam * b2[k]; ss += o[k] * o[k]; }
      ss += __shfl_xor(ss, 1); ss += __shfl_xor(ss, 2); ss += __shfl_xor(ss, 4); ss += __shfl_xor(ss, 8);
      const float rstd = 1.0f / sqrtf(ss * (1.0f / 128.0f) + EPS);
#pragma unroll
      for (int k = 0; k < 8; ++k) o[k] = o[k] * rstd * P(diff_subln_g)[j * 128 + (col & 127) + k] * osc;
      *(uint4*)(OC + (size_t)m * D + col) = pack8(o);
    }
  }
}

constexpr int N_PHASES = 1 + 4 * 10;
template <int PH> __device__ __forceinline__ bool phase_body(unsigned char* lds) {
  bool did = true;
  if constexpr (PH == 0) { ph_prologue(lds); __syncthreads(); ph_weights(lds); }
  else {
    constexpr int i = (PH - 1) / 10, lp = (PH - 1) % 10, j = i >> 1; constexpr bool nsa = (i & 1) == 0;
    float* MOD = (float*)(P(ws) + WS_MOD);
    bf16_t* H = (bf16_t*)(P(ws) + WS_H); bf16_t* PROJ = (bf16_t*)(P(ws) + WS_PROJ); bf16_t* OC = (bf16_t*)(P(ws) + WS_OC); bf16_t* HID = (bf16_t*)(P(ws) + WS_HID);
    const float* mod = MOD + (size_t)i * 4 * 6144;
    const float* xcur = (i == 0 && lp < 7) ? P(x) : P(out);
    if constexpr (lp == 0) ph_norm(xcur, P(ln_mix_g) + i * D, mod, 0, 1024, H);
    const bf16_t* WTL = (const bf16_t*)(P(ws) + WS_WT + (size_t)i * WT_LAYER);
    PG8_LAS unsigned char* l3 = (PG8_LAS unsigned char*)lds;
    if constexpr (lp == 1) {
      constexpr int N = nsa ? NSA_P : DIFF_IN;
      pg8::Gemm g{H, WTL, T, N, D}; pg8::StaticOrder S; S.init(T, N, gdim_(), bid_());
      pg8::EpiBf16<0> E{PROJ, N};
      pg8::gemm_phase<pg8::EpiBf16<0>, pg8::StaticOrder, true, true>(l3, g, S, E);
    }
    if constexpr (lp == 2) { if constexpr (nsa) { ph_post_nsa(j, PROJ, OC); ph_compress(j, lds); } else ph_post_diff(j, PROJ); }
    if constexpr (lp == 3) { if constexpr (nsa) { ph_cmp_attn(lds); if (REPEAT_SUB == 1) { __syncthreads(); ph_cmp_attn(lds); } __syncthreads(); ph_attn_win_fast(lds); if (REPEAT_SUB == 2) ph_attn_win_fast(lds); } else ph_attn_diff_fast(j, lds); }
    if constexpr (lp == 4) { if constexpr (nsa) ph_attn_sel_fast(j, lds); else did = false; }
    if constexpr (lp == 5) did = false;
    if constexpr (lp == 6) {
      pg8::Gemm g{OC, WTL + WT_OUT / 2, T, D, D}; pg8::StaticOrder S; S.init(T, D, gdim_(), bid_());
      pg8::EpiResid E{xcur, P(out), mod + 2048};
      pg8::gemm_phase<pg8::EpiResid, pg8::StaticOrder, true, true>(l3, g, S, E);
    }
    if constexpr (lp == 7) ph_norm(P(out), P(ln_mlp_g) + i * D, mod, 3072, 4096, H);
    if constexpr (lp == 8) {
      pg8::Gemm g{H, WTL + WT_MI / 2, T, DFF, D}; pg8::StaticOrder S; S.init(T, DFF, gdim_(), bid_());
      pg8::EpiBf16<2> E{HID, DFF};
      pg8::gemm_phase<pg8::EpiBf16<2>, pg8::StaticOrder, true, true>(l3, g, S, E);
    }
    if constexpr (lp == 9) {
      pg8::Gemm g{HID, WTL + WT_MO / 2, T, D, DFF}; pg8::StaticOrder S; S.init(T, D, gdim_(), bid_());
      pg8::EpiResid E{P(out), P(out), mod + 5120};
      pg8::gemm_phase<pg8::EpiResid, pg8::StaticOrder, true, true>(l3, g, S, E);
    }
  }
  return did;
}
template <int PH> __device__ __forceinline__ void run_phase(unsigned char* lds, int lo, int hi, const XcdBarrier& bar) {
  if (PH < lo || PH >= hi) return;
  const bool did = phase_body<PH>(lds);
  if constexpr (((REPEAT_MASK >> PH) & 1ull) != 0ull) { if (did) { if (PH == 0) cg::this_grid().sync(); else xcd_barrier(bar); phase_body<PH>(lds); } }
  if (did && PH + 1 < hi) { if (PH == 0) cg::this_grid().sync(); else xcd_barrier(bar); }
}
template <int... I> __device__ __forceinline__ void run_all(std::integer_sequence<int, I...>, unsigned char* lds, int lo, int hi, const XcdBarrier& bar) { (run_phase<I>(lds, lo, hi, bar), ...); }
__global__ void __launch_bounds__(NTHR) fwd_kernel(Params p) {
  extern __shared__ __attribute__((aligned(16))) unsigned char lds[];
  volatile __attribute__((address_space(3))) unsigned* misc = (volatile __attribute__((address_space(3))) unsigned*)((__attribute__((address_space(3))) unsigned char*)lds + MISC_OFF);
  if (tid_() < 16) misc[tid_()] = 0u;
  __syncthreads();
  const XcdBarrier bar = xcd_barrier_post((unsigned*)(P(ws) + WS_CTL) + CW_BAR, misc);
  run_all(std::make_integer_sequence<int, N_PHASES>{}, lds, p.ph_lo, p.ph_hi, bar);
}

extern "C" void kernel_launch(void* const* d_in, const int* in_sizes, int n_in, void* d_out, int out_size, void* d_ws, size_t ws_size, hipStream_t stream) {
  static int grid = 0;
  if (grid == 0) {
    if (n_in != 29 || out_size != T * D || ws_size < WS_END) { fprintf(stderr, "kernel_launch: unexpected problem (n_in %d, out %d, ws %zu)\n", n_in, out_size, ws_size); grid = -1; return; }
    int dev = 0, cus = 0, per_cu = 0;
    hipGetDevice(&dev); hipDeviceGetAttribute(&cus, hipDeviceAttributeMultiprocessorCount, dev);
    hipFuncSetAttribute((const void*)fwd_kernel, hipFuncAttributeMaxDynamicSharedMemorySize, LDS_BYTES);
    hipOccupancyMaxActiveBlocksPerMultiprocessor(&per_cu, (const void*)fwd_kernel, NTHR, LDS_BYTES);
    if (per_cu < 1) { fprintf(stderr, "kernel_launch: occupancy query says %d blocks/CU\n", per_cu); per_cu = 1; }
    grid = cus * 1;
    (void)hipGetLastError();
  }
  if (grid < 0) return;
  if (hipMemsetAsync((char*)d_ws + WS_CTL, 0, CTL_ZERO_BYTES, stream) != hipSuccess) { fprintf(stderr, "kernel_launch: memset failed\n"); return; }
  Params p{};
  memcpy((void*)&p, (const void*)d_in, 29 * sizeof(void*));
  p.out = (float*)d_out; p.ws = (unsigned char*)d_ws; p.ph_lo = 0; p.ph_hi = N_PHASES;
  void* args[] = {&p};
  hipError_t e = hipLaunchCooperativeKernel((const void*)fwd_kernel, dim3(grid), dim3(NTHR), args, LDS_BYTES, stream);
  if (e != hipSuccess) fprintf(stderr, "cooperative launch failed: %s (grid %d)\n", hipGetErrorString(e), grid);
}
```
